# Optimizing an MI355X kernel written in HIP

```python
import functools
import jax, jax.numpy as jnp
from jax import lax
import numpy as np

D_MODEL = 1024
BATCH = 8
SEQ = 4096
DEPTH = 1
DEC_BATCH = 32
DEC_SEQ = 4
PAST_LEN = 16384
PAGE_SIZE = 128

HEAD_DIM = 64
N_HEADS_A = 8
N_HEADS_B = 8
C_A = N_HEADS_A * HEAD_DIM
C_B = N_HEADS_B * HEAD_DIM
DILATIONS = ((128, 1), (512, 4), (2048, 16))
WINDOW_MAX = 2048
Q_BLOCK = 128
D_W_LORA = 64
D_A_LORA = 64
D_G_LORA = 128
D_B_IN = 3 * C_B + D_W_LORA + D_A_LORA + D_G_LORA
D_IN = 3 * C_A + D_B_IN
D_FF = ((8 * D_MODEL + 3 * 256 - 1) // (3 * 256)) * 256
PLE_DIM = 256
ALPHA = (2 * DEPTH) ** 0.25
BETA = (8 * DEPTH) ** -0.25
LN_EPS = 1e-5
GN_EPS = 64e-5

kernel_name = "hymba_longnet_rwkv7_decoder_step"


def layer_norm(x, w, b):
    xf = x.astype(jnp.float32)
    mu = jnp.mean(xf, axis=-1, keepdims=True)
    var = jnp.mean(jnp.square(xf - mu), axis=-1, keepdims=True)
    return ((xf - mu) * lax.rsqrt(var + LN_EPS) * w + b).astype(x.dtype)


def alibi_slopes():
    h = jnp.arange(1, N_HEADS_A + 1, dtype=jnp.float32)
    return jnp.exp2(-8.0 * h / N_HEADS_A)


def dilated_attn_prompt(q, k, v, window, dil):
    B, T, H, Dh = q.shape
    span = window // dil
    M = T // dil
    nb = -(-M // Q_BLOCK)
    Mp = nb * Q_BLOCK

    def to_blocks(a):
        a = a.astype(jnp.float32).reshape(B, M, dil, H, Dh).transpose(0, 2, 1, 3, 4)
        a = jnp.pad(a, ((0, 0), (0, 0), (0, Mp - M), (0, 0), (0, 0)))
        return a.reshape(B, dil, nb, Q_BLOCK, H, Dh)

    def with_prev(a):
        prev = jnp.pad(a, ((0, 0), (0, 0), (1, 0), (0, 0), (0, 0), (0, 0)))[:, :, :-1]
        return jnp.concatenate([prev, a], axis=3)

    qb = to_blocks(q) * (HEAD_DIM ** -0.5)
    kb = with_prev(to_blocks(k))
    vb = with_prev(to_blocks(v))
    qi = jnp.arange(Q_BLOCK)[:, None]
    ki = jnp.arange(2 * Q_BLOCK)[None, :]
    dist = Q_BLOCK + qi - ki
    band = (dist >= 0) & (dist <= span)
    exists = (jnp.arange(nb)[:, None, None] > 0) | (ki[None] >= Q_BLOCK)
    valid = band[None] & exists
    bias = -alibi_slopes()[:, None, None] * (dist * dil).astype(jnp.float32)
    s = jnp.einsum("brnqhd,brnkhd->brnhqk", qb, kb) + bias
    s = jnp.where(valid[None, None, :, None], s, -jnp.inf)
    m = jnp.max(s, axis=-1, keepdims=True)
    p = jnp.exp(s - m)
    den = jnp.sum(p, axis=-1)
    o = jnp.einsum("brnhqk,brnkhd->brnqhd", p, vb) / jnp.swapaxes(den, -1, -2)[..., None]
    lse = jnp.swapaxes(m[..., 0] + jnp.log(den), -1, -2)
    o = o.reshape(B, dil, Mp, H, Dh)[:, :, :M].transpose(0, 2, 1, 3, 4).reshape(B, T, H, Dh)
    lse = lse.reshape(B, dil, Mp, H)[:, :, :M].transpose(0, 2, 1, 3).reshape(B, T, H)
    return o, lse


def dilated_attn_sample(q, kc, vc, window, dil):
    B, S, H, Dh = q.shape
    L = kc.shape[1] - S
    off = jnp.arange(window // dil + 1) * dil
    idx = L + jnp.arange(S)[:, None] - off[None, :]
    valid = idx >= 0
    idx = jnp.maximum(idx, 0)
    kg = kc[:, idx].astype(jnp.float32)
    vg = vc[:, idx].astype(jnp.float32)
    bias = -alibi_slopes()[:, None, None] * off.astype(jnp.float32)[None, None, :]
    s = jnp.einsum("bshd,bskhd->bhsk", q.astype(jnp.float32) * (HEAD_DIM ** -0.5), kg) + bias
    s = jnp.where(valid[None, None], s, -jnp.inf)
    m = jnp.max(s, axis=-1, keepdims=True)
    p = jnp.exp(s - m)
    den = jnp.sum(p, axis=-1)
    o = jnp.einsum("bhsk,bskhd->bshd", p, vg) / jnp.swapaxes(den, 1, 2)[..., None]
    lse = jnp.swapaxes(m[..., 0] + jnp.log(den), 1, 2)
    return o, lse


def merge_dilations(results):
    o = jnp.stack([r[0] for r in results])
    lse = jnp.stack([r[1] for r in results])
    wts = jax.nn.softmax(lse, axis=0)
    return jnp.einsum("gbth,gbthd->bthd", wts, o)


def prompt_attention(q, k, v):
    o = merge_dilations([dilated_attn_prompt(q, k, v, w, d) for (w, d) in DILATIONS])
    return o, k[:, -WINDOW_MAX:], v[:, -WINDOW_MAX:]


def sample_attention(cache_k, cache_v, q, k, v):
    S = q.shape[1]
    kc = jnp.concatenate([cache_k.astype(k.dtype), k], axis=1)
    vc = jnp.concatenate([cache_v.astype(v.dtype), v], axis=1)
    o = merge_dilations([dilated_attn_sample(q, kc, vc, w, d) for (w, d) in DILATIONS])
    return o, kc[:, S:], vc[:, S:]


def rwkv7_mix(zb, shift_prev, wkv_prev, mu_shift, w0, w2, a0, a2, g2, k_k, k_a, r_k, lnx_w, lnx_b):
    B, T, _ = zb.shape
    H, N = N_HEADS_B, HEAD_DIM
    prev = jnp.concatenate([shift_prev[:, None].astype(zb.dtype), zb[:, :-1]], axis=1)
    zm = (zb + (prev - zb) * mu_shift).astype(jnp.float32)
    r = zm[..., :C_B]
    k = zm[..., C_B:2 * C_B]
    v = zm[..., 2 * C_B:3 * C_B]
    w_in = zm[..., 3 * C_B:3 * C_B + D_W_LORA]
    a_in = zm[..., 3 * C_B + D_W_LORA:3 * C_B + D_W_LORA + D_A_LORA]
    g_in = zm[..., 3 * C_B + D_W_LORA + D_A_LORA:]
    w_log = -jax.nn.softplus(-(w0 + jnp.tanh(w_in) @ w2)) - 0.5
    decay = jnp.exp(-jnp.exp(w_log))
    a = jax.nn.sigmoid(a0 + a_in @ a2)
    g = jax.nn.sigmoid(g_in) @ g2
    kk = (k * k_k).reshape(B, T, H, N)
    kk = kk / jnp.maximum(jnp.sqrt(jnp.sum(kk * kk, axis=-1, keepdims=True)), 1e-12)
    k = k * (1.0 + (a - 1.0) * k_a)
    rh, kh, vh, dh, ah = (t.reshape(B, T, H, N) for t in (r, k, v, decay, a))

    def step(S, inp):
        r_t, k_t, v_t, d_t, kk_t, a_t = inp
        sa = jnp.einsum("bhij,bhj->bhi", S, -kk_t)
        S = S * d_t[:, :, None, :] + sa[..., None] * (kk_t * a_t)[:, :, None, :] \
            + v_t[..., None] * k_t[:, :, None, :]
        return S, jnp.einsum("bhij,bhj->bhi", S, r_t)

    xs = tuple(jnp.swapaxes(t, 0, 1) for t in (rh, kh, vh, dh, kk, ah))
    S_last, ys = lax.scan(step, wkv_prev.astype(jnp.float32), xs)
    y = jnp.swapaxes(ys, 0, 1)
    ym = jnp.mean(y, axis=-1, keepdims=True)
    yv = jnp.mean(jnp.square(y - ym), axis=-1, keepdims=True)
    yn = ((y - ym) * lax.rsqrt(yv + GN_EPS)).reshape(B, T, C_B) * lnx_w + lnx_b
    bonus = jnp.sum(rh * kh * r_k, axis=-1, keepdims=True) * vh
    out = (yn + bonus.reshape(B, T, C_B)) * g
    return out.astype(zb.dtype), zb[:, -1], S_last.astype(wkv_prev.dtype)


def hybrid_layer(x, p_l, attend, shift_prev, wkv_prev, w_in, mu_shift, w0, w2, a0, a2, g2,
                 k_k, k_a, r_k, lnx_w, lnx_b, w_out, ln1_w, ln1_b, w_gate, w_up, w_down,
                 ln2_w, ln2_b, w_ple_gate, w_ple_proj, ln3_w, ln3_b):
    B, T, _ = x.shape
    z = jnp.einsum("btd,de->bte", x, w_in)
    q = z[..., :C_A].reshape(B, T, N_HEADS_A, HEAD_DIM)
    k = z[..., C_A:2 * C_A].reshape(B, T, N_HEADS_A, HEAD_DIM)
    v = z[..., 2 * C_A:3 * C_A].reshape(B, T, N_HEADS_A, HEAD_DIM)
    att, k_win, v_win = attend(q, k, v)
    rw, shift_new, wkv_new = rwkv7_mix(z[..., 3 * C_A:], shift_prev, wkv_prev, mu_shift, w0, w2,
                                       a0, a2, g2, k_k, k_a, r_k, lnx_w, lnx_b)
    heads = jnp.concatenate([att.reshape(B, T, C_A).astype(x.dtype), rw], axis=-1)
    mix = jnp.einsum("btc,cd->btd", heads, w_out)
    h = layer_norm(ALPHA * x + mix, ln1_w, ln1_b)
    ffn = jnp.einsum("btf,fd->btd", jax.nn.silu(h @ w_gate) * (h @ w_up), w_down)
    h = layer_norm(ALPHA * h + ffn, ln2_w, ln2_b)
    ple = jax.nn.sigmoid(h @ w_ple_gate) * (p_l @ w_ple_proj)
    y = layer_norm(ALPHA * h + ple, ln3_w, ln3_b)
    return y, k_win, v_win, shift_new, wkv_new


def setup_inputs(seed: int = 0) -> dict:
    key = jax.random.key(seed)
    ks = iter(jax.random.split(key, 40))

    def nrm(shape, s=1.0):
        return s * jax.random.normal(next(ks), shape, jnp.float32)

    L = DEPTH
    win_buf = min(WINDOW_MAX, PAST_LEN)
    return {
        "x_prompt": nrm((BATCH, SEQ, D_MODEL)),
        "x_sample": nrm((DEC_BATCH, DEC_SEQ, D_MODEL)),
        "p_prompt": nrm((L, BATCH, SEQ, PLE_DIM)),
        "p_sample": nrm((L, DEC_BATCH, DEC_SEQ, PLE_DIM)),
        "cache_k_win": nrm((L, DEC_BATCH, win_buf, N_HEADS_A, HEAD_DIM)),
        "cache_v_win": nrm((L, DEC_BATCH, win_buf, N_HEADS_A, HEAD_DIM)),
        "state_wkv": nrm((L, DEC_BATCH, N_HEADS_B, HEAD_DIM, HEAD_DIM), 0.2),
        "state_shift": nrm((L, DEC_BATCH, D_B_IN)),
        "w_in": nrm((L, D_MODEL, D_IN), D_MODEL ** -0.5),
        "mu_shift": jax.random.uniform(next(ks), (L, D_B_IN), jnp.float32),
        "w0": jax.random.uniform(next(ks), (L, C_B), jnp.float32, minval=-6.0, maxval=-1.0),
        "w2": nrm((L, D_W_LORA, C_B), 0.1),
        "a0": nrm((L, C_B), 0.1),
        "a2": nrm((L, D_A_LORA, C_B), 0.1),
        "g2": nrm((L, D_G_LORA, C_B), D_G_LORA ** -0.5),
        "k_k": 0.85 + nrm((L, C_B), 0.05),
        "k_a": 1.0 + nrm((L, C_B), 0.05),
        "r_k": nrm((L, N_HEADS_B, HEAD_DIM), 0.1),
        "lnx_w": 1.0 + nrm((L, C_B), 0.02),
        "lnx_b": nrm((L, C_B), 0.02),
        "w_out": nrm((L, C_A + C_B, D_MODEL), BETA * (C_A + C_B) ** -0.5),
        "ln1_w": 1.0 + nrm((L, D_MODEL), 0.02),
        "ln1_b": nrm((L, D_MODEL), 0.02),
        "w_gate": nrm((L, D_MODEL, D_FF), D_MODEL ** -0.5),
        "w_up": nrm((L, D_MODEL, D_FF), D_MODEL ** -0.5),
        "w_down": nrm((L, D_FF, D_MODEL), BETA * D_FF ** -0.5),
        "ln2_w": 1.0 + nrm((L, D_MODEL), 0.02),
        "ln2_b": nrm((L, D_MODEL), 0.02),
        "w_ple_gate": nrm((L, D_MODEL, D_MODEL), D_MODEL ** -0.5),
        "w_ple_proj": nrm((L, PLE_DIM, D_MODEL), BETA * PLE_DIM ** -0.5),
        "ln3_w": 1.0 + nrm((L, D_MODEL), 0.02),
        "ln3_b": nrm((L, D_MODEL), 0.02),
    }


def reference(x_prompt, x_sample, p_prompt, p_sample, cache_k_win, cache_v_win, state_wkv,
              state_shift, w_in, mu_shift, w0, w2, a0, a2, g2, k_k, k_a, r_k, lnx_w, lnx_b,
              w_out, ln1_w, ln1_b, w_gate, w_up, w_down, ln2_w, ln2_b, w_ple_gate, w_ple_proj,
              ln3_w, ln3_b):
    xp, xs = x_prompt, x_sample
    bp = x_prompt.shape[0]
    shift0 = jnp.zeros((bp, D_B_IN), x_prompt.dtype)
    wkv0 = jnp.zeros((bp, N_HEADS_B, HEAD_DIM, HEAD_DIM), state_wkv.dtype)
    kp_l, vp_l, wp_l, sp_l, ks_l, vs_l, ws_l, ss_l = [], [], [], [], [], [], [], []
    for l in range(DEPTH):
        lw = (w_in[l], mu_shift[l], w0[l], w2[l], a0[l], a2[l], g2[l], k_k[l], k_a[l], r_k[l],
              lnx_w[l], lnx_b[l], w_out[l], ln1_w[l], ln1_b[l], w_gate[l], w_up[l], w_down[l],
              ln2_w[l], ln2_b[l], w_ple_gate[l], w_ple_proj[l], ln3_w[l], ln3_b[l])
        xp, kw, vw, sh, wk = hybrid_layer(xp, p_prompt[l], prompt_attention, shift0, wkv0, *lw)
        kp_l.append(kw); vp_l.append(vw); sp_l.append(sh); wp_l.append(wk)
        attend_s = functools.partial(sample_attention, cache_k_win[l], cache_v_win[l])
        xs, kw, vw, sh, wk = hybrid_layer(xs, p_sample[l], attend_s, state_shift[l], state_wkv[l], *lw)
        ks_l.append(kw); vs_l.append(vw); ss_l.append(sh); ws_l.append(wk)
    return (xp, xs, jnp.stack(kp_l), jnp.stack(vp_l), jnp.stack(wp_l), jnp.stack(sp_l),
            jnp.stack(ks_l), jnp.stack(vs_l), jnp.stack(ws_l), jnp.stack(ss_l))
```

```cpp
#include <hip/hip_runtime.h>
#include <cstdio>
#include <cstdint>
constexpr int DM = 1024, TSEQ = 4096, NBATCH = 8, MPR = NBATCH * TSEQ;
constexpr int SB = 32, SS = 4, MSA = SB * SS;
constexpr int MT = MPR + 256;
constexpr int CA = 512, CB = 512, DBIN = 1792, DIN = 3328, DFF = 2816, PLE = 256, HD = 64, NH = 8;
constexpr int WINL = 2048;
constexpr float ALPHA = 1.18920711500272f;
constexpr float LN_EPS = 1e-5f, GN_EPS = 64e-5f;
constexpr float QSCALE = 0.125f * 1.4426950408889634f;
constexpr float LOG2E = 1.4426950408889634f;
constexpr size_t O_YP = 0, O_YS = O_YP + (size_t)MPR * DM, O_KWP = O_YS + (size_t)MSA * DM, O_VWP = O_KWP + (size_t)NBATCH * WINL * CA,
                 O_WKVP = O_VWP + (size_t)NBATCH * WINL * CA, O_SHP = O_WKVP + (size_t)NBATCH * NH * HD * HD, O_KWS = O_SHP + (size_t)NBATCH * DBIN,
                 O_VWS = O_KWS + (size_t)SB * WINL * CA, O_WKVS = O_VWS + (size_t)SB * WINL * CA, O_SHS = O_WKVS + (size_t)SB * NH * HD * HD,
                 O_END = O_SHS + (size_t)SB * DBIN;
namespace pg8 {
#define PG8_LAS __attribute__((address_space(3)))
typedef unsigned short bf16_t;
typedef short bf16x8 __attribute__((ext_vector_type(8)));
typedef float f32x4 __attribute__((ext_vector_type(4)));
typedef unsigned u32x4 __attribute__((ext_vector_type(4)));
constexpr int BM = 256, BK = 64, HALF = 128, HTB = HALF * BK * 2  , STAGE_BYTES = 8 * HTB, NXCD = 8, WGM = 8;

__host__ __device__ __forceinline__ int lds_byte(int r, int c) { const int st = (r >> 4) * 2 + (c >> 5), rr = r & 15, cc = c & 31, ob = rr * 64 + cc * 2; return st * 1024 + (ob ^ (((ob >> 9) & 1) << 5)); }
__host__ __device__ __forceinline__ void stage_rc(int b, int& R, int& C) { const int st = b / 1024, sb = b % 1024, swz = sb ^ (((sb >> 9) & 1) << 5); R = (st >> 1) * 16 + swz / 64; C = (st & 1) * 32 + (swz % 64) / 2; }
__host__ __device__ __forceinline__ int perm32(int rho) { const int n = rho >> 4, i = rho & 15; return 8 * (i >> 2) + 4 * n + (i & 3); }

struct Unit { int pm, pn; };
struct Gemm { const bf16_t* A; const bf16_t* Bt; int M, N, K; };

struct StaticOrder {
    int nM, nN, nwg, G, c;
    __host__ __device__ void init(int M, int N, int G_, int c_) { nM = M / BM; nN = N / BM; nwg = nM * nN; G = G_; c = c_; }
    __host__ __device__ bool next(int i, Unit& u) const {
        const long L = (long)i * G + c; if (L >= nwg) return false;
        int wgid = (int)L; { const int q = nwg / NXCD, r = nwg % NXCD, xcd = wgid % NXCD, off = wgid / NXCD; wgid = (xcd < r ? xcd * (q + 1) : r * (q + 1) + (xcd - r) * q) + off; }
        const int nig = WGM * nN, gid = wgid / nig, fm = gid * WGM, gsz = (nM - fm) < WGM ? (nM - fm) : WGM;
        u.pm = fm + ((wgid % nig) % gsz); u.pn = (wgid % nig) / gsz; return true;
    }
    __device__ __forceinline__ void a_ready(const Unit&) const {}
    __device__ __forceinline__ void done(const Unit&) const {}
};

typedef unsigned u32x2 __attribute__((ext_vector_type(2)));
__device__ __forceinline__ unsigned cvt_pk_bf16(float lo, float hi) { unsigned r; asm volatile("v_cvt_pk_bf16_f32 %0, %1, %2" : "=v"(r) : "v"(lo), "v"(hi)); return r; }
__device__ __forceinline__ float bf_lo(unsigned w) { return __uint_as_float(w << 16); }
__device__ __forceinline__ float bf_hi(unsigned w) { return __uint_as_float(w & 0xffff0000u); }
__device__ __forceinline__ float sigmoidf_(float x) { return __builtin_amdgcn_rcpf(1.0f + __builtin_amdgcn_exp2f(-x * 1.4426950408889634f)); }
__device__ __forceinline__ u32x4 pack8(const f32x4& a, const f32x4& b) { u32x4 w; w.x = cvt_pk_bf16(a[0], a[1]); w.y = cvt_pk_bf16(a[2], a[3]); w.z = cvt_pk_bf16(b[0], b[1]); w.w = cvt_pk_bf16(b[2], b[3]); return w; }

struct EpiZ {
    static constexpr bool PERM = true, AFTER_DRAIN = false;
    bf16_t *QB, *ZB; float* out;
    __device__ __forceinline__ void operator()(const f32x4 (&acc)[2][2][4][2], const Unit& u, int wr, int wc, int fr, int fq) const {
        const int pn = u.pn, pm = u.pm;
        const int kind = pn < 6 ? (pn >> 1) : 3;
        bf16_t* dst = kind == 3 ? ZB : QB + (size_t)kind * ((size_t)MT * CA);
        const int ld = kind == 3 ? DBIN : CA;
        const int col0 = (kind == 3 ? (pn - 6) * 256 : (pn & 1) * 256) + wc * 32 + 8 * fq;
        const float sc = kind == 0 ? QSCALE : 1.0f;
        const int rbase = pm * BM + wr * 64 + fr;
        const bool win_p = (kind == 1 || kind == 2) && pm < 128 && (pm & 15) >= 8;
        const bool win_s = (kind == 1 || kind == 2) && pm == 128;
        float* wout = out + (win_s ? O_KWS : O_KWP) + (kind == 2 ? (win_s ? (O_VWS - O_KWS) : (O_VWP - O_KWP)) : (size_t)0);
#pragma unroll
        for (int ai = 0; ai < 2; ++ai)
#pragma unroll
            for (int m = 0; m < 4; ++m) {
                const int row = rbase + ai * HALF + m * 16;
                bf16_t* rowp = dst + (size_t)row * ld + col0;
#pragma unroll
                for (int bj = 0; bj < 2; ++bj) {
                    const f32x4 v0 = acc[ai][bj][m][0] * sc, v1 = acc[ai][bj][m][1] * sc;
                    *(u32x4*)(rowp + bj * HALF) = pack8(v0, v1);
                    if (win_p) {
                        const int b = pm >> 4, t = (pm & 15) * 256 + (row & 255);
                        float* o = wout + ((size_t)(b * WINL + t - WINL) * CA + col0 + bj * HALF);
                        *(f32x4*)o = v0; *(f32x4*)(o + 4) = v1;
                    } else if (win_s && ai == 0) {
                        const int rs = row - MPR, b = rs >> 2, s = rs & 3;
                        float* o = wout + ((size_t)(b * WINL + (WINL - SS) + s) * CA + col0 + bj * HALF);
                        *(f32x4*)o = v0; *(f32x4*)(o + 4) = v1;
                    }
                }
            }
    }
};

struct EpiLora {
    static constexpr bool PERM = true, AFTER_DRAIN = false;
    bf16_t *LAM; const float *w0, *a0;
    __device__ __forceinline__ void operator()(const f32x4 (&acc)[2][2][4][2], const Unit& u, int wr, int wc, int fr, int fq) const {
        const int kind = u.pn >> 1;
        bf16_t* dst = LAM + (size_t)kind * ((size_t)MT * CB);
        const int col0 = (u.pn & 1) * 256 + wc * 32 + 8 * fq;
        const float* bias = kind == 0 ? w0 : a0;
        const float mul = kind == 0 ? 0.6065306597126334f : 1.0f;
        const int rbase = u.pm * BM + wr * 64 + fr;
#pragma unroll
        for (int bj = 0; bj < 2; ++bj) {
            f32x4 b0 = {0.f, 0.f, 0.f, 0.f}, b1 = b0;
            if (kind < 2) { b0 = *(const f32x4*)(bias + col0 + bj * HALF); b1 = *(const f32x4*)(bias + col0 + bj * HALF + 4); }
#pragma unroll
            for (int ai = 0; ai < 2; ++ai)
#pragma unroll
                for (int m = 0; m < 4; ++m) {
                    f32x4 v0 = acc[ai][bj][m][0] + b0, v1 = acc[ai][bj][m][1] + b1;
                    if (kind < 2) {
#pragma unroll
                        for (int e = 0; e < 4; ++e) { v0[e] = mul * sigmoidf_(v0[e]); v1[e] = mul * sigmoidf_(v1[e]); }
                    }
                    *(u32x4*)(dst + (size_t)(rbase + ai * HALF + m * 16) * CB + col0 + bj * HALF) = pack8(v0, v1);
                    asm volatile("" ::: "memory");
                }
        }
    }
};

__device__ __forceinline__ f32x4 xres4(const float* xp, const float* xs, int row, int col) {
    if (row < MPR) return *(const f32x4*)(xp + (size_t)row * DM + col);
    if (row < MPR + MSA) return *(const f32x4*)(xs + (size_t)(row - MPR) * DM + col);
    return (f32x4){0.f, 0.f, 0.f, 0.f};
}
struct EpiWout {
    static constexpr bool PERM = false, AFTER_DRAIN = false;
    float* PRE; const float *xp, *xs;
    __device__ __forceinline__ void operator()(const f32x4 (&acc)[2][2][4][2], const Unit& u, int wr, int wc, int fr, int fq) const {
        const int row0 = u.pm * BM + wr * 64 + fr, col0 = u.pn * BM + wc * 32 + 4 * fq;
#pragma unroll
        for (int ai = 0; ai < 2; ++ai)
#pragma unroll
            for (int m = 0; m < 4; ++m) { const int row = row0 + ai * HALF + m * 16; float* rowp = PRE + (size_t)row * DM + col0;
#pragma unroll
                for (int bj = 0; bj < 2; ++bj)
#pragma unroll
                    for (int n = 0; n < 2; ++n) { const f32x4 xr = xres4(xp, xs, row, col0 + bj * HALF + n * 16); *(f32x4*)(rowp + bj * HALF + n * 16) = acc[ai][bj][m][n] + xr * ALPHA; } }
    }
};
struct EpiGU {
    static constexpr bool PERM = true, AFTER_DRAIN = false;
    bf16_t* ACT;
    __device__ __forceinline__ void operator()(const f32x4 (&acc)[2][2][4][2], const Unit& u, int wr, int wc, int fr, int fq) const {
        const int row0 = u.pm * BM + wr * 64 + fr, col0 = u.pn * HALF + wc * 32 + 8 * fq;
#pragma unroll
        for (int ai = 0; ai < 2; ++ai)
#pragma unroll
            for (int m = 0; m < 4; ++m) {
                f32x4 o[2];
#pragma unroll
                for (int n = 0; n < 2; ++n)
#pragma unroll
                    for (int e = 0; e < 4; ++e) { const float g = acc[ai][0][m][n][e], up = acc[ai][1][m][n][e]; o[n][e] = g * sigmoidf_(g) * up; }
                *(u32x4*)(ACT + (size_t)(row0 + ai * HALF + m * 16) * DFF + col0) = pack8(o[0], o[1]);
            }
    }
};
struct EpiDown {
    static constexpr bool PERM = false, AFTER_DRAIN = false;
    float* PRE; const bf16_t* H;
    __device__ __forceinline__ void operator()(const f32x4 (&acc)[2][2][4][2], const Unit& u, int wr, int wc, int fr, int fq) const {
        const int row0 = u.pm * BM + wr * 64 + fr, col0 = u.pn * BM + wc * 32 + 4 * fq;
#pragma unroll
        for (int ai = 0; ai < 2; ++ai)
#pragma unroll
            for (int m = 0; m < 4; ++m) { const size_t off = (size_t)(row0 + ai * HALF + m * 16) * DM + col0;
#pragma unroll
                for (int bj = 0; bj < 2; ++bj)
#pragma unroll
                    for (int n = 0; n < 2; ++n) { const u32x2 hw = *(const u32x2*)(H + off + bj * HALF + n * 16);
                        const f32x4 hr = (f32x4){bf_lo(hw.x), bf_hi(hw.x), bf_lo(hw.y), bf_hi(hw.y)};
                        *(f32x4*)(PRE + off + bj * HALF + n * 16) = acc[ai][bj][m][n] + hr * ALPHA; } }
    }
};
struct EpiPlain {
    static constexpr bool PERM = true, AFTER_DRAIN = false;
    bf16_t* O;
    __device__ __forceinline__ void operator()(const f32x4 (&acc)[2][2][4][2], const Unit& u, int wr, int wc, int fr, int fq) const {
        const int row0 = u.pm * BM + wr * 64 + fr, col0 = u.pn * BM + wc * 32 + 8 * fq;
#pragma unroll
        for (int ai = 0; ai < 2; ++ai)
#pragma unroll
            for (int m = 0; m < 4; ++m)
#pragma unroll
                for (int bj = 0; bj < 2; ++bj) *(u32x4*)(O + (size_t)(row0 + ai * HALF + m * 16) * DM + col0 + bj * HALF) = pack8(acc[ai][bj][m][0], acc[ai][bj][m][1]);
    }
};
struct EpiPle {
    static constexpr bool PERM = false, AFTER_DRAIN = false;
    float* PRE; const bf16_t *H, *PP;
    __device__ __forceinline__ void operator()(const f32x4 (&acc)[2][2][4][2], const Unit& u, int wr, int wc, int fr, int fq) const {
        const int row0 = u.pm * BM + wr * 64 + fr, col0 = u.pn * BM + wc * 32 + 4 * fq;
#pragma unroll
        for (int ai = 0; ai < 2; ++ai)
#pragma unroll
            for (int m = 0; m < 4; ++m) { const size_t off = (size_t)(row0 + ai * HALF + m * 16) * DM + col0;
#pragma unroll
                for (int bj = 0; bj < 2; ++bj)
#pragma unroll
                    for (int n = 0; n < 2; ++n) { const size_t o2 = off + bj * HALF + n * 16;
                        const u32x2 hw = *(const u32x2*)(H + o2), pw = *(const u32x2*)(PP + o2);
                        const f32x4 hr = (f32x4){bf_lo(hw.x), bf_hi(hw.x), bf_lo(hw.y), bf_hi(hw.y)}, pr = (f32x4){bf_lo(pw.x), bf_hi(pw.x), bf_lo(pw.y), bf_hi(pw.y)};
                        f32x4 a = acc[ai][bj][m][n];
#pragma unroll
                        for (int e = 0; e < 4; ++e) a[e] = sigmoidf_(a[e]);
                        *(f32x4*)(PRE + o2) = hr * ALPHA + a * pr; } }
    }
};
template <class Epi, class Sched, bool ALIGN_EPI = false, bool SP2 = false>
__device__ __forceinline__ void gemm_phase(PG8_LAS unsigned char* lds, const Gemm g, const Sched& S, const Epi& E) {
    int tid_ = threadIdx.x; asm volatile("" : "+v"(tid_));
    const int tid = tid_, wid = __builtin_amdgcn_readfirstlane(tid >> 6), lane = tid & 63, wr = wid >> 2, wc = wid & 3, fr = lane & 15, fq = lane >> 4;
    int K_ = g.K; asm volatile("" : "+s"(K_));
    const int K = K_, nt = K / BK;
    unsigned voffA[2], voffB[2];
#pragma unroll
    for (int i = 0; i < 2; ++i) { int R, C; stage_rc(tid * 16 + i * 8192, R, C); const int Rb = Epi::PERM ? ((R & ~31) + perm32(R & 31)) : R;
        voffA[i] = (unsigned)(R * K + C) * 2u; voffB[i] = (unsigned)(Rb * K + C) * 2u; }
    const size_t kstep = (size_t)(BK * 2);
    const size_t hstep = (size_t)HALF * K * 2;
    const size_t tstep = 2 * hstep;
    const unsigned ldsw = (unsigned)wid * 1024u;
    const int aoff = lds_byte(wr * 64 + fr, fq * 8), boff = lds_byte(wc * 32 + fr, fq * 8);
#define PG8_SA(b, h) (((b) * 2 + (h)) * HTB)
#define PG8_SB(b, h) ((4 + (b) * 2 + (h)) * HTB)
#define PG8_STAGE(bufoff, gbase, voff) do { _Pragma("unroll") for (int _i = 0; _i < 2; ++_i) \
        __builtin_amdgcn_global_load_lds((const unsigned*)((const char*)(gbase) + (voff)[_i]), (PG8_LAS unsigned*)(lds + (bufoff) + ldsw + _i * 8192), 16, 0, 0); } while (0)
#define PG8_LDA(dst, b, h) do { _Pragma("unroll") for (int m = 0; m < 4; ++m) _Pragma("unroll") for (int k = 0; k < 2; ++k) dst[m][k] = *(const PG8_LAS bf16x8*)(lds + PG8_SA(b, h) + aoff + m * 2048 + k * 1024); } while (0)
#define PG8_LDB(dst, b, h) do { _Pragma("unroll") for (int n = 0; n < 2; ++n) _Pragma("unroll") for (int k = 0; k < 2; ++k) dst[n][k] = *(const PG8_LAS bf16x8*)(lds + PG8_SB(b, h) + boff + n * 2048 + k * 1024); } while (0)
#define PG8_MMA(ai, bj, At, Bt) do { __builtin_amdgcn_s_setprio(1); _Pragma("unroll") for (int m = 0; m < 4; ++m) _Pragma("unroll") for (int n = 0; n < 2; ++n) _Pragma("unroll") for (int k = 0; k < 2; ++k) \
        acc[ai][bj][m][n] = __builtin_amdgcn_mfma_f32_16x16x32_bf16(Bt[n][k], At[m][k], acc[ai][bj][m][n], 0, 0, 0); __builtin_amdgcn_s_setprio(0); } while (0)
#define PG8_WAIT_V(n) asm volatile("s_waitcnt vmcnt(" #n ")" ::: "memory")
#define PG8_WAIT_L(n) asm volatile("s_waitcnt lgkmcnt(" #n ")" ::: "memory")
#define PG8_BAR __builtin_amdgcn_s_barrier()
#define PG8_SCHED __builtin_amdgcn_sched_barrier(0)
    Unit cur, nxt; int ui = 0;
    if (!S.next(0, cur)) return;
    f32x4 acc[2][2][4][2];
#pragma unroll
    for (int a = 0; a < 2; ++a)
#pragma unroll
        for (int b = 0; b < 2; ++b)
#pragma unroll
            for (int m = 0; m < 4; ++m)
#pragma unroll
                for (int n = 0; n < 2; ++n) acc[a][b][m][n] = (f32x4){0.f, 0.f, 0.f, 0.f};
    bf16x8 At[4][2], B0[2][2], B1[2][2];
    const char* cA = (const char*)g.A + (size_t)cur.pm * tstep; const char* cB = (const char*)g.Bt + (size_t)cur.pn * tstep;
    S.a_ready(cur);
    if constexpr (SP2) {
        PG8_STAGE(PG8_SB(0, 0), cB, voffB); PG8_STAGE(PG8_SB(0, 1), cB + hstep, voffB); PG8_STAGE(PG8_SA(0, 0), cA, voffA); PG8_STAGE(PG8_SA(0, 1), cA + hstep, voffA);
        if (wr == 1) PG8_BAR;
        PG8_WAIT_V(2); PG8_BAR;
        PG8_STAGE(PG8_SB(1, 0), cB + kstep, voffB); PG8_STAGE(PG8_SA(1, 0), cA + kstep, voffA); PG8_STAGE(PG8_SB(1, 1), cB + hstep + kstep, voffB);
        PG8_WAIT_V(6); PG8_BAR;
    } else {
        PG8_STAGE(PG8_SB(0, 0), cB, voffB); PG8_STAGE(PG8_SA(0, 0), cA, voffA); PG8_STAGE(PG8_SB(0, 1), cB + hstep, voffB); PG8_STAGE(PG8_SA(0, 1), cA + hstep, voffA);
        if (wr == 1) PG8_BAR;
        PG8_WAIT_V(4); PG8_BAR;
        PG8_STAGE(PG8_SB(1, 0), cB + kstep, voffB); PG8_STAGE(PG8_SA(1, 0), cA + kstep, voffA); PG8_STAGE(PG8_SB(1, 1), cB + hstep + kstep, voffB);
        PG8_WAIT_V(6); PG8_BAR;
    }
    for (;;) {
        const bool has_next = S.next(ui + 1, nxt);
        const char* nA = has_next ? (const char*)g.A + (size_t)nxt.pm * tstep : cA; const char* nB = has_next ? (const char*)g.Bt + (size_t)nxt.pn * tstep : cB;
        for (int t = 0; t < nt; t += 2) {
            const bool last = (t == nt - 2);
            const char* a1 = cA + (size_t)(t + 1) * kstep;
            const char* a2 = last ? nA : cA + (size_t)(t + 2) * kstep; const char* b2 = last ? nB : cB + (size_t)(t + 2) * kstep;
            const char* a3 = a2 + kstep; const char* b3 = b2 + kstep;
            if (last && has_next) S.a_ready(nxt);
            if constexpr (SP2) {
            PG8_LDB(B0, 0, 0); PG8_LDB(B1, 0, 1); PG8_SCHED; PG8_LDA(At, 0, 0); PG8_STAGE(PG8_SA(1, 1), a1 + hstep, voffA);
            PG8_WAIT_V(8); PG8_WAIT_L(0); PG8_BAR; PG8_MMA(0, 0, At, B0); PG8_MMA(0, 1, At, B1); PG8_BAR; PG8_SCHED;
            PG8_LDA(At, 0, 1); PG8_STAGE(PG8_SB(0, 0), b2, voffB); PG8_STAGE(PG8_SB(0, 1), b2 + hstep, voffB); PG8_STAGE(PG8_SA(0, 0), a2, voffA);
            PG8_WAIT_V(8); PG8_WAIT_L(0); PG8_BAR; PG8_MMA(1, 0, At, B0); PG8_MMA(1, 1, At, B1); PG8_BAR; PG8_SCHED;
            PG8_LDB(B0, 1, 0); PG8_LDB(B1, 1, 1); PG8_SCHED; PG8_LDA(At, 1, 0); PG8_STAGE(PG8_SA(0, 1), a2 + hstep, voffA);
            PG8_WAIT_V(8); PG8_WAIT_L(0); PG8_BAR; PG8_MMA(0, 0, At, B0); PG8_MMA(0, 1, At, B1); PG8_BAR; PG8_SCHED;
            PG8_LDA(At, 1, 1); PG8_STAGE(PG8_SB(1, 0), b3, voffB); PG8_STAGE(PG8_SB(1, 1), b3 + hstep, voffB); PG8_STAGE(PG8_SA(1, 0), a3, voffA);
            PG8_WAIT_V(8); PG8_WAIT_L(0); PG8_BAR; PG8_MMA(1, 0, At, B0); PG8_MMA(1, 1, At, B1); PG8_BAR; PG8_SCHED;
            } else {
            PG8_LDB(B0, 0, 0); PG8_SCHED; PG8_LDA(At, 0, 0); PG8_STAGE(PG8_SA(1, 1), a1 + hstep, voffA);
            PG8_WAIT_L(8); PG8_BAR; PG8_WAIT_L(0); PG8_MMA(0, 0, At, B0); PG8_BAR; PG8_SCHED;
            PG8_LDB(B1, 0, 1); PG8_STAGE(PG8_SB(0, 0), b2, voffB);
            PG8_BAR; PG8_WAIT_L(0); PG8_MMA(0, 1, At, B1); PG8_BAR;
            PG8_LDA(At, 0, 1); PG8_STAGE(PG8_SA(0, 0), a2, voffA);
            PG8_BAR; PG8_WAIT_L(0); PG8_MMA(1, 0, At, B0); PG8_BAR; PG8_SCHED;
            PG8_STAGE(PG8_SB(0, 1), b2 + hstep, voffB);
            PG8_WAIT_V(6); PG8_BAR; PG8_MMA(1, 1, At, B1); PG8_BAR;
            PG8_LDB(B0, 1, 0); PG8_SCHED; PG8_LDA(At, 1, 0); PG8_STAGE(PG8_SA(0, 1), a2 + hstep, voffA);
            PG8_WAIT_L(8); PG8_BAR; PG8_WAIT_L(0); PG8_MMA(0, 0, At, B0); PG8_BAR; PG8_SCHED;
            PG8_LDB(B1, 1, 1); PG8_STAGE(PG8_SB(1, 0), b3, voffB);
            PG8_BAR; PG8_WAIT_L(0); PG8_MMA(0, 1, At, B1); PG8_BAR;
            PG8_LDA(At, 1, 1); PG8_STAGE(PG8_SA(1, 0), a3, voffA);
            PG8_BAR; PG8_WAIT_L(0); PG8_MMA(1, 0, At, B0); PG8_BAR; PG8_SCHED;
            PG8_STAGE(PG8_SB(1, 1), b3 + hstep, voffB);
            PG8_WAIT_V(6); PG8_BAR; PG8_MMA(1, 1, At, B1); PG8_BAR;
            }
        }
        if constexpr (ALIGN_EPI) { if (wr == 0) PG8_BAR; }
        if constexpr (!Epi::AFTER_DRAIN) { E(acc, cur, wr, wc, fr, fq); S.done(cur); }
        if (!has_next) break;
#pragma unroll
        for (int a = 0; a < 2; ++a)
#pragma unroll
            for (int b = 0; b < 2; ++b)
#pragma unroll
                for (int m = 0; m < 4; ++m)
#pragma unroll
                    for (int n = 0; n < 2; ++n) acc[a][b][m][n] = (f32x4){0.f, 0.f, 0.f, 0.f};
        cur = nxt; cA = nA; cB = nB; ++ui;
        if constexpr (ALIGN_EPI) { if (wr == 1) PG8_BAR; }
    }
    PG8_WAIT_V(0);
    if constexpr (!ALIGN_EPI) { if (wr == 0) PG8_BAR; }
    PG8_BAR;
    if constexpr (Epi::AFTER_DRAIN) { E.fused(acc, cur, wr, wc, fr, fq, lds, wid, lane); S.done(cur); }
#undef PG8_SA
#undef PG8_SB
#undef PG8_STAGE
#undef PG8_LDA
#undef PG8_LDB
#undef PG8_MMA
#undef PG8_WAIT_V
#undef PG8_WAIT_L
#undef PG8_BAR
#undef PG8_SCHED
}
}
#define GAS __attribute__((address_space(1)))
#define LAS __attribute__((address_space(3)))
typedef unsigned short bf16;
typedef unsigned v4u __attribute__((ext_vector_type(4)));
typedef float f32x4 __attribute__((ext_vector_type(4)));
typedef short bf16x8 __attribute__((ext_vector_type(8)));
typedef GAS unsigned gu32;
typedef GAS unsigned long long gu64;
#define RLX_AGENT __ATOMIC_RELAXED, __HIP_MEMORY_SCOPE_AGENT
#define LDS_WAIT() asm volatile("s_waitcnt lgkmcnt(0)" ::: "memory")
#define VM_WAIT() asm volatile("s_waitcnt vmcnt(0)" ::: "memory")
__device__ __forceinline__ unsigned long long rt() { return __builtin_amdgcn_s_memrealtime(); }
__device__ __forceinline__ unsigned f2bf(float f) { unsigned u = __builtin_bit_cast(unsigned, f); return (u + 0x7fffu + ((u >> 16) & 1u)) >> 16; }
__device__ __forceinline__ unsigned pk2(float lo, float hi) { return f2bf(lo) | (f2bf(hi) << 16); }

#define XB_TMO      128
#define XB_XCNT(j)  (256  + 64 * (j))
#define XB_XSUB(j)  (1280 + 64 * (j))
#define XB_XGEN(j)  (2304 + 64 * (j))
#define XB_TOP      3328
#define XB_TOPGEN   3392
#define XCD_BAR_WORDS 3456
#define XB_SPIN_CAP (1u << 18)

__device__ __forceinline__ unsigned xb_ld(unsigned* p)              { return __hip_atomic_load(p, __ATOMIC_RELAXED, __HIP_MEMORY_SCOPE_AGENT); }
__device__ __forceinline__ unsigned xb_add(unsigned* p, unsigned v) { return __hip_atomic_fetch_add(p, v, __ATOMIC_RELAXED, __HIP_MEMORY_SCOPE_AGENT); }
__device__ __forceinline__ unsigned xb_xcc_id() { return (unsigned)__builtin_amdgcn_s_getreg((3 << 11) | 20) & 0xFu; }
#define XB_SPIN(cond, bar) do { unsigned _sp = 0; while (cond) { __builtin_amdgcn_s_sleep(1); \
    if ((++_sp & 255u) == 0u) { if (xb_ld(&(bar)[XB_TMO])) break; if (_sp > XB_SPIN_CAP) { atomicAdd(&(bar)[XB_TMO], 1u); break; } } } } while (0)

struct XcdBarrier {
    unsigned* bar; unsigned x;
    volatile LAS unsigned* st;
};

__device__ __forceinline__ XcdBarrier xcd_barrier_post(unsigned* bar, volatile LAS unsigned* st) {
    XcdBarrier b; b.bar = bar; b.x = xb_xcc_id(); b.st = st;
    if (threadIdx.x == 0) (void)xb_add(&bar[XB_XCNT(b.x)], 1u);
    return b;
}
__device__ __forceinline__ void xcd_barrier_complete(unsigned* bar, unsigned x, unsigned& nloc, unsigned& nx) {
    const unsigned G = gridDim.x * gridDim.y * gridDim.z;
    unsigned sum, cnt, mine, sp = 0u;
    for (;;) {
        sum = 0u; cnt = 0u; mine = 0u;
#pragma unroll
        for (unsigned j = 0; j < 16; ++j) { const unsigned c = xb_ld(&bar[XB_XCNT(j)]); sum += c; cnt += (c > 0u) ? 1u : 0u; mine = (j == x) ? c : mine; }
        if (sum == G) break;
        __builtin_amdgcn_s_sleep(1);
        if ((++sp & 255u) == 0u) { if (xb_ld(&bar[XB_TMO])) break; if (sp > XB_SPIN_CAP) { atomicAdd(&bar[XB_TMO], 1u); break; } }
    }
    nloc = mine > 0u ? mine : 1u; nx = cnt > 0u ? cnt : 1u;
}

__device__ __forceinline__ void xcd_barrier(const XcdBarrier& b) {
    asm volatile("s_waitcnt vmcnt(0)" ::: "memory");
    __syncthreads();
    if (threadIdx.x == 0) {
        unsigned* bar = b.bar;
        __builtin_amdgcn_s_waitcnt(0);
        unsigned nloc = b.st[0], nx = b.st[1];
        if (nloc == 0u) { xcd_barrier_complete(bar, b.x, nloc, nx); b.st[0] = nloc; b.st[1] = nx; }
        const unsigned old = xb_add(&bar[XB_XSUB(b.x)], 1u);
        const unsigned gen = old / nloc;
        if (old + 1u == (gen + 1u) * nloc) {
            __builtin_amdgcn_fence(__ATOMIC_RELEASE, "agent");
            asm volatile("s_waitcnt vmcnt(0)" ::: "memory");
            const unsigned og = xb_add(&bar[XB_TOP], 1u);
            const unsigned tg = og / nx;
            if (og + 1u == (tg + 1u) * nx) xb_add(&bar[XB_TOPGEN], 1u);
            else XB_SPIN(xb_ld(&bar[XB_TOPGEN]) == tg, bar);
            __builtin_amdgcn_fence(__ATOMIC_ACQUIRE, "agent");
            xb_add(&bar[XB_XGEN(b.x)], 1u);
            asm volatile("s_waitcnt vmcnt(0)" ::: "memory");
        } else {
            XB_SPIN(xb_ld(&bar[XB_XGEN(b.x)]) == gen, bar);
            __builtin_amdgcn_fence(__ATOMIC_ACQUIRE, "agent");
            asm volatile("s_waitcnt vmcnt(0)" ::: "memory");
        }
    }
    __syncthreads();
}
constexpr size_t MiB = 1u << 20;
constexpr size_t WS_CTL = 0, CTL_ZERO_BYTES = 1 * MiB;
constexpr size_t WS_WIN = 2 * MiB, WS_WOUT = 9 * MiB, WS_WGU = 11 * MiB, WS_WD = 22 * MiB, WS_WPG = 28 * MiB, WS_WPP = 30 * MiB, WS_WL = 30 * MiB + 512 * 1024;
constexpr size_t SZ1024B = (size_t)MT * 1024 * 2, SZ512B = (size_t)MT * 512 * 2, SZ256B = (size_t)MT * 256 * 2;
constexpr size_t WS_R1 = 32 * MiB;
constexpr size_t WS_PB = 97 * MiB;
constexpr size_t WS_QB = 114 * MiB, WS_KB = WS_QB + SZ512B, WS_VB = WS_KB + SZ512B;
constexpr size_t WS_PRE = 114 * MiB;
constexpr size_t WS_ZB = 211 * MiB;
constexpr size_t WS_OG = 324 * MiB, WS_LSE = 420 * MiB;
constexpr size_t WS_BV = 324 * MiB, WS_PHI = 357 * MiB, WS_SLOC = 389 * MiB, WS_SC = 421 * MiB;
constexpr size_t WS_AP = 453 * MiB;
constexpr size_t WS_ACT = 243 * MiB;
constexpr size_t WS_H2 = 243 * MiB, WS_PP = 308 * MiB;
constexpr size_t WS_END = 470 * MiB;
static_assert(WS_VB + SZ512B <= WS_ZB && WS_ZB + (size_t)MT * DBIN * 2 <= WS_OG && WS_PRE + (size_t)MT * DM * 4 <= WS_ACT && WS_ACT + (size_t)MT * DFF * 2 <= WS_SC + 32 * MiB, "ws map");
static_assert(WS_R1 + SZ1024B <= WS_PB && WS_PB + SZ256B <= WS_QB && WS_AP + SZ256B <= WS_END && WS_H2 + SZ1024B <= WS_PP, "ws map 2");
constexpr int NCHUNK = 32, CHL = TSEQ / NCHUNK;
constexpr int CW_BAR = 4096;

constexpr int RING_OFF = 0, RING_BYTES = 131072;
constexpr int LDSCTL_OFF = RING_BYTES, MISC_OFF = LDSCTL_OFF + 320;
constexpr int LDS_BYTES = 147456;
constexpr int NWAVES = 8;
typedef float f32x16 __attribute__((ext_vector_type(16)));
typedef unsigned u32x2 __attribute__((ext_vector_type(2)));
typedef short s16x4 __attribute__((ext_vector_type(4)));
typedef float f32x2_t __attribute__((ext_vector_type(2)));
typedef __bf16 bf16x2_t __attribute__((ext_vector_type(2)));
__device__ __forceinline__ unsigned cvtpk(float lo, float hi) { f32x2_t v = {lo, hi}; bf16x2_t b = __builtin_convertvector(v, bf16x2_t); return __builtin_bit_cast(unsigned, b); }
__device__ __forceinline__ float bflo(unsigned w) { return __uint_as_float(w << 16); }
__device__ __forceinline__ float bfhi(unsigned w) { return __uint_as_float(w & 0xffff0000u); }
__device__ __forceinline__ float bf1(bf16 h) { return __uint_as_float((unsigned)h << 16); }
__device__ __forceinline__ float sigm(float x) { return __builtin_amdgcn_rcpf(1.0f + __builtin_amdgcn_exp2f(-x * LOG2E)); }
__device__ __forceinline__ float shx(float v, int o, int lane) { return __int_as_float(__builtin_amdgcn_ds_bpermute((lane ^ o) << 2, __float_as_int(v))); }
__device__ __forceinline__ float wave_sum(float v, int lane) {
#pragma unroll
    for (int o = 1; o < 64; o <<= 1) v += shx(v, o, lane);
    return v;
}
struct Ctx { LAS unsigned char* lds; int tid, lane, wave, vcu, G; };

__device__ __forceinline__ void p0_transpose_item(const float* W, int N, bf16* WT, int ldk, int drow, int dk, LAS float* scr, int k0, int n0, int lane) {
#pragma unroll 8
    for (int i = 0; i < 32; ++i) { const int kk = 2 * i + (lane >> 5); scr[kk * 33 + (lane & 31)] = W[(size_t)(k0 + kk) * N + n0 + (lane & 31)]; }
    LDS_WAIT(); asm volatile("" ::: "memory");
    const int c = lane & 7;
#pragma unroll
    for (int j = 0; j < 4; ++j) { const int n = (lane >> 3) + 8 * j; const LAS float* s = scr + (8 * c) * 33 + n;
        v4u o; o.x = pk2(s[0 * 33], s[1 * 33]); o.y = pk2(s[2 * 33], s[3 * 33]); o.z = pk2(s[4 * 33], s[5 * 33]); o.w = pk2(s[6 * 33], s[7 * 33]);
        *(GAS v4u*)(WT + (size_t)(drow + n) * ldk + dk + 8 * c) = o; }
    LDS_WAIT(); asm volatile("" ::: "memory");
}
struct P0Args { const float *xp, *xs, *pp, *ps, *ck, *cv, *w_in, *w_out, *w_gate, *w_up, *w_down, *w_pg, *w_pp, *w2, *a2, *g2; bf16 *Win, *Wout, *Wgu, *Wd, *Wpg, *Wpp, *Wl, *XB, *PB; float* out; };
__device__ __forceinline__ void p0_prologue(const Ctx& C, const P0Args& A) {
    LAS float* scr = (LAS float*)(C.lds + RING_OFF + C.wave * 16384);
    const int gw = C.vcu * NWAVES + C.wave, NGW = C.G * NWAVES;
    constexpr int I0 = 16 * 104, I1 = 16 * 32, I2 = 16 * 88, I3 = I2, I4 = 44 * 32, I5 = 16 * 32, I6 = 4 * 32, I7 = 16, I8 = 16, I9 = 32;
    constexpr int NITEMS = I0 + I1 + I2 + I3 + I4 + I5 + I6 + I7 + I8 + I9;
    for (int it = gw; it < NITEMS; it += NGW) {
        int r = it;
        if (r < I0) { const int kb = r / 104, nb = r % 104; p0_transpose_item(A.w_in, DIN, A.Win, 1024, nb * 32, kb * 64, scr, kb * 64, nb * 32, C.lane); continue; } r -= I0;
        if (r < I1) { const int kb = r / 32, nb = r % 32; p0_transpose_item(A.w_out, DM, A.Wout, 1024, nb * 32, kb * 64, scr, kb * 64, nb * 32, C.lane); continue; } r -= I1;
        if (r < I2) { const int kb = r / 88, nb = r % 88, n0 = nb * 32; p0_transpose_item(A.w_gate, DFF, A.Wgu, 1024, (n0 >> 7) * 256 + (n0 & 127), kb * 64, scr, kb * 64, n0, C.lane); continue; } r -= I2;
        if (r < I3) { const int kb = r / 88, nb = r % 88, n0 = nb * 32; p0_transpose_item(A.w_up, DFF, A.Wgu, 1024, (n0 >> 7) * 256 + 128 + (n0 & 127), kb * 64, scr, kb * 64, n0, C.lane); continue; } r -= I3;
        if (r < I4) { const int kb = r / 32, nb = r % 32; p0_transpose_item(A.w_down, DM, A.Wd, DFF, nb * 32, kb * 64, scr, kb * 64, nb * 32, C.lane); continue; } r -= I4;
        if (r < I5) { const int kb = r / 32, nb = r % 32; p0_transpose_item(A.w_pg, DM, A.Wpg, 1024, nb * 32, kb * 64, scr, kb * 64, nb * 32, C.lane); continue; } r -= I5;
        if (r < I6) { const int kb = r / 32, nb = r % 32; p0_transpose_item(A.w_pp, DM, A.Wpp, 256, nb * 32, kb * 64, scr, kb * 64, nb * 32, C.lane); continue; } r -= I6;
        if (r < I7) { p0_transpose_item(A.w2, CB, A.Wl, 256, r * 32, 0, scr, 0, r * 32, C.lane); continue; } r -= I7;
        if (r < I8) { p0_transpose_item(A.a2, CB, A.Wl, 256, 512 + r * 32, 64, scr, 0, r * 32, C.lane); continue; } r -= I8;
        { const int kb = r / 16, nb = r % 16; p0_transpose_item(A.g2, CB, A.Wl, 256, 1024 + nb * 32, 128 + kb * 64, scr, kb * 64, nb * 32, C.lane); }
    }
    const int gt = C.vcu * (NWAVES * 64) + C.tid, NT = C.G * NWAVES * 64;
    for (int i = gt; i < 1536 * 32; i += NT) { const int row = i >> 5, ch = i & 31, blk = row >> 9;
        const bool nz = blk == 0 ? ch < 8 : blk == 1 ? (ch >= 8 && ch < 16) : ch >= 16;
        if (!nz) *(GAS v4u*)(A.Wl + (size_t)row * 256 + ch * 8) = (v4u){0u, 0u, 0u, 0u}; }
    for (int i = gt; i < MT * 128; i += NT) { const int row = i >> 7, ch = i & 127;
        f32x4 a = {0.f, 0.f, 0.f, 0.f}, b = a;
        if (row < MPR + MSA) { const float* src = row < MPR ? A.xp + (size_t)row * DM : A.xs + (size_t)(row - MPR) * DM; a = *(const GAS f32x4*)(src + ch * 8); b = *(const GAS f32x4*)(src + ch * 8 + 4); }
        v4u o; o.x = cvtpk(a[0], a[1]); o.y = cvtpk(a[2], a[3]); o.z = cvtpk(b[0], b[1]); o.w = cvtpk(b[2], b[3]);
        *(GAS v4u*)(A.XB + (size_t)row * DM + ch * 8) = o; }
    for (int i = gt; i < MT * 32; i += NT) { const int row = i >> 5, ch = i & 31;
        f32x4 a = {0.f, 0.f, 0.f, 0.f}, b = a;
        if (row < MPR + MSA) { const float* src = row < MPR ? A.pp + (size_t)row * PLE : A.ps + (size_t)(row - MPR) * PLE; a = *(const GAS f32x4*)(src + ch * 8); b = *(const GAS f32x4*)(src + ch * 8 + 4); }
        v4u o; o.x = cvtpk(a[0], a[1]); o.y = cvtpk(a[2], a[3]); o.z = cvtpk(b[0], b[1]); o.w = cvtpk(b[2], b[3]);
        *(GAS v4u*)(A.PB + (size_t)row * PLE + ch * 8) = o; }
    constexpr int PERB = (WINL - SS) * CA / 4;
    for (int i = gt; i < SB * PERB; i += NT) { const int b = i / PERB, o = i % PERB;
        const size_t src = ((size_t)b * WINL + SS) * CA + (size_t)o * 4, dst = (size_t)b * WINL * CA + (size_t)o * 4;
        const f32x4 k = __builtin_nontemporal_load((const f32x4*)(A.ck + src)), v = __builtin_nontemporal_load((const f32x4*)(A.cv + src));
        __builtin_nontemporal_store(k, (f32x4*)(A.out + O_KWS + dst)); __builtin_nontemporal_store(v, (f32x4*)(A.out + O_VWS + dst)); }
}

__device__ __forceinline__ void prep_a(const Ctx& C, const bf16* ZB, const float* mu, const float* state_shift, bf16* AP, float* out) {
    const int gw = C.vcu * NWAVES + C.wave, NGW = C.G * NWAVES, lane = C.lane;
    const f32x4 m4 = *(const GAS f32x4*)(mu + 1536 + lane * 4);
    for (int row = gw; row < MPR + MSA; row += NGW) {
        const u32x2 zw = *(const GAS u32x2*)(ZB + (size_t)row * DBIN + 1536 + lane * 4);
        f32x4 z = {bflo(zw.x), bfhi(zw.x), bflo(zw.y), bfhi(zw.y)}, p;
        const bool first = row < MPR ? (row & (TSEQ - 1)) == 0 : ((row - MPR) & 3) == 0;
        if (!first) { const u32x2 pw = *(const GAS u32x2*)(ZB + (size_t)(row - 1) * DBIN + 1536 + lane * 4); p = (f32x4){bflo(pw.x), bfhi(pw.x), bflo(pw.y), bfhi(pw.y)}; }
        else if (row < MPR) p = (f32x4){0.f, 0.f, 0.f, 0.f};
        else p = *(const GAS f32x4*)(state_shift + (size_t)((row - MPR) >> 2) * DBIN + 1536 + lane * 4);
        f32x4 zm = z + (p - z) * m4, o;
#pragma unroll
        for (int e = 0; e < 4; ++e) { const float x = zm[e];
            const float th = 1.0f - 2.0f * __builtin_amdgcn_rcpf(1.0f + __builtin_amdgcn_exp2f(2.0f * LOG2E * x));
            o[e] = lane < 16 ? th : lane < 32 ? x : sigm(x); }
        u32x2 w; w.x = cvtpk(o[0], o[1]); w.y = cvtpk(o[2], o[3]);
        *(GAS u32x2*)(AP + (size_t)row * 256 + lane * 4) = w;
    }
    const int gt = C.vcu * (NWAVES * 64) + C.tid, NT = C.G * NWAVES * 64;
    for (int i = gt; i < (NBATCH + SB) * DBIN; i += NT) { const int s = i / DBIN, c = i % DBIN;
        if (s < NBATCH) out[O_SHP + (size_t)s * DBIN + c] = bf1(ZB[(size_t)(s * TSEQ + TSEQ - 1) * DBIN + c]);
        else out[O_SHS + (size_t)(s - NBATCH) * DBIN + c] = bf1(ZB[(size_t)(MPR + (s - NBATCH) * SS + SS - 1) * DBIN + c]); }
}

__device__ __forceinline__ int crow(int r, int hi) { return (r & 3) + 8 * (r >> 2) + 4 * hi; }
typedef short v4i16_t __attribute__((ext_vector_type(4)));
__device__ __forceinline__ s16x4 vtr(LAS const unsigned char* p) { return __builtin_bit_cast(s16x4, __builtin_amdgcn_ds_read_tr16_b64_v4i16((LAS v4i16_t*)p)); }
constexpr int VP = 192;
__device__ __forceinline__ void attn_unit(const Ctx& C, const bf16* QB, const bf16* KB, const bf16* VB, bf16* OGg, float* LSEg, int b, int h, int cls, int mq0, int dil) {
    LAS unsigned char* lds = C.lds;
    const int tid = C.tid, wid = C.wave, lane = C.lane, r32 = lane & 31, hi = lane >> 5;
#pragma unroll
    for (int it = 0; it < 6; ++it) { const int rr = it * 64 + (tid >> 3), ch = tid & 7; int mk = mq0 - 128 + rr; mk = mk < 0 ? 0 : mk;
        const v4u val = *(const GAS v4u*)(VB + (size_t)(b * TSEQ + mk * dil + cls) * CA + h * 64 + ch * 8);
        *(LAS v4u*)(lds + rr * VP + ch * 16) = val; }
    __syncthreads();
    const int mqw = mq0 + 32 * wid;
    const size_t qrow = (size_t)(b * TSEQ + (mqw + r32) * dil + cls);
    bf16x8 qf[4];
#pragma unroll
    for (int s = 0; s < 4; ++s) qf[s] = *(const GAS bf16x8*)(QB + qrow * CA + h * 64 + 16 * s + 8 * hi);
    f32x16 st[5];
#pragma unroll
    for (int j = 0; j < 5; ++j) { int mk = mqw - 128 + 32 * j + r32; mk = mk < 0 ? 0 : mk;
        const bf16* kp = KB + (size_t)(b * TSEQ + mk * dil + cls) * CA + h * 64 + 8 * hi;
        f32x16 a = {0.f, 0.f, 0.f, 0.f, 0.f, 0.f, 0.f, 0.f, 0.f, 0.f, 0.f, 0.f, 0.f, 0.f, 0.f, 0.f};
#pragma unroll
        for (int s = 0; s < 4; ++s) { const bf16x8 kf = *(const GAS bf16x8*)(kp + 16 * s); a = __builtin_amdgcn_mfma_f32_32x32x16_bf16(kf, qf[s], a, 0, 0, 0); }
        st[j] = a; }
    const float slope2 = __builtin_amdgcn_exp2f(-(float)(h + 1)) * LOG2E * (float)dil;
    float mx = -INFINITY;
#pragma unroll
    for (int j = 0; j < 5; ++j)
#pragma unroll
        for (int i = 0; i < 16; ++i) { const int kr = crow(i, hi), dist = 128 - 32 * j + r32 - kr, mke = mqw - 128 + 32 * j + kr;
            const bool ok = dist >= 0 && dist <= 128 && mke >= 0;
            const float v = ok ? st[j][i] - slope2 * (float)dist : -INFINITY; st[j][i] = v; mx = fmaxf(mx, v); }
    mx = fmaxf(mx, shx(mx, 32, lane));
    float l = 0.f;
#pragma unroll
    for (int j = 0; j < 5; ++j)
#pragma unroll
        for (int i = 0; i < 16; ++i) { const float p = __builtin_amdgcn_exp2f(st[j][i] - mx); st[j][i] = p; l += p; }
    l += shx(l, 32, lane);
    f32x16 o0 = {0.f, 0.f, 0.f, 0.f, 0.f, 0.f, 0.f, 0.f, 0.f, 0.f, 0.f, 0.f, 0.f, 0.f, 0.f, 0.f}, o1 = o0;
    const int i16 = lane & 15, qq = i16 >> 2, pp = i16 & 3, blk = (lane >> 4) & 1;
    LAS const unsigned char* vbase = lds + (32 * wid + 4 * hi + qq) * VP + (16 * blk + 4 * pp) * 2;
#pragma unroll
    for (int j = 0; j < 5; ++j)
#pragma unroll
        for (int s2 = 0; s2 < 2; ++s2) {
            v4u pw; pw.x = cvtpk(st[j][8 * s2 + 0], st[j][8 * s2 + 1]); pw.y = cvtpk(st[j][8 * s2 + 2], st[j][8 * s2 + 3]); pw.z = cvtpk(st[j][8 * s2 + 4], st[j][8 * s2 + 5]); pw.w = cvtpk(st[j][8 * s2 + 6], st[j][8 * s2 + 7]);
            const bf16x8 xs = __builtin_bit_cast(bf16x8, pw);
            LAS const unsigned char* vp = vbase + (32 * j + 16 * s2) * VP;
            { const s16x4 lo = vtr(vp), hh = vtr(vp + 8 * VP); const bf16x8 vf = (bf16x8){lo[0], lo[1], lo[2], lo[3], hh[0], hh[1], hh[2], hh[3]};
              o0 = __builtin_amdgcn_mfma_f32_32x32x16_bf16(vf, xs, o0, 0, 0, 0); }
            { const s16x4 lo = vtr(vp + 64), hh = vtr(vp + 8 * VP + 64); const bf16x8 vf = (bf16x8){lo[0], lo[1], lo[2], lo[3], hh[0], hh[1], hh[2], hh[3]};
              o1 = __builtin_amdgcn_mfma_f32_32x32x16_bf16(vf, xs, o1, 0, 0, 0); }
        }
    const float inv = __builtin_amdgcn_rcpf(l);
    bf16* orow = OGg + qrow * CA + h * 64 + 4 * hi;
#pragma unroll
    for (int g4 = 0; g4 < 4; ++g4) {
        u32x2 w0, w1;
        w0.x = cvtpk(o0[4 * g4] * inv, o0[4 * g4 + 1] * inv); w0.y = cvtpk(o0[4 * g4 + 2] * inv, o0[4 * g4 + 3] * inv);
        w1.x = cvtpk(o1[4 * g4] * inv, o1[4 * g4 + 1] * inv); w1.y = cvtpk(o1[4 * g4 + 2] * inv, o1[4 * g4 + 3] * inv);
        *(GAS u32x2*)(orow + 8 * g4) = w0; *(GAS u32x2*)(orow + 32 + 8 * g4) = w1; }
    if (hi == 0) LSEg[qrow * NH + h] = mx + __builtin_amdgcn_logf(l);
    __syncthreads();
}
__device__ __forceinline__ void attn_prompt(const Ctx& C, const bf16* QB, const bf16* KB, const bf16* VB, bf16* OG, float* LSE) {
    for (int i = 0; i < 12; ++i) {
        const int u = C.vcu * 12 + i, bh = u / 48, k48 = u % 48, g = k48 >> 4, k = k48 & 15;
        const int b = bh >> 3, h = bh & 7;
        int cls, mq0, dil;
        if (g == 0) { cls = 0; mq0 = 256 * k; dil = 1; } else if (g == 1) { cls = k >> 2; mq0 = 256 * (k & 3); dil = 4; } else { cls = k; mq0 = 0; dil = 16; }
        attn_unit(C, QB, KB, VB, OG + (size_t)g * MPR * CA, LSE + (size_t)g * MPR * NH, b, h, cls, mq0, dil);
    }
}
__device__ __forceinline__ void attn_sample(const Ctx& C, const bf16* QB, const float* ck, const float* cv, const float* out, bf16* HEADS) {
    const int b = C.vcu >> 3, h = C.vcu & 7, s = C.wave, lane = C.lane;
    if (C.vcu >= SB * NH || s >= SS) return;
    LAS float* qs = (LAS float*)(C.lds + s * 4096);
    LAS float* ps = qs + 64;
    const int row = MPR + b * SS + s;
    qs[lane] = bf1(QB[(size_t)row * CA + h * 64 + lane]);
    LDS_WAIT(); asm volatile("" ::: "memory");
    const float slope2 = __builtin_amdgcn_exp2f(-(float)(h + 1)) * LOG2E;
    float sc[7]; float mx = -INFINITY;
#pragma unroll
    for (int it = 0; it < 7; ++it) {
        const int n = it * 64 + lane; sc[it] = -INFINITY;
        if (n < 387) { const int g = n / 129, jj = n % 129, dil = g == 0 ? 1 : g == 1 ? 4 : 16, idx = WINL + s - jj * dil;
            const float* kr = idx < WINL ? ck + ((size_t)(b * WINL + idx) * NH + h) * HD : out + O_KWS + ((size_t)(b * WINL + (WINL - SS) + idx - WINL) * NH + h) * HD;
            float d = 0.f;
#pragma unroll
            for (int c = 0; c < 16; ++c) { const f32x4 kv = *(const GAS f32x4*)(kr + 4 * c); const f32x4 qv = *(LAS const f32x4*)(qs + 4 * c); d += kv[0] * qv[0] + kv[1] * qv[1] + kv[2] * qv[2] + kv[3] * qv[3]; }
            sc[it] = d - slope2 * (float)(jj * dil); }
        mx = fmaxf(mx, sc[it]); }
#pragma unroll
    for (int o = 1; o < 64; o <<= 1) mx = fmaxf(mx, shx(mx, o, lane));
    float l = 0.f;
#pragma unroll
    for (int it = 0; it < 7; ++it) { const int n = it * 64 + lane; const float p = __builtin_amdgcn_exp2f(sc[it] - mx); if (n < 387) { ps[n] = p; l += p; } }
    l = wave_sum(l, lane);
    LDS_WAIT(); asm volatile("" ::: "memory");
    float o = 0.f;
    for (int n = 0; n < 387; ++n) { const int g = n / 129, jj = n % 129, dil = g == 0 ? 1 : g == 1 ? 4 : 16, idx = WINL + s - jj * dil;
        const float* vr = idx < WINL ? cv + ((size_t)(b * WINL + idx) * NH + h) * HD : out + O_VWS + ((size_t)(b * WINL + (WINL - SS) + idx - WINL) * NH + h) * HD;
        o += ps[n] * vr[lane]; }
    HEADS[(size_t)row * DM + h * 64 + lane] = (bf16)(cvtpk(o / l, 0.f) & 0xffffu);
}

__device__ __forceinline__ void attn_merge(const Ctx& C, const bf16* OG, const float* LSE, bf16* HEADS) {
    const int gt = C.vcu * (NWAVES * 64) + C.tid, NT = C.G * NWAVES * 64;
    for (int i = gt; i < MPR * 64; i += NT) { const int row = i >> 6, ch = i & 63, h = ch >> 3;
        float ls[3], mx = -INFINITY;
#pragma unroll
        for (int g = 0; g < 3; ++g) { ls[g] = LSE[((size_t)g * MPR + row) * NH + h]; mx = fmaxf(mx, ls[g]); }
        float w[3], ws = 0.f;
#pragma unroll
        for (int g = 0; g < 3; ++g) { w[g] = __builtin_amdgcn_exp2f(ls[g] - mx); ws += w[g]; }
        const float inv = __builtin_amdgcn_rcpf(ws);
        float acc[8] = {0.f, 0.f, 0.f, 0.f, 0.f, 0.f, 0.f, 0.f};
#pragma unroll
        for (int g = 0; g < 3; ++g) { const v4u v = *(const GAS v4u*)(OG + ((size_t)g * MPR + row) * CA + ch * 8); const float wg = w[g] * inv;
            acc[0] += wg * bflo(v.x); acc[1] += wg * bfhi(v.x); acc[2] += wg * bflo(v.y); acc[3] += wg * bfhi(v.y); acc[4] += wg * bflo(v.z); acc[5] += wg * bfhi(v.z); acc[6] += wg * bflo(v.w); acc[7] += wg * bfhi(v.w); }
        v4u o; o.x = cvtpk(acc[0], acc[1]); o.y = cvtpk(acc[2], acc[3]); o.z = cvtpk(acc[4], acc[5]); o.w = cvtpk(acc[6], acc[7]);
        *(GAS v4u*)(HEADS + (size_t)row * DM + ch * 8) = o; }
}

struct RwkvW { const float *mu, *k_k, *k_a, *r_k, *lnx_w, *lnx_b; };
struct RwkvTok { float nkk, ka, d, kp, r, v, bon; };
__device__ __forceinline__ RwkvTok rwkv_tok(float zr, float zk, float zv, float pr, float pk, float pv, float lam, float a, float mur, float muk, float muv, float kkw, float kaw, float rkw, int lane) {
    RwkvTok o;
    const float r = zr + (pr - zr) * mur, k = zk + (pk - zk) * muk, v = zv + (pv - zv) * muv;
    const float kkr = k * kkw; const float ss = wave_sum(kkr * kkr, lane);
    const float kk = kkr / fmaxf(sqrtf(ss), 1e-12f);
    const float kp = k * (1.0f + (a - 1.0f) * kaw);
    o.nkk = -kk; o.ka = kk * a; o.d = __builtin_amdgcn_exp2f(-lam * LOG2E); o.kp = kp; o.r = r; o.v = v; o.bon = wave_sum(r * kp * rkw, lane);
    return o;
}
__device__ __forceinline__ void rwkv_chunk(const Ctx& C, const bf16* ZB, const bf16* LAM, const bf16* AA, const RwkvW& W, float* YL, float* U, bf16* BV, float* PHI, float* SLOC, int b, int h, int c) {
    const int lane = C.lane;
    LAS float* tokb = (LAS float*)(C.lds + C.wave * 12288);
    float S[64], P[64];
#pragma unroll
    for (int j = 0; j < 64; ++j) { S[j] = 0.f; P[j] = (j == lane) ? 1.f : 0.f; }
    const int hc = h * 64 + lane;
    const float mur = W.mu[hc], muk = W.mu[512 + hc], muv = W.mu[1024 + hc], kkw = W.k_k[hc], kaw = W.k_a[hc], rkw = W.r_k[hc];
    const int t0 = c * CHL; const size_t row0 = (size_t)b * TSEQ + t0;
    float pr = 0.f, pk = 0.f, pv = 0.f;
    if (t0 > 0) { const bf16* zp = ZB + (row0 - 1) * DBIN + hc; pr = bf1(zp[0]); pk = bf1(zp[512]); pv = bf1(zp[1024]); }
    for (int sb = 0; sb < CHL / 8; ++sb) {
        float zr[8], zk[8], zv[8], lm[8], aa[8];
#pragma unroll
        for (int tt = 0; tt < 8; ++tt) { const size_t row = row0 + sb * 8 + tt; const bf16* zp = ZB + row * DBIN + hc;
            zr[tt] = bf1(zp[0]); zk[tt] = bf1(zp[512]); zv[tt] = bf1(zp[1024]); lm[tt] = bf1(LAM[row * CB + hc]); aa[tt] = bf1(AA[row * CB + hc]); }
#pragma unroll
        for (int tt = 0; tt < 8; ++tt) {
            const RwkvTok o = rwkv_tok(zr[tt], zk[tt], zv[tt], pr, pk, pv, lm[tt], aa[tt], mur, muk, muv, kkw, kaw, rkw, lane);
            pr = zr[tt]; pk = zk[tt]; pv = zv[tt];
            LAS float* tk = tokb + tt * 384;
            tk[lane] = o.nkk; tk[64 + lane] = o.ka; tk[128 + lane] = o.d; tk[192 + lane] = o.kp; tk[256 + lane] = o.r; tk[320 + lane] = o.v;
            BV[(row0 + sb * 8 + tt) * CB + hc] = (bf16)(cvtpk(o.bon * o.v, 0.f) & 0xffffu);
        }
        LDS_WAIT(); asm volatile("" ::: "memory");
#pragma unroll 1
        for (int tt = 0; tt < 8; ++tt) {
            LAS const float* tk = tokb + tt * 384;
            float sS0 = 0.f, sS1 = 0.f, sP0 = 0.f, sP1 = 0.f;
#pragma unroll
            for (int j4 = 0; j4 < 16; ++j4) { const f32x4 nk = *(LAS const f32x4*)(tk + 4 * j4);
                sS0 = fmaf(S[4 * j4], nk[0], sS0); sS1 = fmaf(S[4 * j4 + 1], nk[1], sS1); sS0 = fmaf(S[4 * j4 + 2], nk[2], sS0); sS1 = fmaf(S[4 * j4 + 3], nk[3], sS1);
                sP0 = fmaf(P[4 * j4], nk[0], sP0); sP1 = fmaf(P[4 * j4 + 1], nk[1], sP1); sP0 = fmaf(P[4 * j4 + 2], nk[2], sP0); sP1 = fmaf(P[4 * j4 + 3], nk[3], sP1); }
            const float saS = sS0 + sS1, saP = sP0 + sP1, vi = tk[320 + lane];
            float yS0 = 0.f, yS1 = 0.f, yP0 = 0.f, yP1 = 0.f;
#pragma unroll
            for (int j4 = 0; j4 < 16; ++j4) {
                const f32x4 ka = *(LAS const f32x4*)(tk + 64 + 4 * j4), d = *(LAS const f32x4*)(tk + 128 + 4 * j4), kp = *(LAS const f32x4*)(tk + 192 + 4 * j4), r = *(LAS const f32x4*)(tk + 256 + 4 * j4);
#pragma unroll
                for (int e = 0; e < 4; ++e) { const int j = 4 * j4 + e;
                    float t = vi * kp[e]; t = fmaf(saS, ka[e], t); S[j] = fmaf(S[j], d[e], t);
                    const float u = saP * ka[e]; P[j] = fmaf(P[j], d[e], u);
                    if (e & 1) { yS1 = fmaf(S[j], r[e], yS1); yP1 = fmaf(P[j], r[e], yP1); } else { yS0 = fmaf(S[j], r[e], yS0); yP0 = fmaf(P[j], r[e], yP0); } }
            }
            const size_t row = row0 + sb * 8 + tt;
            YL[row * CB + hc] = yS0 + yS1; U[row * CB + hc] = yP0 + yP1;
        }
    }
    float* so = SLOC + ((size_t)((b * NH + h) * NCHUNK + c) * 64 + lane) * 64;
    float* po = PHI + ((size_t)((b * NH + h) * NCHUNK + c) * 64 + lane) * 64;
#pragma unroll
    for (int j4 = 0; j4 < 16; ++j4) { *(GAS f32x4*)(so + 4 * j4) = (f32x4){S[4 * j4], S[4 * j4 + 1], S[4 * j4 + 2], S[4 * j4 + 3]}; *(GAS f32x4*)(po + 4 * j4) = (f32x4){P[4 * j4], P[4 * j4 + 1], P[4 * j4 + 2], P[4 * j4 + 3]}; }
}
__device__ __forceinline__ void rwkv_sample(const Ctx& C, const bf16* ZB, const bf16* LAM, const bf16* AA, const bf16* G, const RwkvW& W, const float* state_wkv, const float* state_shift, bf16* HEADS, float* out) {
    if (C.vcu >= SB * NH || C.wave != 0) return;
    const int b = C.vcu >> 3, h = C.vcu & 7, lane = C.lane, hc = h * 64 + lane;
    LAS float* tk = (LAS float*)(C.lds + 98304);
    LAS float* Sl = (LAS float*)(C.lds + 98304 + 2048) + lane * 65;
    const float* s0 = state_wkv + ((size_t)(b * NH + h) * 64 + lane) * 64;
#pragma unroll 4
    for (int j = 0; j < 64; ++j) Sl[j] = s0[j];
    float pr = state_shift[(size_t)b * DBIN + hc], pk = state_shift[(size_t)b * DBIN + 512 + hc], pv = state_shift[(size_t)b * DBIN + 1024 + hc];
#pragma unroll 1
    for (int s = 0; s < SS; ++s) {
        const size_t row = (size_t)MPR + b * SS + s; const bf16* zp = ZB + row * DBIN + hc;
        const float zr = bf1(zp[0]), zk = bf1(zp[512]), zv = bf1(zp[1024]);
        const RwkvTok o = rwkv_tok(zr, zk, zv, pr, pk, pv, bf1(LAM[row * CB + hc]), bf1(AA[row * CB + hc]), W.mu[hc], W.mu[512 + hc], W.mu[1024 + hc], W.k_k[hc], W.k_a[hc], W.r_k[hc], lane);
        pr = zr; pk = zk; pv = zv;
        tk[lane] = o.nkk; tk[64 + lane] = o.ka; tk[128 + lane] = o.d; tk[192 + lane] = o.kp; tk[256 + lane] = o.r;
        LDS_WAIT(); asm volatile("" ::: "memory");
        float sa = 0.f;
#pragma unroll 4
        for (int j = 0; j < 64; ++j) sa = fmaf(Sl[j], tk[j], sa);
        float y = 0.f;
#pragma unroll 4
        for (int j = 0; j < 64; ++j) { float t = o.v * tk[192 + j]; t = fmaf(sa, tk[64 + j], t); const float sn = fmaf(Sl[j], tk[128 + j], t); Sl[j] = sn; y = fmaf(sn, tk[256 + j], y); }
        const float ym = wave_sum(y, lane) * (1.0f / 64.0f), dy = y - ym, yv = wave_sum(dy * dy, lane) * (1.0f / 64.0f);
        const float yn = dy * __builtin_amdgcn_rsqf(yv + GN_EPS) * W.lnx_w[hc] + W.lnx_b[hc];
        const float res = (yn + o.bon * o.v) * bf1(G[row * CB + hc]);
        HEADS[row * DM + CA + hc] = (bf16)(cvtpk(res, 0.f) & 0xffffu);
        LDS_WAIT(); asm volatile("" ::: "memory");
    }
    float* so = out + O_WKVS + ((size_t)(b * NH + h) * 64 + lane) * 64;
#pragma unroll 4
    for (int j = 0; j < 64; ++j) so[j] = Sl[j];
}

__device__ __forceinline__ void rwkv_carry(const Ctx& C, const float* PHI, const float* SLOC, float* SC, float* out) {
    const int bh = C.vcu >> 2, rq = C.vcu & 3, tid = C.tid;
    if (bh >= NBATCH * NH) return;
    LAS float* cur = (LAS float*)(C.lds);
    LAS float* phi = (LAS float*)(C.lds + 4096);
    const int row = tid >> 5, cp = tid & 31;
    for (int i = tid; i < 1024; i += 512) cur[i] = 0.f;
    f32x4 pre[2];
    { const float* p0 = PHI + (size_t)(bh * NCHUNK) * 4096; pre[0] = *(const GAS f32x4*)(p0 + tid * 4); pre[1] = *(const GAS f32x4*)(p0 + 2048 + tid * 4); }
    for (int c = 0; c < NCHUNK; ++c) {
        __syncthreads();
        *(LAS f32x4*)(phi + tid * 4) = pre[0]; *(LAS f32x4*)(phi + 2048 + tid * 4) = pre[1];
        if (c + 1 < NCHUNK) { const float* p1 = PHI + (size_t)(bh * NCHUNK + c + 1) * 4096; pre[0] = *(const GAS f32x4*)(p1 + tid * 4); pre[1] = *(const GAS f32x4*)(p1 + 2048 + tid * 4); }
        const size_t go = ((size_t)(bh * NCHUNK + c) * 64 + rq * 16 + row) * 64 + 2 * cp;
        const f32x2_t sl = *(const GAS f32x2_t*)(SLOC + go);
        const f32x2_t cv = *(LAS const f32x2_t*)(cur + row * 64 + 2 * cp);
        *(GAS f32x2_t*)(SC + go) = cv;
        __syncthreads();
        float a0 = sl[0], a1 = sl[1];
#pragma unroll 4
        for (int k4 = 0; k4 < 16; ++k4) { const f32x4 cr = *(LAS const f32x4*)(cur + row * 64 + 4 * k4);
#pragma unroll
            for (int e = 0; e < 4; ++e) { const f32x2_t ph = *(LAS const f32x2_t*)(phi + (4 * k4 + e) * 64 + 2 * cp); a0 = fmaf(cr[e], ph[0], a0); a1 = fmaf(cr[e], ph[1], a1); } }
        __syncthreads();
        *(LAS f32x2_t*)(cur + row * 64 + 2 * cp) = (f32x2_t){a0, a1};
    }
    __syncthreads();
    const f32x2_t fin = *(LAS const f32x2_t*)(cur + row * 64 + 2 * cp);
    *(GAS f32x2_t*)(out + O_WKVP + ((size_t)bh * 64 + rq * 16 + row) * 64 + 2 * cp) = fin;
    __syncthreads();
}

__device__ __forceinline__ void rwkv_finish(const Ctx& C, const float* YL, const float* U, const float* SC, const bf16* BV, const bf16* G, const RwkvW& W, bf16* HEADS) {
    const int tid = C.tid;
    LAS float* spT = (LAS float*)(C.lds);
    LAS float* ut = (LAS float*)(C.lds + 16384);
    const int tok = tid >> 2, iq = tid & 3;
    for (int it = 0; it < 8; ++it) {
        const int item = C.vcu * 8 + it, bh = item >> 5, c = item & 31, b = bh >> 3, h = bh & 7;
        if (bh >= NBATCH * NH) break;
        const float* sc = SC + (size_t)(bh * NCHUNK + c) * 4096;
        for (int e = tid; e < 4096; e += 512) { const int i = e >> 6, j = e & 63; spT[j * 64 + i] = sc[e]; }
        const size_t row0 = (size_t)b * TSEQ + c * CHL;
        for (int e = tid; e < CHL * 16; e += 512) { const int t = e >> 4, j4 = e & 15; *(LAS f32x4*)(ut + t * 64 + 4 * j4) = *(const GAS f32x4*)(U + (row0 + t) * CB + h * 64 + 4 * j4); }
        __syncthreads();
        const size_t row = row0 + tok; const int hc = h * 64 + 16 * iq;
        float y[16];
#pragma unroll
        for (int q = 0; q < 4; ++q) { const f32x4 v = *(const GAS f32x4*)(YL + row * CB + hc + 4 * q); y[4 * q] = v[0]; y[4 * q + 1] = v[1]; y[4 * q + 2] = v[2]; y[4 * q + 3] = v[3]; }
#pragma unroll 4
        for (int j = 0; j < 64; ++j) { const float u = ut[tok * 64 + j];
#pragma unroll
            for (int q = 0; q < 4; ++q) { const f32x4 s4 = *(LAS const f32x4*)(spT + j * 64 + 16 * iq + 4 * q); y[4 * q] = fmaf(s4[0], u, y[4 * q]); y[4 * q + 1] = fmaf(s4[1], u, y[4 * q + 1]); y[4 * q + 2] = fmaf(s4[2], u, y[4 * q + 2]); y[4 * q + 3] = fmaf(s4[3], u, y[4 * q + 3]); } }
        float sm = 0.f;
#pragma unroll
        for (int e = 0; e < 16; ++e) sm += y[e];
        sm += shx(sm, 1, C.lane); sm += shx(sm, 2, C.lane);
        const float ym = sm * (1.0f / 64.0f); float sv = 0.f;
#pragma unroll
        for (int e = 0; e < 16; ++e) { y[e] -= ym; sv += y[e] * y[e]; }
        sv += shx(sv, 1, C.lane); sv += shx(sv, 2, C.lane);
        const float rs = __builtin_amdgcn_rsqf(sv * (1.0f / 64.0f) + GN_EPS);
        const v4u bw0 = *(const GAS v4u*)(BV + row * CB + hc), bw1 = *(const GAS v4u*)(BV + row * CB + hc + 8);
        const v4u gw0 = *(const GAS v4u*)(G + row * CB + hc), gw1 = *(const GAS v4u*)(G + row * CB + hc + 8);
        const unsigned bwv[8] = {bw0.x, bw0.y, bw0.z, bw0.w, bw1.x, bw1.y, bw1.z, bw1.w}, gwv[8] = {gw0.x, gw0.y, gw0.z, gw0.w, gw1.x, gw1.y, gw1.z, gw1.w};
        unsigned ow[8];
#pragma unroll
        for (int q = 0; q < 8; ++q) {
            const float r0 = (y[2 * q] * rs * W.lnx_w[hc + 2 * q] + W.lnx_b[hc + 2 * q] + bflo(bwv[q])) * bflo(gwv[q]);
            const float r1 = (y[2 * q + 1] * rs * W.lnx_w[hc + 2 * q + 1] + W.lnx_b[hc + 2 * q + 1] + bfhi(bwv[q])) * bfhi(gwv[q]);
            ow[q] = cvtpk(r0, r1); }
        *(GAS v4u*)(HEADS + row * DM + CA + hc) = (v4u){ow[0], ow[1], ow[2], ow[3]};
        *(GAS v4u*)(HEADS + row * DM + CA + hc + 8) = (v4u){ow[4], ow[5], ow[6], ow[7]};
        __syncthreads();
    }
}

template <int MODE> __device__ __forceinline__ void ln_pass(const Ctx& C, const float* PRE, const float* w, const float* bsh, bf16* Hout, float* out) {
    const int gw = C.vcu * NWAVES + C.wave, NGW = C.G * NWAVES, lane = C.lane;
    f32x4 wv[4], bv[4];
#pragma unroll
    for (int j = 0; j < 4; ++j) { wv[j] = *(const GAS f32x4*)(w + 256 * j + 4 * lane); bv[j] = *(const GAS f32x4*)(bsh + 256 * j + 4 * lane); }
    for (int row = gw; row < MPR + MSA; row += NGW) {
        const GAS f32x4* xr = (const GAS f32x4*)(PRE + (size_t)row * DM) + lane;
        f32x4 v[4]; float s = 0.f;
#pragma unroll
        for (int j = 0; j < 4; ++j) { v[j] = xr[64 * j]; s += (v[j][0] + v[j][1]) + (v[j][2] + v[j][3]); }
        const float mean = wave_sum(s, lane) * (1.f / DM); float s2 = 0.f;
#pragma unroll
        for (int j = 0; j < 4; ++j) { v[j] = v[j] - mean; s2 += (v[j][0] * v[j][0] + v[j][1] * v[j][1]) + (v[j][2] * v[j][2] + v[j][3] * v[j][3]); }
        const float rstd = __builtin_amdgcn_rsqf(wave_sum(s2, lane) * (1.f / DM) + LN_EPS);
        if (MODE == 0) {
            GAS u32x2* o8 = (GAS u32x2*)(Hout + (size_t)row * DM) + lane;
#pragma unroll
            for (int j = 0; j < 4; ++j) { const f32x4 o = v[j] * rstd * wv[j] + bv[j]; u32x2 wq; wq.x = cvtpk(o[0], o[1]); wq.y = cvtpk(o[2], o[3]); o8[64 * j] = wq; }
        } else {
            float* dst = row < MPR ? out + O_YP + (size_t)row * DM : out + O_YS + (size_t)(row - MPR) * DM;
#pragma unroll
            for (int j = 0; j < 4; ++j) *((GAS f32x4*)dst + lane + 64 * j) = v[j] * rstd * wv[j] + bv[j];
        }
    }
}
struct Args { const float* in[32]; float* out; unsigned char* ws; int nphase, pad; };
#ifndef PHMASK
#define PHMASK 0xFFFFFF
#endif
#define PHON(n) if constexpr (((PHMASK) >> (n)) & 1)
#ifndef GEMM_ALIGN
#define GEMM_ALIGN true
#endif
#ifndef GEMM_SP2
#define GEMM_SP2 true
#endif
__global__ void __launch_bounds__(NWAVES * 64, 2) mega_fwd(Args args) {
    extern __shared__ __attribute__((aligned(16))) unsigned char lds_raw[];
    LAS unsigned char* const lds0 = (LAS unsigned char*)lds_raw;
    volatile LAS unsigned* MISC = (volatile LAS unsigned*)(lds0 + MISC_OFF);
    const int G0 = gridDim.x;
    for (int u = threadIdx.x; u < (LDS_BYTES - LDSCTL_OFF) / 4; u += NWAVES * 64) ((LAS unsigned*)(lds0 + LDSCTL_OFF))[u] = 0u;
    __syncthreads();
    gu32* ctl = (gu32*)(args.ws + WS_CTL);
    XcdBarrier bar = xcd_barrier_post((unsigned*)(ctl + CW_BAR), MISC + 8);
    const int nph = args.nphase;
#define GRID_BAR() xcd_barrier(bar)
    typedef const __attribute__((address_space(4))) Args* KArgs;
#define PH_BEGIN Ctx C; { int t_ = threadIdx.x; asm volatile("" : "+v"(t_)); C.lds = lds0; C.tid = t_; C.lane = t_ & 63; C.wave = __builtin_amdgcn_readfirstlane(t_ >> 6); C.G = G0; const int bx_ = blockIdx.x; C.vcu = (G0 % 8 == 0) ? (bx_ % 8) * (G0 / 8) + bx_ / 8 : bx_; } KArgs kp = (KArgs)__builtin_amdgcn_kernarg_segment_ptr(); asm volatile("" : "+s"(kp)); unsigned char* ws = kp->ws; float* out = kp->out; (void)ws; (void)out;
#define IN_(i) (kp->in[i])
#define WSB(off) ((bf16*)(ws + (off)))
#define WSF(off) ((float*)(ws + (off)))
    const int bx = (int)blockIdx.x;

    PHON(0) { PH_BEGIN P0Args A{IN_(0), IN_(1), IN_(2), IN_(3), IN_(4), IN_(5), IN_(8), IN_(20), IN_(23), IN_(24), IN_(25), IN_(28), IN_(29), IN_(11), IN_(13), IN_(14),
                       WSB(WS_WIN), WSB(WS_WOUT), WSB(WS_WGU), WSB(WS_WD), WSB(WS_WPG), WSB(WS_WPP), WSB(WS_WL), WSB(WS_R1), WSB(WS_PB), out};
      p0_prologue(C, A); }
    GRID_BAR(); if (nph <= 1) return;
    PHON(1) { PH_BEGIN pg8::Gemm g{WSB(WS_R1), WSB(WS_WIN), MT, DIN, DM}; pg8::StaticOrder S; S.init(MT, DIN, C.G, bx);
      pg8::EpiZ E{WSB(WS_QB), WSB(WS_ZB), out};
      pg8::gemm_phase<pg8::EpiZ, pg8::StaticOrder, GEMM_ALIGN, GEMM_SP2>(C.lds + RING_OFF, g, S, E); }
    GRID_BAR(); if (nph <= 2) return;
    PHON(2) { PH_BEGIN prep_a(C, WSB(WS_ZB), IN_(9), IN_(7), WSB(WS_AP), out); }
    PHON(3) { PH_BEGIN attn_prompt(C, WSB(WS_QB), WSB(WS_KB), WSB(WS_VB), WSB(WS_OG), WSF(WS_LSE)); }
    PHON(4) { PH_BEGIN attn_sample(C, WSB(WS_QB), IN_(4), IN_(5), out, WSB(WS_R1)); }
    GRID_BAR(); if (nph <= 3) return;
    PHON(5) { PH_BEGIN pg8::Gemm g{WSB(WS_AP), WSB(WS_WL), MT, 1536, 256}; pg8::StaticOrder S; S.init(MT, 1536, C.G, bx);
      pg8::EpiLora E{WSB(WS_QB), IN_(10), IN_(12)};
      pg8::gemm_phase<pg8::EpiLora, pg8::StaticOrder, GEMM_ALIGN, GEMM_SP2>(C.lds + RING_OFF, g, S, E); }
    PHON(6) { PH_BEGIN attn_merge(C, WSB(WS_OG), WSF(WS_LSE), WSB(WS_R1)); }
    GRID_BAR(); if (nph <= 4) return;
    PHON(7) { PH_BEGIN const RwkvW RW{IN_(9), IN_(15), IN_(16), IN_(17), IN_(18), IN_(19)};
      rwkv_sample(C, WSB(WS_ZB), WSB(WS_QB), WSB(WS_KB), WSB(WS_VB), RW, IN_(6), IN_(7), WSB(WS_R1), out); }
    PHON(8) { PH_BEGIN const RwkvW RW{IN_(9), IN_(15), IN_(16), IN_(17), IN_(18), IN_(19)};
      const int bh = C.vcu >> 2, c = (C.vcu & 3) * 8 + C.wave;
      if (bh < NBATCH * NH) rwkv_chunk(C, WSB(WS_ZB), WSB(WS_QB), WSB(WS_KB), RW, out + O_YP, out + O_YP + (size_t)MPR * CB, WSB(WS_BV), WSF(WS_PHI), WSF(WS_SLOC), bh >> 3, bh & 7, c); }
    GRID_BAR(); if (nph <= 5) return;
    PHON(9) { PH_BEGIN rwkv_carry(C, WSF(WS_PHI), WSF(WS_SLOC), WSF(WS_SC), out); }
    GRID_BAR(); if (nph <= 6) return;
    PHON(10) { PH_BEGIN const RwkvW RW{IN_(9), IN_(15), IN_(16), IN_(17), IN_(18), IN_(19)};
      rwkv_finish(C, out + O_YP, out + O_YP + (size_t)MPR * CB, WSF(WS_SC), WSB(WS_BV), WSB(WS_VB), RW, WSB(WS_R1)); }
    GRID_BAR(); if (nph <= 7) return;
    PHON(11) { PH_BEGIN pg8::Gemm g{WSB(WS_R1), WSB(WS_WOUT), MT, DM, DM}; pg8::StaticOrder S; S.init(MT, DM, C.G, bx);
      pg8::EpiWout E{WSF(WS_PRE), IN_(0), IN_(1)};
      pg8::gemm_phase<pg8::EpiWout, pg8::StaticOrder, GEMM_ALIGN, GEMM_SP2>(C.lds + RING_OFF, g, S, E); }
    GRID_BAR(); if (nph <= 8) return;
    PHON(12) { PH_BEGIN ln_pass<0>(C, WSF(WS_PRE), IN_(21), IN_(22), WSB(WS_R1), out); }
    GRID_BAR(); if (nph <= 9) return;
    PHON(13) { PH_BEGIN pg8::Gemm g{WSB(WS_R1), WSB(WS_WGU), MT, 2 * DFF, DM}; pg8::StaticOrder S; S.init(MT, 2 * DFF, C.G, bx);
      pg8::EpiGU E{WSB(WS_ACT)};
      pg8::gemm_phase<pg8::EpiGU, pg8::StaticOrder, GEMM_ALIGN, GEMM_SP2>(C.lds + RING_OFF, g, S, E); }
    GRID_BAR(); if (nph <= 10) return;
    PHON(14) { PH_BEGIN pg8::Gemm g{WSB(WS_ACT), WSB(WS_WD), MT, DM, DFF}; pg8::StaticOrder S; S.init(MT, DM, C.G, bx);
      pg8::EpiDown E{WSF(WS_PRE), WSB(WS_R1)};
      pg8::gemm_phase<pg8::EpiDown, pg8::StaticOrder, GEMM_ALIGN, GEMM_SP2>(C.lds + RING_OFF, g, S, E); }
    GRID_BAR(); if (nph <= 11) return;
    PHON(15) { PH_BEGIN ln_pass<0>(C, WSF(WS_PRE), IN_(26), IN_(27), WSB(WS_H2), out); }
    GRID_BAR(); if (nph <= 12) return;
    PHON(16) { PH_BEGIN pg8::Gemm g{WSB(WS_PB), WSB(WS_WPP), MT, DM, PLE}; pg8::StaticOrder S; S.init(MT, DM, C.G, bx);
      pg8::EpiPlain E{WSB(WS_PP)};
      pg8::gemm_phase<pg8::EpiPlain, pg8::StaticOrder, GEMM_ALIGN, GEMM_SP2>(C.lds + RING_OFF, g, S, E); }
    GRID_BAR(); if (nph <= 13) return;
    PHON(17) { PH_BEGIN pg8::Gemm g{WSB(WS_H2), WSB(WS_WPG), MT, DM, DM}; pg8::StaticOrder S; S.init(MT, DM, C.G, bx);
      pg8::EpiPle E{WSF(WS_PRE), WSB(WS_H2), WSB(WS_PP)};
      pg8::gemm_phase<pg8::EpiPle, pg8::StaticOrder, GEMM_ALIGN, GEMM_SP2>(C.lds + RING_OFF, g, S, E); }
    GRID_BAR(); if (nph <= 14) return;
    PHON(18) { PH_BEGIN ln_pass<1>(C, WSF(WS_PRE), IN_(30), IN_(31), nullptr, out); }
}

#ifndef N_PHASES
#define N_PHASES 99
#endif
extern "C" void kernel_launch(void* const* d_in, const int* in_sizes, int n_in, void* d_out, int out_size, void* d_ws, size_t ws_size, hipStream_t stream) {
    static int grid = 0;
    if (grid == 0) {
        if (n_in != 32 || in_sizes[0] != MPR * DM || (size_t)out_size != O_END || ws_size < WS_END) {
            fprintf(stderr, "kernel_launch: unexpected shapes: n_in %d in0 %d out %d (want %zu) ws %zu (want >= %zu); nothing launched\n", n_in, n_in > 0 ? in_sizes[0] : -1, out_size, (size_t)O_END, ws_size, (size_t)WS_END);
            grid = -1; return; }
        int dev = 0, cus = 0, per_cu = 0;
        if (hipGetDevice(&dev) != hipSuccess || hipDeviceGetAttribute(&cus, hipDeviceAttributeMultiprocessorCount, dev) != hipSuccess) { fprintf(stderr, "kernel_launch: device query failed\n"); grid = -1; return; }
        if (hipFuncSetAttribute((const void*)mega_fwd, hipFuncAttributeMaxDynamicSharedMemorySize, LDS_BYTES) != hipSuccess) { fprintf(stderr, "kernel_launch: hipFuncSetAttribute failed\n"); grid = -1; return; }
        if (hipOccupancyMaxActiveBlocksPerMultiprocessor(&per_cu, (const void*)mega_fwd, NWAVES * 64, LDS_BYTES) != hipSuccess || per_cu < 1) { fprintf(stderr, "kernel_launch: occupancy query reports %d blocks per CU\n", per_cu); }
        (void)hipGetLastError();
        grid = cus;
        if (grid != 256) fprintf(stderr, "kernel_launch: note: %d CUs (work distribution assumes 256)\n", grid);
    }
    if (grid < 0) return;
    if (hipMemsetAsync((char*)d_ws + WS_CTL, 0, CTL_ZERO_BYTES, stream) != hipSuccess) { fprintf(stderr, "kernel_launch: memset failed\n"); return; }
    Args a{};
    for (int i = 0; i < 32; ++i) a.in[i] = (const float*)d_in[i];
    a.out = (float*)d_out; a.ws = (unsigned char*)d_ws; a.nphase = N_PHASES; a.pad = 0;
    hipLaunchKernelGGL(mega_fwd, dim3(grid), dim3(NWAVES * 64), LDS_BYTES, stream, a);
    const hipError_t le = hipPeekAtLastError();
    if (le != hipSuccess) fprintf(stderr, "kernel_launch: launch failed: %s\n", hipGetErrorName(le));
}
```

```cpp
#include <hip/hip_runtime.h>
#include <cstdio>
#include <cstdint>
constexpr int DM = 1024, TSEQ = 4096, NBATCH = 8, MPR = NBATCH * TSEQ;
constexpr int SB = 32, SS = 4, MSA = SB * SS;
constexpr int MT = MPR + 256;
constexpr int CA = 512, CB = 512, DBIN = 1792, DIN = 3328, DFF = 2816, PLE = 256, HD = 64, NH = 8;
constexpr int WINL = 2048;
constexpr float ALPHA = 1.18920711500272f;
constexpr float LN_EPS = 1e-5f, GN_EPS = 64e-5f;
constexpr float QSCALE = 0.125f * 1.4426950408889634f;
constexpr float LOG2E = 1.4426950408889634f;
constexpr size_t O_YP = 0, O_YS = O_YP + (size_t)MPR * DM, O_KWP = O_YS + (size_t)MSA * DM, O_VWP = O_KWP + (size_t)NBATCH * WINL * CA,
                 O_WKVP = O_VWP + (size_t)NBATCH * WINL * CA, O_SHP = O_WKVP + (size_t)NBATCH * NH * HD * HD, O_KWS = O_SHP + (size_t)NBATCH * DBIN,
                 O_VWS = O_KWS + (size_t)SB * WINL * CA, O_WKVS = O_VWS + (size_t)SB * WINL * CA, O_SHS = O_WKVS + (size_t)SB * NH * HD * HD,
                 O_END = O_SHS + (size_t)SB * DBIN;
namespace pg8 {
#define PG8_LAS __attribute__((address_space(3)))
typedef unsigned short bf16_t;
typedef short bf16x8 __attribute__((ext_vector_type(8)));
typedef float f32x4 __attribute__((ext_vector_type(4)));
typedef unsigned u32x4 __attribute__((ext_vector_type(4)));
constexpr int BM = 256, BK = 64, HALF = 128, HTB = HALF * BK * 2  , STAGE_BYTES = 8 * HTB, NXCD = 8, WGM = 8;

__host__ __device__ __forceinline__ int lds_byte(int r, int c) { const int st = (r >> 4) * 2 + (c >> 5), rr = r & 15, cc = c & 31, ob = rr * 64 + cc * 2; return st * 1024 + (ob ^ (((ob >> 9) & 1) << 5)); }
__host__ __device__ __forceinline__ void stage_rc(int b, int& R, int& C) { const int st = b / 1024, sb = b % 1024, swz = sb ^ (((sb >> 9) & 1) << 5); R = (st >> 1) * 16 + swz / 64; C = (st & 1) * 32 + (swz % 64) / 2; }
__host__ __device__ __forceinline__ int perm32(int rho) { const int n = rho >> 4, i = rho & 15; return 8 * (i >> 2) + 4 * n + (i & 3); }

struct Unit { int pm, pn; };
struct Gemm { const bf16_t* A; const bf16_t* Bt; int M, N, K; };

struct StaticOrder {
    int nM, nN, nwg, G, c;
    __host__ __device__ void init(int M, int N, int G_, int c_) { nM = M / BM; nN = N / BM; nwg = nM * nN; G = G_; c = c_; }
    __host__ __device__ bool next(int i, Unit& u) const {
        const long L = (long)i * G + c; if (L >= nwg) return false;
        int wgid = (int)L; { const int q = nwg / NXCD, r = nwg % NXCD, xcd = wgid % NXCD, off = wgid / NXCD; wgid = (xcd < r ? xcd * (q + 1) : r * (q + 1) + (xcd - r) * q) + off; }
        const int nig = WGM * nN, gid = wgid / nig, fm = gid * WGM, gsz = (nM - fm) < WGM ? (nM - fm) : WGM;
        u.pm = fm + ((wgid % nig) % gsz); u.pn = (wgid % nig) / gsz; return true;
    }
    __device__ __forceinline__ void a_ready(const Unit&) const {}
    __device__ __forceinline__ void done(const Unit&) const {}
};

typedef unsigned u32x2 __attribute__((ext_vector_type(2)));
__device__ __forceinline__ unsigned cvt_pk_bf16(float lo, float hi) { unsigned r; asm volatile("v_cvt_pk_bf16_f32 %0, %1, %2" : "=v"(r) : "v"(lo), "v"(hi)); return r; }
__device__ __forceinline__ float bf_lo(unsigned w) { return __uint_as_float(w << 16); }
__device__ __forceinline__ float bf_hi(unsigned w) { return __uint_as_float(w & 0xffff0000u); }
__device__ __forceinline__ float sigmoidf_(float x) { return __builtin_amdgcn_rcpf(1.0f + __builtin_amdgcn_exp2f(-x * 1.4426950408889634f)); }
__device__ __forceinline__ u32x4 pack8(const f32x4& a, const f32x4& b) { u32x4 w; w.x = cvt_pk_bf16(a[0], a[1]); w.y = cvt_pk_bf16(a[2], a[3]); w.z = cvt_pk_bf16(b[0], b[1]); w.w = cvt_pk_bf16(b[2], b[3]); return w; }

struct EpiZ {
    static constexpr bool PERM = true, AFTER_DRAIN = false;
    bf16_t *QB, *ZB; float* out;
    __device__ __forceinline__ void operator()(const f32x4 (&acc)[2][2][4][2], const Unit& u, int wr, int wc, int fr, int fq) const {
        const int pn = u.pn, pm = u.pm;
        const int kind = pn < 6 ? (pn >> 1) : 3;
        bf16_t* dst = kind == 3 ? ZB : QB + (size_t)kind * ((size_t)MT * CA);
        const int ld = kind == 3 ? DBIN : CA;
        const int col0 = (kind == 3 ? (pn - 6) * 256 : (pn & 1) * 256) + wc * 32 + 8 * fq;
        const float sc = kind == 0 ? QSCALE : 1.0f;
        const int rbase = pm * BM + wr * 64 + fr;
        const bool win_p = (kind == 1 || kind == 2) && pm < 128 && (pm & 15) >= 8;
        const bool win_s = (kind == 1 || kind == 2) && pm == 128;
        float* wout = out + (win_s ? O_KWS : O_KWP) + (kind == 2 ? (win_s ? (O_VWS - O_KWS) : (O_VWP - O_KWP)) : (size_t)0);
#pragma unroll
        for (int ai = 0; ai < 2; ++ai)
#pragma unroll
            for (int m = 0; m < 4; ++m) {
                const int row = rbase + ai * HALF + m * 16;
                bf16_t* rowp = dst + (size_t)row * ld + col0;
#pragma unroll
                for (int bj = 0; bj < 2; ++bj) {
                    const f32x4 v0 = acc[ai][bj][m][0] * sc, v1 = acc[ai][bj][m][1] * sc;
                    *(u32x4*)(rowp + bj * HALF) = pack8(v0, v1);
                    if (win_p) {
                        const int b = pm >> 4, t = (pm & 15) * 256 + (row & 255);
                        float* o = wout + ((size_t)(b * WINL + t - WINL) * CA + col0 + bj * HALF);
                        *(f32x4*)o = v0; *(f32x4*)(o + 4) = v1;
                    } else if (win_s && ai == 0) {
                        const int rs = row - MPR, b = rs >> 2, s = rs & 3;
                        float* o = wout + ((size_t)(b * WINL + (WINL - SS) + s) * CA + col0 + bj * HALF);
                        *(f32x4*)o = v0; *(f32x4*)(o + 4) = v1;
                    }
                }
            }
    }
};

struct EpiLora {
    static constexpr bool PERM = true, AFTER_DRAIN = false;
    bf16_t *LAM; const float *w0, *a0;
    __device__ __forceinline__ void operator()(const f32x4 (&acc)[2][2][4][2], const Unit& u, int wr, int wc, int fr, int fq) const {
        const int kind = u.pn >> 1;
        bf16_t* dst = LAM + (size_t)kind * ((size_t)MT * CB);
        const int col0 = (u.pn & 1) * 256 + wc * 32 + 8 * fq;
        const float* bias = kind == 0 ? w0 : a0;
        const float mul = kind == 0 ? 0.6065306597126334f : 1.0f;
        const int rbase = u.pm * BM + wr * 64 + fr;
#pragma unroll
        for (int bj = 0; bj < 2; ++bj) {
            f32x4 b0 = {0.f, 0.f, 0.f, 0.f}, b1 = b0;
            if (kind < 2) { b0 = *(const f32x4*)(bias + col0 + bj * HALF); b1 = *(const f32x4*)(bias + col0 + bj * HALF + 4); }
#pragma unroll
            for (int ai = 0; ai < 2; ++ai)
#pragma unroll
                for (int m = 0; m < 4; ++m) {
                    f32x4 v0 = acc[ai][bj][m][0] + b0, v1 = acc[ai][bj][m][1] + b1;
                    if (kind < 2) {
#pragma unroll
                        for (int e = 0; e < 4; ++e) { v0[e] = mul * sigmoidf_(v0[e]); v1[e] = mul * sigmoidf_(v1[e]); }
                    }
                    *(u32x4*)(dst + (size_t)(rbase + ai * HALF + m * 16) * CB + col0 + bj * HALF) = pack8(v0, v1);
                    asm volatile("" ::: "memory");
                }
        }
    }
};

__device__ __forceinline__ f32x4 xres4(const float* xp, const float* xs, int row, int col) {
    if (row < MPR) return *(const f32x4*)(xp + (size_t)row * DM + col);
    if (row < MPR + MSA) return *(const f32x4*)(xs + (size_t)(row - MPR) * DM + col);
    return (f32x4){0.f, 0.f, 0.f, 0.f};
}
struct EpiWout {
    static constexpr bool PERM = false, AFTER_DRAIN = false;
    float* PRE; const float *xp, *xs;
    __device__ __forceinline__ void operator()(const f32x4 (&acc)[2][2][4][2], const Unit& u, int wr, int wc, int fr, int fq) const {
        const int row0 = u.pm * BM + wr * 64 + fr, col0 = u.pn * BM + wc * 32 + 4 * fq;
#pragma unroll
        for (int ai = 0; ai < 2; ++ai)
#pragma unroll
            for (int m = 0; m < 4; ++m) { const int row = row0 + ai * HALF + m * 16; float* rowp = PRE + (size_t)row * DM + col0;
#pragma unroll
                for (int bj = 0; bj < 2; ++bj)
#pragma unroll
                    for (int n = 0; n < 2; ++n) { const f32x4 xr = xres4(xp, xs, row, col0 + bj * HALF + n * 16); *(f32x4*)(rowp + bj * HALF + n * 16) = acc[ai][bj][m][n] + xr * ALPHA; } }
    }
};
struct EpiGU {
    static constexpr bool PERM = true, AFTER_DRAIN = false;
    bf16_t* ACT;
    __device__ __forceinline__ void operator()(const f32x4 (&acc)[2][2][4][2], const Unit& u, int wr, int wc, int fr, int fq) const {
        const int row0 = u.pm * BM + wr * 64 + fr, col0 = u.pn * HALF + wc * 32 + 8 * fq;
#pragma unroll
        for (int ai = 0; ai < 2; ++ai)
#pragma unroll
            for (int m = 0; m < 4; ++m) {
                f32x4 o[2];
#pragma unroll
                for (int n = 0; n < 2; ++n)
#pragma unroll
                    for (int e = 0; e < 4; ++e) { const float g = acc[ai][0][m][n][e], up = acc[ai][1][m][n][e]; o[n][e] = g * sigmoidf_(g) * up; }
                *(u32x4*)(ACT + (size_t)(row0 + ai * HALF + m * 16) * DFF + col0) = pack8(o[0], o[1]);
            }
    }
};
struct EpiDown {
    static constexpr bool PERM = false, AFTER_DRAIN = false;
    float* PRE; const bf16_t* H;
    __device__ __forceinline__ void operator()(const f32x4 (&acc)[2][2][4][2], const Unit& u, int wr, int wc, int fr, int fq) const {
        const int row0 = u.pm * BM + wr * 64 + fr, col0 = u.pn * BM + wc * 32 + 4 * fq;
#pragma unroll
        for (int ai = 0; ai < 2; ++ai)
#pragma unroll
            for (int m = 0; m < 4; ++m) { const size_t off = (size_t)(row0 + ai * HALF + m * 16) * DM + col0;
#pragma unroll
                for (int bj = 0; bj < 2; ++bj)
#pragma unroll
                    for (int n = 0; n < 2; ++n) { const u32x2 hw = *(const u32x2*)(H + off + bj * HALF + n * 16);
                        const f32x4 hr = (f32x4){bf_lo(hw.x), bf_hi(hw.x), bf_lo(hw.y), bf_hi(hw.y)};
                        *(f32x4*)(PRE + off + bj * HALF + n * 16) = acc[ai][bj][m][n] + hr * ALPHA; } }
    }
};
struct EpiPlain {
    static constexpr bool PERM = true, AFTER_DRAIN = false;
    bf16_t* O;
    __device__ __forceinline__ void operator()(const f32x4 (&acc)[2][2][4][2], const Unit& u, int wr, int wc, int fr, int fq) const {
        const int row0 = u.pm * BM + wr * 64 + fr, col0 = u.pn * BM + wc * 32 + 8 * fq;
#pragma unroll
        for (int ai = 0; ai < 2; ++ai)
#pragma unroll
            for (int m = 0; m < 4; ++m)
#pragma unroll
                for (int bj = 0; bj < 2; ++bj) *(u32x4*)(O + (size_t)(row0 + ai * HALF + m * 16) * DM + col0 + bj * HALF) = pack8(acc[ai][bj][m][0], acc[ai][bj][m][1]);
    }
};
struct EpiPle {
    static constexpr bool PERM = false, AFTER_DRAIN = false;
    float* PRE; const bf16_t *H, *PP;
    __device__ __forceinline__ void operator()(const f32x4 (&acc)[2][2][4][2], const Unit& u, int wr, int wc, int fr, int fq) const {
        const int row0 = u.pm * BM + wr * 64 + fr, col0 = u.pn * BM + wc * 32 + 4 * fq;
#pragma unroll
        for (int ai = 0; ai < 2; ++ai)
#pragma unroll
            for (int m = 0; m < 4; ++m) { const size_t off = (size_t)(row0 + ai * HALF + m * 16) * DM + col0;
#pragma unroll
                for (int bj = 0; bj < 2; ++bj)
#pragma unroll
                    for (int n = 0; n < 2; ++n) { const size_t o2 = off + bj * HALF + n * 16;
                        const u32x2 hw = *(const u32x2*)(H + o2), pw = *(const u32x2*)(PP + o2);
                        const f32x4 hr = (f32x4){bf_lo(hw.x), bf_hi(hw.x), bf_lo(hw.y), bf_hi(hw.y)}, pr = (f32x4){bf_lo(pw.x), bf_hi(pw.x), bf_lo(pw.y), bf_hi(pw.y)};
                        f32x4 a = acc[ai][bj][m][n];
#pragma unroll
                        for (int e = 0; e < 4; ++e) a[e] = sigmoidf_(a[e]);
                        *(f32x4*)(PRE + o2) = hr * ALPHA + a * pr; } }
    }
};
template <class Epi, class Sched, bool ALIGN_EPI = false, bool SP2 = false>
__device__ __forceinline__ void gemm_phase(PG8_LAS unsigned char* lds, const Gemm g, const Sched& S, const Epi& E) {
    int tid_ = threadIdx.x; asm volatile("" : "+v"(tid_));
    const int tid = tid_, wid = __builtin_amdgcn_readfirstlane(tid >> 6), lane = tid & 63, wr = wid >> 2, wc = wid & 3, fr = lane & 15, fq = lane >> 4;
    int K_ = g.K; asm volatile("" : "+s"(K_));
    const int K = K_, nt = K / BK;
    unsigned voffA[2], voffB[2];
#pragma unroll
    for (int i = 0; i < 2; ++i) { int R, C; stage_rc(tid * 16 + i * 8192, R, C); const int Rb = Epi::PERM ? ((R & ~31) + perm32(R & 31)) : R;
        voffA[i] = (unsigned)(R * K + C) * 2u; voffB[i] = (unsigned)(Rb * K + C) * 2u; }
    const size_t kstep = (size_t)(BK * 2);
    const size_t hstep = (size_t)HALF * K * 2;
    const size_t tstep = 2 * hstep;
    const unsigned ldsw = (unsigned)wid * 1024u;
    const int aoff = lds_byte(wr * 64 + fr, fq * 8), boff = lds_byte(wc * 32 + fr, fq * 8);
#define PG8_SA(b, h) (((b) * 2 + (h)) * HTB)
#define PG8_SB(b, h) ((4 + (b) * 2 + (h)) * HTB)
#define PG8_STAGE(bufoff, gbase, voff) do { _Pragma("unroll") for (int _i = 0; _i < 2; ++_i) \
        __builtin_amdgcn_global_load_lds((const unsigned*)((const char*)(gbase) + (voff)[_i]), (PG8_LAS unsigned*)(lds + (bufoff) + ldsw + _i * 8192), 16, 0, 0); } while (0)
#define PG8_LDA(dst, b, h) do { _Pragma("unroll") for (int m = 0; m < 4; ++m) _Pragma("unroll") for (int k = 0; k < 2; ++k) dst[m][k] = *(const PG8_LAS bf16x8*)(lds + PG8_SA(b, h) + aoff + m * 2048 + k * 1024); } while (0)
#define PG8_LDB(dst, b, h) do { _Pragma("unroll") for (int n = 0; n < 2; ++n) _Pragma("unroll") for (int k = 0; k < 2; ++k) dst[n][k] = *(const PG8_LAS bf16x8*)(lds + PG8_SB(b, h) + boff + n * 2048 + k * 1024); } while (0)
#define PG8_MMA(ai, bj, At, Bt) do { __builtin_amdgcn_s_setprio(1); _Pragma("unroll") for (int m = 0; m < 4; ++m) _Pragma("unroll") for (int n = 0; n < 2; ++n) _Pragma("unroll") for (int k = 0; k < 2; ++k) \
        acc[ai][bj][m][n] = __builtin_amdgcn_mfma_f32_16x16x32_bf16(Bt[n][k], At[m][k], acc[ai][bj][m][n], 0, 0, 0); __builtin_amdgcn_s_setprio(0); } while (0)
#define PG8_WAIT_V(n) asm volatile("s_waitcnt vmcnt(" #n ")" ::: "memory")
#define PG8_WAIT_L(n) asm volatile("s_waitcnt lgkmcnt(" #n ")" ::: "memory")
#define PG8_BAR __builtin_amdgcn_s_barrier()
#define PG8_SCHED __builtin_amdgcn_sched_barrier(0)
    Unit cur, nxt; int ui = 0;
    if (!S.next(0, cur)) return;
    f32x4 acc[2][2][4][2];
#pragma unroll
    for (int a = 0; a < 2; ++a)
#pragma unroll
        for (int b = 0; b < 2; ++b)
#pragma unroll
            for (int m = 0; m < 4; ++m)
#pragma unroll
                for (int n = 0; n < 2; ++n) acc[a][b][m][n] = (f32x4){0.f, 0.f, 0.f, 0.f};
    bf16x8 At[4][2], B0[2][2], B1[2][2];
    const char* cA = (const char*)g.A + (size_t)cur.pm * tstep; const char* cB = (const char*)g.Bt + (size_t)cur.pn * tstep;
    S.a_ready(cur);
    if constexpr (SP2) {
        PG8_STAGE(PG8_SB(0, 0), cB, voffB); PG8_STAGE(PG8_SB(0, 1), cB + hstep, voffB); PG8_STAGE(PG8_SA(0, 0), cA, voffA); PG8_STAGE(PG8_SA(0, 1), cA + hstep, voffA);
        if (wr == 1) PG8_BAR;
        PG8_WAIT_V(2); PG8_BAR;
        PG8_STAGE(PG8_SB(1, 0), cB + kstep, voffB); PG8_STAGE(PG8_SA(1, 0), cA + kstep, voffA); PG8_STAGE(PG8_SB(1, 1), cB + hstep + kstep, voffB);
        PG8_WAIT_V(6); PG8_BAR;
    } else {
        PG8_STAGE(PG8_SB(0, 0), cB, voffB); PG8_STAGE(PG8_SA(0, 0), cA, voffA); PG8_STAGE(PG8_SB(0, 1), cB + hstep, voffB); PG8_STAGE(PG8_SA(0, 1), cA + hstep, voffA);
        if (wr == 1) PG8_BAR;
        PG8_WAIT_V(4); PG8_BAR;
        PG8_STAGE(PG8_SB(1, 0), cB + kstep, voffB); PG8_STAGE(PG8_SA(1, 0), cA + kstep, voffA); PG8_STAGE(PG8_SB(1, 1), cB + hstep + kstep, voffB);
        PG8_WAIT_V(6); PG8_BAR;
    }
    for (;;) {
        const bool has_next = S.next(ui + 1, nxt);
        const char* nA = has_next ? (const char*)g.A + (size_t)nxt.pm * tstep : cA; const char* nB = has_next ? (const char*)g.Bt + (size_t)nxt.pn * tstep : cB;
        for (int t = 0; t < nt; t += 2) {
            const bool last = (t == nt - 2);
            const char* a1 = cA + (size_t)(t + 1) * kstep;
            const char* a2 = last ? nA : cA + (size_t)(t + 2) * kstep; const char* b2 = last ? nB : cB + (size_t)(t + 2) * kstep;
            const char* a3 = a2 + kstep; const char* b3 = b2 + kstep;
            if (last && has_next) S.a_ready(nxt);
            if constexpr (SP2) {
            PG8_LDB(B0, 0, 0); PG8_LDB(B1, 0, 1); PG8_SCHED; PG8_LDA(At, 0, 0); PG8_STAGE(PG8_SA(1, 1), a1 + hstep, voffA);
            PG8_WAIT_V(8); PG8_WAIT_L(0); PG8_BAR; PG8_MMA(0, 0, At, B0); PG8_MMA(0, 1, At, B1); PG8_BAR; PG8_SCHED;
            PG8_LDA(At, 0, 1); PG8_STAGE(PG8_SB(0, 0), b2, voffB); PG8_STAGE(PG8_SB(0, 1), b2 + hstep, voffB); PG8_STAGE(PG8_SA(0, 0), a2, voffA);
            PG8_WAIT_V(8); PG8_WAIT_L(0); PG8_BAR; PG8_MMA(1, 0, At, B0); PG8_MMA(1, 1, At, B1); PG8_BAR; PG8_SCHED;
            PG8_LDB(B0, 1, 0); PG8_LDB(B1, 1, 1); PG8_SCHED; PG8_LDA(At, 1, 0); PG8_STAGE(PG8_SA(0, 1), a2 + hstep, voffA);
            PG8_WAIT_V(8); PG8_WAIT_L(0); PG8_BAR; PG8_MMA(0, 0, At, B0); PG8_MMA(0, 1, At, B1); PG8_BAR; PG8_SCHED;
            PG8_LDA(At, 1, 1); PG8_STAGE(PG8_SB(1, 0), b3, voffB); PG8_STAGE(PG8_SB(1, 1), b3 + hstep, voffB); PG8_STAGE(PG8_SA(1, 0), a3, voffA);
            PG8_WAIT_V(8); PG8_WAIT_L(0); PG8_BAR; PG8_MMA(1, 0, At, B0); PG8_MMA(1, 1, At, B1); PG8_BAR; PG8_SCHED;
            } else {
            PG8_LDB(B0, 0, 0); PG8_SCHED; PG8_LDA(At, 0, 0); PG8_STAGE(PG8_SA(1, 1), a1 + hstep, voffA);
            PG8_WAIT_L(8); PG8_BAR; PG8_WAIT_L(0); PG8_MMA(0, 0, At, B0); PG8_BAR; PG8_SCHED;
            PG8_LDB(B1, 0, 1); PG8_STAGE(PG8_SB(0, 0), b2, voffB);
            PG8_BAR; PG8_WAIT_L(0); PG8_MMA(0, 1, At, B1); PG8_BAR;
            PG8_LDA(At, 0, 1); PG8_STAGE(PG8_SA(0, 0), a2, voffA);
            PG8_BAR; PG8_WAIT_L(0); PG8_MMA(1, 0, At, B0); PG8_BAR; PG8_SCHED;
            PG8_STAGE(PG8_SB(0, 1), b2 + hstep, voffB);
            PG8_WAIT_V(6); PG8_BAR; PG8_MMA(1, 1, At, B1); PG8_BAR;
            PG8_LDB(B0, 1, 0); PG8_SCHED; PG8_LDA(At, 1, 0); PG8_STAGE(PG8_SA(0, 1), a2 + hstep, voffA);
            PG8_WAIT_L(8); PG8_BAR; PG8_WAIT_L(0); PG8_MMA(0, 0, At, B0); PG8_BAR; PG8_SCHED;
            PG8_LDB(B1, 1, 1); PG8_STAGE(PG8_SB(1, 0), b3, voffB);
            PG8_BAR; PG8_WAIT_L(0); PG8_MMA(0, 1, At, B1); PG8_BAR;
            PG8_LDA(At, 1, 1); PG8_STAGE(PG8_SA(1, 0), a3, voffA);
            PG8_BAR; PG8_WAIT_L(0); PG8_MMA(1, 0, At, B0); PG8_BAR; PG8_SCHED;
            PG8_STAGE(PG8_SB(1, 1), b3 + hstep, voffB);
            PG8_WAIT_V(6); PG8_BAR; PG8_MMA(1, 1, At, B1); PG8_BAR;
            }
        }
        if constexpr (ALIGN_EPI) { if (wr == 0) PG8_BAR; }
        if constexpr (!Epi::AFTER_DRAIN) { E(acc, cur, wr, wc, fr, fq); S.done(cur); }
        if (!has_next) break;
#pragma unroll
        for (int a = 0; a < 2; ++a)
#pragma unroll
            for (int b = 0; b < 2; ++b)
#pragma unroll
                for (int m = 0; m < 4; ++m)
#pragma unroll
                    for (int n = 0; n < 2; ++n) acc[a][b][m][n] = (f32x4){0.f, 0.f, 0.f, 0.f};
        cur = nxt; cA = nA; cB = nB; ++ui;
        if constexpr (ALIGN_EPI) { if (wr == 1) PG8_BAR; }
    }
    PG8_WAIT_V(0);
    if constexpr (!ALIGN_EPI) { if (wr == 0) PG8_BAR; }
    PG8_BAR;
    if constexpr (Epi::AFTER_DRAIN) { E.fused(acc, cur, wr, wc, fr, fq, lds, wid, lane); S.done(cur); }
#undef PG8_SA
#undef PG8_SB
#undef PG8_STAGE
#undef PG8_LDA
#undef PG8_LDB
#undef PG8_MMA
#undef PG8_WAIT_V
#undef PG8_WAIT_L
#undef PG8_BAR
#undef PG8_SCHED
}
}
#define GAS __attribute__((address_space(1)))
#define LAS __attribute__((address_space(3)))
typedef unsigned short bf16;
typedef unsigned v4u __attribute__((ext_vector_type(4)));
typedef float f32x4 __attribute__((ext_vector_type(4)));
typedef short bf16x8 __attribute__((ext_vector_type(8)));
typedef GAS unsigned gu32;
typedef GAS unsigned long long gu64;
#define RLX_AGENT __ATOMIC_RELAXED, __HIP_MEMORY_SCOPE_AGENT
#define LDS_WAIT() asm volatile("s_waitcnt lgkmcnt(0)" ::: "memory")
#define VM_WAIT() asm volatile("s_waitcnt vmcnt(0)" ::: "memory")
__device__ __forceinline__ unsigned long long rt() { return __builtin_amdgcn_s_memrealtime(); }
__device__ __forceinline__ unsigned f2bf(float f) { unsigned u = __builtin_bit_cast(unsigned, f); return (u + 0x7fffu + ((u >> 16) & 1u)) >> 16; }
__device__ __forceinline__ unsigned pk2(float lo, float hi) { return f2bf(lo) | (f2bf(hi) << 16); }

#define XB_TMO      128
#define XB_XCNT(j)  (256  + 64 * (j))
#define XB_XSUB(j)  (1280 + 64 * (j))
#define XB_XGEN(j)  (2304 + 64 * (j))
#define XB_TOP      3328
#define XB_TOPGEN   3392
#define XCD_BAR_WORDS 3456
#define XB_SPIN_CAP (1u << 18)

__device__ __forceinline__ unsigned xb_ld(unsigned* p)              { return __hip_atomic_load(p, __ATOMIC_RELAXED, __HIP_MEMORY_SCOPE_AGENT); }
__device__ __forceinline__ unsigned xb_add(unsigned* p, unsigned v) { return __hip_atomic_fetch_add(p, v, __ATOMIC_RELAXED, __HIP_MEMORY_SCOPE_AGENT); }
__device__ __forceinline__ unsigned xb_xcc_id() { return (unsigned)__builtin_amdgcn_s_getreg((3 << 11) | 20) & 0xFu; }
#define XB_SPIN(cond, bar) do { unsigned _sp = 0; while (cond) { __builtin_amdgcn_s_sleep(1); \
    if ((++_sp & 255u) == 0u) { if (xb_ld(&(bar)[XB_TMO])) break; if (_sp > XB_SPIN_CAP) { atomicAdd(&(bar)[XB_TMO], 1u); break; } } } } while (0)

struct XcdBarrier {
    unsigned* bar; unsigned x;
    volatile LAS unsigned* st;
};

__device__ __forceinline__ XcdBarrier xcd_barrier_post(unsigned* bar, volatile LAS unsigned* st) {
    XcdBarrier b; b.bar = bar; b.x = xb_xcc_id(); b.st = st;
    if (threadIdx.x == 0) (void)xb_add(&bar[XB_XCNT(b.x)], 1u);
    return b;
}
__device__ __forceinline__ void xcd_barrier_complete(unsigned* bar, unsigned x, unsigned& nloc, unsigned& nx) {
    const unsigned G = gridDim.x * gridDim.y * gridDim.z;
    unsigned sum, cnt, mine, sp = 0u;
    for (;;) {
        sum = 0u; cnt = 0u; mine = 0u;
#pragma unroll
        for (unsigned j = 0; j < 16; ++j) { const unsigned c = xb_ld(&bar[XB_XCNT(j)]); sum += c; cnt += (c > 0u) ? 1u : 0u; mine = (j == x) ? c : mine; }
        if (sum == G) break;
        __builtin_amdgcn_s_sleep(1);
        if ((++sp & 255u) == 0u) { if (xb_ld(&bar[XB_TMO])) break; if (sp > XB_SPIN_CAP) { atomicAdd(&bar[XB_TMO], 1u); break; } }
    }
    nloc = mine > 0u ? mine : 1u; nx = cnt > 0u ? cnt : 1u;
}

__device__ __forceinline__ void xcd_barrier(const XcdBarrier& b) {
    asm volatile("s_waitcnt vmcnt(0)" ::: "memory");
    __syncthreads();
    if (threadIdx.x == 0) {
        unsigned* bar = b.bar;
        __builtin_amdgcn_s_waitcnt(0);
        unsigned nloc = b.st[0], nx = b.st[1];
        if (nloc == 0u) { xcd_barrier_complete(bar, b.x, nloc, nx); b.st[0] = nloc; b.st[1] = nx; }
        const unsigned old = xb_add(&bar[XB_XSUB(b.x)], 1u);
        const unsigned gen = old / nloc;
        if (old + 1u == (gen + 1u) * nloc) {
            __builtin_amdgcn_fence(__ATOMIC_RELEASE, "agent");
            asm volatile("s_waitcnt vmcnt(0)" ::: "memory");
            const unsigned og = xb_add(&bar[XB_TOP], 1u);
            const unsigned tg = og / nx;
            if (og + 1u == (tg + 1u) * nx) xb_add(&bar[XB_TOPGEN], 1u);
            else XB_SPIN(xb_ld(&bar[XB_TOPGEN]) == tg, bar);
            __builtin_amdgcn_fence(__ATOMIC_ACQUIRE, "agent");
            xb_add(&bar[XB_XGEN(b.x)], 1u);
            asm volatile("s_waitcnt vmcnt(0)" ::: "memory");
        } else {
            XB_SPIN(xb_ld(&bar[XB_XGEN(b.x)]) == gen, bar);
            __builtin_amdgcn_fence(__ATOMIC_ACQUIRE, "agent");
            asm volatile("s_waitcnt vmcnt(0)" ::: "memory");
        }
    }
    __syncthreads();
}
constexpr size_t MiB = 1u << 20;
constexpr size_t WS_CTL = 0, CTL_ZERO_BYTES = 1 * MiB;
constexpr size_t WS_WIN = 2 * MiB, WS_WOUT = 9 * MiB, WS_WGU = 11 * MiB, WS_WD = 22 * MiB, WS_WPG = 28 * MiB, WS_WPP = 30 * MiB, WS_WL = 30 * MiB + 512 * 1024;
constexpr size_t SZ1024B = (size_t)MT * 1024 * 2, SZ512B = (size_t)MT * 512 * 2, SZ256B = (size_t)MT * 256 * 2;
constexpr size_t WS_R1 = 32 * MiB;
constexpr size_t WS_PB = 97 * MiB;
constexpr size_t WS_QB = 114 * MiB, WS_KB = WS_QB + SZ512B, WS_VB = WS_KB + SZ512B;
constexpr size_t WS_PRE = 114 * MiB;
constexpr size_t WS_ZB = 211 * MiB;
constexpr size_t WS_OG = 324 * MiB, WS_LSE = 420 * MiB;
constexpr size_t WS_BV = 324 * MiB, WS_PHI = 357 * MiB, WS_SLOC = 389 * MiB, WS_SC = 421 * MiB;
constexpr size_t WS_AP = 453 * MiB;
constexpr size_t WS_ACT = 243 * MiB;
constexpr size_t WS_H2 = 243 * MiB, WS_PP = 308 * MiB;
constexpr size_t WS_END = 470 * MiB;
static_assert(WS_VB + SZ512B <= WS_ZB && WS_ZB + (size_t)MT * DBIN * 2 <= WS_OG && WS_PRE + (size_t)MT * DM * 4 <= WS_ACT && WS_ACT + (size_t)MT * DFF * 2 <= WS_SC + 32 * MiB, "ws map");
static_assert(WS_R1 + SZ1024B <= WS_PB && WS_PB + SZ256B <= WS_QB && WS_AP + SZ256B <= WS_END && WS_H2 + SZ1024B <= WS_PP, "ws map 2");
constexpr int NCHUNK = 32, CHL = TSEQ / NCHUNK;
constexpr int CW_BAR = 4096;

constexpr int RING_OFF = 0, RING_BYTES = 131072;
constexpr int LDSCTL_OFF = RING_BYTES, MISC_OFF = LDSCTL_OFF + 320;
constexpr int LDS_BYTES = 147456;
constexpr int NWAVES = 8;
typedef float f32x16 __attribute__((ext_vector_type(16)));
typedef unsigned u32x2 __attribute__((ext_vector_type(2)));
typedef short s16x4 __attribute__((ext_vector_type(4)));
typedef float f32x2_t __attribute__((ext_vector_type(2)));
typedef __bf16 bf16x2_t __attribute__((ext_vector_type(2)));
__device__ __forceinline__ unsigned cvtpk(float lo, float hi) { f32x2_t v = {lo, hi}; bf16x2_t b = __builtin_convertvector(v, bf16x2_t); return __builtin_bit_cast(unsigned, b); }
__device__ __forceinline__ float bflo(unsigned w) { return __uint_as_float(w << 16); }
__device__ __forceinline__ float bfhi(unsigned w) { return __uint_as_float(w & 0xffff0000u); }
__device__ __forceinline__ float bf1(bf16 h) { return __uint_as_float((unsigned)h << 16); }
__device__ __forceinline__ float sigm(float x) { return __builtin_amdgcn_rcpf(1.0f + __builtin_amdgcn_exp2f(-x * LOG2E)); }
__device__ __forceinline__ float shx(float v, int o, int lane) { return __int_as_float(__builtin_amdgcn_ds_bpermute((lane ^ o) << 2, __float_as_int(v))); }
__device__ __forceinline__ float wave_sum(float v, int lane) {
#pragma unroll
    for (int o = 1; o < 64; o <<= 1) v += shx(v, o, lane);
    return v;
}
struct Ctx { LAS unsigned char* lds; int tid, lane, wave, vcu, G; };

__device__ __forceinline__ void p0_transpose_item(const float* W, int N, bf16* WT, int ldk, int drow, int dk, LAS float* scr, int k0, int n0, int lane) {
#pragma unroll 8
    for (int i = 0; i < 32; ++i) { const int kk = 2 * i + (lane >> 5); scr[kk * 33 + (lane & 31)] = W[(size_t)(k0 + kk) * N + n0 + (lane & 31)]; }
    LDS_WAIT(); asm volatile("" ::: "memory");
    const int c = lane & 7;
#pragma unroll
    for (int j = 0; j < 4; ++j) { const int n = (lane >> 3) + 8 * j; const LAS float* s = scr + (8 * c) * 33 + n;
        v4u o; o.x = pk2(s[0 * 33], s[1 * 33]); o.y = pk2(s[2 * 33], s[3 * 33]); o.z = pk2(s[4 * 33], s[5 * 33]); o.w = pk2(s[6 * 33], s[7 * 33]);
        *(GAS v4u*)(WT + (size_t)(drow + n) * ldk + dk + 8 * c) = o; }
    LDS_WAIT(); asm volatile("" ::: "memory");
}
struct P0Args { const float *xp, *xs, *pp, *ps, *ck, *cv, *w_in, *w_out, *w_gate, *w_up, *w_down, *w_pg, *w_pp, *w2, *a2, *g2; bf16 *Win, *Wout, *Wgu, *Wd, *Wpg, *Wpp, *Wl, *XB, *PB; float* out; };
__device__ __forceinline__ void p0_prologue(const Ctx& C, const P0Args& A) {
    LAS float* scr = (LAS float*)(C.lds + RING_OFF + C.wave * 16384);
    const int gw = C.vcu * NWAVES + C.wave, NGW = C.G * NWAVES;
    constexpr int I0 = 16 * 104, I1 = 16 * 32, I2 = 16 * 88, I3 = I2, I4 = 44 * 32, I5 = 16 * 32, I6 = 4 * 32, I7 = 16, I8 = 16, I9 = 32;
    constexpr int NITEMS = I0 + I1 + I2 + I3 + I4 + I5 + I6 + I7 + I8 + I9;
    for (int it = gw; it < NITEMS; it += NGW) {
        int r = it;
        if (r < I0) { const int kb = r / 104, nb = r % 104; p0_transpose_item(A.w_in, DIN, A.Win, 1024, nb * 32, kb * 64, scr, kb * 64, nb * 32, C.lane); continue; } r -= I0;
        if (r < I1) { const int kb = r / 32, nb = r % 32; p0_transpose_item(A.w_out, DM, A.Wout, 1024, nb * 32, kb * 64, scr, kb * 64, nb * 32, C.lane); continue; } r -= I1;
        if (r < I2) { const int kb = r / 88, nb = r % 88, n0 = nb * 32; p0_transpose_item(A.w_gate, DFF, A.Wgu, 1024, (n0 >> 7) * 256 + (n0 & 127), kb * 64, scr, kb * 64, n0, C.lane); continue; } r -= I2;
        if (r < I3) { const int kb = r / 88, nb = r % 88, n0 = nb * 32; p0_transpose_item(A.w_up, DFF, A.Wgu, 1024, (n0 >> 7) * 256 + 128 + (n0 & 127), kb * 64, scr, kb * 64, n0, C.lane); continue; } r -= I3;
        if (r < I4) { const int kb = r / 32, nb = r % 32; p0_transpose_item(A.w_down, DM, A.Wd, DFF, nb * 32, kb * 64, scr, kb * 64, nb * 32, C.lane); continue; } r -= I4;
        if (r < I5) { const int kb = r / 32, nb = r % 32; p0_transpose_item(A.w_pg, DM, A.Wpg, 1024, nb * 32, kb * 64, scr, kb * 64, nb * 32, C.lane); continue; } r -= I5;
        if (r < I6) { const int kb = r / 32, nb = r % 32; p0_transpose_item(A.w_pp, DM, A.Wpp, 256, nb * 32, kb * 64, scr, kb * 64, nb * 32, C.lane); continue; } r -= I6;
        if (r < I7) { p0_transpose_item(A.w2, CB, A.Wl, 256, r * 32, 0, scr, 0, r * 32, C.lane); continue; } r -= I7;
        if (r < I8) { p0_transpose_item(A.a2, CB, A.Wl, 256, 512 + r * 32, 64, scr, 0, r * 32, C.lane); continue; } r -= I8;
        { const int kb = r / 16, nb = r % 16; p0_transpose_item(A.g2, CB, A.Wl, 256, 1024 + nb * 32, 128 + kb * 64, scr, kb * 64, nb * 32, C.lane); }
    }
    const int gt = C.vcu * (NWAVES * 64) + C.tid, NT = C.G * NWAVES * 64;
    for (int i = gt; i < 1536 * 32; i += NT) { const int row = i >> 5, ch = i & 31, blk = row >> 9;
        const bool nz = blk == 0 ? ch < 8 : blk == 1 ? (ch >= 8 && ch < 16) : ch >= 16;
        if (!nz) *(GAS v4u*)(A.Wl + (size_t)row * 256 + ch * 8) = (v4u){0u, 0u, 0u, 0u}; }
    for (int i = gt; i < MT * 128; i += NT) { const int row = i >> 7, ch = i & 127;
        f32x4 a = {0.f, 0.f, 0.f, 0.f}, b = a;
        if (row < MPR + MSA) { const float* src = row < MPR ? A.xp + (size_t)row * DM : A.xs + (size_t)(row - MPR) * DM; a = *(const GAS f32x4*)(src + ch * 8); b = *(const GAS f32x4*)(src + ch * 8 + 4); }
        v4u o; o.x = cvtpk(a[0], a[1]); o.y = cvtpk(a[2], a[3]); o.z = cvtpk(b[0], b[1]); o.w = cvtpk(b[2], b[3]);
        *(GAS v4u*)(A.XB + (size_t)row * DM + ch * 8) = o; }
    for (int i = gt; i < MT * 32; i += NT) { const int row = i >> 5, ch = i & 31;
        f32x4 a = {0.f, 0.f, 0.f, 0.f}, b = a;
        if (row < MPR + MSA) { const float* src = row < MPR ? A.pp + (size_t)row * PLE : A.ps + (size_t)(row - MPR) * PLE; a = *(const GAS f32x4*)(src + ch * 8); b = *(const GAS f32x4*)(src + ch * 8 + 4); }
        v4u o; o.x = cvtpk(a[0], a[1]); o.y = cvtpk(a[2], a[3]); o.z = cvtpk(b[0], b[1]); o.w = cvtpk(b[2], b[3]);
        *(GAS v4u*)(A.PB + (size_t)row * PLE + ch * 8) = o; }
}

__device__ __forceinline__ void prep_a(const Ctx& C, const bf16* ZB, const float* mu, const float* state_shift, bf16* AP, float* out) {
    const int gw = C.vcu * NWAVES + C.wave, NGW = C.G * NWAVES, lane = C.lane;
    const f32x4 m4 = *(const GAS f32x4*)(mu + 1536 + lane * 4);
    for (int row = gw; row < MPR + MSA; row += NGW) {
        const u32x2 zw = *(const GAS u32x2*)(ZB + (size_t)row * DBIN + 1536 + lane * 4);
        f32x4 z = {bflo(zw.x), bfhi(zw.x), bflo(zw.y), bfhi(zw.y)}, p;
        const bool first = row < MPR ? (row & (TSEQ - 1)) == 0 : ((row - MPR) & 3) == 0;
        if (!first) { const u32x2 pw = *(const GAS u32x2*)(ZB + (size_t)(row - 1) * DBIN + 1536 + lane * 4); p = (f32x4){bflo(pw.x), bfhi(pw.x), bflo(pw.y), bfhi(pw.y)}; }
        else if (row < MPR) p = (f32x4){0.f, 0.f, 0.f, 0.f};
        else p = *(const GAS f32x4*)(state_shift + (size_t)((row - MPR) >> 2) * DBIN + 1536 + lane * 4);
        f32x4 zm = z + (p - z) * m4, o;
#pragma unroll
        for (int e = 0; e < 4; ++e) { const float x = zm[e];
            const float th = 1.0f - 2.0f * __builtin_amdgcn_rcpf(1.0f + __builtin_amdgcn_exp2f(2.0f * LOG2E * x));
            o[e] = lane < 16 ? th : lane < 32 ? x : sigm(x); }
        u32x2 w; w.x = cvtpk(o[0], o[1]); w.y = cvtpk(o[2], o[3]);
        *(GAS u32x2*)(AP + (size_t)row * 256 + lane * 4) = w;
    }
    const int gt = C.vcu * (NWAVES * 64) + C.tid, NT = C.G * NWAVES * 64;
    for (int i = gt; i < (NBATCH + SB) * DBIN; i += NT) { const int s = i / DBIN, c = i % DBIN;
        if (s < NBATCH) out[O_SHP + (size_t)s * DBIN + c] = bf1(ZB[(size_t)(s * TSEQ + TSEQ - 1) * DBIN + c]);
        else out[O_SHS + (size_t)(s - NBATCH) * DBIN + c] = bf1(ZB[(size_t)(MPR + (s - NBATCH) * SS + SS - 1) * DBIN + c]); }
}

__device__ __forceinline__ int crow(int r, int hi) { return (r & 3) + 8 * (r >> 2) + 4 * hi; }
typedef short v4i16_t __attribute__((ext_vector_type(4)));
__device__ __forceinline__ s16x4 vtr(LAS const unsigned char* p) { return __builtin_bit_cast(s16x4, __builtin_amdgcn_ds_read_tr16_b64_v4i16((LAS v4i16_t*)p)); }
constexpr int VP = 192;
__device__ __forceinline__ void attn_unit(const Ctx& C, const bf16* QB, const bf16* KB, const bf16* VB, bf16* OGg, float* LSEg, int b, int h, int cls, int mq0, int dil) {
    LAS unsigned char* lds = C.lds;
    const int tid = C.tid, wid = C.wave, lane = C.lane, r32 = lane & 31, hi = lane >> 5;
#pragma unroll
    for (int it = 0; it < 6; ++it) { const int rr = it * 64 + (tid >> 3), ch = tid & 7; int mk = mq0 - 128 + rr; mk = mk < 0 ? 0 : mk;
        const v4u val = *(const GAS v4u*)(VB + (size_t)(b * TSEQ + mk * dil + cls) * CA + h * 64 + ch * 8);
        *(LAS v4u*)(lds + rr * VP + ch * 16) = val; }
    __syncthreads();
    const int mqw = mq0 + 32 * wid;
    const size_t qrow = (size_t)(b * TSEQ + (mqw + r32) * dil + cls);
    bf16x8 qf[4];
#pragma unroll
    for (int s = 0; s < 4; ++s) qf[s] = *(const GAS bf16x8*)(QB + qrow * CA + h * 64 + 16 * s + 8 * hi);
    f32x16 st[5];
#pragma unroll
    for (int j = 0; j < 5; ++j) { int mk = mqw - 128 + 32 * j + r32; mk = mk < 0 ? 0 : mk;
        const bf16* kp = KB + (size_t)(b * TSEQ + mk * dil + cls) * CA + h * 64 + 8 * hi;
        f32x16 a = {0.f, 0.f, 0.f, 0.f, 0.f, 0.f, 0.f, 0.f, 0.f, 0.f, 0.f, 0.f, 0.f, 0.f, 0.f, 0.f};
#pragma unroll
        for (int s = 0; s < 4; ++s) { const bf16x8 kf = *(const GAS bf16x8*)(kp + 16 * s); a = __builtin_amdgcn_mfma_f32_32x32x16_bf16(kf, qf[s], a, 0, 0, 0); }
        st[j] = a; }
    const float slope2 = __builtin_amdgcn_exp2f(-(float)(h + 1)) * LOG2E * (float)dil;
    float mx = -INFINITY;
#pragma unroll
    for (int j = 0; j < 5; ++j)
#pragma unroll
        for (int i = 0; i < 16; ++i) { const int kr = crow(i, hi), dist = 128 - 32 * j + r32 - kr, mke = mqw - 128 + 32 * j + kr;
            const bool ok = dist >= 0 && dist <= 128 && mke >= 0;
            const float v = ok ? st[j][i] - slope2 * (float)dist : -INFINITY; st[j][i] = v; mx = fmaxf(mx, v); }
    mx = fmaxf(mx, shx(mx, 32, lane));
    float l = 0.f;
#pragma unroll
    for (int j = 0; j < 5; ++j)
#pragma unroll
        for (int i = 0; i < 16; ++i) { const float p = __builtin_amdgcn_exp2f(st[j][i] - mx); st[j][i] = p; l += p; }
    l += shx(l, 32, lane);
    f32x16 o0 = {0.f, 0.f, 0.f, 0.f, 0.f, 0.f, 0.f, 0.f, 0.f, 0.f, 0.f, 0.f, 0.f, 0.f, 0.f, 0.f}, o1 = o0;
    const int i16 = lane & 15, qq = i16 >> 2, pp = i16 & 3, blk = (lane >> 4) & 1;
    LAS const unsigned char* vbase = lds + (32 * wid + 4 * hi + qq) * VP + (16 * blk + 4 * pp) * 2;
#pragma unroll
    for (int j = 0; j < 5; ++j)
#pragma unroll
        for (int s2 = 0; s2 < 2; ++s2) {
            v4u pw; pw.x = cvtpk(st[j][8 * s2 + 0], st[j][8 * s2 + 1]); pw.y = cvtpk(st[j][8 * s2 + 2], st[j][8 * s2 + 3]); pw.z = cvtpk(st[j][8 * s2 + 4], st[j][8 * s2 + 5]); pw.w = cvtpk(st[j][8 * s2 + 6], st[j][8 * s2 + 7]);
            const bf16x8 xs = __builtin_bit_cast(bf16x8, pw);
            LAS const unsigned char* vp = vbase + (32 * j + 16 * s2) * VP;
            { const s16x4 lo = vtr(vp), hh = vtr(vp + 8 * VP); const bf16x8 vf = (bf16x8){lo[0], lo[1], lo[2], lo[3], hh[0], hh[1], hh[2], hh[3]};
              o0 = __builtin_amdgcn_mfma_f32_32x32x16_bf16(vf, xs, o0, 0, 0, 0); }
            { const s16x4 lo = vtr(vp + 64), hh = vtr(vp + 8 * VP + 64); const bf16x8 vf = (bf16x8){lo[0], lo[1], lo[2], lo[3], hh[0], hh[1], hh[2], hh[3]};
              o1 = __builtin_amdgcn_mfma_f32_32x32x16_bf16(vf, xs, o1, 0, 0, 0); }
        }
    const float inv = __builtin_amdgcn_rcpf(l);
    bf16* orow = OGg + qrow * CA + h * 64 + 4 * hi;
#pragma unroll
    for (int g4 = 0; g4 < 4; ++g4) {
        u32x2 w0, w1;
        w0.x = cvtpk(o0[4 * g4] * inv, o0[4 * g4 + 1] * inv); w0.y = cvtpk(o0[4 * g4 + 2] * inv, o0[4 * g4 + 3] * inv);
        w1.x = cvtpk(o1[4 * g4] * inv, o1[4 * g4 + 1] * inv); w1.y = cvtpk(o1[4 * g4 + 2] * inv, o1[4 * g4 + 3] * inv);
        *(GAS u32x2*)(orow + 8 * g4) = w0; *(GAS u32x2*)(orow + 32 + 8 * g4) = w1; }
    if (hi == 0) LSEg[qrow * NH + h] = mx + __builtin_amdgcn_logf(l);
    __syncthreads();
}
__device__ __forceinline__ void attn_prompt(const Ctx& C, const bf16* QB, const bf16* KB, const bf16* VB, bf16* OG, float* LSE) {
    for (int i = 0; i < 12; ++i) {
        const int u = C.vcu * 12 + i, bh = u / 48, k48 = u % 48, g = k48 >> 4, k = k48 & 15;
        const int b = bh >> 3, h = bh & 7;
        int cls, mq0, dil;
        if (g == 0) { cls = 0; mq0 = 256 * k; dil = 1; } else if (g == 1) { cls = k >> 2; mq0 = 256 * (k & 3); dil = 4; } else { cls = k; mq0 = 0; dil = 16; }
        attn_unit(C, QB, KB, VB, OG + (size_t)g * MPR * CA, LSE + (size_t)g * MPR * NH, b, h, cls, mq0, dil);
    }
}
__device__ __forceinline__ void attn_sample(const Ctx& C, const bf16* QB, const float* ck, const float* cv, const float* out, bf16* HEADS) {
    const int b = C.vcu >> 3, h = C.vcu & 7, s = C.wave, lane = C.lane;
    if (C.vcu >= SB * NH || s >= SS) return;
    LAS float* qs = (LAS float*)(C.lds + s * 4096);
    LAS float* ps = qs + 64;
    const int row = MPR + b * SS + s;
    qs[lane] = bf1(QB[(size_t)row * CA + h * 64 + lane]);
    LDS_WAIT(); asm volatile("" ::: "memory");
    const float slope2 = __builtin_amdgcn_exp2f(-(float)(h + 1)) * LOG2E;
    float sc[7]; float mx = -INFINITY;
#pragma unroll
    for (int it = 0; it < 7; ++it) {
        const int n = it * 64 + lane; sc[it] = -INFINITY;
        if (n < 387) { const int g = n / 129, jj = n % 129, dil = g == 0 ? 1 : g == 1 ? 4 : 16, idx = WINL + s - jj * dil;
            const float* kr = idx < WINL ? ck + ((size_t)(b * WINL + idx) * NH + h) * HD : out + O_KWS + ((size_t)(b * WINL + (WINL - SS) + idx - WINL) * NH + h) * HD;
            float d = 0.f;
#pragma unroll
            for (int c = 0; c < 16; ++c) { const f32x4 kv = *(const GAS f32x4*)(kr + 4 * c); const f32x4 qv = *(LAS const f32x4*)(qs + 4 * c); d += kv[0] * qv[0] + kv[1] * qv[1] + kv[2] * qv[2] + kv[3] * qv[3]; }
            sc[it] = d - slope2 * (float)(jj * dil); }
        mx = fmaxf(mx, sc[it]); }
#pragma unroll
    for (int o = 1; o < 64; o <<= 1) mx = fmaxf(mx, shx(mx, o, lane));
    float l = 0.f;
#pragma unroll
    for (int it = 0; it < 7; ++it) { const int n = it * 64 + lane; const float p = __builtin_amdgcn_exp2f(sc[it] - mx); if (n < 387) { ps[n] = p; l += p; } }
    l = wave_sum(l, lane);
    LDS_WAIT(); asm volatile("" ::: "memory");
    float o = 0.f;
    for (int n = 0; n < 387; ++n) { const int g = n / 129, jj = n % 129, dil = g == 0 ? 1 : g == 1 ? 4 : 16, idx = WINL + s - jj * dil;
        const float* vr = idx < WINL ? cv + ((size_t)(b * WINL + idx) * NH + h) * HD : out + O_VWS + ((size_t)(b * WINL + (WINL - SS) + idx - WINL) * NH + h) * HD;
        o += ps[n] * vr[lane]; }
    HEADS[(size_t)row * DM + h * 64 + lane] = (bf16)(cvtpk(o / l, 0.f) & 0xffffu);
}

__device__ __forceinline__ void attn_merge(const Ctx& C, const bf16* OG, const float* LSE, bf16* HEADS) {
    const int gt = C.vcu * (NWAVES * 64) + C.tid, NT = C.G * NWAVES * 64;
    for (int i = gt; i < MPR * 64; i += NT) { const int row = i >> 6, ch = i & 63, h = ch >> 3;
        float ls[3], mx = -INFINITY;
#pragma unroll
        for (int g = 0; g < 3; ++g) { ls[g] = LSE[((size_t)g * MPR + row) * NH + h]; mx = fmaxf(mx, ls[g]); }
        float w[3], ws = 0.f;
#pragma unroll
        for (int g = 0; g < 3; ++g) { w[g] = __builtin_amdgcn_exp2f(ls[g] - mx); ws += w[g]; }
        const float inv = __builtin_amdgcn_rcpf(ws);
        float acc[8] = {0.f, 0.f, 0.f, 0.f, 0.f, 0.f, 0.f, 0.f};
#pragma unroll
        for (int g = 0; g < 3; ++g) { const v4u v = *(const GAS v4u*)(OG + ((size_t)g * MPR + row) * CA + ch * 8); const float wg = w[g] * inv;
            acc[0] += wg * bflo(v.x); acc[1] += wg * bfhi(v.x); acc[2] += wg * bflo(v.y); acc[3] += wg * bfhi(v.y); acc[4] += wg * bflo(v.z); acc[5] += wg * bfhi(v.z); acc[6] += wg * bflo(v.w); acc[7] += wg * bfhi(v.w); }
        v4u o; o.x = cvtpk(acc[0], acc[1]); o.y = cvtpk(acc[2], acc[3]); o.z = cvtpk(acc[4], acc[5]); o.w = cvtpk(acc[6], acc[7]);
        *(GAS v4u*)(HEADS + (size_t)row * DM + ch * 8) = o; }
}

struct RwkvW { const float *mu, *k_k, *k_a, *r_k, *lnx_w, *lnx_b; };
struct RwkvTok { float nkk, ka, d, kp, r, v, bon; };
__device__ __forceinline__ RwkvTok rwkv_tok(float zr, float zk, float zv, float pr, float pk, float pv, float lam, float a, float mur, float muk, float muv, float kkw, float kaw, float rkw, int lane) {
    RwkvTok o;
    const float r = zr + (pr - zr) * mur, k = zk + (pk - zk) * muk, v = zv + (pv - zv) * muv;
    const float kkr = k * kkw; const float ss = wave_sum(kkr * kkr, lane);
    const float kk = kkr / fmaxf(sqrtf(ss), 1e-12f);
    const float kp = k * (1.0f + (a - 1.0f) * kaw);
    o.nkk = -kk; o.ka = kk * a; o.d = __builtin_amdgcn_exp2f(-lam * LOG2E); o.kp = kp; o.r = r; o.v = v; o.bon = wave_sum(r * kp * rkw, lane);
    return o;
}
__device__ __forceinline__ void rwkv_chunk(const Ctx& C, const bf16* ZB, const bf16* LAM, const bf16* AA, const RwkvW& W, float* YL, float* U, bf16* BV, float* PHI, float* SLOC, int b, int h, int c,
                                           const float* ck, const float* cv, float* out) {
    constexpr unsigned PERB = (WINL - SS) * CA / 4, CPY_TOTAL = SB * PERB;
    const unsigned cbase = (unsigned)(C.vcu * NWAVES + C.wave) * (CHL * 64) + C.lane;
    const int lane = C.lane;
    LAS float* tokb = (LAS float*)(C.lds + C.wave * 12288);
    float S[64], P[64];
#pragma unroll
    for (int j = 0; j < 64; ++j) { S[j] = 0.f; P[j] = (j == lane) ? 1.f : 0.f; }
    const int hc = h * 64 + lane;
    const float mur = W.mu[hc], muk = W.mu[512 + hc], muv = W.mu[1024 + hc], kkw = W.k_k[hc], kaw = W.k_a[hc], rkw = W.r_k[hc];
    const int t0 = c * CHL; const size_t row0 = (size_t)b * TSEQ + t0;
    float pr = 0.f, pk = 0.f, pv = 0.f;
    if (t0 > 0) { const bf16* zp = ZB + (row0 - 1) * DBIN + hc; pr = bf1(zp[0]); pk = bf1(zp[512]); pv = bf1(zp[1024]); }
    for (int sb = 0; sb < CHL / 8; ++sb) {
        float zr[8], zk[8], zv[8], lm[8], aa[8];
#pragma unroll
        for (int tt = 0; tt < 8; ++tt) { const size_t row = row0 + sb * 8 + tt; const bf16* zp = ZB + row * DBIN + hc;
            zr[tt] = bf1(zp[0]); zk[tt] = bf1(zp[512]); zv[tt] = bf1(zp[1024]); lm[tt] = bf1(LAM[row * CB + hc]); aa[tt] = bf1(AA[row * CB + hc]); }
#pragma unroll
        for (int tt = 0; tt < 8; ++tt) {
            const RwkvTok o = rwkv_tok(zr[tt], zk[tt], zv[tt], pr, pk, pv, lm[tt], aa[tt], mur, muk, muv, kkw, kaw, rkw, lane);
            pr = zr[tt]; pk = zk[tt]; pv = zv[tt];
            LAS float* tk = tokb + tt * 384;
            tk[lane] = o.nkk; tk[64 + lane] = o.ka; tk[128 + lane] = o.d; tk[192 + lane] = o.kp; tk[256 + lane] = o.r; tk[320 + lane] = o.v;
            BV[(row0 + sb * 8 + tt) * CB + hc] = (bf16)(cvtpk(o.bon * o.v, 0.f) & 0xffffu);
        }
        LDS_WAIT(); asm volatile("" ::: "memory");
#pragma unroll 1
        for (int tt = 0; tt < 8; ++tt) {
            LAS const float* tk = tokb + tt * 384;
            unsigned ci = cbase + (unsigned)(sb * 8 + tt) * 64u; const bool cisv = ci >= CPY_TOTAL; ci -= cisv ? CPY_TOTAL : 0u;
            const bool cok = ci < CPY_TOTAL; const unsigned cb = ci / PERB, co = ci - cb * PERB; const size_t cdst = (size_t)cb * (WINL * CA / 4) + co;
            f32x4 cval = {0.f, 0.f, 0.f, 0.f};
            if (cok) cval = __builtin_nontemporal_load((const f32x4*)(cisv ? cv : ck) + (cdst + (SS * CA / 4)));
            float sS0 = 0.f, sS1 = 0.f, sP0 = 0.f, sP1 = 0.f;
#pragma unroll
            for (int j4 = 0; j4 < 16; ++j4) { const f32x4 nk = *(LAS const f32x4*)(tk + 4 * j4);
                sS0 = fmaf(S[4 * j4], nk[0], sS0); sS1 = fmaf(S[4 * j4 + 1], nk[1], sS1); sS0 = fmaf(S[4 * j4 + 2], nk[2], sS0); sS1 = fmaf(S[4 * j4 + 3], nk[3], sS1);
                sP0 = fmaf(P[4 * j4], nk[0], sP0); sP1 = fmaf(P[4 * j4 + 1], nk[1], sP1); sP0 = fmaf(P[4 * j4 + 2], nk[2], sP0); sP1 = fmaf(P[4 * j4 + 3], nk[3], sP1); }
            const float saS = sS0 + sS1, saP = sP0 + sP1, vi = tk[320 + lane];
            float yS0 = 0.f, yS1 = 0.f, yP0 = 0.f, yP1 = 0.f;
#pragma unroll
            for (int j4 = 0; j4 < 16; ++j4) {
                const f32x4 ka = *(LAS const f32x4*)(tk + 64 + 4 * j4), d = *(LAS const f32x4*)(tk + 128 + 4 * j4), kp = *(LAS const f32x4*)(tk + 192 + 4 * j4), r = *(LAS const f32x4*)(tk + 256 + 4 * j4);
#pragma unroll
                for (int e = 0; e < 4; ++e) { const int j = 4 * j4 + e;
                    float t = vi * kp[e]; t = fmaf(saS, ka[e], t); S[j] = fmaf(S[j], d[e], t);
                    const float u = saP * ka[e]; P[j] = fmaf(P[j], d[e], u);
                    if (e & 1) { yS1 = fmaf(S[j], r[e], yS1); yP1 = fmaf(P[j], r[e], yP1); } else { yS0 = fmaf(S[j], r[e], yS0); yP0 = fmaf(P[j], r[e], yP0); } }
            }
            const size_t row = row0 + sb * 8 + tt;
            YL[row * CB + hc] = yS0 + yS1; U[row * CB + hc] = yP0 + yP1;
            if (cok) __builtin_nontemporal_store(cval, (f32x4*)(out + (cisv ? O_VWS : O_KWS)) + cdst);
        }
    }
    float* so = SLOC + ((size_t)((b * NH + h) * NCHUNK + c) * 64 + lane) * 64;
    float* po = PHI + ((size_t)((b * NH + h) * NCHUNK + c) * 64 + lane) * 64;
#pragma unroll
    for (int j4 = 0; j4 < 16; ++j4) { *(GAS f32x4*)(so + 4 * j4) = (f32x4){S[4 * j4], S[4 * j4 + 1], S[4 * j4 + 2], S[4 * j4 + 3]}; *(GAS f32x4*)(po + 4 * j4) = (f32x4){P[4 * j4], P[4 * j4 + 1], P[4 * j4 + 2], P[4 * j4 + 3]}; }
}
__device__ __forceinline__ void rwkv_sample(const Ctx& C, const bf16* ZB, const bf16* LAM, const bf16* AA, const bf16* G, const RwkvW& W, const float* state_wkv, const float* state_shift, bf16* HEADS, float* out) {
    if (C.vcu >= SB * NH || C.wave != 0) return;
    const int b = C.vcu >> 3, h = C.vcu & 7, lane = C.lane, hc = h * 64 + lane;
    LAS float* tk = (LAS float*)(C.lds + 98304);
    LAS float* Sl = (LAS float*)(C.lds + 98304 + 2048) + lane * 65;
    const float* s0 = state_wkv + ((size_t)(b * NH + h) * 64 + lane) * 64;
#pragma unroll 4
    for (int j = 0; j < 64; ++j) Sl[j] = s0[j];
    float pr = state_shift[(size_t)b * DBIN + hc], pk = state_shift[(size_t)b * DBIN + 512 + hc], pv = state_shift[(size_t)b * DBIN + 1024 + hc];
#pragma unroll 1
    for (int s = 0; s < SS; ++s) {
        const size_t row = (size_t)MPR + b * SS + s; const bf16* zp = ZB + row * DBIN + hc;
        const float zr = bf1(zp[0]), zk = bf1(zp[512]), zv = bf1(zp[1024]);
        const RwkvTok o = rwkv_tok(zr, zk, zv, pr, pk, pv, bf1(LAM[row * CB + hc]), bf1(AA[row * CB + hc]), W.mu[hc], W.mu[512 + hc], W.mu[1024 + hc], W.k_k[hc], W.k_a[hc], W.r_k[hc], lane);
        pr = zr; pk = zk; pv = zv;
        tk[lane] = o.nkk; tk[64 + lane] = o.ka; tk[128 + lane] = o.d; tk[192 + lane] = o.kp; tk[256 + lane] = o.r;
        LDS_WAIT(); asm volatile("" ::: "memory");
        float sa = 0.f;
#pragma unroll 4
        for (int j = 0; j < 64; ++j) sa = fmaf(Sl[j], tk[j], sa);
        float y = 0.f;
#pragma unroll 4
        for (int j = 0; j < 64; ++j) { float t = o.v * tk[192 + j]; t = fmaf(sa, tk[64 + j], t); const float sn = fmaf(Sl[j], tk[128 + j], t); Sl[j] = sn; y = fmaf(sn, tk[256 + j], y); }
        const float ym = wave_sum(y, lane) * (1.0f / 64.0f), dy = y - ym, yv = wave_sum(dy * dy, lane) * (1.0f / 64.0f);
        const float yn = dy * __builtin_amdgcn_rsqf(yv + GN_EPS) * W.lnx_w[hc] + W.lnx_b[hc];
        const float res = (yn + o.bon * o.v) * bf1(G[row * CB + hc]);
        HEADS[row * DM + CA + hc] = (bf16)(cvtpk(res, 0.f) & 0xffffu);
        LDS_WAIT(); asm volatile("" ::: "memory");
    }
    float* so = out + O_WKVS + ((size_t)(b * NH + h) * 64 + lane) * 64;
#pragma unroll 4
    for (int j = 0; j < 64; ++j) so[j] = Sl[j];
}

__device__ __forceinline__ void rwkv_carry(const Ctx& C, const float* PHI, const float* SLOC, float* SC, float* out) {
    const int bh = C.vcu >> 2, rq = C.vcu & 3, tid = C.tid;
    if (bh >= NBATCH * NH) return;
    LAS float* cur = (LAS float*)(C.lds);
    LAS float* phi = (LAS float*)(C.lds + 4096);
    const int row = tid >> 5, cp = tid & 31;
    for (int i = tid; i < 1024; i += 512) cur[i] = 0.f;
    f32x4 pre[2];
    { const float* p0 = PHI + (size_t)(bh * NCHUNK) * 4096; pre[0] = *(const GAS f32x4*)(p0 + tid * 4); pre[1] = *(const GAS f32x4*)(p0 + 2048 + tid * 4); }
    for (int c = 0; c < NCHUNK; ++c) {
        __syncthreads();
        *(LAS f32x4*)(phi + tid * 4) = pre[0]; *(LAS f32x4*)(phi + 2048 + tid * 4) = pre[1];
        if (c + 1 < NCHUNK) { const float* p1 = PHI + (size_t)(bh * NCHUNK + c + 1) * 4096; pre[0] = *(const GAS f32x4*)(p1 + tid * 4); pre[1] = *(const GAS f32x4*)(p1 + 2048 + tid * 4); }
        const size_t go = ((size_t)(bh * NCHUNK + c) * 64 + rq * 16 + row) * 64 + 2 * cp;
        const f32x2_t sl = *(const GAS f32x2_t*)(SLOC + go);
        const f32x2_t cv = *(LAS const f32x2_t*)(cur + row * 64 + 2 * cp);
        *(GAS f32x2_t*)(SC + go) = cv;
        __syncthreads();
        float a0 = sl[0], a1 = sl[1];
#pragma unroll 4
        for (int k4 = 0; k4 < 16; ++k4) { const f32x4 cr = *(LAS const f32x4*)(cur + row * 64 + 4 * k4);
#pragma unroll
            for (int e = 0; e < 4; ++e) { const f32x2_t ph = *(LAS const f32x2_t*)(phi + (4 * k4 + e) * 64 + 2 * cp); a0 = fmaf(cr[e], ph[0], a0); a1 = fmaf(cr[e], ph[1], a1); } }
        __syncthreads();
        *(LAS f32x2_t*)(cur + row * 64 + 2 * cp) = (f32x2_t){a0, a1};
    }
    __syncthreads();
    const f32x2_t fin = *(LAS const f32x2_t*)(cur + row * 64 + 2 * cp);
    *(GAS f32x2_t*)(out + O_WKVP + ((size_t)bh * 64 + rq * 16 + row) * 64 + 2 * cp) = fin;
    __syncthreads();
}

__device__ __forceinline__ void rwkv_finish(const Ctx& C, const float* YL, const float* U, const float* SC, const bf16* BV, const bf16* G, const RwkvW& W, bf16* HEADS) {
    const int tid = C.tid;
    LAS float* spT = (LAS float*)(C.lds);
    LAS float* ut = (LAS float*)(C.lds + 16384);
    const int tok = tid >> 2, iq = tid & 3;
    for (int it = 0; it < 8; ++it) {
        const int item = C.vcu * 8 + it, bh = item >> 5, c = item & 31, b = bh >> 3, h = bh & 7;
        if (bh >= NBATCH * NH) break;
        const float* sc = SC + (size_t)(bh * NCHUNK + c) * 4096;
        for (int e = tid; e < 4096; e += 512) { const int i = e >> 6, j = e & 63; spT[j * 64 + i] = sc[e]; }
        const size_t row0 = (size_t)b * TSEQ + c * CHL;
        for (int e = tid; e < CHL * 16; e += 512) { const int t = e >> 4, j4 = e & 15; *(LAS f32x4*)(ut + t * 64 + 4 * j4) = *(const GAS f32x4*)(U + (row0 + t) * CB + h * 64 + 4 * j4); }
        __syncthreads();
        const size_t row = row0 + tok; const int hc = h * 64 + 16 * iq;
        float y[16];
#pragma unroll
        for (int q = 0; q < 4; ++q) { const f32x4 v = *(const GAS f32x4*)(YL + row * CB + hc + 4 * q); y[4 * q] = v[0]; y[4 * q + 1] = v[1]; y[4 * q + 2] = v[2]; y[4 * q + 3] = v[3]; }
#pragma unroll 4
        for (int j = 0; j < 64; ++j) { const float u = ut[tok * 64 + j];
#pragma unroll
            for (int q = 0; q < 4; ++q) { const f32x4 s4 = *(LAS const f32x4*)(spT + j * 64 + 16 * iq + 4 * q); y[4 * q] = fmaf(s4[0], u, y[4 * q]); y[4 * q + 1] = fmaf(s4[1], u, y[4 * q + 1]); y[4 * q + 2] = fmaf(s4[2], u, y[4 * q + 2]); y[4 * q + 3] = fmaf(s4[3], u, y[4 * q + 3]); } }
        float sm = 0.f;
#pragma unroll
        for (int e = 0; e < 16; ++e) sm += y[e];
        sm += shx(sm, 1, C.lane); sm += shx(sm, 2, C.lane);
        const float ym = sm * (1.0f / 64.0f); float sv = 0.f;
#pragma unroll
        for (int e = 0; e < 16; ++e) { y[e] -= ym; sv += y[e] * y[e]; }
        sv += shx(sv, 1, C.lane); sv += shx(sv, 2, C.lane);
        const float rs = __builtin_amdgcn_rsqf(sv * (1.0f / 64.0f) + GN_EPS);
        const v4u bw0 = *(const GAS v4u*)(BV + row * CB + hc), bw1 = *(const GAS v4u*)(BV + row * CB + hc + 8);
        const v4u gw0 = *(const GAS v4u*)(G + row * CB + hc), gw1 = *(const GAS v4u*)(G + row * CB + hc + 8);
        const unsigned bwv[8] = {bw0.x, bw0.y, bw0.z, bw0.w, bw1.x, bw1.y, bw1.z, bw1.w}, gwv[8] = {gw0.x, gw0.y, gw0.z, gw0.w, gw1.x, gw1.y, gw1.z, gw1.w};
        unsigned ow[8];
#pragma unroll
        for (int q = 0; q < 8; ++q) {
            const float r0 = (y[2 * q] * rs * W.lnx_w[hc + 2 * q] + W.lnx_b[hc + 2 * q] + bflo(bwv[q])) * bflo(gwv[q]);
            const float r1 = (y[2 * q + 1] * rs * W.lnx_w[hc + 2 * q + 1] + W.lnx_b[hc + 2 * q + 1] + bfhi(bwv[q])) * bfhi(gwv[q]);
            ow[q] = cvtpk(r0, r1); }
        *(GAS v4u*)(HEADS + row * DM + CA + hc) = (v4u){ow[0], ow[1], ow[2], ow[3]};
        *(GAS v4u*)(HEADS + row * DM + CA + hc + 8) = (v4u){ow[4], ow[5], ow[6], ow[7]};
        __syncthreads();
    }
}

template <int MODE> __device__ __forceinline__ void ln_pass(const Ctx& C, const float* PRE, const float* w, const float* bsh, bf16* Hout, float* out) {
    const int gw = C.vcu * NWAVES + C.wave, NGW = C.G * NWAVES, lane = C.lane;
    f32x4 wv[4], bv[4];
#pragma unroll
    for (int j = 0; j < 4; ++j) { wv[j] = *(const GAS f32x4*)(w + 256 * j + 4 * lane); bv[j] = *(const GAS f32x4*)(bsh + 256 * j + 4 * lane); }
    for (int row = gw; row < MPR + MSA; row += NGW) {
        const GAS f32x4* xr = (const GAS f32x4*)(PRE + (size_t)row * DM) + lane;
        f32x4 v[4]; float s = 0.f;
#pragma unroll
        for (int j = 0; j < 4; ++j) { v[j] = xr[64 * j]; s += (v[j][0] + v[j][1]) + (v[j][2] + v[j][3]); }
        const float mean = wave_sum(s, lane) * (1.f / DM); float s2 = 0.f;
#pragma unroll
        for (int j = 0; j < 4; ++j) { v[j] = v[j] - mean; s2 += (v[j][0] * v[j][0] + v[j][1] * v[j][1]) + (v[j][2] * v[j][2] + v[j][3] * v[j][3]); }
        const float rstd = __builtin_amdgcn_rsqf(wave_sum(s2, lane) * (1.f / DM) + LN_EPS);
        if (MODE == 0) {
            GAS u32x2* o8 = (GAS u32x2*)(Hout + (size_t)row * DM) + lane;
#pragma unroll
            for (int j = 0; j < 4; ++j) { const f32x4 o = v[j] * rstd * wv[j] + bv[j]; u32x2 wq; wq.x = cvtpk(o[0], o[1]); wq.y = cvtpk(o[2], o[3]); o8[64 * j] = wq; }
        } else {
            float* dst = row < MPR ? out + O_YP + (size_t)row * DM : out + O_YS + (size_t)(row - MPR) * DM;
#pragma unroll
            for (int j = 0; j < 4; ++j) *((GAS f32x4*)dst + lane + 64 * j) = v[j] * rstd * wv[j] + bv[j];
        }
    }
}
struct Args { const float* in[32]; float* out; unsigned char* ws; int nphase, pad; };
#ifndef PHMASK
#define PHMASK 0xFFFFFF
#endif
#ifndef REPPH
#define REPPH -1
#endif
#ifndef REPN
#define REPN 3
#endif
#define PHON(n) if constexpr (((PHMASK) >> (n)) & 1) for (int rep_ = 0; rep_ < ((n) == (REPPH) ? (REPN) : 1); ++rep_)
#ifndef GEMM_ALIGN
#define GEMM_ALIGN true
#endif
#ifndef GEMM_SP2
#define GEMM_SP2 true
#endif
__global__ void __launch_bounds__(NWAVES * 64, 2) mega_fwd(Args args) {
    extern __shared__ __attribute__((aligned(16))) unsigned char lds_raw[];
    LAS unsigned char* const lds0 = (LAS unsigned char*)lds_raw;
    volatile LAS unsigned* MISC = (volatile LAS unsigned*)(lds0 + MISC_OFF);
    const int G0 = gridDim.x;
    for (int u = threadIdx.x; u < (LDS_BYTES - LDSCTL_OFF) / 4; u += NWAVES * 64) ((LAS unsigned*)(lds0 + LDSCTL_OFF))[u] = 0u;
    __syncthreads();
    gu32* ctl = (gu32*)(args.ws + WS_CTL);
    XcdBarrier bar = xcd_barrier_post((unsigned*)(ctl + CW_BAR), MISC + 8);
    const int nph = args.nphase;
#define GRID_BAR() xcd_barrier(bar)
    typedef const __attribute__((address_space(4))) Args* KArgs;
#define PH_BEGIN Ctx C; { int t_ = threadIdx.x; asm volatile("" : "+v"(t_)); C.lds = lds0; C.tid = t_; C.lane = t_ & 63; C.wave = __builtin_amdgcn_readfirstlane(t_ >> 6); C.G = G0; const int bx_ = blockIdx.x; C.vcu = (G0 % 8 == 0) ? (bx_ % 8) * (G0 / 8) + bx_ / 8 : bx_; } KArgs kp = (KArgs)__builtin_amdgcn_kernarg_segment_ptr(); asm volatile("" : "+s"(kp)); unsigned char* ws = kp->ws; float* out = kp->out; (void)ws; (void)out;
#define IN_(i) (kp->in[i])
#define WSB(off) ((bf16*)(ws + (off)))
#define WSF(off) ((float*)(ws + (off)))
    const int bx = (int)blockIdx.x;

    PHON(0) { PH_BEGIN P0Args A{IN_(0), IN_(1), IN_(2), IN_(3), IN_(4), IN_(5), IN_(8), IN_(20), IN_(23), IN_(24), IN_(25), IN_(28), IN_(29), IN_(11), IN_(13), IN_(14),
                       WSB(WS_WIN), WSB(WS_WOUT), WSB(WS_WGU), WSB(WS_WD), WSB(WS_WPG), WSB(WS_WPP), WSB(WS_WL), WSB(WS_R1), WSB(WS_PB), out};
      p0_prologue(C, A); }
    GRID_BAR(); if (nph <= 1) return;
    PHON(1) { PH_BEGIN pg8::Gemm g{WSB(WS_R1), WSB(WS_WIN), MT, DIN, DM}; pg8::StaticOrder S; S.init(MT, DIN, C.G, bx);
      pg8::EpiZ E{WSB(WS_QB), WSB(WS_ZB), out};
      pg8::gemm_phase<pg8::EpiZ, pg8::StaticOrder, GEMM_ALIGN, GEMM_SP2>(C.lds + RING_OFF, g, S, E); }
    GRID_BAR(); if (nph <= 2) return;
    PHON(2) { PH_BEGIN prep_a(C, WSB(WS_ZB), IN_(9), IN_(7), WSB(WS_AP), out); }
    PHON(3) { PH_BEGIN attn_prompt(C, WSB(WS_QB), WSB(WS_KB), WSB(WS_VB), WSB(WS_OG), WSF(WS_LSE)); }
    PHON(4) { PH_BEGIN attn_sample(C, WSB(WS_QB), IN_(4), IN_(5), out, WSB(WS_R1)); }
    GRID_BAR(); if (nph <= 3) return;
    PHON(5) { PH_BEGIN pg8::Gemm g{WSB(WS_AP), WSB(WS_WL), MT, 1536, 256}; pg8::StaticOrder S; S.init(MT, 1536, C.G, bx);
      pg8::EpiLora E{WSB(WS_QB), IN_(10), IN_(12)};
      pg8::gemm_phase<pg8::EpiLora, pg8::StaticOrder, GEMM_ALIGN, GEMM_SP2>(C.lds + RING_OFF, g, S, E); }
    PHON(6) { PH_BEGIN attn_merge(C, WSB(WS_OG), WSF(WS_LSE), WSB(WS_R1)); }
    GRID_BAR(); if (nph <= 4) return;
    PHON(7) { PH_BEGIN const RwkvW RW{IN_(9), IN_(15), IN_(16), IN_(17), IN_(18), IN_(19)};
      rwkv_sample(C, WSB(WS_ZB), WSB(WS_QB), WSB(WS_KB), WSB(WS_VB), RW, IN_(6), IN_(7), WSB(WS_R1), out); }
    PHON(8) { PH_BEGIN const RwkvW RW{IN_(9), IN_(15), IN_(16), IN_(17), IN_(18), IN_(19)};
      const int bh = C.vcu >> 2, c = (C.vcu & 3) * 8 + C.wave;
      if (bh < NBATCH * NH) rwkv_chunk(C, WSB(WS_ZB), WSB(WS_QB), WSB(WS_KB), RW, out + O_YP, out + O_YP + (size_t)MPR * CB, WSB(WS_BV), WSF(WS_PHI), WSF(WS_SLOC), bh >> 3, bh & 7, c, IN_(4), IN_(5), out); }
    GRID_BAR(); if (nph <= 5) return;
    PHON(9) { PH_BEGIN rwkv_carry(C, WSF(WS_PHI), WSF(WS_SLOC), WSF(WS_SC), out); }
    GRID_BAR(); if (nph <= 6) return;
    PHON(10) { PH_BEGIN const RwkvW RW{IN_(9), IN_(15), IN_(16), IN_(17), IN_(18), IN_(19)};
      rwkv_finish(C, out + O_YP, out + O_YP + (size_t)MPR * CB, WSF(WS_SC), WSB(WS_BV), WSB(WS_VB), RW, WSB(WS_R1)); }
    GRID_BAR(); if (nph <= 7) return;
    PHON(11) { PH_BEGIN pg8::Gemm g{WSB(WS_R1), WSB(WS_WOUT), MT, DM, DM}; pg8::StaticOrder S; S.init(MT, DM, C.G, bx);
      pg8::EpiWout E{WSF(WS_PRE), IN_(0), IN_(1)};
      pg8::gemm_phase<pg8::EpiWout, pg8::StaticOrder, GEMM_ALIGN, GEMM_SP2>(C.lds + RING_OFF, g, S, E); }
    GRID_BAR(); if (nph <= 8) return;
    PHON(12) { PH_BEGIN ln_pass<0>(C, WSF(WS_PRE), IN_(21), IN_(22), WSB(WS_R1), out); }
    GRID_BAR(); if (nph <= 9) return;
    PHON(13) { PH_BEGIN pg8::Gemm g{WSB(WS_R1), WSB(WS_WGU), MT, 2 * DFF, DM}; pg8::StaticOrder S; S.init(MT, 2 * DFF, C.G, bx);
      pg8::EpiGU E{WSB(WS_ACT)};
      pg8::gemm_phase<pg8::EpiGU, pg8::StaticOrder, GEMM_ALIGN, GEMM_SP2>(C.lds + RING_OFF, g, S, E); }
    GRID_BAR(); if (nph <= 10) return;
    PHON(14) { PH_BEGIN pg8::Gemm g{WSB(WS_ACT), WSB(WS_WD), MT, DM, DFF}; pg8::StaticOrder S; S.init(MT, DM, C.G, bx);
      pg8::EpiDown E{WSF(WS_PRE), WSB(WS_R1)};
      pg8::gemm_phase<pg8::EpiDown, pg8::StaticOrder, GEMM_ALIGN, GEMM_SP2>(C.lds + RING_OFF, g, S, E); }
    GRID_BAR(); if (nph <= 11) return;
    PHON(15) { PH_BEGIN ln_pass<0>(C, WSF(WS_PRE), IN_(26), IN_(27), WSB(WS_H2), out); }
    GRID_BAR(); if (nph <= 12) return;
    PHON(16) { PH_BEGIN pg8::Gemm g{WSB(WS_PB), WSB(WS_WPP), MT, DM, PLE}; pg8::StaticOrder S; S.init(MT, DM, C.G, bx);
      pg8::EpiPlain E{WSB(WS_PP)};
      pg8::gemm_phase<pg8::EpiPlain, pg8::StaticOrder, GEMM_ALIGN, GEMM_SP2>(C.lds + RING_OFF, g, S, E); }
    GRID_BAR(); if (nph <= 13) return;
    PHON(17) { PH_BEGIN pg8::Gemm g{WSB(WS_H2), WSB(WS_WPG), MT, DM, DM}; pg8::StaticOrder S; S.init(MT, DM, C.G, bx);
      pg8::EpiPle E{WSF(WS_PRE), WSB(WS_H2), WSB(WS_PP)};
      pg8::gemm_phase<pg8::EpiPle, pg8::StaticOrder, GEMM_ALIGN, GEMM_SP2>(C.lds + RING_OFF, g, S, E); }
    GRID_BAR(); if (nph <= 14) return;
    PHON(18) { PH_BEGIN ln_pass<1>(C, WSF(WS_PRE), IN_(30), IN_(31), nullptr, out); }
}

#ifndef N_PHASES
#define N_PHASES 99
#endif
extern "C" void kernel_launch(void* const* d_in, const int* in_sizes, int n_in, void* d_out, int out_size, void* d_ws, size_t ws_size, hipStream_t stream) {
    static int grid = 0;
    if (grid == 0) {
        if (n_in != 32 || in_sizes[0] != MPR * DM || (size_t)out_size != O_END || ws_size < WS_END) {
            fprintf(stderr, "kernel_launch: unexpected shapes: n_in %d in0 %d out %d (want %zu) ws %zu (want >= %zu); nothing launched\n", n_in, n_in > 0 ? in_sizes[0] : -1, out_size, (size_t)O_END, ws_size, (size_t)WS_END);
            grid = -1; return; }
        int dev = 0, cus = 0, per_cu = 0;
        if (hipGetDevice(&dev) != hipSuccess || hipDeviceGetAttribute(&cus, hipDeviceAttributeMultiprocessorCount, dev) != hipSuccess) { fprintf(stderr, "kernel_launch: device query failed\n"); grid = -1; return; }
        if (hipFuncSetAttribute((const void*)mega_fwd, hipFuncAttributeMaxDynamicSharedMemorySize, LDS_BYTES) != hipSuccess) { fprintf(stderr, "kernel_launch: hipFuncSetAttribute failed\n"); grid = -1; return; }
        if (hipOccupancyMaxActiveBlocksPerMultiprocessor(&per_cu, (const void*)mega_fwd, NWAVES * 64, LDS_BYTES) != hipSuccess || per_cu < 1) { fprintf(stderr, "kernel_launch: occupancy query reports %d blocks per CU\n", per_cu); }
        (void)hipGetLastError();
        grid = cus;
        if (grid != 256) fprintf(stderr, "kernel_launch: note: %d CUs (work distribution assumes 256)\n", grid);
    }
    if (grid < 0) return;
    if (hipMemsetAsync((char*)d_ws + WS_CTL, 0, CTL_ZERO_BYTES, stream) != hipSuccess) { fprintf(stderr, "kernel_launch: memset failed\n"); return; }
    Args a{};
    for (int i = 0; i < 32; ++i) a.in[i] = (const float*)d_in[i];
    a.out = (float*)d_out; a.ws = (unsigned char*)d_ws; a.nphase = N_PHASES; a.pad = 0;
    hipLaunchKernelGGL(mega_fwd, dim3(grid), dim3(NWAVES * 64), LDS_BYTES, stream, a);
    const hipError_t le = hipPeekAtLastError();
    if (le != hipSuccess) fprintf(stderr, "kernel_launch: launch failed: %s\n", hipGetErrorName(le));
}
```

```cpp
#include <hip/hip_runtime.h>
#include <cstdio>
#include <cstdint>
constexpr int DM = 1024, TSEQ = 4096, NBATCH = 8, MPR = NBATCH * TSEQ;
constexpr int SB = 32, SS = 4, MSA = SB * SS;
constexpr int MT = MPR + 256;
constexpr int CA = 512, CB = 512, DBIN = 1792, DIN = 3328, DFF = 2816, PLE = 256, HD = 64, NH = 8;
constexpr int WINL = 2048;
constexpr float ALPHA = 1.18920711500272f;
constexpr float LN_EPS = 1e-5f, GN_EPS = 64e-5f;
constexpr float QSCALE = 0.125f * 1.4426950408889634f;
constexpr float LOG2E = 1.4426950408889634f;
constexpr size_t O_YP = 0, O_YS = O_YP + (size_t)MPR * DM, O_KWP = O_YS + (size_t)MSA * DM, O_VWP = O_KWP + (size_t)NBATCH * WINL * CA,
                 O_WKVP = O_VWP + (size_t)NBATCH * WINL * CA, O_SHP = O_WKVP + (size_t)NBATCH * NH * HD * HD, O_KWS = O_SHP + (size_t)NBATCH * DBIN,
                 O_VWS = O_KWS + (size_t)SB * WINL * CA, O_WKVS = O_VWS + (size_t)SB * WINL * CA, O_SHS = O_WKVS + (size_t)SB * NH * HD * HD,
                 O_END = O_SHS + (size_t)SB * DBIN;
namespace pg8 {
#define PG8_LAS __attribute__((address_space(3)))
typedef unsigned short bf16_t;
typedef short bf16x8 __attribute__((ext_vector_type(8)));
typedef float f32x4 __attribute__((ext_vector_type(4)));
typedef unsigned u32x4 __attribute__((ext_vector_type(4)));
constexpr int BM = 256, BK = 64, HALF = 128, HTB = HALF * BK * 2  , STAGE_BYTES = 8 * HTB, NXCD = 8, WGM = 8;

__host__ __device__ __forceinline__ int lds_byte(int r, int c) { const int st = (r >> 4) * 2 + (c >> 5), rr = r & 15, cc = c & 31, ob = rr * 64 + cc * 2; return st * 1024 + (ob ^ (((ob >> 9) & 1) << 5)); }
__host__ __device__ __forceinline__ void stage_rc(int b, int& R, int& C) { const int st = b / 1024, sb = b % 1024, swz = sb ^ (((sb >> 9) & 1) << 5); R = (st >> 1) * 16 + swz / 64; C = (st & 1) * 32 + (swz % 64) / 2; }
__host__ __device__ __forceinline__ int perm32(int rho) { const int n = rho >> 4, i = rho & 15; return 8 * (i >> 2) + 4 * n + (i & 3); }

struct Unit { int pm, pn; };
struct Gemm { const bf16_t* A; const bf16_t* Bt; int M, N, K; };

struct StaticOrder {
    int nM, nN, nwg, G, c;
    __host__ __device__ void init(int M, int N, int G_, int c_) { nM = M / BM; nN = N / BM; nwg = nM * nN; G = G_; c = c_; }
    __host__ __device__ bool next(int i, Unit& u) const {
        const long L = (long)i * G + c; if (L >= nwg) return false;
        int wgid = (int)L; { const int q = nwg / NXCD, r = nwg % NXCD, xcd = wgid % NXCD, off = wgid / NXCD; wgid = (xcd < r ? xcd * (q + 1) : r * (q + 1) + (xcd - r) * q) + off; }
        const int nig = WGM * nN, gid = wgid / nig, fm = gid * WGM, gsz = (nM - fm) < WGM ? (nM - fm) : WGM;
        u.pm = fm + ((wgid % nig) % gsz); u.pn = (wgid % nig) / gsz; return true;
    }
    __device__ __forceinline__ void a_ready(const Unit&) const {}
    __device__ __forceinline__ void done(const Unit&) const {}
};

typedef unsigned u32x2 __attribute__((ext_vector_type(2)));
__device__ __forceinline__ unsigned cvt_pk_bf16(float lo, float hi) { unsigned r; asm volatile("v_cvt_pk_bf16_f32 %0, %1, %2" : "=v"(r) : "v"(lo), "v"(hi)); return r; }
__device__ __forceinline__ float bf_lo(unsigned w) { return __uint_as_float(w << 16); }
__device__ __forceinline__ float bf_hi(unsigned w) { return __uint_as_float(w & 0xffff0000u); }
__device__ __forceinline__ float sigmoidf_(float x) { return __builtin_amdgcn_rcpf(1.0f + __builtin_amdgcn_exp2f(-x * 1.4426950408889634f)); }
__device__ __forceinline__ u32x4 pack8(const f32x4& a, const f32x4& b) { u32x4 w; w.x = cvt_pk_bf16(a[0], a[1]); w.y = cvt_pk_bf16(a[2], a[3]); w.z = cvt_pk_bf16(b[0], b[1]); w.w = cvt_pk_bf16(b[2], b[3]); return w; }

struct EpiZ {
    static constexpr bool PERM = true, AFTER_DRAIN = false;
    bf16_t *QB, *ZB; float* out;
    __device__ __forceinline__ void operator()(const f32x4 (&acc)[2][2][4][2], const Unit& u, int wr, int wc, int fr, int fq) const {
        const int pn = u.pn, pm = u.pm;
        const int kind = pn < 6 ? (pn >> 1) : 3;
        bf16_t* dst = kind == 3 ? ZB : QB + (size_t)kind * ((size_t)MT * CA);
        const int ld = kind == 3 ? DBIN : CA;
        const int col0 = (kind == 3 ? (pn - 6) * 256 : (pn & 1) * 256) + wc * 32 + 8 * fq;
        const float sc = kind == 0 ? QSCALE : 1.0f;
        const int rbase = pm * BM + wr * 64 + fr;
        const bool win_p = (kind == 1 || kind == 2) && pm < 128 && (pm & 15) >= 8;
        const bool win_s = (kind == 1 || kind == 2) && pm == 128;
        float* wout = out + (win_s ? O_KWS : O_KWP) + (kind == 2 ? (win_s ? (O_VWS - O_KWS) : (O_VWP - O_KWP)) : (size_t)0);
#pragma unroll
        for (int ai = 0; ai < 2; ++ai)
#pragma unroll
            for (int m = 0; m < 4; ++m) {
                const int row = rbase + ai * HALF + m * 16;
                bf16_t* rowp = dst + (size_t)row * ld + col0;
#pragma unroll
                for (int bj = 0; bj < 2; ++bj) {
                    const f32x4 v0 = acc[ai][bj][m][0] * sc, v1 = acc[ai][bj][m][1] * sc;
                    *(u32x4*)(rowp + bj * HALF) = pack8(v0, v1);
                    if (win_p) {
                        const int b = pm >> 4, t = (pm & 15) * 256 + (row & 255);
                        float* o = wout + ((size_t)(b * WINL + t - WINL) * CA + col0 + bj * HALF);
                        *(f32x4*)o = v0; *(f32x4*)(o + 4) = v1;
                    } else if (win_s && ai == 0) {
                        const int rs = row - MPR, b = rs >> 2, s = rs & 3;
                        float* o = wout + ((size_t)(b * WINL + (WINL - SS) + s) * CA + col0 + bj * HALF);
                        *(f32x4*)o = v0; *(f32x4*)(o + 4) = v1;
                    }
                }
            }
    }
};

struct EpiLora {
    static constexpr bool PERM = true, AFTER_DRAIN = false;
    bf16_t *LAM; const float *w0, *a0;
    __device__ __forceinline__ void operator()(const f32x4 (&acc)[2][2][4][2], const Unit& u, int wr, int wc, int fr, int fq) const {
        const int kind = u.pn >> 1;
        bf16_t* dst = LAM + (size_t)kind * ((size_t)MT * CB);
        const int col0 = (u.pn & 1) * 256 + wc * 32 + 8 * fq;
        const float* bias = kind == 0 ? w0 : a0;
        const float mul = kind == 0 ? 0.6065306597126334f : 1.0f;
        const int rbase = u.pm * BM + wr * 64 + fr;
#pragma unroll
        for (int bj = 0; bj < 2; ++bj) {
            f32x4 b0 = {0.f, 0.f, 0.f, 0.f}, b1 = b0;
            if (kind < 2) { b0 = *(const f32x4*)(bias + col0 + bj * HALF); b1 = *(const f32x4*)(bias + col0 + bj * HALF + 4); }
#pragma unroll
            for (int ai = 0; ai < 2; ++ai)
#pragma unroll
                for (int m = 0; m < 4; ++m) {
                    f32x4 v0 = acc[ai][bj][m][0] + b0, v1 = acc[ai][bj][m][1] + b1;
                    if (kind < 2) {
#pragma unroll
                        for (int e = 0; e < 4; ++e) { v0[e] = mul * sigmoidf_(v0[e]); v1[e] = mul * sigmoidf_(v1[e]); }
                    }
                    *(u32x4*)(dst + (size_t)(rbase + ai * HALF + m * 16) * CB + col0 + bj * HALF) = pack8(v0, v1);
                    asm volatile("" ::: "memory");
                }
        }
    }
};

__device__ __forceinline__ f32x4 xres4(const float* xp, const float* xs, int row, int col) {
    if (row < MPR) return *(const f32x4*)(xp + (size_t)row * DM + col);
    if (row < MPR + MSA) return *(const f32x4*)(xs + (size_t)(row - MPR) * DM + col);
    return (f32x4){0.f, 0.f, 0.f, 0.f};
}
struct EpiWout {
    static constexpr bool PERM = false, AFTER_DRAIN = false;
    float* PRE; const float *xp, *xs;
    __device__ __forceinline__ void operator()(const f32x4 (&acc)[2][2][4][2], const Unit& u, int wr, int wc, int fr, int fq) const {
        const int row0 = u.pm * BM + wr * 64 + fr, col0 = u.pn * BM + wc * 32 + 4 * fq;
#pragma unroll
        for (int ai = 0; ai < 2; ++ai)
#pragma unroll
            for (int m = 0; m < 4; ++m) { const int row = row0 + ai * HALF + m * 16; float* rowp = PRE + (size_t)row * DM + col0;
#pragma unroll
                for (int bj = 0; bj < 2; ++bj)
#pragma unroll
                    for (int n = 0; n < 2; ++n) { const f32x4 xr = xres4(xp, xs, row, col0 + bj * HALF + n * 16); *(f32x4*)(rowp + bj * HALF + n * 16) = acc[ai][bj][m][n] + xr * ALPHA; } }
    }
};
struct EpiGU {
    static constexpr bool PERM = true, AFTER_DRAIN = false;
    bf16_t* ACT;
    __device__ __forceinline__ void operator()(const f32x4 (&acc)[2][2][4][2], const Unit& u, int wr, int wc, int fr, int fq) const {
        const int row0 = u.pm * BM + wr * 64 + fr, col0 = u.pn * HALF + wc * 32 + 8 * fq;
#pragma unroll
        for (int ai = 0; ai < 2; ++ai)
#pragma unroll
            for (int m = 0; m < 4; ++m) {
                f32x4 o[2];
#pragma unroll
                for (int n = 0; n < 2; ++n)
#pragma unroll
                    for (int e = 0; e < 4; ++e) { const float g = acc[ai][0][m][n][e], up = acc[ai][1][m][n][e]; o[n][e] = g * sigmoidf_(g) * up; }
                *(u32x4*)(ACT + (size_t)(row0 + ai * HALF + m * 16) * DFF + col0) = pack8(o[0], o[1]);
            }
    }
};
struct EpiDown {
    static constexpr bool PERM = false, AFTER_DRAIN = false;
    float* PRE; const bf16_t* H;
    __device__ __forceinline__ void operator()(const f32x4 (&acc)[2][2][4][2], const Unit& u, int wr, int wc, int fr, int fq) const {
        const int row0 = u.pm * BM + wr * 64 + fr, col0 = u.pn * BM + wc * 32 + 4 * fq;
#pragma unroll
        for (int ai = 0; ai < 2; ++ai)
#pragma unroll
            for (int m = 0; m < 4; ++m) { const size_t off = (size_t)(row0 + ai * HALF + m * 16) * DM + col0;
#pragma unroll
                for (int bj = 0; bj < 2; ++bj)
#pragma unroll
                    for (int n = 0; n < 2; ++n) { const u32x2 hw = *(const u32x2*)(H + off + bj * HALF + n * 16);
                        const f32x4 hr = (f32x4){bf_lo(hw.x), bf_hi(hw.x), bf_lo(hw.y), bf_hi(hw.y)};
                        *(f32x4*)(PRE + off + bj * HALF + n * 16) = acc[ai][bj][m][n] + hr * ALPHA; } }
    }
};
struct EpiPlain {
    static constexpr bool PERM = true, AFTER_DRAIN = false;
    bf16_t* O;
    __device__ __forceinline__ void operator()(const f32x4 (&acc)[2][2][4][2], const Unit& u, int wr, int wc, int fr, int fq) const {
        const int row0 = u.pm * BM + wr * 64 + fr, col0 = u.pn * BM + wc * 32 + 8 * fq;
#pragma unroll
        for (int ai = 0; ai < 2; ++ai)
#pragma unroll
            for (int m = 0; m < 4; ++m)
#pragma unroll
                for (int bj = 0; bj < 2; ++bj) *(u32x4*)(O + (size_t)(row0 + ai * HALF + m * 16) * DM + col0 + bj * HALF) = pack8(acc[ai][bj][m][0], acc[ai][bj][m][1]);
    }
};
struct EpiPle {
    static constexpr bool PERM = false, AFTER_DRAIN = false;
    float* PRE; const bf16_t *H, *PP;
    __device__ __forceinline__ void operator()(const f32x4 (&acc)[2][2][4][2], const Unit& u, int wr, int wc, int fr, int fq) const {
        const int row0 = u.pm * BM + wr * 64 + fr, col0 = u.pn * BM + wc * 32 + 4 * fq;
#pragma unroll
        for (int ai = 0; ai < 2; ++ai)
#pragma unroll
            for (int m = 0; m < 4; ++m) { const size_t off = (size_t)(row0 + ai * HALF + m * 16) * DM + col0;
#pragma unroll
                for (int bj = 0; bj < 2; ++bj)
#pragma unroll
                    for (int n = 0; n < 2; ++n) { const size_t o2 = off + bj * HALF + n * 16;
                        const u32x2 hw = *(const u32x2*)(H + o2), pw = *(const u32x2*)(PP + o2);
                        const f32x4 hr = (f32x4){bf_lo(hw.x), bf_hi(hw.x), bf_lo(hw.y), bf_hi(hw.y)}, pr = (f32x4){bf_lo(pw.x), bf_hi(pw.x), bf_lo(pw.y), bf_hi(pw.y)};
                        f32x4 a = acc[ai][bj][m][n];
#pragma unroll
                        for (int e = 0; e < 4; ++e) a[e] = sigmoidf_(a[e]);
                        *(f32x4*)(PRE + o2) = hr * ALPHA + a * pr; } }
    }
};
template <class Epi, class Sched, bool ALIGN_EPI = false, bool SP2 = false>
__device__ __forceinline__ void gemm_phase(PG8_LAS unsigned char* lds, const Gemm g, const Sched& S, const Epi& E) {
    int tid_ = threadIdx.x; asm volatile("" : "+v"(tid_));
    const int tid = tid_, wid = __builtin_amdgcn_readfirstlane(tid >> 6), lane = tid & 63, wr = wid >> 2, wc = wid & 3, fr = lane & 15, fq = lane >> 4;
    int K_ = g.K; asm volatile("" : "+s"(K_));
    const int K = K_, nt = K / BK;
    unsigned voffA[2], voffB[2];
#pragma unroll
    for (int i = 0; i < 2; ++i) { int R, C; stage_rc(tid * 16 + i * 8192, R, C); const int Rb = Epi::PERM ? ((R & ~31) + perm32(R & 31)) : R;
        voffA[i] = (unsigned)(R * K + C) * 2u; voffB[i] = (unsigned)(Rb * K + C) * 2u; }
    const size_t kstep = (size_t)(BK * 2);
    const size_t hstep = (size_t)HALF * K * 2;
    const size_t tstep = 2 * hstep;
    const unsigned ldsw = (unsigned)wid * 1024u;
    const int aoff = lds_byte(wr * 64 + fr, fq * 8), boff = lds_byte(wc * 32 + fr, fq * 8);
#define PG8_SA(b, h) (((b) * 2 + (h)) * HTB)
#define PG8_SB(b, h) ((4 + (b) * 2 + (h)) * HTB)
#define PG8_STAGE(bufoff, gbase, voff) do { _Pragma("unroll") for (int _i = 0; _i < 2; ++_i) \
        __builtin_amdgcn_global_load_lds((const unsigned*)((const char*)(gbase) + (voff)[_i]), (PG8_LAS unsigned*)(lds + (bufoff) + ldsw + _i * 8192), 16, 0, 0); } while (0)
#define PG8_LDA(dst, b, h) do { _Pragma("unroll") for (int m = 0; m < 4; ++m) _Pragma("unroll") for (int k = 0; k < 2; ++k) dst[m][k] = *(const PG8_LAS bf16x8*)(lds + PG8_SA(b, h) + aoff + m * 2048 + k * 1024); } while (0)
#define PG8_LDB(dst, b, h) do { _Pragma("unroll") for (int n = 0; n < 2; ++n) _Pragma("unroll") for (int k = 0; k < 2; ++k) dst[n][k] = *(const PG8_LAS bf16x8*)(lds + PG8_SB(b, h) + boff + n * 2048 + k * 1024); } while (0)
#define PG8_MMA(ai, bj, At, Bt) do { __builtin_amdgcn_s_setprio(1); _Pragma("unroll") for (int m = 0; m < 4; ++m) _Pragma("unroll") for (int n = 0; n < 2; ++n) _Pragma("unroll") for (int k = 0; k < 2; ++k) \
        acc[ai][bj][m][n] = __builtin_amdgcn_mfma_f32_16x16x32_bf16(Bt[n][k], At[m][k], acc[ai][bj][m][n], 0, 0, 0); __builtin_amdgcn_s_setprio(0); } while (0)
#define PG8_WAIT_V(n) asm volatile("s_waitcnt vmcnt(" #n ")" ::: "memory")
#define PG8_WAIT_L(n) asm volatile("s_waitcnt lgkmcnt(" #n ")" ::: "memory")
#define PG8_BAR __builtin_amdgcn_s_barrier()
#define PG8_SCHED __builtin_amdgcn_sched_barrier(0)
    Unit cur, nxt; int ui = 0;
    if (!S.next(0, cur)) return;
    f32x4 acc[2][2][4][2];
#pragma unroll
    for (int a = 0; a < 2; ++a)
#pragma unroll
        for (int b = 0; b < 2; ++b)
#pragma unroll
            for (int m = 0; m < 4; ++m)
#pragma unroll
                for (int n = 0; n < 2; ++n) acc[a][b][m][n] = (f32x4){0.f, 0.f, 0.f, 0.f};
    bf16x8 At[4][2], B0[2][2], B1[2][2];
    const char* cA = (const char*)g.A + (size_t)cur.pm * tstep; const char* cB = (const char*)g.Bt + (size_t)cur.pn * tstep;
    S.a_ready(cur);
    if constexpr (SP2) {
        PG8_STAGE(PG8_SB(0, 0), cB, voffB); PG8_STAGE(PG8_SB(0, 1), cB + hstep, voffB); PG8_STAGE(PG8_SA(0, 0), cA, voffA); PG8_STAGE(PG8_SA(0, 1), cA + hstep, voffA);
        if (wr == 1) PG8_BAR;
        PG8_WAIT_V(2); PG8_BAR;
        PG8_STAGE(PG8_SB(1, 0), cB + kstep, voffB); PG8_STAGE(PG8_SA(1, 0), cA + kstep, voffA); PG8_STAGE(PG8_SB(1, 1), cB + hstep + kstep, voffB);
        PG8_WAIT_V(6); PG8_BAR;
    } else {
        PG8_STAGE(PG8_SB(0, 0), cB, voffB); PG8_STAGE(PG8_SA(0, 0), cA, voffA); PG8_STAGE(PG8_SB(0, 1), cB + hstep, voffB); PG8_STAGE(PG8_SA(0, 1), cA + hstep, voffA);
        if (wr == 1) PG8_BAR;
        PG8_WAIT_V(4); PG8_BAR;
        PG8_STAGE(PG8_SB(1, 0), cB + kstep, voffB); PG8_STAGE(PG8_SA(1, 0), cA + kstep, voffA); PG8_STAGE(PG8_SB(1, 1), cB + hstep + kstep, voffB);
        PG8_WAIT_V(6); PG8_BAR;
    }
    for (;;) {
        const bool has_next = S.next(ui + 1, nxt);
        const char* nA = has_next ? (const char*)g.A + (size_t)nxt.pm * tstep : cA; const char* nB = has_next ? (const char*)g.Bt + (size_t)nxt.pn * tstep : cB;
        for (int t = 0; t < nt; t += 2) {
            const bool last = (t == nt - 2);
            const char* a1 = cA + (size_t)(t + 1) * kstep;
            const char* a2 = last ? nA : cA + (size_t)(t + 2) * kstep; const char* b2 = last ? nB : cB + (size_t)(t + 2) * kstep;
            const char* a3 = a2 + kstep; const char* b3 = b2 + kstep;
            if (last && has_next) S.a_ready(nxt);
            if constexpr (SP2) {
            PG8_LDB(B0, 0, 0); PG8_LDB(B1, 0, 1); PG8_SCHED; PG8_LDA(At, 0, 0); PG8_STAGE(PG8_SA(1, 1), a1 + hstep, voffA);
            PG8_WAIT_V(8); PG8_WAIT_L(0); PG8_BAR; PG8_MMA(0, 0, At, B0); PG8_MMA(0, 1, At, B1); PG8_BAR; PG8_SCHED;
            PG8_LDA(At, 0, 1); PG8_STAGE(PG8_SB(0, 0), b2, voffB); PG8_STAGE(PG8_SB(0, 1), b2 + hstep, voffB); PG8_STAGE(PG8_SA(0, 0), a2, voffA);
            PG8_WAIT_V(8); PG8_WAIT_L(0); PG8_BAR; PG8_MMA(1, 0, At, B0); PG8_MMA(1, 1, At, B1); PG8_BAR; PG8_SCHED;
            PG8_LDB(B0, 1, 0); PG8_LDB(B1, 1, 1); PG8_SCHED; PG8_LDA(At, 1, 0); PG8_STAGE(PG8_SA(0, 1), a2 + hstep, voffA);
            PG8_WAIT_V(8); PG8_WAIT_L(0); PG8_BAR; PG8_MMA(0, 0, At, B0); PG8_MMA(0, 1, At, B1); PG8_BAR; PG8_SCHED;
            PG8_LDA(At, 1, 1); PG8_STAGE(PG8_SB(1, 0), b3, voffB); PG8_STAGE(PG8_SB(1, 1), b3 + hstep, voffB); PG8_STAGE(PG8_SA(1, 0), a3, voffA);
            PG8_WAIT_V(8); PG8_WAIT_L(0); PG8_BAR; PG8_MMA(1, 0, At, B0); PG8_MMA(1, 1, At, B1); PG8_BAR; PG8_SCHED;
            } else {
            PG8_LDB(B0, 0, 0); PG8_SCHED; PG8_LDA(At, 0, 0); PG8_STAGE(PG8_SA(1, 1), a1 + hstep, voffA);
            PG8_WAIT_L(8); PG8_BAR; PG8_WAIT_L(0); PG8_MMA(0, 0, At, B0); PG8_BAR; PG8_SCHED;
            PG8_LDB(B1, 0, 1); PG8_STAGE(PG8_SB(0, 0), b2, voffB);
            PG8_BAR; PG8_WAIT_L(0); PG8_MMA(0, 1, At, B1); PG8_BAR;
            PG8_LDA(At, 0, 1); PG8_STAGE(PG8_SA(0, 0), a2, voffA);
            PG8_BAR; PG8_WAIT_L(0); PG8_MMA(1, 0, At, B0); PG8_BAR; PG8_SCHED;
            PG8_STAGE(PG8_SB(0, 1), b2 + hstep, voffB);
            PG8_WAIT_V(6); PG8_BAR; PG8_MMA(1, 1, At, B1); PG8_BAR;
            PG8_LDB(B0, 1, 0); PG8_SCHED; PG8_LDA(At, 1, 0); PG8_STAGE(PG8_SA(0, 1), a2 + hstep, voffA);
            PG8_WAIT_L(8); PG8_BAR; PG8_WAIT_L(0); PG8_MMA(0, 0, At, B0); PG8_BAR; PG8_SCHED;
            PG8_LDB(B1, 1, 1); PG8_STAGE(PG8_SB(1, 0), b3, voffB);
            PG8_BAR; PG8_WAIT_L(0); PG8_MMA(0, 1, At, B1); PG8_BAR;
            PG8_LDA(At, 1, 1); PG8_STAGE(PG8_SA(1, 0), a3, voffA);
            PG8_BAR; PG8_WAIT_L(0); PG8_MMA(1, 0, At, B0); PG8_BAR; PG8_SCHED;
            PG8_STAGE(PG8_SB(1, 1), b3 + hstep, voffB);
            PG8_WAIT_V(6); PG8_BAR; PG8_MMA(1, 1, At, B1); PG8_BAR;
            }
        }
        if constexpr (ALIGN_EPI) { if (wr == 0) PG8_BAR; }
        if constexpr (!Epi::AFTER_DRAIN) { E(acc, cur, wr, wc, fr, fq); S.done(cur); }
        if (!has_next) break;
#pragma unroll
        for (int a = 0; a < 2; ++a)
#pragma unroll
            for (int b = 0; b < 2; ++b)
#pragma unroll
                for (int m = 0; m < 4; ++m)
#pragma unroll
                    for (int n = 0; n < 2; ++n) acc[a][b][m][n] = (f32x4){0.f, 0.f, 0.f, 0.f};
        cur = nxt; cA = nA; cB = nB; ++ui;
        if constexpr (ALIGN_EPI) { if (wr == 1) PG8_BAR; }
    }
    PG8_WAIT_V(0);
    if constexpr (!ALIGN_EPI) { if (wr == 0) PG8_BAR; }
    PG8_BAR;
    if constexpr (Epi::AFTER_DRAIN) { E.fused(acc, cur, wr, wc, fr, fq, lds, wid, lane); S.done(cur); }
#undef PG8_SA
#undef PG8_SB
#undef PG8_STAGE
#undef PG8_LDA
#undef PG8_LDB
#undef PG8_MMA
#undef PG8_WAIT_V
#undef PG8_WAIT_L
#undef PG8_BAR
#undef PG8_SCHED
}
}
#define GAS __attribute__((address_space(1)))
#define LAS __attribute__((address_space(3)))
typedef unsigned short bf16;
typedef unsigned v4u __attribute__((ext_vector_type(4)));
typedef float f32x4 __attribute__((ext_vector_type(4)));
typedef short bf16x8 __attribute__((ext_vector_type(8)));
typedef GAS unsigned gu32;
typedef GAS unsigned long long gu64;
#define RLX_AGENT __ATOMIC_RELAXED, __HIP_MEMORY_SCOPE_AGENT
#define LDS_WAIT() asm volatile("s_waitcnt lgkmcnt(0)" ::: "memory")
#define VM_WAIT() asm volatile("s_waitcnt vmcnt(0)" ::: "memory")
__device__ __forceinline__ unsigned long long rt() { return __builtin_amdgcn_s_memrealtime(); }
__device__ __forceinline__ unsigned f2bf(float f) { unsigned u = __builtin_bit_cast(unsigned, f); return (u + 0x7fffu + ((u >> 16) & 1u)) >> 16; }
__device__ __forceinline__ unsigned pk2(float lo, float hi) { return f2bf(lo) | (f2bf(hi) << 16); }

#define XB_TMO      128
#define XB_XCNT(j)  (256  + 64 * (j))
#define XB_XSUB(j)  (1280 + 64 * (j))
#define XB_XGEN(j)  (2304 + 64 * (j))
#define XB_TOP      3328
#define XB_TOPGEN   3392
#define XCD_BAR_WORDS 3456
#define XB_SPIN_CAP (1u << 18)

__device__ __forceinline__ unsigned xb_ld(unsigned* p)              { return __hip_atomic_load(p, __ATOMIC_RELAXED, __HIP_MEMORY_SCOPE_AGENT); }
__device__ __forceinline__ unsigned xb_add(unsigned* p, unsigned v) { return __hip_atomic_fetch_add(p, v, __ATOMIC_RELAXED, __HIP_MEMORY_SCOPE_AGENT); }
__device__ __forceinline__ unsigned xb_xcc_id() { return (unsigned)__builtin_amdgcn_s_getreg((3 << 11) | 20) & 0xFu; }
#define XB_SPIN(cond, bar) do { unsigned _sp = 0; while (cond) { __builtin_amdgcn_s_sleep(1); \
    if ((++_sp & 255u) == 0u) { if (xb_ld(&(bar)[XB_TMO])) break; if (_sp > XB_SPIN_CAP) { atomicAdd(&(bar)[XB_TMO], 1u); break; } } } } while (0)

struct XcdBarrier {
    unsigned* bar; unsigned x;
    volatile LAS unsigned* st;
};

__device__ __forceinline__ XcdBarrier xcd_barrier_post(unsigned* bar, volatile LAS unsigned* st) {
    XcdBarrier b; b.bar = bar; b.x = xb_xcc_id(); b.st = st;
    if (threadIdx.x == 0) (void)xb_add(&bar[XB_XCNT(b.x)], 1u);
    return b;
}
__device__ __forceinline__ void xcd_barrier_complete(unsigned* bar, unsigned x, unsigned& nloc, unsigned& nx) {
    const unsigned G = gridDim.x * gridDim.y * gridDim.z;
    unsigned sum, cnt, mine, sp = 0u;
    for (;;) {
        sum = 0u; cnt = 0u; mine = 0u;
#pragma unroll
        for (unsigned j = 0; j < 16; ++j) { const unsigned c = xb_ld(&bar[XB_XCNT(j)]); sum += c; cnt += (c > 0u) ? 1u : 0u; mine = (j == x) ? c : mine; }
        if (sum == G) break;
        __builtin_amdgcn_s_sleep(1);
        if ((++sp & 255u) == 0u) { if (xb_ld(&bar[XB_TMO])) break; if (sp > XB_SPIN_CAP) { atomicAdd(&bar[XB_TMO], 1u); break; } }
    }
    nloc = mine > 0u ? mine : 1u; nx = cnt > 0u ? cnt : 1u;
}

__device__ __forceinline__ void xcd_barrier(const XcdBarrier& b) {
    asm volatile("s_waitcnt vmcnt(0)" ::: "memory");
    __syncthreads();
    if (threadIdx.x == 0) {
        unsigned* bar = b.bar;
        __builtin_amdgcn_s_waitcnt(0);
        unsigned nloc = b.st[0], nx = b.st[1];
        if (nloc == 0u) { xcd_barrier_complete(bar, b.x, nloc, nx); b.st[0] = nloc; b.st[1] = nx; }
        const unsigned old = xb_add(&bar[XB_XSUB(b.x)], 1u);
        const unsigned gen = old / nloc;
        if (old + 1u == (gen + 1u) * nloc) {
            __builtin_amdgcn_fence(__ATOMIC_RELEASE, "agent");
            asm volatile("s_waitcnt vmcnt(0)" ::: "memory");
            const unsigned og = xb_add(&bar[XB_TOP], 1u);
            const unsigned tg = og / nx;
            if (og + 1u == (tg + 1u) * nx) xb_add(&bar[XB_TOPGEN], 1u);
            else XB_SPIN(xb_ld(&bar[XB_TOPGEN]) == tg, bar);
            __builtin_amdgcn_fence(__ATOMIC_ACQUIRE, "agent");
            xb_add(&bar[XB_XGEN(b.x)], 1u);
            asm volatile("s_waitcnt vmcnt(0)" ::: "memory");
        } else {
            XB_SPIN(xb_ld(&bar[XB_XGEN(b.x)]) == gen, bar);
            __builtin_amdgcn_fence(__ATOMIC_ACQUIRE, "agent");
            asm volatile("s_waitcnt vmcnt(0)" ::: "memory");
        }
    }
    __syncthreads();
}
constexpr size_t MiB = 1u << 20;
constexpr size_t WS_CTL = 0, CTL_ZERO_BYTES = 1 * MiB;
constexpr size_t WS_WIN = 2 * MiB, WS_WOUT = 9 * MiB, WS_WGU = 11 * MiB, WS_WD = 22 * MiB, WS_WPG = 28 * MiB, WS_WPP = 30 * MiB, WS_WL = 30 * MiB + 512 * 1024;
constexpr size_t SZ1024B = (size_t)MT * 1024 * 2, SZ512B = (size_t)MT * 512 * 2, SZ256B = (size_t)MT * 256 * 2;
constexpr size_t WS_R1 = 32 * MiB;
constexpr size_t WS_PB = 97 * MiB;
constexpr size_t WS_QB = 114 * MiB, WS_KB = WS_QB + SZ512B, WS_VB = WS_KB + SZ512B;
constexpr size_t WS_PRE = 114 * MiB;
constexpr size_t WS_ZB = 211 * MiB;
constexpr size_t WS_OG = 324 * MiB, WS_LSE = 420 * MiB;
constexpr size_t WS_BV = 324 * MiB, WS_PHI = 357 * MiB, WS_SLOC = 389 * MiB, WS_SC = 421 * MiB;
constexpr size_t WS_AP = 453 * MiB;
constexpr size_t WS_ACT = 243 * MiB;
constexpr size_t WS_H2 = 243 * MiB, WS_PP = 308 * MiB;
constexpr size_t WS_END = 470 * MiB;
static_assert(WS_VB + SZ512B <= WS_ZB && WS_ZB + (size_t)MT * DBIN * 2 <= WS_OG && WS_PRE + (size_t)MT * DM * 4 <= WS_ACT && WS_ACT + (size_t)MT * DFF * 2 <= WS_SC + 32 * MiB, "ws map");
static_assert(WS_R1 + SZ1024B <= WS_PB && WS_PB + SZ256B <= WS_QB && WS_AP + SZ256B <= WS_END && WS_H2 + SZ1024B <= WS_PP, "ws map 2");
constexpr int NCHUNK = 32, CHL = TSEQ / NCHUNK;
constexpr int CW_BAR = 4096;

constexpr int RING_OFF = 0, RING_BYTES = 131072;
constexpr int LDSCTL_OFF = RING_BYTES, MISC_OFF = LDSCTL_OFF + 320;
constexpr int LDS_BYTES = 147456;
constexpr int NWAVES = 8;
typedef float f32x16 __attribute__((ext_vector_type(16)));
typedef unsigned u32x2 __attribute__((ext_vector_type(2)));
typedef short s16x4 __attribute__((ext_vector_type(4)));
typedef float f32x2_t __attribute__((ext_vector_type(2)));
typedef __bf16 bf16x2_t __attribute__((ext_vector_type(2)));
__device__ __forceinline__ unsigned cvtpk(float lo, float hi) { f32x2_t v = {lo, hi}; bf16x2_t b = __builtin_convertvector(v, bf16x2_t); return __builtin_bit_cast(unsigned, b); }
__device__ __forceinline__ float bflo(unsigned w) { return __uint_as_float(w << 16); }
__device__ __forceinline__ float bfhi(unsigned w) { return __uint_as_float(w & 0xffff0000u); }
__device__ __forceinline__ float bf1(bf16 h) { return __uint_as_float((unsigned)h << 16); }
__device__ __forceinline__ float sigm(float x) { return __builtin_amdgcn_rcpf(1.0f + __builtin_amdgcn_exp2f(-x * LOG2E)); }
__device__ __forceinline__ float shx(float v, int o, int lane) { return __int_as_float(__builtin_amdgcn_ds_bpermute((lane ^ o) << 2, __float_as_int(v))); }
__device__ __forceinline__ float wave_sum(float v, int lane) {
#pragma unroll
    for (int o = 1; o < 64; o <<= 1) v += shx(v, o, lane);
    return v;
}
struct Ctx { LAS unsigned char* lds; int tid, lane, wave, vcu, G; };

__device__ __forceinline__ void p0_transpose_item(const float* W, int N, bf16* WT, int ldk, int drow, int dk, LAS float* scr, int k0, int n0, int lane) {
#pragma unroll 8
    for (int i = 0; i < 32; ++i) { const int kk = 2 * i + (lane >> 5); scr[kk * 33 + (lane & 31)] = W[(size_t)(k0 + kk) * N + n0 + (lane & 31)]; }
    LDS_WAIT(); asm volatile("" ::: "memory");
    const int c = lane & 7;
#pragma unroll
    for (int j = 0; j < 4; ++j) { const int n = (lane >> 3) + 8 * j; const LAS float* s = scr + (8 * c) * 33 + n;
        v4u o; o.x = pk2(s[0 * 33], s[1 * 33]); o.y = pk2(s[2 * 33], s[3 * 33]); o.z = pk2(s[4 * 33], s[5 * 33]); o.w = pk2(s[6 * 33], s[7 * 33]);
        *(GAS v4u*)(WT + (size_t)(drow + n) * ldk + dk + 8 * c) = o; }
    LDS_WAIT(); asm volatile("" ::: "memory");
}
struct P0Args { const float *xp, *xs, *pp, *ps, *ck, *cv, *w_in, *w_out, *w_gate, *w_up, *w_down, *w_pg, *w_pp, *w2, *a2, *g2; bf16 *Win, *Wout, *Wgu, *Wd, *Wpg, *Wpp, *Wl, *XB, *PB; float* out; };
__device__ __forceinline__ void p0_prologue(const Ctx& C, const P0Args& A) {
    LAS float* scr = (LAS float*)(C.lds + RING_OFF + C.wave * 16384);
    const int gw = C.vcu * NWAVES + C.wave, NGW = C.G * NWAVES;
    constexpr int I0 = 16 * 104, I1 = 16 * 32, I2 = 16 * 88, I3 = I2, I4 = 44 * 32, I5 = 16 * 32, I6 = 4 * 32, I7 = 16, I8 = 16, I9 = 32;
    constexpr int NITEMS = I0 + I1 + I2 + I3 + I4 + I5 + I6 + I7 + I8 + I9;
    for (int it = gw; it < NITEMS; it += NGW) {
        int r = it;
        if (r < I0) { const int kb = r / 104, nb = r % 104; p0_transpose_item(A.w_in, DIN, A.Win, 1024, nb * 32, kb * 64, scr, kb * 64, nb * 32, C.lane); continue; } r -= I0;
        if (r < I1) { const int kb = r / 32, nb = r % 32; p0_transpose_item(A.w_out, DM, A.Wout, 1024, nb * 32, kb * 64, scr, kb * 64, nb * 32, C.lane); continue; } r -= I1;
        if (r < I2) { const int kb = r / 88, nb = r % 88, n0 = nb * 32; p0_transpose_item(A.w_gate, DFF, A.Wgu, 1024, (n0 >> 7) * 256 + (n0 & 127), kb * 64, scr, kb * 64, n0, C.lane); continue; } r -= I2;
        if (r < I3) { const int kb = r / 88, nb = r % 88, n0 = nb * 32; p0_transpose_item(A.w_up, DFF, A.Wgu, 1024, (n0 >> 7) * 256 + 128 + (n0 & 127), kb * 64, scr, kb * 64, n0, C.lane); continue; } r -= I3;
        if (r < I4) { const int kb = r / 32, nb = r % 32; p0_transpose_item(A.w_down, DM, A.Wd, DFF, nb * 32, kb * 64, scr, kb * 64, nb * 32, C.lane); continue; } r -= I4;
        if (r < I5) { const int kb = r / 32, nb = r % 32; p0_transpose_item(A.w_pg, DM, A.Wpg, 1024, nb * 32, kb * 64, scr, kb * 64, nb * 32, C.lane); continue; } r -= I5;
        if (r < I6) { const int kb = r / 32, nb = r % 32; p0_transpose_item(A.w_pp, DM, A.Wpp, 256, nb * 32, kb * 64, scr, kb * 64, nb * 32, C.lane); continue; } r -= I6;
        if (r < I7) { p0_transpose_item(A.w2, CB, A.Wl, 256, r * 32, 0, scr, 0, r * 32, C.lane); continue; } r -= I7;
        if (r < I8) { p0_transpose_item(A.a2, CB, A.Wl, 256, 512 + r * 32, 64, scr, 0, r * 32, C.lane); continue; } r -= I8;
        { const int kb = r / 16, nb = r % 16; p0_transpose_item(A.g2, CB, A.Wl, 256, 1024 + nb * 32, 128 + kb * 64, scr, kb * 64, nb * 32, C.lane); }
    }
    const int gt = C.vcu * (NWAVES * 64) + C.tid, NT = C.G * NWAVES * 64;
    for (int i = gt; i < 1536 * 32; i += NT) { const int row = i >> 5, ch = i & 31, blk = row >> 9;
        const bool nz = blk == 0 ? ch < 8 : blk == 1 ? (ch >= 8 && ch < 16) : ch >= 16;
        if (!nz) *(GAS v4u*)(A.Wl + (size_t)row * 256 + ch * 8) = (v4u){0u, 0u, 0u, 0u}; }
    for (int i = gt; i < MT * 128; i += NT) { const int row = i >> 7, ch = i & 127;
        f32x4 a = {0.f, 0.f, 0.f, 0.f}, b = a;
        if (row < MPR + MSA) { const float* src = row < MPR ? A.xp + (size_t)row * DM : A.xs + (size_t)(row - MPR) * DM; a = *(const GAS f32x4*)(src + ch * 8); b = *(const GAS f32x4*)(src + ch * 8 + 4); }
        v4u o; o.x = cvtpk(a[0], a[1]); o.y = cvtpk(a[2], a[3]); o.z = cvtpk(b[0], b[1]); o.w = cvtpk(b[2], b[3]);
        *(GAS v4u*)(A.XB + (size_t)row * DM + ch * 8) = o; }
    for (int i = gt; i < MT * 32; i += NT) { const int row = i >> 5, ch = i & 31;
        f32x4 a = {0.f, 0.f, 0.f, 0.f}, b = a;
        if (row < MPR + MSA) { const float* src = row < MPR ? A.pp + (size_t)row * PLE : A.ps + (size_t)(row - MPR) * PLE; a = *(const GAS f32x4*)(src + ch * 8); b = *(const GAS f32x4*)(src + ch * 8 + 4); }
        v4u o; o.x = cvtpk(a[0], a[1]); o.y = cvtpk(a[2], a[3]); o.z = cvtpk(b[0], b[1]); o.w = cvtpk(b[2], b[3]);
        *(GAS v4u*)(A.PB + (size_t)row * PLE + ch * 8) = o; }
}

__device__ __forceinline__ void prep_a(const Ctx& C, const bf16* ZB, const float* mu, const float* state_shift, bf16* AP, float* out) {
    const int gw = C.vcu * NWAVES + C.wave, NGW = C.G * NWAVES, lane = C.lane;
    const f32x4 m4 = *(const GAS f32x4*)(mu + 1536 + lane * 4);
    for (int row = gw; row < MPR + MSA; row += NGW) {
        const u32x2 zw = *(const GAS u32x2*)(ZB + (size_t)row * DBIN + 1536 + lane * 4);
        f32x4 z = {bflo(zw.x), bfhi(zw.x), bflo(zw.y), bfhi(zw.y)}, p;
        const bool first = row < MPR ? (row & (TSEQ - 1)) == 0 : ((row - MPR) & 3) == 0;
        if (!first) { const u32x2 pw = *(const GAS u32x2*)(ZB + (size_t)(row - 1) * DBIN + 1536 + lane * 4); p = (f32x4){bflo(pw.x), bfhi(pw.x), bflo(pw.y), bfhi(pw.y)}; }
        else if (row < MPR) p = (f32x4){0.f, 0.f, 0.f, 0.f};
        else p = *(const GAS f32x4*)(state_shift + (size_t)((row - MPR) >> 2) * DBIN + 1536 + lane * 4);
        f32x4 zm = z + (p - z) * m4, o;
#pragma unroll
        for (int e = 0; e < 4; ++e) { const float x = zm[e];
            const float th = 1.0f - 2.0f * __builtin_amdgcn_rcpf(1.0f + __builtin_amdgcn_exp2f(2.0f * LOG2E * x));
            o[e] = lane < 16 ? th : lane < 32 ? x : sigm(x); }
        u32x2 w; w.x = cvtpk(o[0], o[1]); w.y = cvtpk(o[2], o[3]);
        *(GAS u32x2*)(AP + (size_t)row * 256 + lane * 4) = w;
    }
    const int gt = C.vcu * (NWAVES * 64) + C.tid, NT = C.G * NWAVES * 64;
    for (int i = gt; i < (NBATCH + SB) * DBIN; i += NT) { const int s = i / DBIN, c = i % DBIN;
        if (s < NBATCH) out[O_SHP + (size_t)s * DBIN + c] = bf1(ZB[(size_t)(s * TSEQ + TSEQ - 1) * DBIN + c]);
        else out[O_SHS + (size_t)(s - NBATCH) * DBIN + c] = bf1(ZB[(size_t)(MPR + (s - NBATCH) * SS + SS - 1) * DBIN + c]); }
}

__device__ __forceinline__ int crow(int r, int hi) { return (r & 3) + 8 * (r >> 2) + 4 * hi; }
typedef short v4i16_t __attribute__((ext_vector_type(4)));
__device__ __forceinline__ s16x4 vtr(LAS const unsigned char* p) { return __builtin_bit_cast(s16x4, __builtin_amdgcn_ds_read_tr16_b64_v4i16((LAS v4i16_t*)p)); }
constexpr int VP = 192;
__device__ __forceinline__ void attn_unit(const Ctx& C, const bf16* QB, const bf16* KB, const bf16* VB, bf16* OGg, float* LSEg, int b, int h, int cls, int mq0, int dil) {
    LAS unsigned char* lds = C.lds;
    const int tid = C.tid, wid = C.wave, lane = C.lane, r32 = lane & 31, hi = lane >> 5;
#pragma unroll
    for (int it = 0; it < 6; ++it) { const int rr = it * 64 + (tid >> 3), ch = tid & 7; int mk = mq0 - 128 + rr; mk = mk < 0 ? 0 : mk;
        const v4u val = *(const GAS v4u*)(VB + (size_t)(b * TSEQ + mk * dil + cls) * CA + h * 64 + ch * 8);
        *(LAS v4u*)(lds + rr * VP + ch * 16) = val; }
    __syncthreads();
    const int mqw = mq0 + 32 * wid;
    const size_t qrow = (size_t)(b * TSEQ + (mqw + r32) * dil + cls);
    bf16x8 qf[4];
#pragma unroll
    for (int s = 0; s < 4; ++s) qf[s] = *(const GAS bf16x8*)(QB + qrow * CA + h * 64 + 16 * s + 8 * hi);
    f32x16 st[5];
#pragma unroll
    for (int j = 0; j < 5; ++j) { int mk = mqw - 128 + 32 * j + r32; mk = mk < 0 ? 0 : mk;
        const bf16* kp = KB + (size_t)(b * TSEQ + mk * dil + cls) * CA + h * 64 + 8 * hi;
        f32x16 a = {0.f, 0.f, 0.f, 0.f, 0.f, 0.f, 0.f, 0.f, 0.f, 0.f, 0.f, 0.f, 0.f, 0.f, 0.f, 0.f};
#pragma unroll
        for (int s = 0; s < 4; ++s) { const bf16x8 kf = *(const GAS bf16x8*)(kp + 16 * s); a = __builtin_amdgcn_mfma_f32_32x32x16_bf16(kf, qf[s], a, 0, 0, 0); }
        st[j] = a; }
    const float slope2 = __builtin_amdgcn_exp2f(-(float)(h + 1)) * LOG2E * (float)dil;
    float mx = -INFINITY;
#pragma unroll
    for (int j = 0; j < 5; ++j)
#pragma unroll
        for (int i = 0; i < 16; ++i) { const int kr = crow(i, hi), dist = 128 - 32 * j + r32 - kr, mke = mqw - 128 + 32 * j + kr;
            const bool ok = dist >= 0 && dist <= 128 && mke >= 0;
            const float v = ok ? st[j][i] - slope2 * (float)dist : -INFINITY; st[j][i] = v; mx = fmaxf(mx, v); }
    mx = fmaxf(mx, shx(mx, 32, lane));
    float l = 0.f;
#pragma unroll
    for (int j = 0; j < 5; ++j)
#pragma unroll
        for (int i = 0; i < 16; ++i) { const float p = __builtin_amdgcn_exp2f(st[j][i] - mx); st[j][i] = p; l += p; }
    l += shx(l, 32, lane);
    f32x16 o0 = {0.f, 0.f, 0.f, 0.f, 0.f, 0.f, 0.f, 0.f, 0.f, 0.f, 0.f, 0.f, 0.f, 0.f, 0.f, 0.f}, o1 = o0;
    const int i16 = lane & 15, qq = i16 >> 2, pp = i16 & 3, blk = (lane >> 4) & 1;
    LAS const unsigned char* vbase = lds + (32 * wid + 4 * hi + qq) * VP + (16 * blk + 4 * pp) * 2;
#pragma unroll
    for (int j = 0; j < 5; ++j)
#pragma unroll
        for (int s2 = 0; s2 < 2; ++s2) {
            v4u pw; pw.x = cvtpk(st[j][8 * s2 + 0], st[j][8 * s2 + 1]); pw.y = cvtpk(st[j][8 * s2 + 2], st[j][8 * s2 + 3]); pw.z = cvtpk(st[j][8 * s2 + 4], st[j][8 * s2 + 5]); pw.w = cvtpk(st[j][8 * s2 + 6], st[j][8 * s2 + 7]);
            const bf16x8 xs = __builtin_bit_cast(bf16x8, pw);
            LAS const unsigned char* vp = vbase + (32 * j + 16 * s2) * VP;
            { const s16x4 lo = vtr(vp), hh = vtr(vp + 8 * VP); const bf16x8 vf = (bf16x8){lo[0], lo[1], lo[2], lo[3], hh[0], hh[1], hh[2], hh[3]};
              o0 = __builtin_amdgcn_mfma_f32_32x32x16_bf16(vf, xs, o0, 0, 0, 0); }
            { const s16x4 lo = vtr(vp + 64), hh = vtr(vp + 8 * VP + 64); const bf16x8 vf = (bf16x8){lo[0], lo[1], lo[2], lo[3], hh[0], hh[1], hh[2], hh[3]};
              o1 = __builtin_amdgcn_mfma_f32_32x32x16_bf16(vf, xs, o1, 0, 0, 0); }
        }
    const float inv = __builtin_amdgcn_rcpf(l);
    bf16* orow = OGg + qrow * CA + h * 64 + 4 * hi;
#pragma unroll
    for (int g4 = 0; g4 < 4; ++g4) {
        u32x2 w0, w1;
        w0.x = cvtpk(o0[4 * g4] * inv, o0[4 * g4 + 1] * inv); w0.y = cvtpk(o0[4 * g4 + 2] * inv, o0[4 * g4 + 3] * inv);
        w1.x = cvtpk(o1[4 * g4] * inv, o1[4 * g4 + 1] * inv); w1.y = cvtpk(o1[4 * g4 + 2] * inv, o1[4 * g4 + 3] * inv);
        *(GAS u32x2*)(orow + 8 * g4) = w0; *(GAS u32x2*)(orow + 32 + 8 * g4) = w1; }
    if (hi == 0) LSEg[qrow * NH + h] = mx + __builtin_amdgcn_logf(l);
    __syncthreads();
}
__device__ __forceinline__ void attn_prompt(const Ctx& C, const bf16* QB, const bf16* KB, const bf16* VB, bf16* OG, float* LSE) {
    for (int i = 0; i < 12; ++i) {
        const int u = C.vcu * 12 + i, bh = u / 48, k48 = u % 48, g = k48 >> 4, k = k48 & 15;
        const int b = bh >> 3, h = bh & 7;
        int cls, mq0, dil;
        if (g == 0) { cls = 0; mq0 = 256 * k; dil = 1; } else if (g == 1) { cls = k >> 2; mq0 = 256 * (k & 3); dil = 4; } else { cls = k; mq0 = 0; dil = 16; }
        attn_unit(C, QB, KB, VB, OG + (size_t)g * MPR * CA, LSE + (size_t)g * MPR * NH, b, h, cls, mq0, dil);
    }
}
__device__ __forceinline__ void attn_sample(const Ctx& C, const bf16* QB, const float* ck, const float* cv, const float* out, bf16* HEADS) {
    const int b = C.vcu >> 3, h = C.vcu & 7, s = C.wave, lane = C.lane;
    if (C.vcu >= SB * NH || s >= SS) return;
    LAS float* qs = (LAS float*)(C.lds + s * 4096);
    LAS float* ps = qs + 64;
    const int row = MPR + b * SS + s;
    qs[lane] = bf1(QB[(size_t)row * CA + h * 64 + lane]);
    LDS_WAIT(); asm volatile("" ::: "memory");
    const float slope2 = __builtin_amdgcn_exp2f(-(float)(h + 1)) * LOG2E;
    float sc[7]; float mx = -INFINITY;
#pragma unroll
    for (int it = 0; it < 7; ++it) {
        const int n = it * 64 + lane; sc[it] = -INFINITY;
        if (n < 387) { const int g = n / 129, jj = n % 129, dil = g == 0 ? 1 : g == 1 ? 4 : 16, idx = WINL + s - jj * dil;
            const float* kr = idx < WINL ? ck + ((size_t)(b * WINL + idx) * NH + h) * HD : out + O_KWS + ((size_t)(b * WINL + (WINL - SS) + idx - WINL) * NH + h) * HD;
            float d = 0.f;
#pragma unroll
            for (int c = 0; c < 16; ++c) { const f32x4 kv = *(const GAS f32x4*)(kr + 4 * c); const f32x4 qv = *(LAS const f32x4*)(qs + 4 * c); d += kv[0] * qv[0] + kv[1] * qv[1] + kv[2] * qv[2] + kv[3] * qv[3]; }
            sc[it] = d - slope2 * (float)(jj * dil); }
        mx = fmaxf(mx, sc[it]); }
#pragma unroll
    for (int o = 1; o < 64; o <<= 1) mx = fmaxf(mx, shx(mx, o, lane));
    float l = 0.f;
#pragma unroll
    for (int it = 0; it < 7; ++it) { const int n = it * 64 + lane; const float p = __builtin_amdgcn_exp2f(sc[it] - mx); if (n < 387) { ps[n] = p; l += p; } }
    l = wave_sum(l, lane);
    LDS_WAIT(); asm volatile("" ::: "memory");
    float o = 0.f;
    for (int n = 0; n < 387; ++n) { const int g = n / 129, jj = n % 129, dil = g == 0 ? 1 : g == 1 ? 4 : 16, idx = WINL + s - jj * dil;
        const float* vr = idx < WINL ? cv + ((size_t)(b * WINL + idx) * NH + h) * HD : out + O_VWS + ((size_t)(b * WINL + (WINL - SS) + idx - WINL) * NH + h) * HD;
        o += ps[n] * vr[lane]; }
    HEADS[(size_t)row * DM + h * 64 + lane] = (bf16)(cvtpk(o / l, 0.f) & 0xffffu);
}

__device__ __forceinline__ void attn_merge(const Ctx& C, const bf16* OG, const float* LSE, bf16* HEADS) {
    const int gt = C.vcu * (NWAVES * 64) + C.tid, NT = C.G * NWAVES * 64;
    for (int i = gt; i < MPR * 64; i += NT) { const int row = i >> 6, ch = i & 63, h = ch >> 3;
        float ls[3], mx = -INFINITY;
#pragma unroll
        for (int g = 0; g < 3; ++g) { ls[g] = LSE[((size_t)g * MPR + row) * NH + h]; mx = fmaxf(mx, ls[g]); }
        float w[3], ws = 0.f;
#pragma unroll
        for (int g = 0; g < 3; ++g) { w[g] = __builtin_amdgcn_exp2f(ls[g] - mx); ws += w[g]; }
        const float inv = __builtin_amdgcn_rcpf(ws);
        float acc[8] = {0.f, 0.f, 0.f, 0.f, 0.f, 0.f, 0.f, 0.f};
#pragma unroll
        for (int g = 0; g < 3; ++g) { const v4u v = *(const GAS v4u*)(OG + ((size_t)g * MPR + row) * CA + ch * 8); const float wg = w[g] * inv;
            acc[0] += wg * bflo(v.x); acc[1] += wg * bfhi(v.x); acc[2] += wg * bflo(v.y); acc[3] += wg * bfhi(v.y); acc[4] += wg * bflo(v.z); acc[5] += wg * bfhi(v.z); acc[6] += wg * bflo(v.w); acc[7] += wg * bfhi(v.w); }
        v4u o; o.x = cvtpk(acc[0], acc[1]); o.y = cvtpk(acc[2], acc[3]); o.z = cvtpk(acc[4], acc[5]); o.w = cvtpk(acc[6], acc[7]);
        *(GAS v4u*)(HEADS + (size_t)row * DM + ch * 8) = o; }
}

struct RwkvW { const float *mu, *k_k, *k_a, *r_k, *lnx_w, *lnx_b; };
struct RwkvTok { float nkk, ka, d, kp, r, v, bon; };
__device__ __forceinline__ RwkvTok rwkv_tok(float zr, float zk, float zv, float pr, float pk, float pv, float lam, float a, float mur, float muk, float muv, float kkw, float kaw, float rkw, int lane) {
    RwkvTok o;
    const float r = zr + (pr - zr) * mur, k = zk + (pk - zk) * muk, v = zv + (pv - zv) * muv;
    const float kkr = k * kkw; const float ss = wave_sum(kkr * kkr, lane);
    const float kk = kkr / fmaxf(sqrtf(ss), 1e-12f);
    const float kp = k * (1.0f + (a - 1.0f) * kaw);
    o.nkk = -kk; o.ka = kk * a; o.d = __builtin_amdgcn_exp2f(-lam * LOG2E); o.kp = kp; o.r = r; o.v = v; o.bon = wave_sum(r * kp * rkw, lane);
    return o;
}
__device__ __forceinline__ void rwkv_chunk(const Ctx& C, const bf16* ZB, const bf16* LAM, const bf16* AA, const RwkvW& W, float* YL, float* U, bf16* BV, float* PHI, float* SLOC, int b, int h, int c,
                                           const float* ck, const float* cv, float* out) {
    constexpr unsigned PERB = (WINL - SS) * CA / 4, CPY_TOTAL = SB * PERB;
    const unsigned cbase = (unsigned)(C.vcu * NWAVES + C.wave) * (CHL * 64) + C.lane;
    const int lane = C.lane;
    LAS float* tokb = (LAS float*)(C.lds + C.wave * 12288);
    float S[64], P[64];
#pragma unroll
    for (int j = 0; j < 64; ++j) { S[j] = 0.f; P[j] = (j == lane) ? 1.f : 0.f; }
    const int hc = h * 64 + lane;
    const float mur = W.mu[hc], muk = W.mu[512 + hc], muv = W.mu[1024 + hc], kkw = W.k_k[hc], kaw = W.k_a[hc], rkw = W.r_k[hc];
    const int t0 = c * CHL; const size_t row0 = (size_t)b * TSEQ + t0;
    float pr = 0.f, pk = 0.f, pv = 0.f;
    if (t0 > 0) { const bf16* zp = ZB + (row0 - 1) * DBIN + hc; pr = bf1(zp[0]); pk = bf1(zp[512]); pv = bf1(zp[1024]); }
    for (int sb = 0; sb < CHL / 8; ++sb) {
        float zr[8], zk[8], zv[8], lm[8], aa[8];
#pragma unroll
        for (int tt = 0; tt < 8; ++tt) { const size_t row = row0 + sb * 8 + tt; const bf16* zp = ZB + row * DBIN + hc;
            zr[tt] = bf1(zp[0]); zk[tt] = bf1(zp[512]); zv[tt] = bf1(zp[1024]); lm[tt] = bf1(LAM[row * CB + hc]); aa[tt] = bf1(AA[row * CB + hc]); }
#pragma unroll
        for (int tt = 0; tt < 8; ++tt) {
            const RwkvTok o = rwkv_tok(zr[tt], zk[tt], zv[tt], pr, pk, pv, lm[tt], aa[tt], mur, muk, muv, kkw, kaw, rkw, lane);
            pr = zr[tt]; pk = zk[tt]; pv = zv[tt];
            LAS float* tk = tokb + tt * 384;
            tk[lane] = o.nkk; tk[64 + lane] = o.ka; tk[128 + lane] = o.d; tk[192 + lane] = o.kp; tk[256 + lane] = o.r; tk[320 + lane] = o.v;
            BV[(row0 + sb * 8 + tt) * CB + hc] = (bf16)(cvtpk(o.bon * o.v, 0.f) & 0xffffu);
        }
        LDS_WAIT(); asm volatile("" ::: "memory");
#pragma unroll 1
        for (int tt = 0; tt < 8; ++tt) {
            LAS const float* tk = tokb + tt * 384;
            unsigned ci = cbase + (unsigned)(sb * 8 + tt) * 64u; const bool cisv = ci >= CPY_TOTAL; ci -= cisv ? CPY_TOTAL : 0u;
            const bool cok = ci < CPY_TOTAL; const unsigned cb = ci / PERB, co = ci - cb * PERB; const size_t cdst = (size_t)cb * (WINL * CA / 4) + co;
            f32x4 cval = {0.f, 0.f, 0.f, 0.f};
            if (cok) cval = __builtin_nontemporal_load((const f32x4*)(cisv ? cv : ck) + (cdst + (SS * CA / 4)));
            float sS0 = 0.f, sS1 = 0.f, sP0 = 0.f, sP1 = 0.f;
#pragma unroll
            for (int j4 = 0; j4 < 16; ++j4) { const f32x4 nk = *(LAS const f32x4*)(tk + 4 * j4);
                sS0 = fmaf(S[4 * j4], nk[0], sS0); sS1 = fmaf(S[4 * j4 + 1], nk[1], sS1); sS0 = fmaf(S[4 * j4 + 2], nk[2], sS0); sS1 = fmaf(S[4 * j4 + 3], nk[3], sS1);
                sP0 = fmaf(P[4 * j4], nk[0], sP0); sP1 = fmaf(P[4 * j4 + 1], nk[1], sP1); sP0 = fmaf(P[4 * j4 + 2], nk[2], sP0); sP1 = fmaf(P[4 * j4 + 3], nk[3], sP1); }
            const float saS = sS0 + sS1, saP = sP0 + sP1, vi = tk[320 + lane];
            float yS0 = 0.f, yS1 = 0.f, yP0 = 0.f, yP1 = 0.f;
#pragma unroll
            for (int j4 = 0; j4 < 16; ++j4) {
                const f32x4 ka = *(LAS const f32x4*)(tk + 64 + 4 * j4), d = *(LAS const f32x4*)(tk + 128 + 4 * j4), kp = *(LAS const f32x4*)(tk + 192 + 4 * j4), r = *(LAS const f32x4*)(tk + 256 + 4 * j4);
#pragma unroll
                for (int e = 0; e < 4; ++e) { const int j = 4 * j4 + e;
                    float t = vi * kp[e]; t = fmaf(saS, ka[e], t); S[j] = fmaf(S[j], d[e], t);
                    const float u = saP * ka[e]; P[j] = fmaf(P[j], d[e], u);
                    if (e & 1) { yS1 = fmaf(S[j], r[e], yS1); yP1 = fmaf(P[j], r[e], yP1); } else { yS0 = fmaf(S[j], r[e], yS0); yP0 = fmaf(P[j], r[e], yP0); } }
            }
            const size_t row = row0 + sb * 8 + tt;
            YL[row * CB + hc] = yS0 + yS1; U[row * CB + hc] = yP0 + yP1;
            if (cok) __builtin_nontemporal_store(cval, (f32x4*)(out + (cisv ? O_VWS : O_KWS)) + cdst);
        }
    }
    float* so = SLOC + ((size_t)((b * NH + h) * NCHUNK + c) * 64 + lane) * 64;
    float* po = PHI + ((size_t)((b * NH + h) * NCHUNK + c) * 64 + lane) * 64;
#pragma unroll
    for (int j4 = 0; j4 < 16; ++j4) { *(GAS f32x4*)(so + 4 * j4) = (f32x4){S[4 * j4], S[4 * j4 + 1], S[4 * j4 + 2], S[4 * j4 + 3]}; *(GAS f32x4*)(po + 4 * j4) = (f32x4){P[4 * j4], P[4 * j4 + 1], P[4 * j4 + 2], P[4 * j4 + 3]}; }
}
__device__ __forceinline__ void rwkv_sample(const Ctx& C, const bf16* ZB, const bf16* LAM, const bf16* AA, const bf16* G, const RwkvW& W, const float* state_wkv, const float* state_shift, bf16* HEADS, float* out) {
    if (C.vcu >= SB * NH || C.wave != 0) return;
    const int b = C.vcu >> 3, h = C.vcu & 7, lane = C.lane, hc = h * 64 + lane;
    LAS float* tk = (LAS float*)(C.lds + 98304);
    LAS float* Sl = (LAS float*)(C.lds + 98304 + 2048) + lane * 65;
    const float* s0 = state_wkv + ((size_t)(b * NH + h) * 64 + lane) * 64;
#pragma unroll 4
    for (int j = 0; j < 64; ++j) Sl[j] = s0[j];
    float pr = state_shift[(size_t)b * DBIN + hc], pk = state_shift[(size_t)b * DBIN + 512 + hc], pv = state_shift[(size_t)b * DBIN + 1024 + hc];
#pragma unroll 1
    for (int s = 0; s < SS; ++s) {
        const size_t row = (size_t)MPR + b * SS + s; const bf16* zp = ZB + row * DBIN + hc;
        const float zr = bf1(zp[0]), zk = bf1(zp[512]), zv = bf1(zp[1024]);
        const RwkvTok o = rwkv_tok(zr, zk, zv, pr, pk, pv, bf1(LAM[row * CB + hc]), bf1(AA[row * CB + hc]), W.mu[hc], W.mu[512 + hc], W.mu[1024 + hc], W.k_k[hc], W.k_a[hc], W.r_k[hc], lane);
        pr = zr; pk = zk; pv = zv;
        tk[lane] = o.nkk; tk[64 + lane] = o.ka; tk[128 + lane] = o.d; tk[192 + lane] = o.kp; tk[256 + lane] = o.r;
        LDS_WAIT(); asm volatile("" ::: "memory");
        float sa = 0.f;
#pragma unroll 4
        for (int j = 0; j < 64; ++j) sa = fmaf(Sl[j], tk[j], sa);
        float y = 0.f;
#pragma unroll 4
        for (int j = 0; j < 64; ++j) { float t = o.v * tk[192 + j]; t = fmaf(sa, tk[64 + j], t); const float sn = fmaf(Sl[j], tk[128 + j], t); Sl[j] = sn; y = fmaf(sn, tk[256 + j], y); }
        const float ym = wave_sum(y, lane) * (1.0f / 64.0f), dy = y - ym, yv = wave_sum(dy * dy, lane) * (1.0f / 64.0f);
        const float yn = dy * __builtin_amdgcn_rsqf(yv + GN_EPS) * W.lnx_w[hc] + W.lnx_b[hc];
        const float res = (yn + o.bon * o.v) * bf1(G[row * CB + hc]);
        HEADS[row * DM + CA + hc] = (bf16)(cvtpk(res, 0.f) & 0xffffu);
        LDS_WAIT(); asm volatile("" ::: "memory");
    }
    float* so = out + O_WKVS + ((size_t)(b * NH + h) * 64 + lane) * 64;
#pragma unroll 4
    for (int j = 0; j < 64; ++j) so[j] = Sl[j];
}

__device__ __forceinline__ void rwkv_carry(const Ctx& C, const float* PHI, const float* SLOC, float* SC, float* out) {
    const int bh = C.vcu >> 2, rq = C.vcu & 3, tid = C.tid;
    if (bh >= NBATCH * NH) return;
    LAS float* cur = (LAS float*)(C.lds);
    LAS float* phi = (LAS float*)(C.lds + 4096);
    const int row = tid >> 5, cp = tid & 31;
    for (int i = tid; i < 1024; i += 512) cur[i] = 0.f;
    f32x4 pre[2];
    { const float* p0 = PHI + (size_t)(bh * NCHUNK) * 4096; pre[0] = *(const GAS f32x4*)(p0 + tid * 4); pre[1] = *(const GAS f32x4*)(p0 + 2048 + tid * 4); }
    for (int c = 0; c < NCHUNK; ++c) {
        __syncthreads();
        *(LAS f32x4*)(phi + tid * 4) = pre[0]; *(LAS f32x4*)(phi + 2048 + tid * 4) = pre[1];
        if (c + 1 < NCHUNK) { const float* p1 = PHI + (size_t)(bh * NCHUNK + c + 1) * 4096; pre[0] = *(const GAS f32x4*)(p1 + tid * 4); pre[1] = *(const GAS f32x4*)(p1 + 2048 + tid * 4); }
        const size_t go = ((size_t)(bh * NCHUNK + c) * 64 + rq * 16 + row) * 64 + 2 * cp;
        const f32x2_t sl = *(const GAS f32x2_t*)(SLOC + go);
        const f32x2_t cv = *(LAS const f32x2_t*)(cur + row * 64 + 2 * cp);
        *(GAS f32x2_t*)(SC + go) = cv;
        __syncthreads();
        float a0 = sl[0], a1 = sl[1];
#pragma unroll 4
        for (int k4 = 0; k4 < 16; ++k4) { const f32x4 cr = *(LAS const f32x4*)(cur + row * 64 + 4 * k4);
#pragma unroll
            for (int e = 0; e < 4; ++e) { const f32x2_t ph = *(LAS const f32x2_t*)(phi + (4 * k4 + e) * 64 + 2 * cp); a0 = fmaf(cr[e], ph[0], a0); a1 = fmaf(cr[e], ph[1], a1); } }
        __syncthreads();
        *(LAS f32x2_t*)(cur + row * 64 + 2 * cp) = (f32x2_t){a0, a1};
    }
    __syncthreads();
    const f32x2_t fin = *(LAS const f32x2_t*)(cur + row * 64 + 2 * cp);
    *(GAS f32x2_t*)(out + O_WKVP + ((size_t)bh * 64 + rq * 16 + row) * 64 + 2 * cp) = fin;
    __syncthreads();
}

__device__ __forceinline__ void rwkv_finish(const Ctx& C, const float* YL, const float* U, const float* SC, const bf16* BV, const bf16* G, const RwkvW& W, bf16* HEADS) {
    const int tid = C.tid;
    LAS float* spT = (LAS float*)(C.lds);
    LAS float* ut = (LAS float*)(C.lds + 16384);
    const int tok = tid >> 2, iq = tid & 3;
    for (int it = 0; it < 8; ++it) {
        const int item = C.vcu * 8 + it, bh = item >> 5, c = item & 31, b = bh >> 3, h = bh & 7;
        if (bh >= NBATCH * NH) break;
        const float* sc = SC + (size_t)(bh * NCHUNK + c) * 4096;
        for (int e = tid; e < 4096; e += 512) { const int i = e >> 6, j = e & 63; spT[j * 64 + i] = sc[e]; }
        const size_t row0 = (size_t)b * TSEQ + c * CHL;
        for (int e = tid; e < CHL * 16; e += 512) { const int t = e >> 4, j4 = e & 15; *(LAS f32x4*)(ut + t * 64 + 4 * j4) = *(const GAS f32x4*)(U + (row0 + t) * CB + h * 64 + 4 * j4); }
        __syncthreads();
        const size_t row = row0 + tok; const int hc = h * 64 + 16 * iq;
        float y[16];
#pragma unroll
        for (int q = 0; q < 4; ++q) { const f32x4 v = *(const GAS f32x4*)(YL + row * CB + hc + 4 * q); y[4 * q] = v[0]; y[4 * q + 1] = v[1]; y[4 * q + 2] = v[2]; y[4 * q + 3] = v[3]; }
#pragma unroll 4
        for (int j = 0; j < 64; ++j) { const float u = ut[tok * 64 + j];
#pragma unroll
            for (int q = 0; q < 4; ++q) { const f32x4 s4 = *(LAS const f32x4*)(spT + j * 64 + 16 * iq + 4 * q); y[4 * q] = fmaf(s4[0], u, y[4 * q]); y[4 * q + 1] = fmaf(s4[1], u, y[4 * q + 1]); y[4 * q + 2] = fmaf(s4[2], u, y[4 * q + 2]); y[4 * q + 3] = fmaf(s4[3], u, y[4 * q + 3]); } }
        float sm = 0.f;
#pragma unroll
        for (int e = 0; e < 16; ++e) sm += y[e];
        sm += shx(sm, 1, C.lane); sm += shx(sm, 2, C.lane);
        const float ym = sm * (1.0f / 64.0f); float sv = 0.f;
#pragma unroll
        for (int e = 0; e < 16; ++e) { y[e] -= ym; sv += y[e] * y[e]; }
        sv += shx(sv, 1, C.lane); sv += shx(sv, 2, C.lane);
        const float rs = __builtin_amdgcn_rsqf(sv * (1.0f / 64.0f) + GN_EPS);
        const v4u bw0 = *(const GAS v4u*)(BV + row * CB + hc), bw1 = *(const GAS v4u*)(BV + row * CB + hc + 8);
        const v4u gw0 = *(const GAS v4u*)(G + row * CB + hc), gw1 = *(const GAS v4u*)(G + row * CB + hc + 8);
        const unsigned bwv[8] = {bw0.x, bw0.y, bw0.z, bw0.w, bw1.x, bw1.y, bw1.z, bw1.w}, gwv[8] = {gw0.x, gw0.y, gw0.z, gw0.w, gw1.x, gw1.y, gw1.z, gw1.w};
        unsigned ow[8];
#pragma unroll
        for (int q = 0; q < 8; ++q) {
            const float r0 = (y[2 * q] * rs * W.lnx_w[hc + 2 * q] + W.lnx_b[hc + 2 * q] + bflo(bwv[q])) * bflo(gwv[q]);
            const float r1 = (y[2 * q + 1] * rs * W.lnx_w[hc + 2 * q + 1] + W.lnx_b[hc + 2 * q + 1] + bfhi(bwv[q])) * bfhi(gwv[q]);
            ow[q] = cvtpk(r0, r1); }
        *(GAS v4u*)(HEADS + row * DM + CA + hc) = (v4u){ow[0], ow[1], ow[2], ow[3]};
        *(GAS v4u*)(HEADS + row * DM + CA + hc + 8) = (v4u){ow[4], ow[5], ow[6], ow[7]};
        __syncthreads();
    }
}


template <int U> __device__ __forceinline__ f32x16 thin_acc(const bf16* ap, const bf16* bp, int klen, f32x16 acc) {
#pragma unroll 1
    for (int k = 0; k < klen; k += 16 * U) {
        bf16x8 a[U], b[U];
#pragma unroll
        for (int u = 0; u < U; ++u) { a[u] = *(const GAS bf16x8*)(ap + k + 16 * u); b[u] = *(const GAS bf16x8*)(bp + k + 16 * u); }
#pragma unroll
        for (int u = 0; u < U; ++u) acc = __builtin_amdgcn_mfma_f32_32x32x16_bf16(a[u], b[u], acc, 0, 0, 0);
    }
    return acc;
}
#define F16Z (f32x16){0.f, 0.f, 0.f, 0.f, 0.f, 0.f, 0.f, 0.f, 0.f, 0.f, 0.f, 0.f, 0.f, 0.f, 0.f, 0.f}
#define THIN_LOOP(ntiles) const int lane = C.lane, r32 = lane & 31, hi = lane >> 5; for (int t = (255 - (int)blockIdx.x) * NWAVES + C.wave; t < (ntiles); t += 256 * NWAVES)
__device__ __forceinline__ void thin_lora(const Ctx& C, const bf16* AP, const bf16* Wl, const float* w0, const float* a0, bf16* LAM) {
    THIN_LOOP(192) { const int grp = t >> 6, rb = (t >> 4) & 3, cb = t & 15, koff = grp == 0 ? 0 : grp == 1 ? 64 : 128, klen = grp == 2 ? 128 : 64;
        const f32x16 acc = thin_acc<4>(AP + (size_t)(MPR + rb * 32 + r32) * 256 + koff + 8 * hi, Wl + (size_t)(grp * 512 + cb * 32 + r32) * 256 + koff + 8 * hi, klen, F16Z);
        const int n = cb * 32 + r32; const float bias = grp == 0 ? w0[n] : grp == 1 ? a0[n] : 0.f, mul = grp == 0 ? 0.6065306597126334f : 1.0f;
        bf16* dst = LAM + (size_t)grp * ((size_t)MT * CB);
#pragma unroll
        for (int i = 0; i < 16; ++i) { float v = acc[i] + bias; if (grp < 2) v = mul * sigm(v); dst[(size_t)(MPR + rb * 32 + crow(i, hi)) * CB + n] = (bf16)(cvtpk(v, 0.f) & 0xffffu); } }
}
#define THIN_WG_LOOP(ntiles) const int lane = C.lane, r32 = lane & 31, hi = lane >> 5, wv = C.wave; for (int t = 255 - (int)blockIdx.x; t < (ntiles); t += 256)
template <int NACC> __device__ __forceinline__ void thin_reduce(const Ctx& C, const f32x16 (&acc)[NACC], float (&res)[NACC][2]) {
    LAS float* red = (LAS float*)C.lds;
#pragma unroll
    for (int a = 0; a < NACC; ++a)
#pragma unroll
        for (int i = 0; i < 16; ++i) red[((a * 8 + C.wave) * 16 + i) * 64 + C.lane] = acc[a][i];
    __syncthreads();
#pragma unroll
    for (int a = 0; a < NACC; ++a)
#pragma unroll
        for (int q = 0; q < 2; ++q) { float s = 0.f;
#pragma unroll
            for (int w = 0; w < 8; ++w) s += red[((a * 8 + w) * 16 + 2 * C.wave + q) * 64 + C.lane];
            res[a][q] = s; }
    __syncthreads();
}
__device__ __forceinline__ void thin_wout(const Ctx& C, const bf16* HEADS, const bf16* Wout, const float* xs, float* PRE) {
    THIN_WG_LOOP(128) { const int rb = t >> 5, cb = t & 31, n = cb * 32 + r32;
        f32x16 acc[1]; float res[1][2];
        acc[0] = thin_acc<8>(HEADS + (size_t)(MPR + rb * 32 + r32) * DM + 8 * hi + wv * 128, Wout + (size_t)n * DM + 8 * hi + wv * 128, 128, F16Z);
        thin_reduce<1>(C, acc, res);
#pragma unroll
        for (int q = 0; q < 2; ++q) { const int rs = rb * 32 + crow(2 * wv + q, hi); PRE[(size_t)(MPR + rs) * DM + n] = res[0][q] + ALPHA * xs[(size_t)rs * DM + n]; } }
}
__device__ __forceinline__ void thin_gu(const Ctx& C, const bf16* H1, const bf16* Wgu, bf16* ACT) {
    THIN_WG_LOOP(352) { const int rb = t / 88, fb = t % 88, f = fb * 32 + r32, grow = (f >> 7) * 256 + (f & 127);
        const bf16* ap = H1 + (size_t)(MPR + rb * 32 + r32) * DM + 8 * hi + wv * 128;
        f32x16 acc[2]; float res[2][2];
        acc[0] = thin_acc<8>(ap, Wgu + (size_t)grow * DM + 8 * hi + wv * 128, 128, F16Z);
        acc[1] = thin_acc<8>(ap, Wgu + (size_t)(grow + 128) * DM + 8 * hi + wv * 128, 128, F16Z);
        thin_reduce<2>(C, acc, res);
#pragma unroll
        for (int q = 0; q < 2; ++q) { const float g = res[0][q]; ACT[(size_t)(MPR + rb * 32 + crow(2 * wv + q, hi)) * DFF + f] = (bf16)(cvtpk(g * sigm(g) * res[1][q], 0.f) & 0xffffu); } }
}
__device__ __forceinline__ void thin_down(const Ctx& C, const bf16* ACT, const bf16* Wd, const bf16* H1, float* PRE) {
    THIN_WG_LOOP(128) { const int rb = t >> 5, cb = t & 31, n = cb * 32 + r32;
        f32x16 acc[1]; float res[1][2];
        acc[0] = thin_acc<11>(ACT + (size_t)(MPR + rb * 32 + r32) * DFF + 8 * hi + wv * 352, Wd + (size_t)n * DFF + 8 * hi + wv * 352, 352, F16Z);
        thin_reduce<1>(C, acc, res);
#pragma unroll
        for (int q = 0; q < 2; ++q) { const size_t o = (size_t)(MPR + rb * 32 + crow(2 * wv + q, hi)) * DM + n; PRE[o] = res[0][q] + ALPHA * bf1(H1[o]); } }
}
__device__ __forceinline__ void thin_pp(const Ctx& C, const bf16* PB, const bf16* Wpp, bf16* PP) {
    THIN_WG_LOOP(128) { const int rb = t >> 5, cb = t & 31, n = cb * 32 + r32;
        f32x16 acc[1]; float res[1][2];
        acc[0] = thin_acc<2>(PB + (size_t)(MPR + rb * 32 + r32) * PLE + 8 * hi + wv * 32, Wpp + (size_t)n * PLE + 8 * hi + wv * 32, 32, F16Z);
        thin_reduce<1>(C, acc, res);
#pragma unroll
        for (int q = 0; q < 2; ++q) PP[(size_t)(MPR + rb * 32 + crow(2 * wv + q, hi)) * DM + n] = (bf16)(cvtpk(res[0][q], 0.f) & 0xffffu); }
}
__device__ __forceinline__ void thin_pg(const Ctx& C, const bf16* H2, const bf16* Wpg, const bf16* PP, float* PRE) {
    THIN_WG_LOOP(128) { const int rb = t >> 5, cb = t & 31, n = cb * 32 + r32;
        f32x16 acc[1]; float res[1][2];
        acc[0] = thin_acc<8>(H2 + (size_t)(MPR + rb * 32 + r32) * DM + 8 * hi + wv * 128, Wpg + (size_t)n * DM + 8 * hi + wv * 128, 128, F16Z);
        thin_reduce<1>(C, acc, res);
#pragma unroll
        for (int q = 0; q < 2; ++q) { const size_t o = (size_t)(MPR + rb * 32 + crow(2 * wv + q, hi)) * DM + n; PRE[o] = ALPHA * bf1(H2[o]) + sigm(res[0][q]) * bf1(PP[o]); } }
}

template <int MODE> __device__ __forceinline__ void ln_pass(const Ctx& C, const float* PRE, const float* w, const float* bsh, bf16* Hout, float* out) {
    const int gw = C.vcu * NWAVES + C.wave, NGW = C.G * NWAVES, lane = C.lane;
    f32x4 wv[4], bv[4];
#pragma unroll
    for (int j = 0; j < 4; ++j) { wv[j] = *(const GAS f32x4*)(w + 256 * j + 4 * lane); bv[j] = *(const GAS f32x4*)(bsh + 256 * j + 4 * lane); }
    for (int row = gw; row < MPR + MSA; row += NGW) {
        const GAS f32x4* xr = (const GAS f32x4*)(PRE + (size_t)row * DM) + lane;
        f32x4 v[4]; float s = 0.f;
#pragma unroll
        for (int j = 0; j < 4; ++j) { v[j] = xr[64 * j]; s += (v[j][0] + v[j][1]) + (v[j][2] + v[j][3]); }
        const float mean = wave_sum(s, lane) * (1.f / DM); float s2 = 0.f;
#pragma unroll
        for (int j = 0; j < 4; ++j) { v[j] = v[j] - mean; s2 += (v[j][0] * v[j][0] + v[j][1] * v[j][1]) + (v[j][2] * v[j][2] + v[j][3] * v[j][3]); }
        const float rstd = __builtin_amdgcn_rsqf(wave_sum(s2, lane) * (1.f / DM) + LN_EPS);
        if (MODE == 0) {
            GAS u32x2* o8 = (GAS u32x2*)(Hout + (size_t)row * DM) + lane;
#pragma unroll
            for (int j = 0; j < 4; ++j) { const f32x4 o = v[j] * rstd * wv[j] + bv[j]; u32x2 wq; wq.x = cvtpk(o[0], o[1]); wq.y = cvtpk(o[2], o[3]); o8[64 * j] = wq; }
        } else {
            float* dst = row < MPR ? out + O_YP + (size_t)row * DM : out + O_YS + (size_t)(row - MPR) * DM;
#pragma unroll
            for (int j = 0; j < 4; ++j) *((GAS f32x4*)dst + lane + 64 * j) = v[j] * rstd * wv[j] + bv[j];
        }
    }
}
struct Args { const float* in[32]; float* out; unsigned char* ws; int nphase, pad; };
#ifndef PHMASK
#define PHMASK 0xFFFFFF
#endif
#ifndef REPPH
#define REPPH -1
#endif
#ifndef REPN
#define REPN 3
#endif
#define PHON(n) if constexpr (((PHMASK) >> (n)) & 1) for (int rep_ = 0; rep_ < ((n) == (REPPH) ? (REPN) : 1); ++rep_)
#ifndef GEMM_ALIGN
#define GEMM_ALIGN true
#endif
#ifndef GEMM_SP2
#define GEMM_SP2 true
#endif
__global__ void __launch_bounds__(NWAVES * 64, 2) mega_fwd(Args args) {
    extern __shared__ __attribute__((aligned(16))) unsigned char lds_raw[];
    LAS unsigned char* const lds0 = (LAS unsigned char*)lds_raw;
    volatile LAS unsigned* MISC = (volatile LAS unsigned*)(lds0 + MISC_OFF);
    const int G0 = gridDim.x;
    for (int u = threadIdx.x; u < (LDS_BYTES - LDSCTL_OFF) / 4; u += NWAVES * 64) ((LAS unsigned*)(lds0 + LDSCTL_OFF))[u] = 0u;
    __syncthreads();
    gu32* ctl = (gu32*)(args.ws + WS_CTL);
    XcdBarrier bar = xcd_barrier_post((unsigned*)(ctl + CW_BAR), MISC + 8);
    const int nph = args.nphase;
#define GRID_BAR() xcd_barrier(bar)
    typedef const __attribute__((address_space(4))) Args* KArgs;
#define PH_BEGIN Ctx C; { int t_ = threadIdx.x; asm volatile("" : "+v"(t_)); C.lds = lds0; C.tid = t_; C.lane = t_ & 63; C.wave = __builtin_amdgcn_readfirstlane(t_ >> 6); C.G = G0; const int bx_ = blockIdx.x; C.vcu = (G0 % 8 == 0) ? (bx_ % 8) * (G0 / 8) + bx_ / 8 : bx_; } KArgs kp = (KArgs)__builtin_amdgcn_kernarg_segment_ptr(); asm volatile("" : "+s"(kp)); unsigned char* ws = kp->ws; float* out = kp->out; (void)ws; (void)out;
#define IN_(i) (kp->in[i])
#define WSB(off) ((bf16*)(ws + (off)))
#define WSF(off) ((float*)(ws + (off)))
    const int bx = (int)blockIdx.x;

    PHON(0) { PH_BEGIN P0Args A{IN_(0), IN_(1), IN_(2), IN_(3), IN_(4), IN_(5), IN_(8), IN_(20), IN_(23), IN_(24), IN_(25), IN_(28), IN_(29), IN_(11), IN_(13), IN_(14),
                       WSB(WS_WIN), WSB(WS_WOUT), WSB(WS_WGU), WSB(WS_WD), WSB(WS_WPG), WSB(WS_WPP), WSB(WS_WL), WSB(WS_R1), WSB(WS_PB), out};
      p0_prologue(C, A); }
    GRID_BAR(); if (nph <= 1) return;
    PHON(1) { PH_BEGIN pg8::Gemm g{WSB(WS_R1), WSB(WS_WIN), MT, DIN, DM}; pg8::StaticOrder S; S.init(MT, DIN, C.G, bx);
      pg8::EpiZ E{WSB(WS_QB), WSB(WS_ZB), out};
      pg8::gemm_phase<pg8::EpiZ, pg8::StaticOrder, GEMM_ALIGN, GEMM_SP2>(C.lds + RING_OFF, g, S, E); }
    GRID_BAR(); if (nph <= 2) return;
    PHON(2) { PH_BEGIN prep_a(C, WSB(WS_ZB), IN_(9), IN_(7), WSB(WS_AP), out); }
    PHON(3) { PH_BEGIN attn_prompt(C, WSB(WS_QB), WSB(WS_KB), WSB(WS_VB), WSB(WS_OG), WSF(WS_LSE)); }
    PHON(4) { PH_BEGIN attn_sample(C, WSB(WS_QB), IN_(4), IN_(5), out, WSB(WS_R1)); }
    GRID_BAR(); if (nph <= 3) return;
    PHON(5) { PH_BEGIN pg8::Gemm g{WSB(WS_AP), WSB(WS_WL), MPR, 1536, 256}; pg8::StaticOrder S; S.init(MPR, 1536, C.G, bx);
      pg8::EpiLora E{WSB(WS_QB), IN_(10), IN_(12)};
      pg8::gemm_phase<pg8::EpiLora, pg8::StaticOrder, GEMM_ALIGN, GEMM_SP2>(C.lds + RING_OFF, g, S, E);
      thin_lora(C, WSB(WS_AP), WSB(WS_WL), IN_(10), IN_(12), WSB(WS_QB)); }
    PHON(6) { PH_BEGIN attn_merge(C, WSB(WS_OG), WSF(WS_LSE), WSB(WS_R1)); }
    GRID_BAR(); if (nph <= 4) return;
    PHON(7) { PH_BEGIN const RwkvW RW{IN_(9), IN_(15), IN_(16), IN_(17), IN_(18), IN_(19)};
      rwkv_sample(C, WSB(WS_ZB), WSB(WS_QB), WSB(WS_KB), WSB(WS_VB), RW, IN_(6), IN_(7), WSB(WS_R1), out); }
    PHON(8) { PH_BEGIN const RwkvW RW{IN_(9), IN_(15), IN_(16), IN_(17), IN_(18), IN_(19)};
      const int bh = C.vcu >> 2, c = (C.vcu & 3) * 8 + C.wave;
      if (bh < NBATCH * NH) rwkv_chunk(C, WSB(WS_ZB), WSB(WS_QB), WSB(WS_KB), RW, out + O_YP, out + O_YP + (size_t)MPR * CB, WSB(WS_BV), WSF(WS_PHI), WSF(WS_SLOC), bh >> 3, bh & 7, c, IN_(4), IN_(5), out); }
    GRID_BAR(); if (nph <= 5) return;
    PHON(9) { PH_BEGIN rwkv_carry(C, WSF(WS_PHI), WSF(WS_SLOC), WSF(WS_SC), out); }
    GRID_BAR(); if (nph <= 6) return;
    PHON(10) { PH_BEGIN const RwkvW RW{IN_(9), IN_(15), IN_(16), IN_(17), IN_(18), IN_(19)};
      rwkv_finish(C, out + O_YP, out + O_YP + (size_t)MPR * CB, WSF(WS_SC), WSB(WS_BV), WSB(WS_VB), RW, WSB(WS_R1)); }
    GRID_BAR(); if (nph <= 7) return;
    PHON(11) { PH_BEGIN pg8::Gemm g{WSB(WS_R1), WSB(WS_WOUT), MPR, DM, DM}; pg8::StaticOrder S; S.init(MPR, DM, C.G, bx);
      pg8::EpiWout E{WSF(WS_PRE), IN_(0), IN_(1)};
      pg8::gemm_phase<pg8::EpiWout, pg8::StaticOrder, GEMM_ALIGN, GEMM_SP2>(C.lds + RING_OFF, g, S, E);
      thin_wout(C, WSB(WS_R1), WSB(WS_WOUT), IN_(1), WSF(WS_PRE)); }
    GRID_BAR(); if (nph <= 8) return;
    PHON(12) { PH_BEGIN ln_pass<0>(C, WSF(WS_PRE), IN_(21), IN_(22), WSB(WS_R1), out); }
    GRID_BAR(); if (nph <= 9) return;
    PHON(13) { PH_BEGIN pg8::Gemm g{WSB(WS_R1), WSB(WS_WGU), MPR, 2 * DFF, DM}; pg8::StaticOrder S; S.init(MPR, 2 * DFF, C.G, bx);
      pg8::EpiGU E{WSB(WS_ACT)};
      pg8::gemm_phase<pg8::EpiGU, pg8::StaticOrder, GEMM_ALIGN, GEMM_SP2>(C.lds + RING_OFF, g, S, E);
      thin_gu(C, WSB(WS_R1), WSB(WS_WGU), WSB(WS_ACT)); }
    GRID_BAR(); if (nph <= 10) return;
    PHON(14) { PH_BEGIN pg8::Gemm g{WSB(WS_ACT), WSB(WS_WD), MPR, DM, DFF}; pg8::StaticOrder S; S.init(MPR, DM, C.G, bx);
      pg8::EpiDown E{WSF(WS_PRE), WSB(WS_R1)};
      pg8::gemm_phase<pg8::EpiDown, pg8::StaticOrder, GEMM_ALIGN, GEMM_SP2>(C.lds + RING_OFF, g, S, E);
      thin_down(C, WSB(WS_ACT), WSB(WS_WD), WSB(WS_R1), WSF(WS_PRE)); }
    GRID_BAR(); if (nph <= 11) return;
    PHON(15) { PH_BEGIN ln_pass<0>(C, WSF(WS_PRE), IN_(26), IN_(27), WSB(WS_H2), out); }
    GRID_BAR(); if (nph <= 12) return;
    PHON(16) { PH_BEGIN pg8::Gemm g{WSB(WS_PB), WSB(WS_WPP), MPR, DM, PLE}; pg8::StaticOrder S; S.init(MPR, DM, C.G, bx);
      pg8::EpiPlain E{WSB(WS_PP)};
      pg8::gemm_phase<pg8::EpiPlain, pg8::StaticOrder, GEMM_ALIGN, GEMM_SP2>(C.lds + RING_OFF, g, S, E);
      thin_pp(C, WSB(WS_PB), WSB(WS_WPP), WSB(WS_PP)); }
    GRID_BAR(); if (nph <= 13) return;
    PHON(17) { PH_BEGIN pg8::Gemm g{WSB(WS_H2), WSB(WS_WPG), MPR, DM, DM}; pg8::StaticOrder S; S.init(MPR, DM, C.G, bx);
      pg8::EpiPle E{WSF(WS_PRE), WSB(WS_H2), WSB(WS_PP)};
      pg8::gemm_phase<pg8::EpiPle, pg8::StaticOrder, GEMM_ALIGN, GEMM_SP2>(C.lds + RING_OFF, g, S, E);
      thin_pg(C, WSB(WS_H2), WSB(WS_WPG), WSB(WS_PP), WSF(WS_PRE)); }
    GRID_BAR(); if (nph <= 14) return;
    PHON(18) { PH_BEGIN ln_pass<1>(C, WSF(WS_PRE), IN_(30), IN_(31), nullptr, out); }
}

#ifndef N_PHASES
#define N_PHASES 99
#endif
extern "C" void kernel_launch(void* const* d_in, const int* in_sizes, int n_in, void* d_out, int out_size, void* d_ws, size_t ws_size, hipStream_t stream) {
    static int grid = 0;
    if (grid == 0) {
        if (n_in != 32 || in_sizes[0] != MPR * DM || (size_t)out_size != O_END || ws_size < WS_END) {
            fprintf(stderr, "kernel_launch: unexpected shapes: n_in %d in0 %d out %d (want %zu) ws %zu (want >= %zu); nothing launched\n", n_in, n_in > 0 ? in_sizes[0] : -1, out_size, (size_t)O_END, ws_size, (size_t)WS_END);
            grid = -1; return; }
        int dev = 0, cus = 0, per_cu = 0;
        if (hipGetDevice(&dev) != hipSuccess || hipDeviceGetAttribute(&cus, hipDeviceAttributeMultiprocessorCount, dev) != hipSuccess) { fprintf(stderr, "kernel_launch: device query failed\n"); grid = -1; return; }
        if (hipFuncSetAttribute((const void*)mega_fwd, hipFuncAttributeMaxDynamicSharedMemorySize, LDS_BYTES) != hipSuccess) { fprintf(stderr, "kernel_launch: hipFuncSetAttribute failed\n"); grid = -1; return; }
        if (hipOccupancyMaxActiveBlocksPerMultiprocessor(&per_cu, (const void*)mega_fwd, NWAVES * 64, LDS_BYTES) != hipSuccess || per_cu < 1) { fprintf(stderr, "kernel_launch: occupancy query reports %d blocks per CU\n", per_cu); }
        (void)hipGetLastError();
        grid = cus;
        if (grid != 256) fprintf(stderr, "kernel_launch: note: %d CUs (work distribution assumes 256)\n", grid);
    }
    if (grid < 0) return;
    if (hipMemsetAsync((char*)d_ws + WS_CTL, 0, CTL_ZERO_BYTES, stream) != hipSuccess) { fprintf(stderr, "kernel_launch: memset failed\n"); return; }
    Args a{};
    for (int i = 0; i < 32; ++i) a.in[i] = (const float*)d_in[i];
    a.out = (float*)d_out; a.ws = (unsigned char*)d_ws; a.nphase = N_PHASES; a.pad = 0;
    hipLaunchKernelGGL(mega_fwd, dim3(grid), dim3(NWAVES * 64), LDS_BYTES, stream, a);
    const hipError_t le = hipPeekAtLastError();
    if (le != hipSuccess) fprintf(stderr, "kernel_launch: launch failed: %s\n", hipGetErrorName(le));
}
```

```cpp
#include <hip/hip_runtime.h>
#include <cstdio>
#include <cstdint>
constexpr int DM = 1024, TSEQ = 4096, NBATCH = 8, MPR = NBATCH * TSEQ;
constexpr int SB = 32, SS = 4, MSA = SB * SS;
constexpr int MT = MPR + 256;
constexpr int CA = 512, CB = 512, DBIN = 1792, DIN = 3328, DFF = 2816, PLE = 256, HD = 64, NH = 8;
constexpr int WINL = 2048;
constexpr float ALPHA = 1.18920711500272f;
constexpr float LN_EPS = 1e-5f, GN_EPS = 64e-5f;
constexpr float QSCALE = 0.125f * 1.4426950408889634f;
constexpr float LOG2E = 1.4426950408889634f;
constexpr size_t O_YP = 0, O_YS = O_YP + (size_t)MPR * DM, O_KWP = O_YS + (size_t)MSA * DM, O_VWP = O_KWP + (size_t)NBATCH * WINL * CA,
                 O_WKVP = O_VWP + (size_t)NBATCH * WINL * CA, O_SHP = O_WKVP + (size_t)NBATCH * NH * HD * HD, O_KWS = O_SHP + (size_t)NBATCH * DBIN,
                 O_VWS = O_KWS + (size_t)SB * WINL * CA, O_WKVS = O_VWS + (size_t)SB * WINL * CA, O_SHS = O_WKVS + (size_t)SB * NH * HD * HD,
                 O_END = O_SHS + (size_t)SB * DBIN;
namespace pg8 {
#define PG8_LAS __attribute__((address_space(3)))
typedef unsigned short bf16_t;
typedef short bf16x8 __attribute__((ext_vector_type(8)));
typedef float f32x4 __attribute__((ext_vector_type(4)));
typedef unsigned u32x4 __attribute__((ext_vector_type(4)));
constexpr int BM = 256, BK = 64, HALF = 128, HTB = HALF * BK * 2  , STAGE_BYTES = 8 * HTB, NXCD = 8, WGM = 8;

__host__ __device__ __forceinline__ int lds_byte(int r, int c) { const int st = (r >> 4) * 2 + (c >> 5), rr = r & 15, cc = c & 31, ob = rr * 64 + cc * 2; return st * 1024 + (ob ^ (((ob >> 9) & 1) << 5)); }
__host__ __device__ __forceinline__ void stage_rc(int b, int& R, int& C) { const int st = b / 1024, sb = b % 1024, swz = sb ^ (((sb >> 9) & 1) << 5); R = (st >> 1) * 16 + swz / 64; C = (st & 1) * 32 + (swz % 64) / 2; }
__host__ __device__ __forceinline__ int perm32(int rho) { const int n = rho >> 4, i = rho & 15; return 8 * (i >> 2) + 4 * n + (i & 3); }

struct Unit { int pm, pn; };
struct Gemm { const bf16_t* A; const bf16_t* Bt; int M, N, K; };

struct StaticOrder {
    int nM, nN, nwg, G, c;
    __host__ __device__ void init(int M, int N, int G_, int c_) { nM = M / BM; nN = N / BM; nwg = nM * nN; G = G_; c = c_; }
    __host__ __device__ bool next(int i, Unit& u) const {
        const long L = (long)i * G + c; if (L >= nwg) return false;
        int wgid = (int)L; { const int q = nwg / NXCD, r = nwg % NXCD, xcd = wgid % NXCD, off = wgid / NXCD; wgid = (xcd < r ? xcd * (q + 1) : r * (q + 1) + (xcd - r) * q) + off; }
        const int nig = WGM * nN, gid = wgid / nig, fm = gid * WGM, gsz = (nM - fm) < WGM ? (nM - fm) : WGM;
        u.pm = fm + ((wgid % nig) % gsz); u.pn = (wgid % nig) / gsz; return true;
    }
    __device__ __forceinline__ void a_ready(const Unit&) const {}
    __device__ __forceinline__ void done(const Unit&) const {}
};

typedef unsigned u32x2 __attribute__((ext_vector_type(2)));
__device__ __forceinline__ unsigned cvt_pk_bf16(float lo, float hi) { unsigned r; asm volatile("v_cvt_pk_bf16_f32 %0, %1, %2" : "=v"(r) : "v"(lo), "v"(hi)); return r; }
__device__ __forceinline__ float bf_lo(unsigned w) { return __uint_as_float(w << 16); }
__device__ __forceinline__ float bf_hi(unsigned w) { return __uint_as_float(w & 0xffff0000u); }
__device__ __forceinline__ float sigmoidf_(float x) { return __builtin_amdgcn_rcpf(1.0f + __builtin_amdgcn_exp2f(-x * 1.4426950408889634f)); }
__device__ __forceinline__ u32x4 pack8(const f32x4& a, const f32x4& b) { u32x4 w; w.x = cvt_pk_bf16(a[0], a[1]); w.y = cvt_pk_bf16(a[2], a[3]); w.z = cvt_pk_bf16(b[0], b[1]); w.w = cvt_pk_bf16(b[2], b[3]); return w; }

struct EpiZ {
    static constexpr bool PERM = true, AFTER_DRAIN = false;
    bf16_t *QB, *ZB; float* out;
    __device__ __forceinline__ void operator()(const f32x4 (&acc)[2][2][4][2], const Unit& u, int wr, int wc, int fr, int fq) const {
        const int pn = u.pn, pm = u.pm;
        const int kind = pn < 6 ? (pn >> 1) : 3;
        bf16_t* dst = kind == 3 ? ZB : QB + (size_t)kind * ((size_t)MT * CA);
        const int ld = kind == 3 ? DBIN : CA;
        const int col0 = (kind == 3 ? (pn - 6) * 256 : (pn & 1) * 256) + wc * 32 + 8 * fq;
        const float sc = kind == 0 ? QSCALE : 1.0f;
        const int rbase = pm * BM + wr * 64 + fr;
        const bool win_p = (kind == 1 || kind == 2) && pm < 128 && (pm & 15) >= 8;
        const bool win_s = (kind == 1 || kind == 2) && pm == 128;
        float* wout = out + (win_s ? O_KWS : O_KWP) + (kind == 2 ? (win_s ? (O_VWS - O_KWS) : (O_VWP - O_KWP)) : (size_t)0);
#pragma unroll
        for (int ai = 0; ai < 2; ++ai)
#pragma unroll
            for (int m = 0; m < 4; ++m) {
                const int row = rbase + ai * HALF + m * 16;
                bf16_t* rowp = dst + (size_t)row * ld + col0;
#pragma unroll
                for (int bj = 0; bj < 2; ++bj) {
                    const f32x4 v0 = acc[ai][bj][m][0] * sc, v1 = acc[ai][bj][m][1] * sc;
                    *(u32x4*)(rowp + bj * HALF) = pack8(v0, v1);
                    if (win_p) {
                        const int b = pm >> 4, t = (pm & 15) * 256 + (row & 255);
                        float* o = wout + ((size_t)(b * WINL + t - WINL) * CA + col0 + bj * HALF);
                        *(f32x4*)o = v0; *(f32x4*)(o + 4) = v1;
                    } else if (win_s && ai == 0) {
                        const int rs = row - MPR, b = rs >> 2, s = rs & 3;
                        float* o = wout + ((size_t)(b * WINL + (WINL - SS) + s) * CA + col0 + bj * HALF);
                        *(f32x4*)o = v0; *(f32x4*)(o + 4) = v1;
                    }
                }
            }
    }
};

struct EpiLora {
    static constexpr bool PERM = true, AFTER_DRAIN = false;
    bf16_t *LAM; const float *w0, *a0;
    __device__ __forceinline__ void operator()(const f32x4 (&acc)[2][2][4][2], const Unit& u, int wr, int wc, int fr, int fq) const {
        const int kind = u.pn >> 1;
        bf16_t* dst = LAM + (size_t)kind * ((size_t)MT * CB);
        const int col0 = (u.pn & 1) * 256 + wc * 32 + 8 * fq;
        const float* bias = kind == 0 ? w0 : a0;
        const float mul = kind == 0 ? 0.6065306597126334f : 1.0f;
        const int rbase = u.pm * BM + wr * 64 + fr;
#pragma unroll
        for (int bj = 0; bj < 2; ++bj) {
            f32x4 b0 = {0.f, 0.f, 0.f, 0.f}, b1 = b0;
            if (kind < 2) { b0 = *(const f32x4*)(bias + col0 + bj * HALF); b1 = *(const f32x4*)(bias + col0 + bj * HALF + 4); }
#pragma unroll
            for (int ai = 0; ai < 2; ++ai)
#pragma unroll
                for (int m = 0; m < 4; ++m) {
                    f32x4 v0 = acc[ai][bj][m][0] + b0, v1 = acc[ai][bj][m][1] + b1;
                    if (kind < 2) {
#pragma unroll
                        for (int e = 0; e < 4; ++e) { v0[e] = mul * sigmoidf_(v0[e]); v1[e] = mul * sigmoidf_(v1[e]); }
                    }
                    *(u32x4*)(dst + (size_t)(rbase + ai * HALF + m * 16) * CB + col0 + bj * HALF) = pack8(v0, v1);
                    asm volatile("" ::: "memory");
                }
        }
    }
};

__device__ __forceinline__ f32x4 xres4(const float* xp, const float* xs, int row, int col) {
    if (row < MPR) return *(const f32x4*)(xp + (size_t)row * DM + col);
    if (row < MPR + MSA) return *(const f32x4*)(xs + (size_t)(row - MPR) * DM + col);
    return (f32x4){0.f, 0.f, 0.f, 0.f};
}
struct EpiWout {
    static constexpr bool PERM = false, AFTER_DRAIN = false;
    float* PRE; const float *xp, *xs;
    __device__ __forceinline__ void operator()(const f32x4 (&acc)[2][2][4][2], const Unit& u, int wr, int wc, int fr, int fq) const {
        const int row0 = u.pm * BM + wr * 64 + fr, col0 = u.pn * BM + wc * 32 + 4 * fq;
#pragma unroll
        for (int ai = 0; ai < 2; ++ai)
#pragma unroll
            for (int m = 0; m < 4; ++m) { const int row = row0 + ai * HALF + m * 16; float* rowp = PRE + (size_t)row * DM + col0;
#pragma unroll
                for (int bj = 0; bj < 2; ++bj)
#pragma unroll
                    for (int n = 0; n < 2; ++n) { const f32x4 xr = xres4(xp, xs, row, col0 + bj * HALF + n * 16); *(f32x4*)(rowp + bj * HALF + n * 16) = acc[ai][bj][m][n] + xr * ALPHA; } }
    }
};
struct EpiGU {
    static constexpr bool PERM = true, AFTER_DRAIN = false;
    bf16_t* ACT;
    __device__ __forceinline__ void operator()(const f32x4 (&acc)[2][2][4][2], const Unit& u, int wr, int wc, int fr, int fq) const {
        const int row0 = u.pm * BM + wr * 64 + fr, col0 = u.pn * HALF + wc * 32 + 8 * fq;
#pragma unroll
        for (int ai = 0; ai < 2; ++ai)
#pragma unroll
            for (int m = 0; m < 4; ++m) {
                f32x4 o[2];
#pragma unroll
                for (int n = 0; n < 2; ++n)
#pragma unroll
                    for (int e = 0; e < 4; ++e) { const float g = acc[ai][0][m][n][e], up = acc[ai][1][m][n][e]; o[n][e] = g * sigmoidf_(g) * up; }
                *(u32x4*)(ACT + (size_t)(row0 + ai * HALF + m * 16) * DFF + col0) = pack8(o[0], o[1]);
            }
    }
};
struct EpiDown {
    static constexpr bool PERM = false, AFTER_DRAIN = false;
    float* PRE; const bf16_t* H;
    __device__ __forceinline__ void operator()(const f32x4 (&acc)[2][2][4][2], const Unit& u, int wr, int wc, int fr, int fq) const {
        const int row0 = u.pm * BM + wr * 64 + fr, col0 = u.pn * BM + wc * 32 + 4 * fq;
#pragma unroll
        for (int ai = 0; ai < 2; ++ai)
#pragma unroll
            for (int m = 0; m < 4; ++m) { const size_t off = (size_t)(row0 + ai * HALF + m * 16) * DM + col0;
#pragma unroll
                for (int bj = 0; bj < 2; ++bj)
#pragma unroll
                    for (int n = 0; n < 2; ++n) { const u32x2 hw = *(const u32x2*)(H + off + bj * HALF + n * 16);
                        const f32x4 hr = (f32x4){bf_lo(hw.x), bf_hi(hw.x), bf_lo(hw.y), bf_hi(hw.y)};
                        *(f32x4*)(PRE + off + bj * HALF + n * 16) = acc[ai][bj][m][n] + hr * ALPHA; } }
    }
};
struct EpiPlain {
    static constexpr bool PERM = true, AFTER_DRAIN = false;
    bf16_t* O;
    __device__ __forceinline__ void operator()(const f32x4 (&acc)[2][2][4][2], const Unit& u, int wr, int wc, int fr, int fq) const {
        const int row0 = u.pm * BM + wr * 64 + fr, col0 = u.pn * BM + wc * 32 + 8 * fq;
#pragma unroll
        for (int ai = 0; ai < 2; ++ai)
#pragma unroll
            for (int m = 0; m < 4; ++m)
#pragma unroll
                for (int bj = 0; bj < 2; ++bj) *(u32x4*)(O + (size_t)(row0 + ai * HALF + m * 16) * DM + col0 + bj * HALF) = pack8(acc[ai][bj][m][0], acc[ai][bj][m][1]);
    }
};
struct EpiPle {
    static constexpr bool PERM = false, AFTER_DRAIN = false;
    float* PRE; const bf16_t *H, *PP;
    __device__ __forceinline__ void operator()(const f32x4 (&acc)[2][2][4][2], const Unit& u, int wr, int wc, int fr, int fq) const {
        const int row0 = u.pm * BM + wr * 64 + fr, col0 = u.pn * BM + wc * 32 + 4 * fq;
#pragma unroll
        for (int ai = 0; ai < 2; ++ai)
#pragma unroll
            for (int m = 0; m < 4; ++m) { const size_t off = (size_t)(row0 + ai * HALF + m * 16) * DM + col0;
#pragma unroll
                for (int bj = 0; bj < 2; ++bj)
#pragma unroll
                    for (int n = 0; n < 2; ++n) { const size_t o2 = off + bj * HALF + n * 16;
                        const u32x2 hw = *(const u32x2*)(H + o2), pw = *(const u32x2*)(PP + o2);
                        const f32x4 hr = (f32x4){bf_lo(hw.x), bf_hi(hw.x), bf_lo(hw.y), bf_hi(hw.y)}, pr = (f32x4){bf_lo(pw.x), bf_hi(pw.x), bf_lo(pw.y), bf_hi(pw.y)};
                        f32x4 a = acc[ai][bj][m][n];
#pragma unroll
                        for (int e = 0; e < 4; ++e) a[e] = sigmoidf_(a[e]);
                        *(f32x4*)(PRE + o2) = hr * ALPHA + a * pr; } }
    }
};
template <class Epi, class Sched, bool ALIGN_EPI = false, bool SP2 = false>
__device__ __forceinline__ void gemm_phase(PG8_LAS unsigned char* lds, const Gemm g, const Sched& S, const Epi& E) {
    int tid_ = threadIdx.x; asm volatile("" : "+v"(tid_));
    const int tid = tid_, wid = __builtin_amdgcn_readfirstlane(tid >> 6), lane = tid & 63, wr = wid >> 2, wc = wid & 3, fr = lane & 15, fq = lane >> 4;
    int K_ = g.K; asm volatile("" : "+s"(K_));
    const int K = K_, nt = K / BK;
    unsigned voffA[2], voffB[2];
#pragma unroll
    for (int i = 0; i < 2; ++i) { int R, C; stage_rc(tid * 16 + i * 8192, R, C); const int Rb = Epi::PERM ? ((R & ~31) + perm32(R & 31)) : R;
        voffA[i] = (unsigned)(R * K + C) * 2u; voffB[i] = (unsigned)(Rb * K + C) * 2u; }
    const size_t kstep = (size_t)(BK * 2);
    const size_t hstep = (size_t)HALF * K * 2;
    const size_t tstep = 2 * hstep;
    const unsigned ldsw = (unsigned)wid * 1024u;
    const int aoff = lds_byte(wr * 64 + fr, fq * 8), boff = lds_byte(wc * 32 + fr, fq * 8);
#define PG8_SA(b, h) (((b) * 2 + (h)) * HTB)
#define PG8_SB(b, h) ((4 + (b) * 2 + (h)) * HTB)
#define PG8_STAGE(bufoff, gbase, voff) do { _Pragma("unroll") for (int _i = 0; _i < 2; ++_i) \
        __builtin_amdgcn_global_load_lds((const unsigned*)((const char*)(gbase) + (voff)[_i]), (PG8_LAS unsigned*)(lds + (bufoff) + ldsw + _i * 8192), 16, 0, 0); } while (0)
#define PG8_LDA(dst, b, h) do { _Pragma("unroll") for (int m = 0; m < 4; ++m) _Pragma("unroll") for (int k = 0; k < 2; ++k) dst[m][k] = *(const PG8_LAS bf16x8*)(lds + PG8_SA(b, h) + aoff + m * 2048 + k * 1024); } while (0)
#define PG8_LDB(dst, b, h) do { _Pragma("unroll") for (int n = 0; n < 2; ++n) _Pragma("unroll") for (int k = 0; k < 2; ++k) dst[n][k] = *(const PG8_LAS bf16x8*)(lds + PG8_SB(b, h) + boff + n * 2048 + k * 1024); } while (0)
#define PG8_MMA(ai, bj, At, Bt) do { __builtin_amdgcn_s_setprio(1); _Pragma("unroll") for (int m = 0; m < 4; ++m) _Pragma("unroll") for (int n = 0; n < 2; ++n) _Pragma("unroll") for (int k = 0; k < 2; ++k) \
        acc[ai][bj][m][n] = __builtin_amdgcn_mfma_f32_16x16x32_bf16(Bt[n][k], At[m][k], acc[ai][bj][m][n], 0, 0, 0); __builtin_amdgcn_s_setprio(0); } while (0)
#define PG8_WAIT_V(n) asm volatile("s_waitcnt vmcnt(" #n ")" ::: "memory")
#define PG8_WAIT_L(n) asm volatile("s_waitcnt lgkmcnt(" #n ")" ::: "memory")
#define PG8_BAR __builtin_amdgcn_s_barrier()
#define PG8_SCHED __builtin_amdgcn_sched_barrier(0)
    Unit cur, nxt; int ui = 0;
    if (!S.next(0, cur)) return;
    f32x4 acc[2][2][4][2];
#pragma unroll
    for (int a = 0; a < 2; ++a)
#pragma unroll
        for (int b = 0; b < 2; ++b)
#pragma unroll
            for (int m = 0; m < 4; ++m)
#pragma unroll
                for (int n = 0; n < 2; ++n) acc[a][b][m][n] = (f32x4){0.f, 0.f, 0.f, 0.f};
    bf16x8 At[4][2], B0[2][2], B1[2][2];
    const char* cA = (const char*)g.A + (size_t)cur.pm * tstep; const char* cB = (const char*)g.Bt + (size_t)cur.pn * tstep;
    S.a_ready(cur);
    if constexpr (SP2) {
        PG8_STAGE(PG8_SB(0, 0), cB, voffB); PG8_STAGE(PG8_SB(0, 1), cB + hstep, voffB); PG8_STAGE(PG8_SA(0, 0), cA, voffA); PG8_STAGE(PG8_SA(0, 1), cA + hstep, voffA);
        if (wr == 1) PG8_BAR;
        PG8_WAIT_V(2); PG8_BAR;
        PG8_STAGE(PG8_SB(1, 0), cB + kstep, voffB); PG8_STAGE(PG8_SA(1, 0), cA + kstep, voffA); PG8_STAGE(PG8_SB(1, 1), cB + hstep + kstep, voffB);
        PG8_WAIT_V(6); PG8_BAR;
    } else {
        PG8_STAGE(PG8_SB(0, 0), cB, voffB); PG8_STAGE(PG8_SA(0, 0), cA, voffA); PG8_STAGE(PG8_SB(0, 1), cB + hstep, voffB); PG8_STAGE(PG8_SA(0, 1), cA + hstep, voffA);
        if (wr == 1) PG8_BAR;
        PG8_WAIT_V(4); PG8_BAR;
        PG8_STAGE(PG8_SB(1, 0), cB + kstep, voffB); PG8_STAGE(PG8_SA(1, 0), cA + kstep, voffA); PG8_STAGE(PG8_SB(1, 1), cB + hstep + kstep, voffB);
        PG8_WAIT_V(6); PG8_BAR;
    }
    for (;;) {
        const bool has_next = S.next(ui + 1, nxt);
        const char* nA = has_next ? (const char*)g.A + (size_t)nxt.pm * tstep : cA; const char* nB = has_next ? (const char*)g.Bt + (size_t)nxt.pn * tstep : cB;
        for (int t = 0; t < nt; t += 2) {
            const bool last = (t == nt - 2);
            const char* a1 = cA + (size_t)(t + 1) * kstep;
            const char* a2 = last ? nA : cA + (size_t)(t + 2) * kstep; const char* b2 = last ? nB : cB + (size_t)(t + 2) * kstep;
            const char* a3 = a2 + kstep; const char* b3 = b2 + kstep;
            if (last && has_next) S.a_ready(nxt);
            if constexpr (SP2) {
            PG8_LDB(B0, 0, 0); PG8_LDB(B1, 0, 1); PG8_SCHED; PG8_LDA(At, 0, 0); PG8_STAGE(PG8_SA(1, 1), a1 + hstep, voffA);
            PG8_WAIT_V(8); PG8_WAIT_L(0); PG8_BAR; PG8_MMA(0, 0, At, B0); PG8_MMA(0, 1, At, B1); PG8_BAR; PG8_SCHED;
            PG8_LDA(At, 0, 1); PG8_STAGE(PG8_SB(0, 0), b2, voffB); PG8_STAGE(PG8_SB(0, 1), b2 + hstep, voffB); PG8_STAGE(PG8_SA(0, 0), a2, voffA);
            PG8_WAIT_V(8); PG8_WAIT_L(0); PG8_BAR; PG8_MMA(1, 0, At, B0); PG8_MMA(1, 1, At, B1); PG8_BAR; PG8_SCHED;
            PG8_LDB(B0, 1, 0); PG8_LDB(B1, 1, 1); PG8_SCHED; PG8_LDA(At, 1, 0); PG8_STAGE(PG8_SA(0, 1), a2 + hstep, voffA);
            PG8_WAIT_V(8); PG8_WAIT_L(0); PG8_BAR; PG8_MMA(0, 0, At, B0); PG8_MMA(0, 1, At, B1); PG8_BAR; PG8_SCHED;
            PG8_LDA(At, 1, 1); PG8_STAGE(PG8_SB(1, 0), b3, voffB); PG8_STAGE(PG8_SB(1, 1), b3 + hstep, voffB); PG8_STAGE(PG8_SA(1, 0), a3, voffA);
            PG8_WAIT_V(8); PG8_WAIT_L(0); PG8_BAR; PG8_MMA(1, 0, At, B0); PG8_MMA(1, 1, At, B1); PG8_BAR; PG8_SCHED;
            } else {
            PG8_LDB(B0, 0, 0); PG8_SCHED; PG8_LDA(At, 0, 0); PG8_STAGE(PG8_SA(1, 1), a1 + hstep, voffA);
            PG8_WAIT_L(8); PG8_BAR; PG8_WAIT_L(0); PG8_MMA(0, 0, At, B0); PG8_BAR; PG8_SCHED;
            PG8_LDB(B1, 0, 1); PG8_STAGE(PG8_SB(0, 0), b2, voffB);
            PG8_BAR; PG8_WAIT_L(0); PG8_MMA(0, 1, At, B1); PG8_BAR;
            PG8_LDA(At, 0, 1); PG8_STAGE(PG8_SA(0, 0), a2, voffA);
            PG8_BAR; PG8_WAIT_L(0); PG8_MMA(1, 0, At, B0); PG8_BAR; PG8_SCHED;
            PG8_STAGE(PG8_SB(0, 1), b2 + hstep, voffB);
            PG8_WAIT_V(6); PG8_BAR; PG8_MMA(1, 1, At, B1); PG8_BAR;
            PG8_LDB(B0, 1, 0); PG8_SCHED; PG8_LDA(At, 1, 0); PG8_STAGE(PG8_SA(0, 1), a2 + hstep, voffA);
            PG8_WAIT_L(8); PG8_BAR; PG8_WAIT_L(0); PG8_MMA(0, 0, At, B0); PG8_BAR; PG8_SCHED;
            PG8_LDB(B1, 1, 1); PG8_STAGE(PG8_SB(1, 0), b3, voffB);
            PG8_BAR; PG8_WAIT_L(0); PG8_MMA(0, 1, At, B1); PG8_BAR;
            PG8_LDA(At, 1, 1); PG8_STAGE(PG8_SA(1, 0), a3, voffA);
            PG8_BAR; PG8_WAIT_L(0); PG8_MMA(1, 0, At, B0); PG8_BAR; PG8_SCHED;
            PG8_STAGE(PG8_SB(1, 1), b3 + hstep, voffB);
            PG8_WAIT_V(6); PG8_BAR; PG8_MMA(1, 1, At, B1); PG8_BAR;
            }
        }
        if constexpr (ALIGN_EPI) { if (wr == 0) PG8_BAR; }
        if constexpr (!Epi::AFTER_DRAIN) { E(acc, cur, wr, wc, fr, fq); S.done(cur); }
        if (!has_next) break;
#pragma unroll
        for (int a = 0; a < 2; ++a)
#pragma unroll
            for (int b = 0; b < 2; ++b)
#pragma unroll
                for (int m = 0; m < 4; ++m)
#pragma unroll
                    for (int n = 0; n < 2; ++n) acc[a][b][m][n] = (f32x4){0.f, 0.f, 0.f, 0.f};
        cur = nxt; cA = nA; cB = nB; ++ui;
        if constexpr (ALIGN_EPI) { if (wr == 1) PG8_BAR; }
    }
    PG8_WAIT_V(0);
    if constexpr (!ALIGN_EPI) { if (wr == 0) PG8_BAR; }
    PG8_BAR;
    if constexpr (Epi::AFTER_DRAIN) { E.fused(acc, cur, wr, wc, fr, fq, lds, wid, lane); S.done(cur); }
#undef PG8_SA
#undef PG8_SB
#undef PG8_STAGE
#undef PG8_LDA
#undef PG8_LDB
#undef PG8_MMA
#undef PG8_WAIT_V
#undef PG8_WAIT_L
#undef PG8_BAR
#undef PG8_SCHED
}
}
#define GAS __attribute__((address_space(1)))
#define LAS __attribute__((address_space(3)))
typedef unsigned short bf16;
typedef unsigned v4u __attribute__((ext_vector_type(4)));
typedef float f32x4 __attribute__((ext_vector_type(4)));
typedef short bf16x8 __attribute__((ext_vector_type(8)));
typedef GAS unsigned gu32;
typedef GAS unsigned long long gu64;
#define RLX_AGENT __ATOMIC_RELAXED, __HIP_MEMORY_SCOPE_AGENT
#define LDS_WAIT() asm volatile("s_waitcnt lgkmcnt(0)" ::: "memory")
#define VM_WAIT() asm volatile("s_waitcnt vmcnt(0)" ::: "memory")
__device__ __forceinline__ unsigned long long rt() { return __builtin_amdgcn_s_memrealtime(); }
__device__ __forceinline__ unsigned f2bf(float f) { unsigned u = __builtin_bit_cast(unsigned, f); return (u + 0x7fffu + ((u >> 16) & 1u)) >> 16; }
__device__ __forceinline__ unsigned pk2(float lo, float hi) { return f2bf(lo) | (f2bf(hi) << 16); }

#define XB_TMO      128
#define XB_XCNT(j)  (256  + 64 * (j))
#define XB_XSUB(j)  (1280 + 64 * (j))
#define XB_XGEN(j)  (2304 + 64 * (j))
#define XB_TOP      3328
#define XB_TOPGEN   3392
#define XCD_BAR_WORDS 3456
#define XB_SPIN_CAP (1u << 18)

__device__ __forceinline__ unsigned xb_ld(unsigned* p)              { return __hip_atomic_load(p, __ATOMIC_RELAXED, __HIP_MEMORY_SCOPE_AGENT); }
__device__ __forceinline__ unsigned xb_add(unsigned* p, unsigned v) { return __hip_atomic_fetch_add(p, v, __ATOMIC_RELAXED, __HIP_MEMORY_SCOPE_AGENT); }
__device__ __forceinline__ unsigned xb_xcc_id() { return (unsigned)__builtin_amdgcn_s_getreg((3 << 11) | 20) & 0xFu; }
#define XB_SPIN(cond, bar) do { unsigned _sp = 0; while (cond) { __builtin_amdgcn_s_sleep(1); \
    if ((++_sp & 255u) == 0u) { if (xb_ld(&(bar)[XB_TMO])) break; if (_sp > XB_SPIN_CAP) { atomicAdd(&(bar)[XB_TMO], 1u); break; } } } } while (0)

struct XcdBarrier {
    unsigned* bar; unsigned x;
    volatile LAS unsigned* st;
};

__device__ __forceinline__ XcdBarrier xcd_barrier_post(unsigned* bar, volatile LAS unsigned* st) {
    XcdBarrier b; b.bar = bar; b.x = xb_xcc_id(); b.st = st;
    if (threadIdx.x == 0) (void)xb_add(&bar[XB_XCNT(b.x)], 1u);
    return b;
}
__device__ __forceinline__ void xcd_barrier_complete(unsigned* bar, unsigned x, unsigned& nloc, unsigned& nx) {
    const unsigned G = gridDim.x * gridDim.y * gridDim.z;
    unsigned sum, cnt, mine, sp = 0u;
    for (;;) {
        sum = 0u; cnt = 0u; mine = 0u;
#pragma unroll
        for (unsigned j = 0; j < 16; ++j) { const unsigned c = xb_ld(&bar[XB_XCNT(j)]); sum += c; cnt += (c > 0u) ? 1u : 0u; mine = (j == x) ? c : mine; }
        if (sum == G) break;
        __builtin_amdgcn_s_sleep(1);
        if ((++sp & 255u) == 0u) { if (xb_ld(&bar[XB_TMO])) break; if (sp > XB_SPIN_CAP) { atomicAdd(&bar[XB_TMO], 1u); break; } }
    }
    nloc = mine > 0u ? mine : 1u; nx = cnt > 0u ? cnt : 1u;
}

__device__ __forceinline__ void xcd_barrier(const XcdBarrier& b) {
    asm volatile("s_waitcnt vmcnt(0)" ::: "memory");
    __syncthreads();
    if (threadIdx.x == 0) {
        unsigned* bar = b.bar;
        __builtin_amdgcn_s_waitcnt(0);
        unsigned nloc = b.st[0], nx = b.st[1];
        if (nloc == 0u) { xcd_barrier_complete(bar, b.x, nloc, nx); b.st[0] = nloc; b.st[1] = nx; }
        const unsigned old = xb_add(&bar[XB_XSUB(b.x)], 1u);
        const unsigned gen = old / nloc;
        if (old + 1u == (gen + 1u) * nloc) {
            __builtin_amdgcn_fence(__ATOMIC_RELEASE, "agent");
            asm volatile("s_waitcnt vmcnt(0)" ::: "memory");
            const unsigned og = xb_add(&bar[XB_TOP], 1u);
            const unsigned tg = og / nx;
            if (og + 1u == (tg + 1u) * nx) xb_add(&bar[XB_TOPGEN], 1u);
            else XB_SPIN(xb_ld(&bar[XB_TOPGEN]) == tg, bar);
            __builtin_amdgcn_fence(__ATOMIC_ACQUIRE, "agent");
            xb_add(&bar[XB_XGEN(b.x)], 1u);
            asm volatile("s_waitcnt vmcnt(0)" ::: "memory");
        } else {
            XB_SPIN(xb_ld(&bar[XB_XGEN(b.x)]) == gen, bar);
            __builtin_amdgcn_fence(__ATOMIC_ACQUIRE, "agent");
            asm volatile("s_waitcnt vmcnt(0)" ::: "memory");
        }
    }
    __syncthreads();
}
constexpr size_t MiB = 1u << 20;
constexpr size_t WS_CTL = 0, CTL_ZERO_BYTES = 1 * MiB;
constexpr size_t WS_WIN = 2 * MiB, WS_WOUT = 9 * MiB, WS_WGU = 11 * MiB, WS_WD = 22 * MiB, WS_WPG = 28 * MiB, WS_WPP = 30 * MiB, WS_WL = 30 * MiB + 512 * 1024;
constexpr size_t SZ1024B = (size_t)MT * 1024 * 2, SZ512B = (size_t)MT * 512 * 2, SZ256B = (size_t)MT * 256 * 2;
constexpr size_t WS_R1 = 32 * MiB;
constexpr size_t WS_PB = 97 * MiB;
constexpr size_t WS_QB = 114 * MiB, WS_KB = WS_QB + SZ512B, WS_VB = WS_KB + SZ512B;
constexpr size_t WS_PRE = 114 * MiB;
constexpr size_t WS_ZB = 211 * MiB;
constexpr size_t WS_OG = 324 * MiB, WS_LSE = 420 * MiB;
constexpr size_t WS_BV = 324 * MiB, WS_PHI = 357 * MiB, WS_SLOC = 389 * MiB, WS_SC = 421 * MiB;
constexpr size_t WS_AP = 453 * MiB;
constexpr size_t WS_ACT = 243 * MiB;
constexpr size_t WS_H2 = 243 * MiB, WS_PP = 308 * MiB;
constexpr size_t WS_END = 470 * MiB;
static_assert(WS_VB + SZ512B <= WS_ZB && WS_ZB + (size_t)MT * DBIN * 2 <= WS_OG && WS_PRE + (size_t)MT * DM * 4 <= WS_ACT && WS_ACT + (size_t)MT * DFF * 2 <= WS_SC + 32 * MiB, "ws map");
static_assert(WS_R1 + SZ1024B <= WS_PB && WS_PB + SZ256B <= WS_QB && WS_AP + SZ256B <= WS_END && WS_H2 + SZ1024B <= WS_PP, "ws map 2");
constexpr int NCHUNK = 32, CHL = TSEQ / NCHUNK;
constexpr int CW_BAR = 4096;

constexpr int RING_OFF = 0, RING_BYTES = 131072;
constexpr int LDSCTL_OFF = RING_BYTES, MISC_OFF = LDSCTL_OFF + 320;
constexpr int LDS_BYTES = 147456;
constexpr int NWAVES = 8;
typedef float f32x16 __attribute__((ext_vector_type(16)));
typedef unsigned u32x2 __attribute__((ext_vector_type(2)));
typedef short s16x4 __attribute__((ext_vector_type(4)));
typedef float f32x2_t __attribute__((ext_vector_type(2)));
typedef __bf16 bf16x2_t __attribute__((ext_vector_type(2)));
__device__ __forceinline__ unsigned cvtpk(float lo, float hi) { f32x2_t v = {lo, hi}; bf16x2_t b = __builtin_convertvector(v, bf16x2_t); return __builtin_bit_cast(unsigned, b); }
__device__ __forceinline__ float bflo(unsigned w) { return __uint_as_float(w << 16); }
__device__ __forceinline__ float bfhi(unsigned w) { return __uint_as_float(w & 0xffff0000u); }
__device__ __forceinline__ float bf1(bf16 h) { return __uint_as_float((unsigned)h << 16); }
__device__ __forceinline__ float sigm(float x) { return __builtin_amdgcn_rcpf(1.0f + __builtin_amdgcn_exp2f(-x * LOG2E)); }
__device__ __forceinline__ float shx(float v, int o, int lane) { return __int_as_float(__builtin_amdgcn_ds_bpermute((lane ^ o) << 2, __float_as_int(v))); }
__device__ __forceinline__ float wave_sum(float v, int lane) {
#pragma unroll
    for (int o = 1; o < 64; o <<= 1) v += shx(v, o, lane);
    return v;
}
struct Ctx { LAS unsigned char* lds; int tid, lane, wave, vcu, G; };

__device__ __forceinline__ void p0_transpose_item(const float* W, int N, bf16* WT, int ldk, int drow, int dk, LAS float* scr, int k0, int n0, int lane) {
#pragma unroll 8
    for (int i = 0; i < 32; ++i) { const int kk = 2 * i + (lane >> 5); scr[kk * 33 + (lane & 31)] = W[(size_t)(k0 + kk) * N + n0 + (lane & 31)]; }
    LDS_WAIT(); asm volatile("" ::: "memory");
    const int c = lane & 7;
#pragma unroll
    for (int j = 0; j < 4; ++j) { const int n = (lane >> 3) + 8 * j; const LAS float* s = scr + (8 * c) * 33 + n;
        v4u o; o.x = pk2(s[0 * 33], s[1 * 33]); o.y = pk2(s[2 * 33], s[3 * 33]); o.z = pk2(s[4 * 33], s[5 * 33]); o.w = pk2(s[6 * 33], s[7 * 33]);
        *(GAS v4u*)(WT + (size_t)(drow + n) * ldk + dk + 8 * c) = o; }
    LDS_WAIT(); asm volatile("" ::: "memory");
}
struct P0Args { const float *xp, *xs, *pp, *ps, *ck, *cv, *w_in, *w_out, *w_gate, *w_up, *w_down, *w_pg, *w_pp, *w2, *a2, *g2; bf16 *Win, *Wout, *Wgu, *Wd, *Wpg, *Wpp, *Wl, *XB, *PB; float* out; };
__device__ __forceinline__ void p0_prologue(const Ctx& C, const P0Args& A) {
    LAS float* scr = (LAS float*)(C.lds + RING_OFF + C.wave * 16384);
    const int gw = C.vcu * NWAVES + C.wave, NGW = C.G * NWAVES;
    constexpr int I0 = 16 * 104, I1 = 16 * 32, I2 = 16 * 88, I3 = I2, I4 = 44 * 32, I5 = 16 * 32, I6 = 4 * 32, I7 = 16, I8 = 16, I9 = 32;
    constexpr int NITEMS = I0 + I1 + I2 + I3 + I4 + I5 + I6 + I7 + I8 + I9;
    for (int it = gw; it < NITEMS; it += NGW) {
        int r = it;
        if (r < I0) { const int kb = r / 104, nb = r % 104; p0_transpose_item(A.w_in, DIN, A.Win, 1024, nb * 32, kb * 64, scr, kb * 64, nb * 32, C.lane); continue; } r -= I0;
        if (r < I1) { const int kb = r / 32, nb = r % 32; p0_transpose_item(A.w_out, DM, A.Wout, 1024, nb * 32, kb * 64, scr, kb * 64, nb * 32, C.lane); continue; } r -= I1;
        if (r < I2) { const int kb = r / 88, nb = r % 88, n0 = nb * 32; p0_transpose_item(A.w_gate, DFF, A.Wgu, 1024, (n0 >> 7) * 256 + (n0 & 127), kb * 64, scr, kb * 64, n0, C.lane); continue; } r -= I2;
        if (r < I3) { const int kb = r / 88, nb = r % 88, n0 = nb * 32; p0_transpose_item(A.w_up, DFF, A.Wgu, 1024, (n0 >> 7) * 256 + 128 + (n0 & 127), kb * 64, scr, kb * 64, n0, C.lane); continue; } r -= I3;
        if (r < I4) { const int kb = r / 32, nb = r % 32; p0_transpose_item(A.w_down, DM, A.Wd, DFF, nb * 32, kb * 64, scr, kb * 64, nb * 32, C.lane); continue; } r -= I4;
        if (r < I5) { const int kb = r / 32, nb = r % 32; p0_transpose_item(A.w_pg, DM, A.Wpg, 1024, nb * 32, kb * 64, scr, kb * 64, nb * 32, C.lane); continue; } r -= I5;
        if (r < I6) { const int kb = r / 32, nb = r % 32; p0_transpose_item(A.w_pp, DM, A.Wpp, 256, nb * 32, kb * 64, scr, kb * 64, nb * 32, C.lane); continue; } r -= I6;
        if (r < I7) { p0_transpose_item(A.w2, CB, A.Wl, 256, r * 32, 0, scr, 0, r * 32, C.lane); continue; } r -= I7;
        if (r < I8) { p0_transpose_item(A.a2, CB, A.Wl, 256, 512 + r * 32, 64, scr, 0, r * 32, C.lane); continue; } r -= I8;
        { const int kb = r / 16, nb = r % 16; p0_transpose_item(A.g2, CB, A.Wl, 256, 1024 + nb * 32, 128 + kb * 64, scr, kb * 64, nb * 32, C.lane); }
    }
    const int gt = C.vcu * (NWAVES * 64) + C.tid, NT = C.G * NWAVES * 64;
    for (int i = gt; i < 1536 * 32; i += NT) { const int row = i >> 5, ch = i & 31, blk = row >> 9;
        const bool nz = blk == 0 ? ch < 8 : blk == 1 ? (ch >= 8 && ch < 16) : ch >= 16;
        if (!nz) *(GAS v4u*)(A.Wl + (size_t)row * 256 + ch * 8) = (v4u){0u, 0u, 0u, 0u}; }
    for (int i = gt; i < MT * 128; i += NT) { const int row = i >> 7, ch = i & 127;
        f32x4 a = {0.f, 0.f, 0.f, 0.f}, b = a;
        if (row < MPR + MSA) { const float* src = row < MPR ? A.xp + (size_t)row * DM : A.xs + (size_t)(row - MPR) * DM; a = *(const GAS f32x4*)(src + ch * 8); b = *(const GAS f32x4*)(src + ch * 8 + 4); }
        v4u o; o.x = cvtpk(a[0], a[1]); o.y = cvtpk(a[2], a[3]); o.z = cvtpk(b[0], b[1]); o.w = cvtpk(b[2], b[3]);
        *(GAS v4u*)(A.XB + (size_t)row * DM + ch * 8) = o; }
    for (int i = gt; i < MT * 32; i += NT) { const int row = i >> 5, ch = i & 31;
        f32x4 a = {0.f, 0.f, 0.f, 0.f}, b = a;
        if (row < MPR + MSA) { const float* src = row < MPR ? A.pp + (size_t)row * PLE : A.ps + (size_t)(row - MPR) * PLE; a = *(const GAS f32x4*)(src + ch * 8); b = *(const GAS f32x4*)(src + ch * 8 + 4); }
        v4u o; o.x = cvtpk(a[0], a[1]); o.y = cvtpk(a[2], a[3]); o.z = cvtpk(b[0], b[1]); o.w = cvtpk(b[2], b[3]);
        *(GAS v4u*)(A.PB + (size_t)row * PLE + ch * 8) = o; }
}

__device__ __forceinline__ void prep_a(const Ctx& C, const bf16* ZB, const float* mu, const float* state_shift, bf16* AP, float* out) {
    const int gw = C.vcu * NWAVES + C.wave, NGW = C.G * NWAVES, lane = C.lane;
    const f32x4 m4 = *(const GAS f32x4*)(mu + 1536 + lane * 4);
    for (int row = gw; row < MPR + MSA; row += NGW) {
        const u32x2 zw = *(const GAS u32x2*)(ZB + (size_t)row * DBIN + 1536 + lane * 4);
        f32x4 z = {bflo(zw.x), bfhi(zw.x), bflo(zw.y), bfhi(zw.y)}, p;
        const bool first = row < MPR ? (row & (TSEQ - 1)) == 0 : ((row - MPR) & 3) == 0;
        if (!first) { const u32x2 pw = *(const GAS u32x2*)(ZB + (size_t)(row - 1) * DBIN + 1536 + lane * 4); p = (f32x4){bflo(pw.x), bfhi(pw.x), bflo(pw.y), bfhi(pw.y)}; }
        else if (row < MPR) p = (f32x4){0.f, 0.f, 0.f, 0.f};
        else p = *(const GAS f32x4*)(state_shift + (size_t)((row - MPR) >> 2) * DBIN + 1536 + lane * 4);
        f32x4 zm = z + (p - z) * m4, o;
#pragma unroll
        for (int e = 0; e < 4; ++e) { const float x = zm[e];
            const float th = 1.0f - 2.0f * __builtin_amdgcn_rcpf(1.0f + __builtin_amdgcn_exp2f(2.0f * LOG2E * x));
            o[e] = lane < 16 ? th : lane < 32 ? x : sigm(x); }
        u32x2 w; w.x = cvtpk(o[0], o[1]); w.y = cvtpk(o[2], o[3]);
        *(GAS u32x2*)(AP + (size_t)row * 256 + lane * 4) = w;
    }
    const int gt = C.vcu * (NWAVES * 64) + C.tid, NT = C.G * NWAVES * 64;
    for (int i = gt; i < (NBATCH + SB) * DBIN; i += NT) { const int s = i / DBIN, c = i % DBIN;
        if (s < NBATCH) out[O_SHP + (size_t)s * DBIN + c] = bf1(ZB[(size_t)(s * TSEQ + TSEQ - 1) * DBIN + c]);
        else out[O_SHS + (size_t)(s - NBATCH) * DBIN + c] = bf1(ZB[(size_t)(MPR + (s - NBATCH) * SS + SS - 1) * DBIN + c]); }
}

__device__ __forceinline__ int crow(int r, int hi) { return (r & 3) + 8 * (r >> 2) + 4 * hi; }
typedef short v4i16_t __attribute__((ext_vector_type(4)));
__device__ __forceinline__ s16x4 vtr(LAS const unsigned char* p) { return __builtin_bit_cast(s16x4, __builtin_amdgcn_ds_read_tr16_b64_v4i16((LAS v4i16_t*)p)); }
constexpr int VP = 192;
__device__ __forceinline__ void attn_unit(const Ctx& C, const bf16* QB, const bf16* KB, const bf16* VB, bf16* OGg, float* LSEg, int b, int h, int cls, int mq0, int dil) {
    LAS unsigned char* lds = C.lds;
    const int tid = C.tid, wid = C.wave, lane = C.lane, r32 = lane & 31, hi = lane >> 5;
#pragma unroll
    for (int it = 0; it < 6; ++it) { const int rr = it * 64 + (tid >> 3), ch = tid & 7; int mk = mq0 - 128 + rr; mk = mk < 0 ? 0 : mk;
        const v4u val = *(const GAS v4u*)(VB + (size_t)(b * TSEQ + mk * dil + cls) * CA + h * 64 + ch * 8);
        *(LAS v4u*)(lds + rr * VP + ch * 16) = val; }
    __syncthreads();
    const int mqw = mq0 + 32 * wid;
    const size_t qrow = (size_t)(b * TSEQ + (mqw + r32) * dil + cls);
    bf16x8 qf[4];
#pragma unroll
    for (int s = 0; s < 4; ++s) qf[s] = *(const GAS bf16x8*)(QB + qrow * CA + h * 64 + 16 * s + 8 * hi);
    f32x16 st[5];
#pragma unroll
    for (int j = 0; j < 5; ++j) { int mk = mqw - 128 + 32 * j + r32; mk = mk < 0 ? 0 : mk;
        const bf16* kp = KB + (size_t)(b * TSEQ + mk * dil + cls) * CA + h * 64 + 8 * hi;
        f32x16 a = {0.f, 0.f, 0.f, 0.f, 0.f, 0.f, 0.f, 0.f, 0.f, 0.f, 0.f, 0.f, 0.f, 0.f, 0.f, 0.f};
#pragma unroll
        for (int s = 0; s < 4; ++s) { const bf16x8 kf = *(const GAS bf16x8*)(kp + 16 * s); a = __builtin_amdgcn_mfma_f32_32x32x16_bf16(kf, qf[s], a, 0, 0, 0); }
        st[j] = a; }
    const float slope2 = __builtin_amdgcn_exp2f(-(float)(h + 1)) * LOG2E * (float)dil;
    float mx = -INFINITY;
#pragma unroll
    for (int j = 0; j < 5; ++j)
#pragma unroll
        for (int i = 0; i < 16; ++i) { const int kr = crow(i, hi), dist = 128 - 32 * j + r32 - kr, mke = mqw - 128 + 32 * j + kr;
            const bool ok = dist >= 0 && dist <= 128 && mke >= 0;
            const float v = ok ? st[j][i] - slope2 * (float)dist : -INFINITY; st[j][i] = v; mx = fmaxf(mx, v); }
    mx = fmaxf(mx, shx(mx, 32, lane));
    float l = 0.f;
#pragma unroll
    for (int j = 0; j < 5; ++j)
#pragma unroll
        for (int i = 0; i < 16; ++i) { const float p = __builtin_amdgcn_exp2f(st[j][i] - mx); st[j][i] = p; l += p; }
    l += shx(l, 32, lane);
    f32x16 o0 = {0.f, 0.f, 0.f, 0.f, 0.f, 0.f, 0.f, 0.f, 0.f, 0.f, 0.f, 0.f, 0.f, 0.f, 0.f, 0.f}, o1 = o0;
    const int i16 = lane & 15, qq = i16 >> 2, pp = i16 & 3, blk = (lane >> 4) & 1;
    LAS const unsigned char* vbase = lds + (32 * wid + 4 * hi + qq) * VP + (16 * blk + 4 * pp) * 2;
#pragma unroll
    for (int j = 0; j < 5; ++j)
#pragma unroll
        for (int s2 = 0; s2 < 2; ++s2) {
            v4u pw; pw.x = cvtpk(st[j][8 * s2 + 0], st[j][8 * s2 + 1]); pw.y = cvtpk(st[j][8 * s2 + 2], st[j][8 * s2 + 3]); pw.z = cvtpk(st[j][8 * s2 + 4], st[j][8 * s2 + 5]); pw.w = cvtpk(st[j][8 * s2 + 6], st[j][8 * s2 + 7]);
            const bf16x8 xs = __builtin_bit_cast(bf16x8, pw);
            LAS const unsigned char* vp = vbase + (32 * j + 16 * s2) * VP;
            { const s16x4 lo = vtr(vp), hh = vtr(vp + 8 * VP); const bf16x8 vf = (bf16x8){lo[0], lo[1], lo[2], lo[3], hh[0], hh[1], hh[2], hh[3]};
              o0 = __builtin_amdgcn_mfma_f32_32x32x16_bf16(vf, xs, o0, 0, 0, 0); }
            { const s16x4 lo = vtr(vp + 64), hh = vtr(vp + 8 * VP + 64); const bf16x8 vf = (bf16x8){lo[0], lo[1], lo[2], lo[3], hh[0], hh[1], hh[2], hh[3]};
              o1 = __builtin_amdgcn_mfma_f32_32x32x16_bf16(vf, xs, o1, 0, 0, 0); }
        }
    const float inv = __builtin_amdgcn_rcpf(l);
    bf16* orow = OGg + qrow * CA + h * 64 + 4 * hi;
#pragma unroll
    for (int g4 = 0; g4 < 4; ++g4) {
        u32x2 w0, w1;
        w0.x = cvtpk(o0[4 * g4] * inv, o0[4 * g4 + 1] * inv); w0.y = cvtpk(o0[4 * g4 + 2] * inv, o0[4 * g4 + 3] * inv);
        w1.x = cvtpk(o1[4 * g4] * inv, o1[4 * g4 + 1] * inv); w1.y = cvtpk(o1[4 * g4 + 2] * inv, o1[4 * g4 + 3] * inv);
        *(GAS u32x2*)(orow + 8 * g4) = w0; *(GAS u32x2*)(orow + 32 + 8 * g4) = w1; }
    if (hi == 0) LSEg[qrow * NH + h] = mx + __builtin_amdgcn_logf(l);
    __syncthreads();
}
__device__ __forceinline__ void attn_prompt(const Ctx& C, const bf16* QB, const bf16* KB, const bf16* VB, bf16* OG, float* LSE) {
    for (int i = 0; i < 12; ++i) {
        const int u = C.vcu * 12 + i, bh = u / 48, k48 = u % 48, g = k48 >> 4, k = k48 & 15;
        const int b = bh >> 3, h = bh & 7;
        int cls, mq0, dil;
        if (g == 0) { cls = 0; mq0 = 256 * k; dil = 1; } else if (g == 1) { cls = k >> 2; mq0 = 256 * (k & 3); dil = 4; } else { cls = k; mq0 = 0; dil = 16; }
        attn_unit(C, QB, KB, VB, OG + (size_t)g * MPR * CA, LSE + (size_t)g * MPR * NH, b, h, cls, mq0, dil);
    }
}
__device__ __forceinline__ void attn_sample(const Ctx& C, const bf16* QB, const float* ck, const float* cv, const float* out, bf16* HEADS) {
    if (C.vcu >= SB * NH) return;
    const int b = C.vcu >> 3, h = C.vcu & 7, s = C.wave & 3, half = C.wave >> 2, lane = C.lane;
    LAS float* qs = (LAS float*)(C.lds + C.wave * 2048);
    LAS float* ps = qs + 64;
    LAS float* part = (LAS float*)(C.lds + 16384 + C.wave * 512);
    const int row = MPR + b * SS + s, n0 = half * 194, cnt = half ? 193 : 194;
    qs[lane] = bf1(QB[(size_t)row * CA + h * 64 + lane]);
    LDS_WAIT(); asm volatile("" ::: "memory");
    const float slope2 = __builtin_amdgcn_exp2f(-(float)(h + 1)) * LOG2E;
    const float* kbase = ck + ((size_t)b * WINL * NH + h) * HD; const float* knew = out + O_KWS + ((size_t)(b * WINL + (WINL - SS)) * NH + h) * HD;
    const float* vbase = cv + ((size_t)b * WINL * NH + h) * HD; const float* vnew = out + O_VWS + ((size_t)(b * WINL + (WINL - SS)) * NH + h) * HD;
    float sc[4]; float mx = -INFINITY;
#pragma unroll
    for (int it = 0; it < 4; ++it) {
        const int nl = it * 64 + lane, n = n0 + (nl < cnt ? nl : 0), g = (n >= 129) + (n >= 258), jj = n - 129 * g, dist = jj << (2 * g), idx = WINL + s - dist;
        const float* kr = idx < WINL ? kbase + (size_t)idx * (NH * HD) : knew + (size_t)(idx - WINL) * (NH * HD);
        float d = 0.f;
#pragma unroll
        for (int c = 0; c < 16; ++c) { const f32x4 kv = *(const GAS f32x4*)(kr + 4 * c); const f32x4 qv = *(LAS const f32x4*)(qs + 4 * c); d += kv[0] * qv[0] + kv[1] * qv[1] + kv[2] * qv[2] + kv[3] * qv[3]; }
        sc[it] = nl < cnt ? d - slope2 * (float)dist : -INFINITY;
        mx = fmaxf(mx, sc[it]); }
#pragma unroll
    for (int o = 1; o < 64; o <<= 1) mx = fmaxf(mx, shx(mx, o, lane));
    float l = 0.f;
#pragma unroll
    for (int it = 0; it < 4; ++it) { const float pe = __builtin_amdgcn_exp2f(sc[it] - mx); ps[it * 64 + lane] = pe; l += pe; }
    l = wave_sum(l, lane);
    LDS_WAIT(); asm volatile("" ::: "memory");
    const int kq = lane >> 4, d4 = lane & 15;
    f32x4 o4 = {0.f, 0.f, 0.f, 0.f};
#pragma unroll 7
    for (int nb = 0; nb < 49; ++nb) {
        const int nl = nb * 4 + kq, n = n0 + (nl < cnt ? nl : 0), g = (n >= 129) + (n >= 258), jj = n - 129 * g, dist = jj << (2 * g), idx = WINL + s - dist;
        const float* vr = idx < WINL ? vbase + (size_t)idx * (NH * HD) : vnew + (size_t)(idx - WINL) * (NH * HD);
        const f32x4 vv = *(const GAS f32x4*)(vr + 4 * d4);
        const float pe = nl < cnt ? ps[nl] : 0.f;
        o4 += vv * pe; }
#pragma unroll
    for (int e = 0; e < 4; ++e) { float v = o4[e]; v += shx(v, 16, lane); v += shx(v, 32, lane); o4[e] = v; }
    if (lane < 16) *(LAS f32x4*)(part + 16 + 4 * d4) = o4;
    if (lane == 0) { part[0] = mx; part[1] = l; }
    __syncthreads();
    if (half == 0) {
        LAS const float* p0 = part, *p1 = part + 4 * 128;
        const float m0 = p0[0], m1 = p1[0], M = fmaxf(m0, m1), f0 = __builtin_amdgcn_exp2f(m0 - M), f1 = __builtin_amdgcn_exp2f(m1 - M);
        const float L = p0[1] * f0 + p1[1] * f1, o = (p0[16 + lane] * f0 + p1[16 + lane] * f1) / L;
        HEADS[(size_t)row * DM + h * 64 + lane] = (bf16)(cvtpk(o, 0.f) & 0xffffu);
    }
    __syncthreads();
}

__device__ __forceinline__ void attn_merge(const Ctx& C, const bf16* OG, const float* LSE, bf16* HEADS) {
    const int gt = C.vcu * (NWAVES * 64) + C.tid, NT = C.G * NWAVES * 64;
    for (int i = gt; i < MPR * 64; i += NT) { const int row = i >> 6, ch = i & 63, h = ch >> 3;
        float ls[3], mx = -INFINITY;
#pragma unroll
        for (int g = 0; g < 3; ++g) { ls[g] = LSE[((size_t)g * MPR + row) * NH + h]; mx = fmaxf(mx, ls[g]); }
        float w[3], ws = 0.f;
#pragma unroll
        for (int g = 0; g < 3; ++g) { w[g] = __builtin_amdgcn_exp2f(ls[g] - mx); ws += w[g]; }
        const float inv = __builtin_amdgcn_rcpf(ws);
        float acc[8] = {0.f, 0.f, 0.f, 0.f, 0.f, 0.f, 0.f, 0.f};
#pragma unroll
        for (int g = 0; g < 3; ++g) { const v4u v = *(const GAS v4u*)(OG + ((size_t)g * MPR + row) * CA + ch * 8); const float wg = w[g] * inv;
            acc[0] += wg * bflo(v.x); acc[1] += wg * bfhi(v.x); acc[2] += wg * bflo(v.y); acc[3] += wg * bfhi(v.y); acc[4] += wg * bflo(v.z); acc[5] += wg * bfhi(v.z); acc[6] += wg * bflo(v.w); acc[7] += wg * bfhi(v.w); }
        v4u o; o.x = cvtpk(acc[0], acc[1]); o.y = cvtpk(acc[2], acc[3]); o.z = cvtpk(acc[4], acc[5]); o.w = cvtpk(acc[6], acc[7]);
        *(GAS v4u*)(HEADS + (size_t)row * DM + ch * 8) = o; }
}

struct RwkvW { const float *mu, *k_k, *k_a, *r_k, *lnx_w, *lnx_b; };
struct RwkvTok { float nkk, ka, d, kp, r, v, bon; };
__device__ __forceinline__ RwkvTok rwkv_tok(float zr, float zk, float zv, float pr, float pk, float pv, float lam, float a, float mur, float muk, float muv, float kkw, float kaw, float rkw, int lane) {
    RwkvTok o;
    const float r = zr + (pr - zr) * mur, k = zk + (pk - zk) * muk, v = zv + (pv - zv) * muv;
    const float kkr = k * kkw; const float ss = wave_sum(kkr * kkr, lane);
    const float kk = kkr / fmaxf(sqrtf(ss), 1e-12f);
    const float kp = k * (1.0f + (a - 1.0f) * kaw);
    o.nkk = -kk; o.ka = kk * a; o.d = __builtin_amdgcn_exp2f(-lam * LOG2E); o.kp = kp; o.r = r; o.v = v; o.bon = wave_sum(r * kp * rkw, lane);
    return o;
}
__device__ __forceinline__ void rwkv_chunk(const Ctx& C, const bf16* ZB, const bf16* LAM, const bf16* AA, const RwkvW& W, float* YL, float* U, bf16* BV, float* PHI, float* SLOC, int b, int h, int c,
                                           const float* ck, const float* cv, float* out) {
    constexpr unsigned PERB = (WINL - SS) * CA / 4, CPY_TOTAL = SB * PERB;
    const unsigned cbase = (unsigned)(C.vcu * NWAVES + C.wave) * (CHL * 64) + C.lane;
    const int lane = C.lane;
    LAS float* tokb = (LAS float*)(C.lds + C.wave * 12288);
    float S[64], P[64];
#pragma unroll
    for (int j = 0; j < 64; ++j) { S[j] = 0.f; P[j] = (j == lane) ? 1.f : 0.f; }
    const int hc = h * 64 + lane;
    const float mur = W.mu[hc], muk = W.mu[512 + hc], muv = W.mu[1024 + hc], kkw = W.k_k[hc], kaw = W.k_a[hc], rkw = W.r_k[hc];
    const int t0 = c * CHL; const size_t row0 = (size_t)b * TSEQ + t0;
    float pr = 0.f, pk = 0.f, pv = 0.f;
    if (t0 > 0) { const bf16* zp = ZB + (row0 - 1) * DBIN + hc; pr = bf1(zp[0]); pk = bf1(zp[512]); pv = bf1(zp[1024]); }
    for (int sb = 0; sb < CHL / 8; ++sb) {
        float zr[8], zk[8], zv[8], lm[8], aa[8];
#pragma unroll
        for (int tt = 0; tt < 8; ++tt) { const size_t row = row0 + sb * 8 + tt; const bf16* zp = ZB + row * DBIN + hc;
            zr[tt] = bf1(zp[0]); zk[tt] = bf1(zp[512]); zv[tt] = bf1(zp[1024]); lm[tt] = bf1(LAM[row * CB + hc]); aa[tt] = bf1(AA[row * CB + hc]); }
#pragma unroll
        for (int tt = 0; tt < 8; ++tt) {
            const RwkvTok o = rwkv_tok(zr[tt], zk[tt], zv[tt], pr, pk, pv, lm[tt], aa[tt], mur, muk, muv, kkw, kaw, rkw, lane);
            pr = zr[tt]; pk = zk[tt]; pv = zv[tt];
            LAS float* tk = tokb + tt * 384;
            tk[lane] = o.nkk; tk[64 + lane] = o.ka; tk[128 + lane] = o.d; tk[192 + lane] = o.kp; tk[256 + lane] = o.r; tk[320 + lane] = o.v;
            BV[(row0 + sb * 8 + tt) * CB + hc] = (bf16)(cvtpk(o.bon * o.v, 0.f) & 0xffffu);
        }
        LDS_WAIT(); asm volatile("" ::: "memory");
#pragma unroll 1
        for (int tt = 0; tt < 8; ++tt) {
            LAS const float* tk = tokb + tt * 384;
            unsigned ci = cbase + (unsigned)(sb * 8 + tt) * 64u; const bool cisv = ci >= CPY_TOTAL; ci -= cisv ? CPY_TOTAL : 0u;
            const bool cok = ci < CPY_TOTAL; const unsigned cb = ci / PERB, co = ci - cb * PERB; const size_t cdst = (size_t)cb * (WINL * CA / 4) + co;
            f32x4 cval = {0.f, 0.f, 0.f, 0.f};
            if (cok) cval = __builtin_nontemporal_load((const f32x4*)(cisv ? cv : ck) + (cdst + (SS * CA / 4)));
            float sS0 = 0.f, sS1 = 0.f, sP0 = 0.f, sP1 = 0.f;
#pragma unroll
            for (int j4 = 0; j4 < 16; ++j4) { const f32x4 nk = *(LAS const f32x4*)(tk + 4 * j4);
                sS0 = fmaf(S[4 * j4], nk[0], sS0); sS1 = fmaf(S[4 * j4 + 1], nk[1], sS1); sS0 = fmaf(S[4 * j4 + 2], nk[2], sS0); sS1 = fmaf(S[4 * j4 + 3], nk[3], sS1);
                sP0 = fmaf(P[4 * j4], nk[0], sP0); sP1 = fmaf(P[4 * j4 + 1], nk[1], sP1); sP0 = fmaf(P[4 * j4 + 2], nk[2], sP0); sP1 = fmaf(P[4 * j4 + 3], nk[3], sP1); }
            const float saS = sS0 + sS1, saP = sP0 + sP1, vi = tk[320 + lane];
            float yS0 = 0.f, yS1 = 0.f, yP0 = 0.f, yP1 = 0.f;
#pragma unroll
            for (int j4 = 0; j4 < 16; ++j4) {
                const f32x4 ka = *(LAS const f32x4*)(tk + 64 + 4 * j4), d = *(LAS const f32x4*)(tk + 128 + 4 * j4), kp = *(LAS const f32x4*)(tk + 192 + 4 * j4), r = *(LAS const f32x4*)(tk + 256 + 4 * j4);
#pragma unroll
                for (int e = 0; e < 4; ++e) { const int j = 4 * j4 + e;
                    float t = vi * kp[e]; t = fmaf(saS, ka[e], t); S[j] = fmaf(S[j], d[e], t);
                    const float u = saP * ka[e]; P[j] = fmaf(P[j], d[e], u);
                    if (e & 1) { yS1 = fmaf(S[j], r[e], yS1); yP1 = fmaf(P[j], r[e], yP1); } else { yS0 = fmaf(S[j], r[e], yS0); yP0 = fmaf(P[j], r[e], yP0); } }
            }
            const size_t row = row0 + sb * 8 + tt;
            YL[row * CB + hc] = yS0 + yS1; U[row * CB + hc] = yP0 + yP1;
            if (cok) __builtin_nontemporal_store(cval, (f32x4*)(out + (cisv ? O_VWS : O_KWS)) + cdst);
        }
    }
    float* so = SLOC + ((size_t)((b * NH + h) * NCHUNK + c) * 64 + lane) * 64;
    float* po = PHI + ((size_t)((b * NH + h) * NCHUNK + c) * 64 + lane) * 64;
#pragma unroll
    for (int j4 = 0; j4 < 16; ++j4) { *(GAS f32x4*)(so + 4 * j4) = (f32x4){S[4 * j4], S[4 * j4 + 1], S[4 * j4 + 2], S[4 * j4 + 3]}; *(GAS f32x4*)(po + 4 * j4) = (f32x4){P[4 * j4], P[4 * j4 + 1], P[4 * j4 + 2], P[4 * j4 + 3]}; }
}
__device__ __forceinline__ void rwkv_sample(const Ctx& C, const bf16* ZB, const bf16* LAM, const bf16* AA, const bf16* G, const RwkvW& W, const float* state_wkv, const float* state_shift, bf16* HEADS, float* out) {
    if (C.vcu >= SB * NH || C.wave != 0) return;
    const int b = C.vcu >> 3, h = C.vcu & 7, lane = C.lane, hc = h * 64 + lane;
    LAS float* tk = (LAS float*)(C.lds + 98304);
    LAS float* Sl = (LAS float*)(C.lds + 98304 + 2048) + lane * 65;
    const float* s0 = state_wkv + ((size_t)(b * NH + h) * 64 + lane) * 64;
#pragma unroll 4
    for (int j = 0; j < 64; ++j) Sl[j] = s0[j];
    float pr = state_shift[(size_t)b * DBIN + hc], pk = state_shift[(size_t)b * DBIN + 512 + hc], pv = state_shift[(size_t)b * DBIN + 1024 + hc];
#pragma unroll 1
    for (int s = 0; s < SS; ++s) {
        const size_t row = (size_t)MPR + b * SS + s; const bf16* zp = ZB + row * DBIN + hc;
        const float zr = bf1(zp[0]), zk = bf1(zp[512]), zv = bf1(zp[1024]);
        const RwkvTok o = rwkv_tok(zr, zk, zv, pr, pk, pv, bf1(LAM[row * CB + hc]), bf1(AA[row * CB + hc]), W.mu[hc], W.mu[512 + hc], W.mu[1024 + hc], W.k_k[hc], W.k_a[hc], W.r_k[hc], lane);
        pr = zr; pk = zk; pv = zv;
        tk[lane] = o.nkk; tk[64 + lane] = o.ka; tk[128 + lane] = o.d; tk[192 + lane] = o.kp; tk[256 + lane] = o.r;
        LDS_WAIT(); asm volatile("" ::: "memory");
        float sa = 0.f;
#pragma unroll 4
        for (int j = 0; j < 64; ++j) sa = fmaf(Sl[j], tk[j], sa);
        float y = 0.f;
#pragma unroll 4
        for (int j = 0; j < 64; ++j) { float t = o.v * tk[192 + j]; t = fmaf(sa, tk[64 + j], t); const float sn = fmaf(Sl[j], tk[128 + j], t); Sl[j] = sn; y = fmaf(sn, tk[256 + j], y); }
        const float ym = wave_sum(y, lane) * (1.0f / 64.0f), dy = y - ym, yv = wave_sum(dy * dy, lane) * (1.0f / 64.0f);
        const float yn = dy * __builtin_amdgcn_rsqf(yv + GN_EPS) * W.lnx_w[hc] + W.lnx_b[hc];
        const float res = (yn + o.bon * o.v) * bf1(G[row * CB + hc]);
        HEADS[row * DM + CA + hc] = (bf16)(cvtpk(res, 0.f) & 0xffffu);
        LDS_WAIT(); asm volatile("" ::: "memory");
    }
    float* so = out + O_WKVS + ((size_t)(b * NH + h) * 64 + lane) * 64;
#pragma unroll 4
    for (int j = 0; j < 64; ++j) so[j] = Sl[j];
}

__device__ __forceinline__ void rwkv_carry(const Ctx& C, const float* PHI, const float* SLOC, float* SC, float* out) {
    const int bh = C.vcu >> 2, rq = C.vcu & 3, tid = C.tid;
    if (bh >= NBATCH * NH) return;
    LAS float* cur = (LAS float*)(C.lds);
    LAS float* phi = (LAS float*)(C.lds + 8192);
    const int row = tid >> 5, cp = tid & 31;
    const size_t gbase = ((size_t)(bh * NCHUNK) * 64 + rq * 16 + row) * 64 + 2 * cp;
    f32x4 pre[2]; f32x2_t sl;
    { const float* p0 = PHI + (size_t)(bh * NCHUNK) * 4096; pre[0] = *(const GAS f32x4*)(p0 + tid * 4); pre[1] = *(const GAS f32x4*)(p0 + 2048 + tid * 4); sl = *(const GAS f32x2_t*)(SLOC + gbase); }
    f32x2_t cv = {0.f, 0.f};
    for (int c = 0; c < NCHUNK; ++c) {
        LAS float* ph = phi + (c & 1) * 4096;
        *(LAS f32x4*)(ph + tid * 4) = pre[0]; *(LAS f32x4*)(ph + 2048 + tid * 4) = pre[1];
        *(LAS f32x2_t*)(cur + (c & 1) * 1024 + row * 64 + 2 * cp) = cv;
        const f32x2_t slc = sl;
        if (c + 1 < NCHUNK) { const float* p1 = PHI + (size_t)(bh * NCHUNK + c + 1) * 4096; pre[0] = *(const GAS f32x4*)(p1 + tid * 4); pre[1] = *(const GAS f32x4*)(p1 + 2048 + tid * 4); sl = *(const GAS f32x2_t*)(SLOC + gbase + (size_t)(c + 1) * 4096); }
        *(GAS f32x2_t*)(SC + gbase + (size_t)c * 4096) = cv;
        __syncthreads();
        LAS const float* cr_ = cur + (c & 1) * 1024 + row * 64;
        float a0 = slc[0], a1 = slc[1];
#pragma unroll 4
        for (int k4 = 0; k4 < 16; ++k4) { const f32x4 cr = *(LAS const f32x4*)(cr_ + 4 * k4);
#pragma unroll
            for (int e = 0; e < 4; ++e) { const f32x2_t pv = *(LAS const f32x2_t*)(ph + (4 * k4 + e) * 64 + 2 * cp); a0 = fmaf(cr[e], pv[0], a0); a1 = fmaf(cr[e], pv[1], a1); } }
        cv = (f32x2_t){a0, a1};
    }
    *(GAS f32x2_t*)(out + O_WKVP + ((size_t)bh * 64 + rq * 16 + row) * 64 + 2 * cp) = cv;
    __syncthreads();
}

__device__ __forceinline__ void rwkv_finish(const Ctx& C, const float* YL, const float* U, const float* SC, const bf16* BV, const bf16* G, const RwkvW& W, bf16* HEADS) {
    constexpr int FP = 68;
    const int tid = C.tid, lane = C.lane, r32 = lane & 31, hi = lane >> 5, slot = C.wave >> 2, wq = C.wave & 3, t256 = tid & 255;
    LAS float* Ss = (LAS float*)(C.lds + slot * 52224);
    LAS float* Us = Ss + 64 * FP;
    if ((C.vcu >> 2) >= NBATCH * NH) return;
    for (int pass = 0; pass < 4; ++pass) {
        const int item = C.vcu * 8 + pass * 2 + slot, bh = item >> 5, c = item & 31, b = bh >> 3, h = bh & 7;
        const float* sc = SC + (size_t)(bh * NCHUNK + c) * 4096;
        const size_t row0 = (size_t)b * TSEQ + c * CHL;
#pragma unroll
        for (int k = 0; k < 4; ++k) { const int e = t256 * 4 + k * 1024; *(LAS f32x4*)(Ss + (e >> 6) * FP + (e & 63)) = *(const GAS f32x4*)(sc + e); }
#pragma unroll
        for (int k = 0; k < 8; ++k) { const int e = t256 * 4 + k * 1024, t = e >> 6, j = e & 63; *(LAS f32x4*)(Us + t * FP + j) = *(const GAS f32x4*)(U + (row0 + t) * CB + h * 64 + j); }
        __syncthreads();
        const size_t row = row0 + wq * 32 + r32;
        f32x16 acc[2];
#pragma unroll
        for (int tl = 0; tl < 2; ++tl)
#pragma unroll
            for (int g4 = 0; g4 < 4; ++g4) { const f32x4 v = *(const GAS f32x4*)(YL + row * CB + h * 64 + 32 * tl + 8 * g4 + 4 * hi); acc[tl][4 * g4] = v[0]; acc[tl][4 * g4 + 1] = v[1]; acc[tl][4 * g4 + 2] = v[2]; acc[tl][4 * g4 + 3] = v[3]; }
        LAS const float* ua = Us + (wq * 32 + r32) * FP + 4 * hi;
        LAS const float* sa0 = Ss + r32 * FP + 4 * hi;
#pragma unroll
        for (int q = 0; q < 8; ++q) {
            const f32x4 b4 = *(LAS const f32x4*)(ua + 8 * q), a0 = *(LAS const f32x4*)(sa0 + 8 * q), a1 = *(LAS const f32x4*)(sa0 + 32 * FP + 8 * q);
#pragma unroll
            for (int e = 0; e < 4; ++e) { acc[0] = __builtin_amdgcn_mfma_f32_32x32x2f32(a0[e], b4[e], acc[0], 0, 0, 0); acc[1] = __builtin_amdgcn_mfma_f32_32x32x2f32(a1[e], b4[e], acc[1], 0, 0, 0); }
        }
        float sm = 0.f;
#pragma unroll
        for (int tl = 0; tl < 2; ++tl)
#pragma unroll
            for (int e = 0; e < 16; ++e) sm += acc[tl][e];
        sm += shx(sm, 32, lane);
        const float ym = sm * (1.0f / 64.0f); float sv = 0.f;
#pragma unroll
        for (int tl = 0; tl < 2; ++tl)
#pragma unroll
            for (int e = 0; e < 16; ++e) { const float d = acc[tl][e] - ym; acc[tl][e] = d; sv += d * d; }
        sv += shx(sv, 32, lane);
        const float rs = __builtin_amdgcn_rsqf(sv * (1.0f / 64.0f) + GN_EPS);
#pragma unroll
        for (int tl = 0; tl < 2; ++tl)
#pragma unroll
            for (int g4 = 0; g4 < 4; ++g4) { const int ic = h * 64 + 32 * tl + 8 * g4 + 4 * hi;
                const f32x4 lw = *(const GAS f32x4*)(W.lnx_w + ic), lb = *(const GAS f32x4*)(W.lnx_b + ic);
                const u32x2 bw = *(const GAS u32x2*)(BV + row * CB + ic), gw = *(const GAS u32x2*)(G + row * CB + ic);
                const float r0 = (acc[tl][4 * g4] * rs * lw[0] + lb[0] + bflo(bw.x)) * bflo(gw.x), r1 = (acc[tl][4 * g4 + 1] * rs * lw[1] + lb[1] + bfhi(bw.x)) * bfhi(gw.x);
                const float r2 = (acc[tl][4 * g4 + 2] * rs * lw[2] + lb[2] + bflo(bw.y)) * bflo(gw.y), r3 = (acc[tl][4 * g4 + 3] * rs * lw[3] + lb[3] + bfhi(bw.y)) * bfhi(gw.y);
                u32x2 ow; ow.x = cvtpk(r0, r1); ow.y = cvtpk(r2, r3);
                *(GAS u32x2*)(HEADS + row * DM + CA + ic) = ow; }
        __syncthreads();
    }
}

template <int U> __device__ __forceinline__ f32x16 thin_acc(const bf16* ap, const bf16* bp, int klen, f32x16 acc) {
#pragma unroll 1
    for (int k = 0; k < klen; k += 16 * U) {
        bf16x8 a[U], b[U];
#pragma unroll
        for (int u = 0; u < U; ++u) { a[u] = *(const GAS bf16x8*)(ap + k + 16 * u); b[u] = *(const GAS bf16x8*)(bp + k + 16 * u); }
#pragma unroll
        for (int u = 0; u < U; ++u) acc = __builtin_amdgcn_mfma_f32_32x32x16_bf16(a[u], b[u], acc, 0, 0, 0);
    }
    return acc;
}
#define F16Z (f32x16){0.f, 0.f, 0.f, 0.f, 0.f, 0.f, 0.f, 0.f, 0.f, 0.f, 0.f, 0.f, 0.f, 0.f, 0.f, 0.f}
#define THIN_LOOP(ntiles) const int lane = C.lane, r32 = lane & 31, hi = lane >> 5; for (int t = (255 - (int)blockIdx.x) * NWAVES + C.wave; t < (ntiles); t += 256 * NWAVES)
__device__ __forceinline__ void thin_lora(const Ctx& C, const bf16* AP, const bf16* Wl, const float* w0, const float* a0, bf16* LAM) {
    THIN_LOOP(192) { const int grp = t >> 6, rb = (t >> 4) & 3, cb = t & 15, koff = grp == 0 ? 0 : grp == 1 ? 64 : 128, klen = grp == 2 ? 128 : 64;
        const f32x16 acc = thin_acc<4>(AP + (size_t)(MPR + rb * 32 + r32) * 256 + koff + 8 * hi, Wl + (size_t)(grp * 512 + cb * 32 + r32) * 256 + koff + 8 * hi, klen, F16Z);
        const int n = cb * 32 + r32; const float bias = grp == 0 ? w0[n] : grp == 1 ? a0[n] : 0.f, mul = grp == 0 ? 0.6065306597126334f : 1.0f;
        bf16* dst = LAM + (size_t)grp * ((size_t)MT * CB);
#pragma unroll
        for (int i = 0; i < 16; ++i) { float v = acc[i] + bias; if (grp < 2) v = mul * sigm(v); dst[(size_t)(MPR + rb * 32 + crow(i, hi)) * CB + n] = (bf16)(cvtpk(v, 0.f) & 0xffffu); } }
}
#define THIN_WG_LOOP(ntiles) const int lane = C.lane, r32 = lane & 31, hi = lane >> 5, wv = C.wave; for (int t = 255 - (int)blockIdx.x; t < (ntiles); t += 256)
template <int NACC> __device__ __forceinline__ void thin_reduce(const Ctx& C, const f32x16 (&acc)[NACC], float (&res)[NACC][2]) {
    LAS float* red = (LAS float*)C.lds;
#pragma unroll
    for (int a = 0; a < NACC; ++a)
#pragma unroll
        for (int i = 0; i < 16; ++i) red[((a * 8 + C.wave) * 16 + i) * 64 + C.lane] = acc[a][i];
    __syncthreads();
#pragma unroll
    for (int a = 0; a < NACC; ++a)
#pragma unroll
        for (int q = 0; q < 2; ++q) { float s = 0.f;
#pragma unroll
            for (int w = 0; w < 8; ++w) s += red[((a * 8 + w) * 16 + 2 * C.wave + q) * 64 + C.lane];
            res[a][q] = s; }
    __syncthreads();
}
__device__ __forceinline__ void thin_wout(const Ctx& C, const bf16* HEADS, const bf16* Wout, const float* xs, float* PRE) {
    THIN_WG_LOOP(128) { const int rb = t >> 5, cb = t & 31, n = cb * 32 + r32;
        f32x16 acc[1]; float res[1][2];
        acc[0] = thin_acc<8>(HEADS + (size_t)(MPR + rb * 32 + r32) * DM + 8 * hi + wv * 128, Wout + (size_t)n * DM + 8 * hi + wv * 128, 128, F16Z);
        thin_reduce<1>(C, acc, res);
#pragma unroll
        for (int q = 0; q < 2; ++q) { const int rs = rb * 32 + crow(2 * wv + q, hi); PRE[(size_t)(MPR + rs) * DM + n] = res[0][q] + ALPHA * xs[(size_t)rs * DM + n]; } }
}
__device__ __forceinline__ void thin_gu(const Ctx& C, const bf16* H1, const bf16* Wgu, bf16* ACT) {
    THIN_WG_LOOP(352) { const int rb = t / 88, fb = t % 88, f = fb * 32 + r32, grow = (f >> 7) * 256 + (f & 127);
        const bf16* ap = H1 + (size_t)(MPR + rb * 32 + r32) * DM + 8 * hi + wv * 128;
        f32x16 acc[2]; float res[2][2];
        acc[0] = thin_acc<8>(ap, Wgu + (size_t)grow * DM + 8 * hi + wv * 128, 128, F16Z);
        acc[1] = thin_acc<8>(ap, Wgu + (size_t)(grow + 128) * DM + 8 * hi + wv * 128, 128, F16Z);
        thin_reduce<2>(C, acc, res);
#pragma unroll
        for (int q = 0; q < 2; ++q) { const float g = res[0][q]; ACT[(size_t)(MPR + rb * 32 + crow(2 * wv + q, hi)) * DFF + f] = (bf16)(cvtpk(g * sigm(g) * res[1][q], 0.f) & 0xffffu); } }
}
__device__ __forceinline__ void thin_down(const Ctx& C, const bf16* ACT, const bf16* Wd, const bf16* H1, float* PRE) {
    THIN_WG_LOOP(128) { const int rb = t >> 5, cb = t & 31, n = cb * 32 + r32;
        f32x16 acc[1]; float res[1][2];
        acc[0] = thin_acc<11>(ACT + (size_t)(MPR + rb * 32 + r32) * DFF + 8 * hi + wv * 352, Wd + (size_t)n * DFF + 8 * hi + wv * 352, 352, F16Z);
        thin_reduce<1>(C, acc, res);
#pragma unroll
        for (int q = 0; q < 2; ++q) { const size_t o = (size_t)(MPR + rb * 32 + crow(2 * wv + q, hi)) * DM + n; PRE[o] = res[0][q] + ALPHA * bf1(H1[o]); } }
}
__device__ __forceinline__ void thin_pp(const Ctx& C, const bf16* PB, const bf16* Wpp, bf16* PP) {
    THIN_WG_LOOP(128) { const int rb = t >> 5, cb = t & 31, n = cb * 32 + r32;
        f32x16 acc[1]; float res[1][2];
        acc[0] = thin_acc<2>(PB + (size_t)(MPR + rb * 32 + r32) * PLE + 8 * hi + wv * 32, Wpp + (size_t)n * PLE + 8 * hi + wv * 32, 32, F16Z);
        thin_reduce<1>(C, acc, res);
#pragma unroll
        for (int q = 0; q < 2; ++q) PP[(size_t)(MPR + rb * 32 + crow(2 * wv + q, hi)) * DM + n] = (bf16)(cvtpk(res[0][q], 0.f) & 0xffffu); }
}
__device__ __forceinline__ void thin_pg(const Ctx& C, const bf16* H2, const bf16* Wpg, const bf16* PP, float* PRE) {
    THIN_WG_LOOP(128) { const int rb = t >> 5, cb = t & 31, n = cb * 32 + r32;
        f32x16 acc[1]; float res[1][2];
        acc[0] = thin_acc<8>(H2 + (size_t)(MPR + rb * 32 + r32) * DM + 8 * hi + wv * 128, Wpg + (size_t)n * DM + 8 * hi + wv * 128, 128, F16Z);
        thin_reduce<1>(C, acc, res);
#pragma unroll
        for (int q = 0; q < 2; ++q) { const size_t o = (size_t)(MPR + rb * 32 + crow(2 * wv + q, hi)) * DM + n; PRE[o] = ALPHA * bf1(H2[o]) + sigm(res[0][q]) * bf1(PP[o]); } }
}

template <int MODE> __device__ __forceinline__ void ln_pass(const Ctx& C, const float* PRE, const float* w, const float* bsh, bf16* Hout, float* out) {
    const int gw = C.vcu * NWAVES + C.wave, NGW = C.G * NWAVES, lane = C.lane;
    f32x4 wv[4], bv[4];
#pragma unroll
    for (int j = 0; j < 4; ++j) { wv[j] = *(const GAS f32x4*)(w + 256 * j + 4 * lane); bv[j] = *(const GAS f32x4*)(bsh + 256 * j + 4 * lane); }
    for (int row = gw; row < MPR + MSA; row += NGW) {
        const GAS f32x4* xr = (const GAS f32x4*)(PRE + (size_t)row * DM) + lane;
        f32x4 v[4]; float s = 0.f;
#pragma unroll
        for (int j = 0; j < 4; ++j) { v[j] = xr[64 * j]; s += (v[j][0] + v[j][1]) + (v[j][2] + v[j][3]); }
        const float mean = wave_sum(s, lane) * (1.f / DM); float s2 = 0.f;
#pragma unroll
        for (int j = 0; j < 4; ++j) { v[j] = v[j] - mean; s2 += (v[j][0] * v[j][0] + v[j][1] * v[j][1]) + (v[j][2] * v[j][2] + v[j][3] * v[j][3]); }
        const float rstd = __builtin_amdgcn_rsqf(wave_sum(s2, lane) * (1.f / DM) + LN_EPS);
        if (MODE == 0) {
            GAS u32x2* o8 = (GAS u32x2*)(Hout + (size_t)row * DM) + lane;
#pragma unroll
            for (int j = 0; j < 4; ++j) { const f32x4 o = v[j] * rstd * wv[j] + bv[j]; u32x2 wq; wq.x = cvtpk(o[0], o[1]); wq.y = cvtpk(o[2], o[3]); o8[64 * j] = wq; }
        } else {
            float* dst = row < MPR ? out + O_YP + (size_t)row * DM : out + O_YS + (size_t)(row - MPR) * DM;
#pragma unroll
            for (int j = 0; j < 4; ++j) *((GAS f32x4*)dst + lane + 64 * j) = v[j] * rstd * wv[j] + bv[j];
        }
    }
}
struct Args { const float* in[32]; float* out; unsigned char* ws; int nphase, pad; };
#ifndef PHMASK
#define PHMASK 0xFFFFFF
#endif
#ifndef REPPH
#define REPPH -1
#endif
#ifndef REPN
#define REPN 3
#endif
#define PHON(n) if constexpr (((PHMASK) >> (n)) & 1) for (int rep_ = 0; rep_ < ((n) == (REPPH) ? (REPN) : 1); ++rep_)
#ifndef GEMM_ALIGN
#define GEMM_ALIGN true
#endif
#ifndef GEMM_SP2
#define GEMM_SP2 true
#endif
__global__ void __launch_bounds__(NWAVES * 64, 2) mega_fwd(Args args) {
    extern __shared__ __attribute__((aligned(16))) unsigned char lds_raw[];
    LAS unsigned char* const lds0 = (LAS unsigned char*)lds_raw;
    volatile LAS unsigned* MISC = (volatile LAS unsigned*)(lds0 + MISC_OFF);
    const int G0 = gridDim.x;
    for (int u = threadIdx.x; u < (LDS_BYTES - LDSCTL_OFF) / 4; u += NWAVES * 64) ((LAS unsigned*)(lds0 + LDSCTL_OFF))[u] = 0u;
    __syncthreads();
    gu32* ctl = (gu32*)(args.ws + WS_CTL);
    XcdBarrier bar = xcd_barrier_post((unsigned*)(ctl + CW_BAR), MISC + 8);
    const int nph = args.nphase;
#define GRID_BAR() xcd_barrier(bar)
    typedef const __attribute__((address_space(4))) Args* KArgs;
#define PH_BEGIN Ctx C; { int t_ = threadIdx.x; asm volatile("" : "+v"(t_)); C.lds = lds0; C.tid = t_; C.lane = t_ & 63; C.wave = __builtin_amdgcn_readfirstlane(t_ >> 6); C.G = G0; const int bx_ = blockIdx.x; C.vcu = (G0 % 8 == 0) ? (bx_ % 8) * (G0 / 8) + bx_ / 8 : bx_; } KArgs kp = (KArgs)__builtin_amdgcn_kernarg_segment_ptr(); asm volatile("" : "+s"(kp)); unsigned char* ws = kp->ws; float* out = kp->out; (void)ws; (void)out;
#define IN_(i) (kp->in[i])
#define WSB(off) ((bf16*)(ws + (off)))
#define WSF(off) ((float*)(ws + (off)))
    const int bx = (int)blockIdx.x;

    PHON(0) { PH_BEGIN P0Args A{IN_(0), IN_(1), IN_(2), IN_(3), IN_(4), IN_(5), IN_(8), IN_(20), IN_(23), IN_(24), IN_(25), IN_(28), IN_(29), IN_(11), IN_(13), IN_(14),
                       WSB(WS_WIN), WSB(WS_WOUT), WSB(WS_WGU), WSB(WS_WD), WSB(WS_WPG), WSB(WS_WPP), WSB(WS_WL), WSB(WS_R1), WSB(WS_PB), out};
      p0_prologue(C, A); }
    GRID_BAR(); if (nph <= 1) return;
    PHON(1) { PH_BEGIN pg8::Gemm g{WSB(WS_R1), WSB(WS_WIN), MT, DIN, DM}; pg8::StaticOrder S; S.init(MT, DIN, C.G, bx);
      pg8::EpiZ E{WSB(WS_QB), WSB(WS_ZB), out};
      pg8::gemm_phase<pg8::EpiZ, pg8::StaticOrder, GEMM_ALIGN, GEMM_SP2>(C.lds + RING_OFF, g, S, E); }
    GRID_BAR(); if (nph <= 2) return;
    PHON(2) { PH_BEGIN prep_a(C, WSB(WS_ZB), IN_(9), IN_(7), WSB(WS_AP), out); }
    PHON(3) { PH_BEGIN attn_prompt(C, WSB(WS_QB), WSB(WS_KB), WSB(WS_VB), WSB(WS_OG), WSF(WS_LSE)); }
    PHON(4) { PH_BEGIN attn_sample(C, WSB(WS_QB), IN_(4), IN_(5), out, WSB(WS_R1)); }
    GRID_BAR(); if (nph <= 3) return;
    PHON(5) { PH_BEGIN pg8::Gemm g{WSB(WS_AP), WSB(WS_WL), MPR, 1536, 256}; pg8::StaticOrder S; S.init(MPR, 1536, C.G, bx);
      pg8::EpiLora E{WSB(WS_QB), IN_(10), IN_(12)};
      pg8::gemm_phase<pg8::EpiLora, pg8::StaticOrder, GEMM_ALIGN, GEMM_SP2>(C.lds + RING_OFF, g, S, E);
      thin_lora(C, WSB(WS_AP), WSB(WS_WL), IN_(10), IN_(12), WSB(WS_QB)); }
    PHON(6) { PH_BEGIN attn_merge(C, WSB(WS_OG), WSF(WS_LSE), WSB(WS_R1)); }
    GRID_BAR(); if (nph <= 4) return;
    PHON(7) { PH_BEGIN const RwkvW RW{IN_(9), IN_(15), IN_(16), IN_(17), IN_(18), IN_(19)};
      rwkv_sample(C, WSB(WS_ZB), WSB(WS_QB), WSB(WS_KB), WSB(WS_VB), RW, IN_(6), IN_(7), WSB(WS_R1), out); }
    PHON(8) { PH_BEGIN const RwkvW RW{IN_(9), IN_(15), IN_(16), IN_(17), IN_(18), IN_(19)};
      const int bh = C.vcu >> 2, c = (C.vcu & 3) * 8 + C.wave;
      if (bh < NBATCH * NH) rwkv_chunk(C, WSB(WS_ZB), WSB(WS_QB), WSB(WS_KB), RW, out + O_YP, out + O_YP + (size_t)MPR * CB, WSB(WS_BV), WSF(WS_PHI), WSF(WS_SLOC), bh >> 3, bh & 7, c, IN_(4), IN_(5), out); }
    GRID_BAR(); if (nph <= 5) return;
    PHON(9) { PH_BEGIN rwkv_carry(C, WSF(WS_PHI), WSF(WS_SLOC), WSF(WS_SC), out); }
    GRID_BAR(); if (nph <= 6) return;
    PHON(10) { PH_BEGIN const RwkvW RW{IN_(9), IN_(15), IN_(16), IN_(17), IN_(18), IN_(19)};
      rwkv_finish(C, out + O_YP, out + O_YP + (size_t)MPR * CB, WSF(WS_SC), WSB(WS_BV), WSB(WS_VB), RW, WSB(WS_R1)); }
    GRID_BAR(); if (nph <= 7) return;
    PHON(11) { PH_BEGIN pg8::Gemm g{WSB(WS_R1), WSB(WS_WOUT), MPR, DM, DM}; pg8::StaticOrder S; S.init(MPR, DM, C.G, bx);
      pg8::EpiWout E{WSF(WS_PRE), IN_(0), IN_(1)};
      pg8::gemm_phase<pg8::EpiWout, pg8::StaticOrder, GEMM_ALIGN, GEMM_SP2>(C.lds + RING_OFF, g, S, E);
      thin_wout(C, WSB(WS_R1), WSB(WS_WOUT), IN_(1), WSF(WS_PRE)); }
    GRID_BAR(); if (nph <= 8) return;
    PHON(12) { PH_BEGIN ln_pass<0>(C, WSF(WS_PRE), IN_(21), IN_(22), WSB(WS_R1), out); }
    GRID_BAR(); if (nph <= 9) return;
    PHON(13) { PH_BEGIN pg8::Gemm g{WSB(WS_R1), WSB(WS_WGU), MPR, 2 * DFF, DM}; pg8::StaticOrder S; S.init(MPR, 2 * DFF, C.G, bx);
      pg8::EpiGU E{WSB(WS_ACT)};
      pg8::gemm_phase<pg8::EpiGU, pg8::StaticOrder, GEMM_ALIGN, GEMM_SP2>(C.lds + RING_OFF, g, S, E);
      thin_gu(C, WSB(WS_R1), WSB(WS_WGU), WSB(WS_ACT)); }
    GRID_BAR(); if (nph <= 10) return;
    PHON(14) { PH_BEGIN pg8::Gemm g{WSB(WS_ACT), WSB(WS_WD), MPR, DM, DFF}; pg8::StaticOrder S; S.init(MPR, DM, C.G, bx);
      pg8::EpiDown E{WSF(WS_PRE), WSB(WS_R1)};
      pg8::gemm_phase<pg8::EpiDown, pg8::StaticOrder, GEMM_ALIGN, GEMM_SP2>(C.lds + RING_OFF, g, S, E);
      thin_down(C, WSB(WS_ACT), WSB(WS_WD), WSB(WS_R1), WSF(WS_PRE)); }
    GRID_BAR(); if (nph <= 11) return;
    PHON(15) { PH_BEGIN ln_pass<0>(C, WSF(WS_PRE), IN_(26), IN_(27), WSB(WS_H2), out); }
    GRID_BAR(); if (nph <= 12) return;
    PHON(16) { PH_BEGIN pg8::Gemm g{WSB(WS_PB), WSB(WS_WPP), MPR, DM, PLE}; pg8::StaticOrder S; S.init(MPR, DM, C.G, bx);
      pg8::EpiPlain E{WSB(WS_PP)};
      pg8::gemm_phase<pg8::EpiPlain, pg8::StaticOrder, GEMM_ALIGN, GEMM_SP2>(C.lds + RING_OFF, g, S, E);
      thin_pp(C, WSB(WS_PB), WSB(WS_WPP), WSB(WS_PP)); }
    GRID_BAR(); if (nph <= 13) return;
    PHON(17) { PH_BEGIN pg8::Gemm g{WSB(WS_H2), WSB(WS_WPG), MPR, DM, DM}; pg8::StaticOrder S; S.init(MPR, DM, C.G, bx);
      pg8::EpiPle E{WSF(WS_PRE), WSB(WS_H2), WSB(WS_PP)};
      pg8::gemm_phase<pg8::EpiPle, pg8::StaticOrder, GEMM_ALIGN, GEMM_SP2>(C.lds + RING_OFF, g, S, E);
      thin_pg(C, WSB(WS_H2), WSB(WS_WPG), WSB(WS_PP), WSF(WS_PRE)); }
    GRID_BAR(); if (nph <= 14) return;
    PHON(18) { PH_BEGIN ln_pass<1>(C, WSF(WS_PRE), IN_(30), IN_(31), nullptr, out); }
}

#ifndef N_PHASES
#define N_PHASES 99
#endif
extern "C" void kernel_launch(void* const* d_in, const int* in_sizes, int n_in, void* d_out, int out_size, void* d_ws, size_t ws_size, hipStream_t stream) {
    static int grid = 0;
    if (grid == 0) {
        if (n_in != 32 || in_sizes[0] != MPR * DM || (size_t)out_size != O_END || ws_size < WS_END) {
            fprintf(stderr, "kernel_launch: unexpected shapes: n_in %d in0 %d out %d (want %zu) ws %zu (want >= %zu); nothing launched\n", n_in, n_in > 0 ? in_sizes[0] : -1, out_size, (size_t)O_END, ws_size, (size_t)WS_END);
            grid = -1; return; }
        int dev = 0, cus = 0, per_cu = 0;
        if (hipGetDevice(&dev) != hipSuccess || hipDeviceGetAttribute(&cus, hipDeviceAttributeMultiprocessorCount, dev) != hipSuccess) { fprintf(stderr, "kernel_launch: device query failed\n"); grid = -1; return; }
        if (hipFuncSetAttribute((const void*)mega_fwd, hipFuncAttributeMaxDynamicSharedMemorySize, LDS_BYTES) != hipSuccess) { fprintf(stderr, "kernel_launch: hipFuncSetAttribute failed\n"); grid = -1; return; }
        if (hipOccupancyMaxActiveBlocksPerMultiprocessor(&per_cu, (const void*)mega_fwd, NWAVES * 64, LDS_BYTES) != hipSuccess || per_cu < 1) { fprintf(stderr, "kernel_launch: occupancy query reports %d blocks per CU\n", per_cu); }
        (void)hipGetLastError();
        grid = cus;
        if (grid != 256) fprintf(stderr, "kernel_launch: note: %d CUs (work distribution assumes 256)\n", grid);
    }
    if (grid < 0) return;
    if (hipMemsetAsync((char*)d_ws + WS_CTL, 0, CTL_ZERO_BYTES, stream) != hipSuccess) { fprintf(stderr, "kernel_launch: memset failed\n"); return; }
    Args a{};
    for (int i = 0; i < 32; ++i) a.in[i] = (const float*)d_in[i];
    a.out = (float*)d_out; a.ws = (unsigned char*)d_ws; a.nphase = N_PHASES; a.pad = 0;
    hipLaunchKernelGGL(mega_fwd, dim3(grid), dim3(NWAVES * 64), LDS_BYTES, stream, a);
    const hipError_t le = hipPeekAtLastError();
    if (le != hipSuccess) fprintf(stderr, "kernel_launch: launch failed: %s\n", hipGetErrorName(le));
}
```

```cpp
#include <hip/hip_runtime.h>
#include <cstdio>
#include <cstdint>
constexpr int DM = 1024, TSEQ = 4096, NBATCH = 8, MPR = NBATCH * TSEQ;
constexpr int SB = 32, SS = 4, MSA = SB * SS;
constexpr int MT = MPR + 256;
constexpr int CA = 512, CB = 512, DBIN = 1792, DIN = 3328, DFF = 2816, PLE = 256, HD = 64, NH = 8;
constexpr int WINL = 2048;
constexpr float ALPHA = 1.18920711500272f;
constexpr float LN_EPS = 1e-5f, GN_EPS = 64e-5f;
constexpr float QSCALE = 0.125f * 1.4426950408889634f;
constexpr float LOG2E = 1.4426950408889634f;
constexpr size_t O_YP = 0, O_YS = O_YP + (size_t)MPR * DM, O_KWP = O_YS + (size_t)MSA * DM, O_VWP = O_KWP + (size_t)NBATCH * WINL * CA,
                 O_WKVP = O_VWP + (size_t)NBATCH * WINL * CA, O_SHP = O_WKVP + (size_t)NBATCH * NH * HD * HD, O_KWS = O_SHP + (size_t)NBATCH * DBIN,
                 O_VWS = O_KWS + (size_t)SB * WINL * CA, O_WKVS = O_VWS + (size_t)SB * WINL * CA, O_SHS = O_WKVS + (size_t)SB * NH * HD * HD,
                 O_END = O_SHS + (size_t)SB * DBIN;
namespace pg8 {
#define PG8_LAS __attribute__((address_space(3)))
typedef unsigned short bf16_t;
typedef short bf16x8 __attribute__((ext_vector_type(8)));
typedef float f32x4 __attribute__((ext_vector_type(4)));
typedef unsigned u32x4 __attribute__((ext_vector_type(4)));
constexpr int BM = 256, BK = 64, HALF = 128, HTB = HALF * BK * 2  , STAGE_BYTES = 8 * HTB, NXCD = 8, WGM = 8;

__host__ __device__ __forceinline__ int lds_byte(int r, int c) { const int st = (r >> 4) * 2 + (c >> 5), rr = r & 15, cc = c & 31, ob = rr * 64 + cc * 2; return st * 1024 + (ob ^ (((ob >> 9) & 1) << 5)); }
__host__ __device__ __forceinline__ void stage_rc(int b, int& R, int& C) { const int st = b / 1024, sb = b % 1024, swz = sb ^ (((sb >> 9) & 1) << 5); R = (st >> 1) * 16 + swz / 64; C = (st & 1) * 32 + (swz % 64) / 2; }
__host__ __device__ __forceinline__ int perm32(int rho) { const int n = rho >> 4, i = rho & 15; return 8 * (i >> 2) + 4 * n + (i & 3); }

struct Unit { int pm, pn; };
struct Gemm { const bf16_t* A; const bf16_t* Bt; int M, N, K; };

struct StaticOrder {
    int nM, nN, nwg, G, c;
    __host__ __device__ void init(int M, int N, int G_, int c_) { nM = M / BM; nN = N / BM; nwg = nM * nN; G = G_; c = c_; }
    __host__ __device__ bool next(int i, Unit& u) const {
        const long L = (long)i * G + c; if (L >= nwg) return false;
        int wgid = (int)L; { const int q = nwg / NXCD, r = nwg % NXCD, xcd = wgid % NXCD, off = wgid / NXCD; wgid = (xcd < r ? xcd * (q + 1) : r * (q + 1) + (xcd - r) * q) + off; }
        const int nig = WGM * nN, gid = wgid / nig, fm = gid * WGM, gsz = (nM - fm) < WGM ? (nM - fm) : WGM;
        u.pm = fm + ((wgid % nig) % gsz); u.pn = (wgid % nig) / gsz; return true;
    }
    __device__ __forceinline__ void a_ready(const Unit&) const {}
    __device__ __forceinline__ void done(const Unit&) const {}
};

typedef unsigned u32x2 __attribute__((ext_vector_type(2)));
__device__ __forceinline__ unsigned cvt_pk_bf16(float lo, float hi) { unsigned r; asm volatile("v_cvt_pk_bf16_f32 %0, %1, %2" : "=v"(r) : "v"(lo), "v"(hi)); return r; }
__device__ __forceinline__ float bf_lo(unsigned w) { return __uint_as_float(w << 16); }
__device__ __forceinline__ float bf_hi(unsigned w) { return __uint_as_float(w & 0xffff0000u); }
__device__ __forceinline__ float sigmoidf_(float x) { return __builtin_amdgcn_rcpf(1.0f + __builtin_amdgcn_exp2f(-x * 1.4426950408889634f)); }
__device__ __forceinline__ u32x4 pack8(const f32x4& a, const f32x4& b) { u32x4 w; w.x = cvt_pk_bf16(a[0], a[1]); w.y = cvt_pk_bf16(a[2], a[3]); w.z = cvt_pk_bf16(b[0], b[1]); w.w = cvt_pk_bf16(b[2], b[3]); return w; }

struct EpiZ {
    static constexpr bool PERM = true, AFTER_DRAIN = false;
    bf16_t *QB, *ZB; float* out;
    __device__ __forceinline__ void operator()(const f32x4 (&acc)[2][2][4][2], const Unit& u, int wr, int wc, int fr, int fq) const {
        const int pn = u.pn, pm = u.pm;
        const int kind = pn < 6 ? (pn >> 1) : 3;
        bf16_t* dst = kind == 3 ? ZB : QB + (size_t)kind * ((size_t)MT * CA);
        const int ld = kind == 3 ? DBIN : CA;
        const int col0 = (kind == 3 ? (pn - 6) * 256 : (pn & 1) * 256) + wc * 32 + 8 * fq;
        const float sc = kind == 0 ? QSCALE : 1.0f;
        const int rbase = pm * BM + wr * 64 + fr;
        const bool win_p = (kind == 1 || kind == 2) && pm < 128 && (pm & 15) >= 8;
        const bool win_s = (kind == 1 || kind == 2) && pm == 128;
        float* wout = out + (win_s ? O_KWS : O_KWP) + (kind == 2 ? (win_s ? (O_VWS - O_KWS) : (O_VWP - O_KWP)) : (size_t)0);
#pragma unroll
        for (int ai = 0; ai < 2; ++ai)
#pragma unroll
            for (int m = 0; m < 4; ++m) {
                const int row = rbase + ai * HALF + m * 16;
                bf16_t* rowp = dst + (size_t)row * ld + col0;
#pragma unroll
                for (int bj = 0; bj < 2; ++bj) {
                    const f32x4 v0 = acc[ai][bj][m][0] * sc, v1 = acc[ai][bj][m][1] * sc;
                    *(u32x4*)(rowp + bj * HALF) = pack8(v0, v1);
                    if (win_p) {
                        const int b = pm >> 4, t = (pm & 15) * 256 + (row & 255);
                        float* o = wout + ((size_t)(b * WINL + t - WINL) * CA + col0 + bj * HALF);
                        *(f32x4*)o = v0; *(f32x4*)(o + 4) = v1;
                    } else if (win_s && ai == 0) {
                        const int rs = row - MPR, b = rs >> 2, s = rs & 3;
                        float* o = wout + ((size_t)(b * WINL + (WINL - SS) + s) * CA + col0 + bj * HALF);
                        *(f32x4*)o = v0; *(f32x4*)(o + 4) = v1;
                    }
                }
            }
    }
};

struct EpiLora {
    static constexpr bool PERM = true, AFTER_DRAIN = false;
    bf16_t *LAM; const float *w0, *a0;
    __device__ __forceinline__ void operator()(const f32x4 (&acc)[2][2][4][2], const Unit& u, int wr, int wc, int fr, int fq) const {
        const int kind = u.pn >> 1;
        bf16_t* dst = LAM + (size_t)kind * ((size_t)MT * CB);
        const int col0 = (u.pn & 1) * 256 + wc * 32 + 8 * fq;
        const float* bias = kind == 0 ? w0 : a0;
        const float mul = kind == 0 ? 0.6065306597126334f : 1.0f;
        const int rbase = u.pm * BM + wr * 64 + fr;
#pragma unroll
        for (int bj = 0; bj < 2; ++bj) {
            f32x4 b0 = {0.f, 0.f, 0.f, 0.f}, b1 = b0;
            if (kind < 2) { b0 = *(const f32x4*)(bias + col0 + bj * HALF); b1 = *(const f32x4*)(bias + col0 + bj * HALF + 4); }
#pragma unroll
            for (int ai = 0; ai < 2; ++ai)
#pragma unroll
                for (int m = 0; m < 4; ++m) {
                    f32x4 v0 = acc[ai][bj][m][0] + b0, v1 = acc[ai][bj][m][1] + b1;
                    if (kind < 2) {
#pragma unroll
                        for (int e = 0; e < 4; ++e) { v0[e] = mul * sigmoidf_(v0[e]); v1[e] = mul * sigmoidf_(v1[e]); }
                    }
                    *(u32x4*)(dst + (size_t)(rbase + ai * HALF + m * 16) * CB + col0 + bj * HALF) = pack8(v0, v1);
                    asm volatile("" ::: "memory");
                }
        }
    }
};

__device__ __forceinline__ f32x4 xres4(const float* xp, const float* xs, int row, int col) {
    if (row < MPR) return *(const f32x4*)(xp + (size_t)row * DM + col);
    if (row < MPR + MSA) return *(const f32x4*)(xs + (size_t)(row - MPR) * DM + col);
    return (f32x4){0.f, 0.f, 0.f, 0.f};
}
struct EpiWout {
    static constexpr bool PERM = false, AFTER_DRAIN = false;
    float* PRE; const float *xp, *xs;
    __device__ __forceinline__ void operator()(const f32x4 (&acc)[2][2][4][2], const Unit& u, int wr, int wc, int fr, int fq) const {
        const int row0 = u.pm * BM + wr * 64 + fr, col0 = u.pn * BM + wc * 32 + 4 * fq;
#pragma unroll
        for (int ai = 0; ai < 2; ++ai)
#pragma unroll
            for (int m = 0; m < 4; ++m) { const int row = row0 + ai * HALF + m * 16; float* rowp = PRE + (size_t)row * DM + col0;
#pragma unroll
                for (int bj = 0; bj < 2; ++bj)
#pragma unroll
                    for (int n = 0; n < 2; ++n) { const f32x4 xr = xres4(xp, xs, row, col0 + bj * HALF + n * 16); *(f32x4*)(rowp + bj * HALF + n * 16) = acc[ai][bj][m][n] + xr * ALPHA; } }
    }
};
struct EpiGU {
    static constexpr bool PERM = true, AFTER_DRAIN = false;
    bf16_t* ACT;
    __device__ __forceinline__ void operator()(const f32x4 (&acc)[2][2][4][2], const Unit& u, int wr, int wc, int fr, int fq) const {
        const int row0 = u.pm * BM + wr * 64 + fr, col0 = u.pn * HALF + wc * 32 + 8 * fq;
#pragma unroll
        for (int ai = 0; ai < 2; ++ai)
#pragma unroll
            for (int m = 0; m < 4; ++m) {
                f32x4 o[2];
#pragma unroll
                for (int n = 0; n < 2; ++n)
#pragma unroll
                    for (int e = 0; e < 4; ++e) { const float g = acc[ai][0][m][n][e], up = acc[ai][1][m][n][e]; o[n][e] = g * sigmoidf_(g) * up; }
                *(u32x4*)(ACT + (size_t)(row0 + ai * HALF + m * 16) * DFF + col0) = pack8(o[0], o[1]);
            }
    }
};
struct EpiDown {
    static constexpr bool PERM = false, AFTER_DRAIN = false;
    float* PRE; const bf16_t* H;
    __device__ __forceinline__ void operator()(const f32x4 (&acc)[2][2][4][2], const Unit& u, int wr, int wc, int fr, int fq) const {
        const int row0 = u.pm * BM + wr * 64 + fr, col0 = u.pn * BM + wc * 32 + 4 * fq;
#pragma unroll
        for (int ai = 0; ai < 2; ++ai)
#pragma unroll
            for (int m = 0; m < 4; ++m) { const size_t off = (size_t)(row0 + ai * HALF + m * 16) * DM + col0;
#pragma unroll
                for (int bj = 0; bj < 2; ++bj)
#pragma unroll
                    for (int n = 0; n < 2; ++n) { const u32x2 hw = *(const u32x2*)(H + off + bj * HALF + n * 16);
                        const f32x4 hr = (f32x4){bf_lo(hw.x), bf_hi(hw.x), bf_lo(hw.y), bf_hi(hw.y)};
                        *(f32x4*)(PRE + off + bj * HALF + n * 16) = acc[ai][bj][m][n] + hr * ALPHA; } }
    }
};
struct EpiPlain {
    static constexpr bool PERM = true, AFTER_DRAIN = false;
    bf16_t* O;
    __device__ __forceinline__ void operator()(const f32x4 (&acc)[2][2][4][2], const Unit& u, int wr, int wc, int fr, int fq) const {
        const int row0 = u.pm * BM + wr * 64 + fr, col0 = u.pn * BM + wc * 32 + 8 * fq;
#pragma unroll
        for (int ai = 0; ai < 2; ++ai)
#pragma unroll
            for (int m = 0; m < 4; ++m)
#pragma unroll
                for (int bj = 0; bj < 2; ++bj) *(u32x4*)(O + (size_t)(row0 + ai * HALF + m * 16) * DM + col0 + bj * HALF) = pack8(acc[ai][bj][m][0], acc[ai][bj][m][1]);
    }
};
struct EpiPle {
    static constexpr bool PERM = false, AFTER_DRAIN = false;
    float* PRE; const bf16_t *H, *PP;
    __device__ __forceinline__ void operator()(const f32x4 (&acc)[2][2][4][2], const Unit& u, int wr, int wc, int fr, int fq) const {
        const int row0 = u.pm * BM + wr * 64 + fr, col0 = u.pn * BM + wc * 32 + 4 * fq;
#pragma unroll
        for (int ai = 0; ai < 2; ++ai)
#pragma unroll
            for (int m = 0; m < 4; ++m) { const size_t off = (size_t)(row0 + ai * HALF + m * 16) * DM + col0;
#pragma unroll
                for (int bj = 0; bj < 2; ++bj)
#pragma unroll
                    for (int n = 0; n < 2; ++n) { const size_t o2 = off + bj * HALF + n * 16;
                        const u32x2 hw = *(const u32x2*)(H + o2), pw = *(const u32x2*)(PP + o2);
                        const f32x4 hr = (f32x4){bf_lo(hw.x), bf_hi(hw.x), bf_lo(hw.y), bf_hi(hw.y)}, pr = (f32x4){bf_lo(pw.x), bf_hi(pw.x), bf_lo(pw.y), bf_hi(pw.y)};
                        f32x4 a = acc[ai][bj][m][n];
#pragma unroll
                        for (int e = 0; e < 4; ++e) a[e] = sigmoidf_(a[e]);
                        *(f32x4*)(PRE + o2) = hr * ALPHA + a * pr; } }
    }
};
template <class Epi, class Sched, bool ALIGN_EPI = false, bool SP2 = false>
__device__ __forceinline__ void gemm_phase(PG8_LAS unsigned char* lds, const Gemm g, const Sched& S, const Epi& E) {
    int tid_ = threadIdx.x; asm volatile("" : "+v"(tid_));
    const int tid = tid_, wid = __builtin_amdgcn_readfirstlane(tid >> 6), lane = tid & 63, wr = wid >> 2, wc = wid & 3, fr = lane & 15, fq = lane >> 4;
    int K_ = g.K; asm volatile("" : "+s"(K_));
    const int K = K_, nt = K / BK;
    unsigned voffA[2], voffB[2];
#pragma unroll
    for (int i = 0; i < 2; ++i) { int R, C; stage_rc(tid * 16 + i * 8192, R, C); const int Rb = Epi::PERM ? ((R & ~31) + perm32(R & 31)) : R;
        voffA[i] = (unsigned)(R * K + C) * 2u; voffB[i] = (unsigned)(Rb * K + C) * 2u; }
    const size_t kstep = (size_t)(BK * 2);
    const size_t hstep = (size_t)HALF * K * 2;
    const size_t tstep = 2 * hstep;
    const unsigned ldsw = (unsigned)wid * 1024u;
    const int aoff = lds_byte(wr * 64 + fr, fq * 8), boff = lds_byte(wc * 32 + fr, fq * 8);
#define PG8_SA(b, h) (((b) * 2 + (h)) * HTB)
#define PG8_SB(b, h) ((4 + (b) * 2 + (h)) * HTB)
#define PG8_STAGE(bufoff, gbase, voff) do { _Pragma("unroll") for (int _i = 0; _i < 2; ++_i) \
        __builtin_amdgcn_global_load_lds((const unsigned*)((const char*)(gbase) + (voff)[_i]), (PG8_LAS unsigned*)(lds + (bufoff) + ldsw + _i * 8192), 16, 0, 0); } while (0)
#define PG8_LDA(dst, b, h) do { _Pragma("unroll") for (int m = 0; m < 4; ++m) _Pragma("unroll") for (int k = 0; k < 2; ++k) dst[m][k] = *(const PG8_LAS bf16x8*)(lds + PG8_SA(b, h) + aoff + m * 2048 + k * 1024); } while (0)
#define PG8_LDB(dst, b, h) do { _Pragma("unroll") for (int n = 0; n < 2; ++n) _Pragma("unroll") for (int k = 0; k < 2; ++k) dst[n][k] = *(const PG8_LAS bf16x8*)(lds + PG8_SB(b, h) + boff + n * 2048 + k * 1024); } while (0)
#define PG8_MMA(ai, bj, At, Bt) do { __builtin_amdgcn_s_setprio(1); _Pragma("unroll") for (int m = 0; m < 4; ++m) _Pragma("unroll") for (int n = 0; n < 2; ++n) _Pragma("unroll") for (int k = 0; k < 2; ++k) \
        acc[ai][bj][m][n] = __builtin_amdgcn_mfma_f32_16x16x32_bf16(Bt[n][k], At[m][k], acc[ai][bj][m][n], 0, 0, 0); __builtin_amdgcn_s_setprio(0); } while (0)
#define PG8_WAIT_V(n) asm volatile("s_waitcnt vmcnt(" #n ")" ::: "memory")
#define PG8_WAIT_L(n) asm volatile("s_waitcnt lgkmcnt(" #n ")" ::: "memory")
#define PG8_BAR __builtin_amdgcn_s_barrier()
#define PG8_SCHED __builtin_amdgcn_sched_barrier(0)
    Unit cur, nxt; int ui = 0;
    if (!S.next(0, cur)) return;
    f32x4 acc[2][2][4][2];
#pragma unroll
    for (int a = 0; a < 2; ++a)
#pragma unroll
        for (int b = 0; b < 2; ++b)
#pragma unroll
            for (int m = 0; m < 4; ++m)
#pragma unroll
                for (int n = 0; n < 2; ++n) acc[a][b][m][n] = (f32x4){0.f, 0.f, 0.f, 0.f};
    bf16x8 At[4][2], B0[2][2], B1[2][2];
    const char* cA = (const char*)g.A + (size_t)cur.pm * tstep; const char* cB = (const char*)g.Bt + (size_t)cur.pn * tstep;
    S.a_ready(cur);
    if constexpr (SP2) {
        PG8_STAGE(PG8_SB(0, 0), cB, voffB); PG8_STAGE(PG8_SB(0, 1), cB + hstep, voffB); PG8_STAGE(PG8_SA(0, 0), cA, voffA); PG8_STAGE(PG8_SA(0, 1), cA + hstep, voffA);
        if (wr == 1) PG8_BAR;
        PG8_WAIT_V(2); PG8_BAR;
        PG8_STAGE(PG8_SB(1, 0), cB + kstep, voffB); PG8_STAGE(PG8_SA(1, 0), cA + kstep, voffA); PG8_STAGE(PG8_SB(1, 1), cB + hstep + kstep, voffB);
        PG8_WAIT_V(6); PG8_BAR;
    } else {
        PG8_STAGE(PG8_SB(0, 0), cB, voffB); PG8_STAGE(PG8_SA(0, 0), cA, voffA); PG8_STAGE(PG8_SB(0, 1), cB + hstep, voffB); PG8_STAGE(PG8_SA(0, 1), cA + hstep, voffA);
        if (wr == 1) PG8_BAR;
        PG8_WAIT_V(4); PG8_BAR;
        PG8_STAGE(PG8_SB(1, 0), cB + kstep, voffB); PG8_STAGE(PG8_SA(1, 0), cA + kstep, voffA); PG8_STAGE(PG8_SB(1, 1), cB + hstep + kstep, voffB);
        PG8_WAIT_V(6); PG8_BAR;
    }
    for (;;) {
        const bool has_next = S.next(ui + 1, nxt);
        const char* nA = has_next ? (const char*)g.A + (size_t)nxt.pm * tstep : cA; const char* nB = has_next ? (const char*)g.Bt + (size_t)nxt.pn * tstep : cB;
        for (int t = 0; t < nt; t += 2) {
            const bool last = (t == nt - 2);
            const char* a1 = cA + (size_t)(t + 1) * kstep;
            const char* a2 = last ? nA : cA + (size_t)(t + 2) * kstep; const char* b2 = last ? nB : cB + (size_t)(t + 2) * kstep;
            const char* a3 = a2 + kstep; const char* b3 = b2 + kstep;
            if (last && has_next) S.a_ready(nxt);
            if constexpr (SP2) {
            PG8_LDB(B0, 0, 0); PG8_LDB(B1, 0, 1); PG8_SCHED; PG8_LDA(At, 0, 0); PG8_STAGE(PG8_SA(1, 1), a1 + hstep, voffA);
            PG8_WAIT_V(8); PG8_WAIT_L(0); PG8_BAR; PG8_MMA(0, 0, At, B0); PG8_MMA(0, 1, At, B1); PG8_BAR; PG8_SCHED;
            PG8_LDA(At, 0, 1); PG8_STAGE(PG8_SB(0, 0), b2, voffB); PG8_STAGE(PG8_SB(0, 1), b2 + hstep, voffB); PG8_STAGE(PG8_SA(0, 0), a2, voffA);
            PG8_WAIT_V(8); PG8_WAIT_L(0); PG8_BAR; PG8_MMA(1, 0, At, B0); PG8_MMA(1, 1, At, B1); PG8_BAR; PG8_SCHED;
            PG8_LDB(B0, 1, 0); PG8_LDB(B1, 1, 1); PG8_SCHED; PG8_LDA(At, 1, 0); PG8_STAGE(PG8_SA(0, 1), a2 + hstep, voffA);
            PG8_WAIT_V(8); PG8_WAIT_L(0); PG8_BAR; PG8_MMA(0, 0, At, B0); PG8_MMA(0, 1, At, B1); PG8_BAR; PG8_SCHED;
            PG8_LDA(At, 1, 1); PG8_STAGE(PG8_SB(1, 0), b3, voffB); PG8_STAGE(PG8_SB(1, 1), b3 + hstep, voffB); PG8_STAGE(PG8_SA(1, 0), a3, voffA);
            PG8_WAIT_V(8); PG8_WAIT_L(0); PG8_BAR; PG8_MMA(1, 0, At, B0); PG8_MMA(1, 1, At, B1); PG8_BAR; PG8_SCHED;
            } else {
            PG8_LDB(B0, 0, 0); PG8_SCHED; PG8_LDA(At, 0, 0); PG8_STAGE(PG8_SA(1, 1), a1 + hstep, voffA);
            PG8_WAIT_L(8); PG8_BAR; PG8_WAIT_L(0); PG8_MMA(0, 0, At, B0); PG8_BAR; PG8_SCHED;
            PG8_LDB(B1, 0, 1); PG8_STAGE(PG8_SB(0, 0), b2, voffB);
            PG8_BAR; PG8_WAIT_L(0); PG8_MMA(0, 1, At, B1); PG8_BAR;
            PG8_LDA(At, 0, 1); PG8_STAGE(PG8_SA(0, 0), a2, voffA);
            PG8_BAR; PG8_WAIT_L(0); PG8_MMA(1, 0, At, B0); PG8_BAR; PG8_SCHED;
            PG8_STAGE(PG8_SB(0, 1), b2 + hstep, voffB);
            PG8_WAIT_V(6); PG8_BAR; PG8_MMA(1, 1, At, B1); PG8_BAR;
            PG8_LDB(B0, 1, 0); PG8_SCHED; PG8_LDA(At, 1, 0); PG8_STAGE(PG8_SA(0, 1), a2 + hstep, voffA);
            PG8_WAIT_L(8); PG8_BAR; PG8_WAIT_L(0); PG8_MMA(0, 0, At, B0); PG8_BAR; PG8_SCHED;
            PG8_LDB(B1, 1, 1); PG8_STAGE(PG8_SB(1, 0), b3, voffB);
            PG8_BAR; PG8_WAIT_L(0); PG8_MMA(0, 1, At, B1); PG8_BAR;
            PG8_LDA(At, 1, 1); PG8_STAGE(PG8_SA(1, 0), a3, voffA);
            PG8_BAR; PG8_WAIT_L(0); PG8_MMA(1, 0, At, B0); PG8_BAR; PG8_SCHED;
            PG8_STAGE(PG8_SB(1, 1), b3 + hstep, voffB);
            PG8_WAIT_V(6); PG8_BAR; PG8_MMA(1, 1, At, B1); PG8_BAR;
            }
        }
        if constexpr (ALIGN_EPI) { if (wr == 0) PG8_BAR; }
        if constexpr (!Epi::AFTER_DRAIN) { E(acc, cur, wr, wc, fr, fq); S.done(cur); }
        if (!has_next) break;
#pragma unroll
        for (int a = 0; a < 2; ++a)
#pragma unroll
            for (int b = 0; b < 2; ++b)
#pragma unroll
                for (int m = 0; m < 4; ++m)
#pragma unroll
                    for (int n = 0; n < 2; ++n) acc[a][b][m][n] = (f32x4){0.f, 0.f, 0.f, 0.f};
        cur = nxt; cA = nA; cB = nB; ++ui;
        if constexpr (ALIGN_EPI) { if (wr == 1) PG8_BAR; }
    }
    PG8_WAIT_V(0);
    if constexpr (!ALIGN_EPI) { if (wr == 0) PG8_BAR; }
    PG8_BAR;
    if constexpr (Epi::AFTER_DRAIN) { E.fused(acc, cur, wr, wc, fr, fq, lds, wid, lane); S.done(cur); }
#undef PG8_SA
#undef PG8_SB
#undef PG8_STAGE
#undef PG8_LDA
#undef PG8_LDB
#undef PG8_MMA
#undef PG8_WAIT_V
#undef PG8_WAIT_L
#undef PG8_BAR
#undef PG8_SCHED
}
}
#define GAS __attribute__((address_space(1)))
#define LAS __attribute__((address_space(3)))
typedef unsigned short bf16;
typedef unsigned v4u __attribute__((ext_vector_type(4)));
typedef float f32x4 __attribute__((ext_vector_type(4)));
typedef short bf16x8 __attribute__((ext_vector_type(8)));
typedef GAS unsigned gu32;
typedef GAS unsigned long long gu64;
#define RLX_AGENT __ATOMIC_RELAXED, __HIP_MEMORY_SCOPE_AGENT
#define LDS_WAIT() asm volatile("s_waitcnt lgkmcnt(0)" ::: "memory")
#define VM_WAIT() asm volatile("s_waitcnt vmcnt(0)" ::: "memory")
__device__ __forceinline__ unsigned long long rt() { return __builtin_amdgcn_s_memrealtime(); }
__device__ __forceinline__ unsigned f2bf(float f) { unsigned u = __builtin_bit_cast(unsigned, f); return (u + 0x7fffu + ((u >> 16) & 1u)) >> 16; }
__device__ __forceinline__ unsigned pk2(float lo, float hi) { return f2bf(lo) | (f2bf(hi) << 16); }

#define XB_TMO      128
#define XB_XCNT(j)  (256  + 64 * (j))
#define XB_XSUB(j)  (1280 + 64 * (j))
#define XB_XGEN(j)  (2304 + 64 * (j))
#define XB_TOP      3328
#define XB_TOPGEN   3392
#define XCD_BAR_WORDS 3456
#define XB_SPIN_CAP (1u << 18)

__device__ __forceinline__ unsigned xb_ld(unsigned* p)              { return __hip_atomic_load(p, __ATOMIC_RELAXED, __HIP_MEMORY_SCOPE_AGENT); }
__device__ __forceinline__ unsigned xb_add(unsigned* p, unsigned v) { return __hip_atomic_fetch_add(p, v, __ATOMIC_RELAXED, __HIP_MEMORY_SCOPE_AGENT); }
__device__ __forceinline__ unsigned xb_xcc_id() { return (unsigned)__builtin_amdgcn_s_getreg((3 << 11) | 20) & 0xFu; }
#define XB_SPIN(cond, bar) do { unsigned _sp = 0; while (cond) { __builtin_amdgcn_s_sleep(1); \
    if ((++_sp & 255u) == 0u) { if (xb_ld(&(bar)[XB_TMO])) break; if (_sp > XB_SPIN_CAP) { atomicAdd(&(bar)[XB_TMO], 1u); break; } } } } while (0)

struct XcdBarrier {
    unsigned* bar; unsigned x;
    volatile LAS unsigned* st;
};

__device__ __forceinline__ XcdBarrier xcd_barrier_post(unsigned* bar, volatile LAS unsigned* st) {
    XcdBarrier b; b.bar = bar; b.x = xb_xcc_id(); b.st = st;
    if (threadIdx.x == 0) (void)xb_add(&bar[XB_XCNT(b.x)], 1u);
    return b;
}
__device__ __forceinline__ void xcd_barrier_complete(unsigned* bar, unsigned x, unsigned& nloc, unsigned& nx) {
    const unsigned G = gridDim.x * gridDim.y * gridDim.z;
    unsigned sum, cnt, mine, sp = 0u;
    for (;;) {
        sum = 0u; cnt = 0u; mine = 0u;
#pragma unroll
        for (unsigned j = 0; j < 16; ++j) { const unsigned c = xb_ld(&bar[XB_XCNT(j)]); sum += c; cnt += (c > 0u) ? 1u : 0u; mine = (j == x) ? c : mine; }
        if (sum == G) break;
        __builtin_amdgcn_s_sleep(1);
        if ((++sp & 255u) == 0u) { if (xb_ld(&bar[XB_TMO])) break; if (sp > XB_SPIN_CAP) { atomicAdd(&bar[XB_TMO], 1u); break; } }
    }
    nloc = mine > 0u ? mine : 1u; nx = cnt > 0u ? cnt : 1u;
}

__device__ __forceinline__ void xcd_barrier(const XcdBarrier& b) {
    asm volatile("s_waitcnt vmcnt(0)" ::: "memory");
    __syncthreads();
    if (threadIdx.x == 0) {
        unsigned* bar = b.bar;
        __builtin_amdgcn_s_waitcnt(0);
        unsigned nloc = b.st[0], nx = b.st[1];
        if (nloc == 0u) { xcd_barrier_complete(bar, b.x, nloc, nx); b.st[0] = nloc; b.st[1] = nx; }
        const unsigned old = xb_add(&bar[XB_XSUB(b.x)], 1u);
        const unsigned gen = old / nloc;
        if (old + 1u == (gen + 1u) * nloc) {
            __builtin_amdgcn_fence(__ATOMIC_RELEASE, "agent");
            asm volatile("s_waitcnt vmcnt(0)" ::: "memory");
            const unsigned og = xb_add(&bar[XB_TOP], 1u);
            const unsigned tg = og / nx;
            if (og + 1u == (tg + 1u) * nx) xb_add(&bar[XB_TOPGEN], 1u);
            else XB_SPIN(xb_ld(&bar[XB_TOPGEN]) == tg, bar);
            __builtin_amdgcn_fence(__ATOMIC_ACQUIRE, "agent");
            xb_add(&bar[XB_XGEN(b.x)], 1u);
            asm volatile("s_waitcnt vmcnt(0)" ::: "memory");
        } else {
            XB_SPIN(xb_ld(&bar[XB_XGEN(b.x)]) == gen, bar);
            __builtin_amdgcn_fence(__ATOMIC_ACQUIRE, "agent");
            asm volatile("s_waitcnt vmcnt(0)" ::: "memory");
        }
    }
    __syncthreads();
}
constexpr size_t MiB = 1u << 20;
constexpr size_t WS_CTL = 0, CTL_ZERO_BYTES = 1 * MiB;
constexpr size_t WS_WIN = 2 * MiB, WS_WOUT = 9 * MiB, WS_WGU = 11 * MiB, WS_WD = 22 * MiB, WS_WPG = 28 * MiB, WS_WPP = 30 * MiB, WS_WL = 30 * MiB + 512 * 1024;
constexpr size_t SZ1024B = (size_t)MT * 1024 * 2, SZ512B = (size_t)MT * 512 * 2, SZ256B = (size_t)MT * 256 * 2;
constexpr size_t WS_R1 = 32 * MiB;
constexpr size_t WS_PB = 97 * MiB;
constexpr size_t WS_QB = 114 * MiB, WS_KB = WS_QB + SZ512B, WS_VB = WS_KB + SZ512B;
constexpr size_t WS_PRE = 114 * MiB;
constexpr size_t WS_ZB = 211 * MiB;
constexpr size_t WS_OG = 324 * MiB, WS_LSE = 420 * MiB;
constexpr size_t WS_BV = 324 * MiB, WS_PHI = 357 * MiB, WS_SLOC = 389 * MiB, WS_SC = 421 * MiB;
constexpr size_t WS_AP = 453 * MiB;
constexpr size_t WS_ACT = 243 * MiB;
constexpr size_t WS_H2 = 243 * MiB, WS_PP = 421 * MiB;
constexpr size_t WS_END = 486 * MiB;
static_assert(WS_VB + SZ512B <= WS_ZB && WS_ZB + (size_t)MT * DBIN * 2 <= WS_OG && WS_PRE + (size_t)MT * DM * 4 <= WS_ACT && WS_ACT + (size_t)MT * DFF * 2 <= WS_SC + 32 * MiB, "ws map");
static_assert(WS_R1 + SZ1024B <= WS_PB && WS_PB + SZ256B <= WS_QB && WS_AP + SZ256B <= WS_END && WS_ACT + (size_t)MT * DFF * 2 <= WS_PP && WS_PP + SZ1024B <= 512 * MiB, "ws map 2");
constexpr int NCHUNK = 32, CHL = TSEQ / NCHUNK;
constexpr int CW_BAR = 4096;

constexpr int RING_OFF = 0, RING_BYTES = 131072;
constexpr int LDSCTL_OFF = RING_BYTES, MISC_OFF = LDSCTL_OFF + 320;
constexpr int LDS_BYTES = 147456;
constexpr int NWAVES = 8;
typedef float f32x16 __attribute__((ext_vector_type(16)));
typedef unsigned u32x2 __attribute__((ext_vector_type(2)));
typedef short s16x4 __attribute__((ext_vector_type(4)));
typedef float f32x2_t __attribute__((ext_vector_type(2)));
typedef __bf16 bf16x2_t __attribute__((ext_vector_type(2)));
__device__ __forceinline__ unsigned cvtpk(float lo, float hi) { f32x2_t v = {lo, hi}; bf16x2_t b = __builtin_convertvector(v, bf16x2_t); return __builtin_bit_cast(unsigned, b); }
__device__ __forceinline__ float bflo(unsigned w) { return __uint_as_float(w << 16); }
__device__ __forceinline__ float bfhi(unsigned w) { return __uint_as_float(w & 0xffff0000u); }
__device__ __forceinline__ float bf1(bf16 h) { return __uint_as_float((unsigned)h << 16); }
__device__ __forceinline__ float sigm(float x) { return __builtin_amdgcn_rcpf(1.0f + __builtin_amdgcn_exp2f(-x * LOG2E)); }
__device__ __forceinline__ float shx(float v, int o, int lane) { return __int_as_float(__builtin_amdgcn_ds_bpermute((lane ^ o) << 2, __float_as_int(v))); }
__device__ __forceinline__ float wave_sum(float v, int lane) {
#pragma unroll
    for (int o = 1; o < 64; o <<= 1) v += shx(v, o, lane);
    return v;
}
#define dpp_f(v, ctrl, row_mask) __int_as_float(__builtin_amdgcn_update_dpp(0, __float_as_int(v), (ctrl), (row_mask), 0xF, false))
__device__ __forceinline__ float wave_sum_dpp(float v) {
    v += dpp_f(v, 0xB1, 0xF);
    v += dpp_f(v, 0x4E, 0xF);
    v += dpp_f(v, 0x141, 0xF);
    v += dpp_f(v, 0x140, 0xF);
    v += dpp_f(v, 0x142, 0xA);
    v += dpp_f(v, 0x143, 0xC);
    return __int_as_float(__builtin_amdgcn_readlane(__float_as_int(v), 63));
}

__device__ __forceinline__ void fmac_s(float& c, float a, float b) { asm("v_fmac_f32_e32 %0, %1, %2" : "+v"(c) : "v"(a), "v"(b)); }
__device__ __forceinline__ void mulip_s(float& c, float a) { asm("v_mul_f32_e32 %0, %0, %1" : "+v"(c) : "v"(a)); }
__device__ __forceinline__ float mul_s(float a, float b) { float r; asm("v_mul_f32_e32 %0, %1, %2" : "=v"(r) : "v"(a), "v"(b)); return r; }
struct Ctx { LAS unsigned char* lds; int tid, lane, wave, vcu, G; };

__device__ __forceinline__ void p0_transpose_item(const float* W, int N, bf16* WT, int ldk, int drow, int dk, LAS float* scr, int k0, int n0, int lane) {
#pragma unroll 8
    for (int i = 0; i < 32; ++i) { const int kk = 2 * i + (lane >> 5); scr[kk * 33 + (lane & 31)] = W[(size_t)(k0 + kk) * N + n0 + (lane & 31)]; }
    LDS_WAIT(); asm volatile("" ::: "memory");
    const int c = lane & 7;
#pragma unroll
    for (int j = 0; j < 4; ++j) { const int n = (lane >> 3) + 8 * j; const LAS float* s = scr + (8 * c) * 33 + n;
        v4u o; o.x = pk2(s[0 * 33], s[1 * 33]); o.y = pk2(s[2 * 33], s[3 * 33]); o.z = pk2(s[4 * 33], s[5 * 33]); o.w = pk2(s[6 * 33], s[7 * 33]);
        *(GAS v4u*)(WT + (size_t)(drow + n) * ldk + dk + 8 * c) = o; }
    LDS_WAIT(); asm volatile("" ::: "memory");
}
struct P0Args { const float *xp, *xs, *pp, *ps, *ck, *cv, *w_in, *w_out, *w_gate, *w_up, *w_down, *w_pg, *w_pp, *w2, *a2, *g2; bf16 *Win, *Wout, *Wgu, *Wd, *Wpg, *Wpp, *Wl, *XB, *PB; float* out; };
__device__ __forceinline__ void p0_prologue(const Ctx& C, const P0Args& A) {
    LAS float* scr = (LAS float*)(C.lds + RING_OFF + C.wave * 16384);
    const int gw = C.vcu * NWAVES + C.wave, NGW = C.G * NWAVES;
    constexpr int I0 = 16 * 104, I1 = 16 * 32, I2 = 16 * 88, I3 = I2, I4 = 44 * 32, I5 = 16 * 32, I6 = 4 * 32, I7 = 16, I8 = 16, I9 = 32;
    constexpr int NITEMS = I0 + I1 + I2 + I3 + I4 + I5 + I6 + I7 + I8 + I9;
    for (int it = gw; it < NITEMS; it += NGW) {
        int r = it;
        if (r < I0) { const int kb = r / 104, nb = r % 104; p0_transpose_item(A.w_in, DIN, A.Win, 1024, nb * 32, kb * 64, scr, kb * 64, nb * 32, C.lane); continue; } r -= I0;
        if (r < I1) { const int kb = r / 32, nb = r % 32; p0_transpose_item(A.w_out, DM, A.Wout, 1024, nb * 32, kb * 64, scr, kb * 64, nb * 32, C.lane); continue; } r -= I1;
        if (r < I2) { const int kb = r / 88, nb = r % 88, n0 = nb * 32; p0_transpose_item(A.w_gate, DFF, A.Wgu, 1024, (n0 >> 7) * 256 + (n0 & 127), kb * 64, scr, kb * 64, n0, C.lane); continue; } r -= I2;
        if (r < I3) { const int kb = r / 88, nb = r % 88, n0 = nb * 32; p0_transpose_item(A.w_up, DFF, A.Wgu, 1024, (n0 >> 7) * 256 + 128 + (n0 & 127), kb * 64, scr, kb * 64, n0, C.lane); continue; } r -= I3;
        if (r < I4) { const int kb = r / 32, nb = r % 32; p0_transpose_item(A.w_down, DM, A.Wd, DFF, nb * 32, kb * 64, scr, kb * 64, nb * 32, C.lane); continue; } r -= I4;
        if (r < I5) { const int kb = r / 32, nb = r % 32; p0_transpose_item(A.w_pg, DM, A.Wpg, 1024, nb * 32, kb * 64, scr, kb * 64, nb * 32, C.lane); continue; } r -= I5;
        if (r < I6) { const int kb = r / 32, nb = r % 32; p0_transpose_item(A.w_pp, DM, A.Wpp, 256, nb * 32, kb * 64, scr, kb * 64, nb * 32, C.lane); continue; } r -= I6;
        if (r < I7) { p0_transpose_item(A.w2, CB, A.Wl, 256, r * 32, 0, scr, 0, r * 32, C.lane); continue; } r -= I7;
        if (r < I8) { p0_transpose_item(A.a2, CB, A.Wl, 256, 512 + r * 32, 64, scr, 0, r * 32, C.lane); continue; } r -= I8;
        { const int kb = r / 16, nb = r % 16; p0_transpose_item(A.g2, CB, A.Wl, 256, 1024 + nb * 32, 128 + kb * 64, scr, kb * 64, nb * 32, C.lane); }
    }
    const int gt = C.vcu * (NWAVES * 64) + C.tid, NT = C.G * NWAVES * 64;
    for (int i = gt; i < 1536 * 32; i += NT) { const int row = i >> 5, ch = i & 31, blk = row >> 9;
        const bool nz = blk == 0 ? ch < 8 : blk == 1 ? (ch >= 8 && ch < 16) : ch >= 16;
        if (!nz) *(GAS v4u*)(A.Wl + (size_t)row * 256 + ch * 8) = (v4u){0u, 0u, 0u, 0u}; }
    for (int i = gt; i < MT * 128; i += NT) { const int row = i >> 7, ch = i & 127;
        f32x4 a = {0.f, 0.f, 0.f, 0.f}, b = a;
        if (row < MPR + MSA) { const float* src = row < MPR ? A.xp + (size_t)row * DM : A.xs + (size_t)(row - MPR) * DM; a = *(const GAS f32x4*)(src + ch * 8); b = *(const GAS f32x4*)(src + ch * 8 + 4); }
        v4u o; o.x = cvtpk(a[0], a[1]); o.y = cvtpk(a[2], a[3]); o.z = cvtpk(b[0], b[1]); o.w = cvtpk(b[2], b[3]);
        *(GAS v4u*)(A.XB + (size_t)row * DM + ch * 8) = o; }
    for (int i = gt; i < MT * 32; i += NT) { const int row = i >> 5, ch = i & 31;
        f32x4 a = {0.f, 0.f, 0.f, 0.f}, b = a;
        if (row < MPR + MSA) { const float* src = row < MPR ? A.pp + (size_t)row * PLE : A.ps + (size_t)(row - MPR) * PLE; a = *(const GAS f32x4*)(src + ch * 8); b = *(const GAS f32x4*)(src + ch * 8 + 4); }
        v4u o; o.x = cvtpk(a[0], a[1]); o.y = cvtpk(a[2], a[3]); o.z = cvtpk(b[0], b[1]); o.w = cvtpk(b[2], b[3]);
        *(GAS v4u*)(A.PB + (size_t)row * PLE + ch * 8) = o; }
}

__device__ __forceinline__ void prep_a(const Ctx& C, const bf16* ZB, const float* mu, const float* state_shift, bf16* AP, float* out) {
    const int gw = C.vcu * NWAVES + C.wave, NGW = C.G * NWAVES, lane = C.lane;
    const f32x4 m4 = *(const GAS f32x4*)(mu + 1536 + lane * 4);
    for (int row = gw; row < MPR + MSA; row += NGW) {
        const u32x2 zw = *(const GAS u32x2*)(ZB + (size_t)row * DBIN + 1536 + lane * 4);
        f32x4 z = {bflo(zw.x), bfhi(zw.x), bflo(zw.y), bfhi(zw.y)}, p;
        const bool first = row < MPR ? (row & (TSEQ - 1)) == 0 : ((row - MPR) & 3) == 0;
        if (!first) { const u32x2 pw = *(const GAS u32x2*)(ZB + (size_t)(row - 1) * DBIN + 1536 + lane * 4); p = (f32x4){bflo(pw.x), bfhi(pw.x), bflo(pw.y), bfhi(pw.y)}; }
        else if (row < MPR) p = (f32x4){0.f, 0.f, 0.f, 0.f};
        else p = *(const GAS f32x4*)(state_shift + (size_t)((row - MPR) >> 2) * DBIN + 1536 + lane * 4);
        f32x4 zm = z + (p - z) * m4, o;
#pragma unroll
        for (int e = 0; e < 4; ++e) { const float x = zm[e];
            const float th = 1.0f - 2.0f * __builtin_amdgcn_rcpf(1.0f + __builtin_amdgcn_exp2f(2.0f * LOG2E * x));
            o[e] = lane < 16 ? th : lane < 32 ? x : sigm(x); }
        u32x2 w; w.x = cvtpk(o[0], o[1]); w.y = cvtpk(o[2], o[3]);
        *(GAS u32x2*)(AP + (size_t)row * 256 + lane * 4) = w;
    }
    const int gt = C.vcu * (NWAVES * 64) + C.tid, NT = C.G * NWAVES * 64;
    for (int i = gt; i < (NBATCH + SB) * DBIN; i += NT) { const int s = i / DBIN, c = i % DBIN;
        if (s < NBATCH) out[O_SHP + (size_t)s * DBIN + c] = bf1(ZB[(size_t)(s * TSEQ + TSEQ - 1) * DBIN + c]);
        else out[O_SHS + (size_t)(s - NBATCH) * DBIN + c] = bf1(ZB[(size_t)(MPR + (s - NBATCH) * SS + SS - 1) * DBIN + c]); }
}

__device__ __forceinline__ int crow(int r, int hi) { return (r & 3) + 8 * (r >> 2) + 4 * hi; }
typedef short v4i16_t __attribute__((ext_vector_type(4)));
__device__ __forceinline__ s16x4 vtr(LAS const unsigned char* p) { return __builtin_bit_cast(s16x4, __builtin_amdgcn_ds_read_tr16_b64_v4i16((LAS v4i16_t*)p)); }
constexpr int VP = 192;
__device__ __forceinline__ void attn_unit(const Ctx& C, const bf16* QB, const bf16* KB, const bf16* VB, bf16* OGg, float* LSEg, int b, int h, int cls, int mq0, int dil) {
    LAS unsigned char* lds = C.lds;
    const int tid = C.tid, wid = C.wave, lane = C.lane, r32 = lane & 31, hi = lane >> 5;
#pragma unroll
    for (int it = 0; it < 6; ++it) { const int rr = it * 64 + (tid >> 3), ch = tid & 7; int mk = mq0 - 128 + rr; mk = mk < 0 ? 0 : mk;
        const v4u val = *(const GAS v4u*)(VB + (size_t)(b * TSEQ + mk * dil + cls) * CA + h * 64 + ch * 8);
        *(LAS v4u*)(lds + rr * VP + ch * 16) = val; }
    __syncthreads();
    const int mqw = mq0 + 32 * wid;
    const size_t qrow = (size_t)(b * TSEQ + (mqw + r32) * dil + cls);
    bf16x8 qf[4];
#pragma unroll
    for (int s = 0; s < 4; ++s) qf[s] = *(const GAS bf16x8*)(QB + qrow * CA + h * 64 + 16 * s + 8 * hi);
    f32x16 st[5];
#pragma unroll
    for (int j = 0; j < 5; ++j) { int mk = mqw - 128 + 32 * j + r32; mk = mk < 0 ? 0 : mk;
        const bf16* kp = KB + (size_t)(b * TSEQ + mk * dil + cls) * CA + h * 64 + 8 * hi;
        f32x16 a = {0.f, 0.f, 0.f, 0.f, 0.f, 0.f, 0.f, 0.f, 0.f, 0.f, 0.f, 0.f, 0.f, 0.f, 0.f, 0.f};
#pragma unroll
        for (int s = 0; s < 4; ++s) { const bf16x8 kf = *(const GAS bf16x8*)(kp + 16 * s); a = __builtin_amdgcn_mfma_f32_32x32x16_bf16(kf, qf[s], a, 0, 0, 0); }
        st[j] = a; }
    const float slope2 = __builtin_amdgcn_exp2f(-(float)(h + 1)) * LOG2E * (float)dil;
    float mx = -INFINITY;
#pragma unroll
    for (int j = 0; j < 5; ++j)
#pragma unroll
        for (int i = 0; i < 16; ++i) { const int kr = crow(i, hi), dist = 128 - 32 * j + r32 - kr, mke = mqw - 128 + 32 * j + kr;
            const bool ok = dist >= 0 && dist <= 128 && mke >= 0;
            const float v = ok ? st[j][i] - slope2 * (float)dist : -INFINITY; st[j][i] = v; mx = fmaxf(mx, v); }
    mx = fmaxf(mx, shx(mx, 32, lane));
    float l = 0.f;
#pragma unroll
    for (int j = 0; j < 5; ++j)
#pragma unroll
        for (int i = 0; i < 16; ++i) { const float p = __builtin_amdgcn_exp2f(st[j][i] - mx); st[j][i] = p; l += p; }
    l += shx(l, 32, lane);
    f32x16 o0 = {0.f, 0.f, 0.f, 0.f, 0.f, 0.f, 0.f, 0.f, 0.f, 0.f, 0.f, 0.f, 0.f, 0.f, 0.f, 0.f}, o1 = o0;
    const int i16 = lane & 15, qq = i16 >> 2, pp = i16 & 3, blk = (lane >> 4) & 1;
    LAS const unsigned char* vbase = lds + (32 * wid + 4 * hi + qq) * VP + (16 * blk + 4 * pp) * 2;
#pragma unroll
    for (int j = 0; j < 5; ++j)
#pragma unroll
        for (int s2 = 0; s2 < 2; ++s2) {
            v4u pw; pw.x = cvtpk(st[j][8 * s2 + 0], st[j][8 * s2 + 1]); pw.y = cvtpk(st[j][8 * s2 + 2], st[j][8 * s2 + 3]); pw.z = cvtpk(st[j][8 * s2 + 4], st[j][8 * s2 + 5]); pw.w = cvtpk(st[j][8 * s2 + 6], st[j][8 * s2 + 7]);
            const bf16x8 xs = __builtin_bit_cast(bf16x8, pw);
            LAS const unsigned char* vp = vbase + (32 * j + 16 * s2) * VP;
            { const s16x4 lo = vtr(vp), hh = vtr(vp + 8 * VP); const bf16x8 vf = (bf16x8){lo[0], lo[1], lo[2], lo[3], hh[0], hh[1], hh[2], hh[3]};
              o0 = __builtin_amdgcn_mfma_f32_32x32x16_bf16(vf, xs, o0, 0, 0, 0); }
            { const s16x4 lo = vtr(vp + 64), hh = vtr(vp + 8 * VP + 64); const bf16x8 vf = (bf16x8){lo[0], lo[1], lo[2], lo[3], hh[0], hh[1], hh[2], hh[3]};
              o1 = __builtin_amdgcn_mfma_f32_32x32x16_bf16(vf, xs, o1, 0, 0, 0); }
        }
    const float inv = __builtin_amdgcn_rcpf(l);
    bf16* orow = OGg + qrow * CA + h * 64 + 4 * hi;
#pragma unroll
    for (int g4 = 0; g4 < 4; ++g4) {
        u32x2 w0, w1;
        w0.x = cvtpk(o0[4 * g4] * inv, o0[4 * g4 + 1] * inv); w0.y = cvtpk(o0[4 * g4 + 2] * inv, o0[4 * g4 + 3] * inv);
        w1.x = cvtpk(o1[4 * g4] * inv, o1[4 * g4 + 1] * inv); w1.y = cvtpk(o1[4 * g4 + 2] * inv, o1[4 * g4 + 3] * inv);
        *(GAS u32x2*)(orow + 8 * g4) = w0; *(GAS u32x2*)(orow + 32 + 8 * g4) = w1; }
    if (hi == 0) LSEg[qrow * NH + h] = mx + __builtin_amdgcn_logf(l);
    __syncthreads();
}
__device__ __forceinline__ void attn_prompt(const Ctx& C, const bf16* QB, const bf16* KB, const bf16* VB, bf16* OG, float* LSE) {
    for (int i = 0; i < 12; ++i) {
        const int u = C.vcu * 12 + i, bh = u / 48, k48 = u % 48, g = k48 >> 4, k = k48 & 15;
        const int b = bh >> 3, h = bh & 7;
        int cls, mq0, dil;
        if (g == 0) { cls = 0; mq0 = 256 * k; dil = 1; } else if (g == 1) { cls = k >> 2; mq0 = 256 * (k & 3); dil = 4; } else { cls = k; mq0 = 0; dil = 16; }
        attn_unit(C, QB, KB, VB, OG + (size_t)g * MPR * CA, LSE + (size_t)g * MPR * NH, b, h, cls, mq0, dil);
    }
}
__device__ __forceinline__ void attn_sample(const Ctx& C, const bf16* QB, const float* ck, const float* cv, const float* out, bf16* HEADS) {
    if (C.vcu >= SB * NH) return;
    const int b = C.vcu >> 3, h = C.vcu & 7, s = C.wave & 3, half = C.wave >> 2, lane = C.lane;
    LAS float* qs = (LAS float*)(C.lds + C.wave * 2048);
    LAS float* ps = qs + 64;
    LAS float* part = (LAS float*)(C.lds + 16384 + C.wave * 512);
    const int row = MPR + b * SS + s, n0 = half * 194, cnt = half ? 193 : 194;
    qs[lane] = bf1(QB[(size_t)row * CA + h * 64 + lane]);
    LDS_WAIT(); asm volatile("" ::: "memory");
    const float slope2 = __builtin_amdgcn_exp2f(-(float)(h + 1)) * LOG2E;
    const float* kbase = ck + ((size_t)b * WINL * NH + h) * HD; const float* knew = out + O_KWS + ((size_t)(b * WINL + (WINL - SS)) * NH + h) * HD;
    const float* vbase = cv + ((size_t)b * WINL * NH + h) * HD; const float* vnew = out + O_VWS + ((size_t)(b * WINL + (WINL - SS)) * NH + h) * HD;
    float sc[4]; float mx = -INFINITY;
#pragma unroll
    for (int it = 0; it < 4; ++it) {
        const int nl = it * 64 + lane, n = n0 + (nl < cnt ? nl : 0), g = (n >= 129) + (n >= 258), jj = n - 129 * g, dist = jj << (2 * g), idx = WINL + s - dist;
        const float* kr = idx < WINL ? kbase + (size_t)idx * (NH * HD) : knew + (size_t)(idx - WINL) * (NH * HD);
        float d = 0.f;
#pragma unroll
        for (int c = 0; c < 16; ++c) { const f32x4 kv = *(const GAS f32x4*)(kr + 4 * c); const f32x4 qv = *(LAS const f32x4*)(qs + 4 * c); d += kv[0] * qv[0] + kv[1] * qv[1] + kv[2] * qv[2] + kv[3] * qv[3]; }
        sc[it] = nl < cnt ? d - slope2 * (float)dist : -INFINITY;
        mx = fmaxf(mx, sc[it]); }
#pragma unroll
    for (int o = 1; o < 64; o <<= 1) mx = fmaxf(mx, shx(mx, o, lane));
    float l = 0.f;
#pragma unroll
    for (int it = 0; it < 4; ++it) { const float pe = __builtin_amdgcn_exp2f(sc[it] - mx); ps[it * 64 + lane] = pe; l += pe; }
    l = wave_sum(l, lane);
    LDS_WAIT(); asm volatile("" ::: "memory");
    const int kq = lane >> 4, d4 = lane & 15;
    f32x4 o4 = {0.f, 0.f, 0.f, 0.f};
#pragma unroll 7
    for (int nb = 0; nb < 49; ++nb) {
        const int nl = nb * 4 + kq, n = n0 + (nl < cnt ? nl : 0), g = (n >= 129) + (n >= 258), jj = n - 129 * g, dist = jj << (2 * g), idx = WINL + s - dist;
        const float* vr = idx < WINL ? vbase + (size_t)idx * (NH * HD) : vnew + (size_t)(idx - WINL) * (NH * HD);
        const f32x4 vv = *(const GAS f32x4*)(vr + 4 * d4);
        const float pe = nl < cnt ? ps[nl] : 0.f;
        o4 += vv * pe; }
#pragma unroll
    for (int e = 0; e < 4; ++e) { float v = o4[e]; v += shx(v, 16, lane); v += shx(v, 32, lane); o4[e] = v; }
    if (lane < 16) *(LAS f32x4*)(part + 16 + 4 * d4) = o4;
    if (lane == 0) { part[0] = mx; part[1] = l; }
    __syncthreads();
    if (half == 0) {
        LAS const float* p0 = part, *p1 = part + 4 * 128;
        const float m0 = p0[0], m1 = p1[0], M = fmaxf(m0, m1), f0 = __builtin_amdgcn_exp2f(m0 - M), f1 = __builtin_amdgcn_exp2f(m1 - M);
        const float L = p0[1] * f0 + p1[1] * f1, o = (p0[16 + lane] * f0 + p1[16 + lane] * f1) / L;
        HEADS[(size_t)row * DM + h * 64 + lane] = (bf16)(cvtpk(o, 0.f) & 0xffffu);
    }
    __syncthreads();
}

__device__ __forceinline__ void attn_merge(const Ctx& C, const bf16* OG, const float* LSE, bf16* HEADS) {
    const int gt = C.vcu * (NWAVES * 64) + C.tid, NT = C.G * NWAVES * 64;
    for (int i = gt; i < MPR * 64; i += NT) { const int row = i >> 6, ch = i & 63, h = ch >> 3;
        float ls[3], mx = -INFINITY;
#pragma unroll
        for (int g = 0; g < 3; ++g) { ls[g] = LSE[((size_t)g * MPR + row) * NH + h]; mx = fmaxf(mx, ls[g]); }
        float w[3], ws = 0.f;
#pragma unroll
        for (int g = 0; g < 3; ++g) { w[g] = __builtin_amdgcn_exp2f(ls[g] - mx); ws += w[g]; }
        const float inv = __builtin_amdgcn_rcpf(ws);
        float acc[8] = {0.f, 0.f, 0.f, 0.f, 0.f, 0.f, 0.f, 0.f};
#pragma unroll
        for (int g = 0; g < 3; ++g) { const v4u v = *(const GAS v4u*)(OG + ((size_t)g * MPR + row) * CA + ch * 8); const float wg = w[g] * inv;
            acc[0] += wg * bflo(v.x); acc[1] += wg * bfhi(v.x); acc[2] += wg * bflo(v.y); acc[3] += wg * bfhi(v.y); acc[4] += wg * bflo(v.z); acc[5] += wg * bfhi(v.z); acc[6] += wg * bflo(v.w); acc[7] += wg * bfhi(v.w); }
        v4u o; o.x = cvtpk(acc[0], acc[1]); o.y = cvtpk(acc[2], acc[3]); o.z = cvtpk(acc[4], acc[5]); o.w = cvtpk(acc[6], acc[7]);
        *(GAS v4u*)(HEADS + (size_t)row * DM + ch * 8) = o; }
}

struct RwkvW { const float *mu, *k_k, *k_a, *r_k, *lnx_w, *lnx_b; };
struct RwkvTok { float nkk, ka, d, kp, r, v, bon; };
__device__ __forceinline__ RwkvTok rwkv_tok(float zr, float zk, float zv, float pr, float pk, float pv, float lam, float a, float mur, float muk, float muv, float kkw, float kaw, float rkw, int lane) {
    RwkvTok o;
    const float r = zr + (pr - zr) * mur, k = zk + (pk - zk) * muk, v = zv + (pv - zv) * muv;
    const float kkr = k * kkw; const float ss = wave_sum_dpp(kkr * kkr);
    const float kk = kkr * __builtin_amdgcn_rsqf(fmaxf(ss, 1e-24f));
    const float kp = k * (1.0f + (a - 1.0f) * kaw);
    o.nkk = -kk; o.ka = kk * a; o.d = __builtin_amdgcn_exp2f(-lam * LOG2E); o.kp = kp; o.r = r; o.v = v; o.bon = wave_sum_dpp(r * kp * rkw);
    return o;
}
__device__ __forceinline__ void rwkv_chunk(const Ctx& C, const bf16* ZB, const bf16* LAM, const bf16* AA, const RwkvW& W, float* YL, float* U, bf16* BV, float* PHI, float* SLOC, int b, int h, int c,
                                           const float* ck, const float* cv, float* out) {
    constexpr unsigned PERB = (WINL - SS) * CA / 4, CPY_TOTAL = SB * PERB;
    const unsigned cbase = (unsigned)(C.vcu * NWAVES + C.wave) * (CHL * 64) + C.lane;
    const int lane = C.lane;
    LAS float* tokb = (LAS float*)(C.lds + C.wave * 12288);
    float S[64], P[64];
#pragma unroll
    for (int j = 0; j < 64; ++j) { S[j] = 0.f; P[j] = (j == lane) ? 1.f : 0.f; }
    const int hc = h * 64 + lane;
    const float mur = W.mu[hc], muk = W.mu[512 + hc], muv = W.mu[1024 + hc], kkw = W.k_k[hc], kaw = W.k_a[hc], rkw = W.r_k[hc];
    const int t0 = c * CHL; const size_t row0 = (size_t)b * TSEQ + t0;
    float pr = 0.f, pk = 0.f, pv = 0.f;
    if (t0 > 0) { const bf16* zp = ZB + (row0 - 1) * DBIN + hc; pr = bf1(zp[0]); pk = bf1(zp[512]); pv = bf1(zp[1024]); }
    LAS float* dend = tokb + 8 * 320;
    for (int sb = 0; sb < CHL / 8; ++sb) {
        float zr[8], zk[8], zv[8], lm[8], aa[8];
#pragma unroll
        for (int tt = 0; tt < 8; ++tt) { const size_t row = row0 + sb * 8 + tt; const bf16* zp = ZB + row * DBIN + hc;
            zr[tt] = bf1(zp[0]); zk[tt] = bf1(zp[512]); zv[tt] = bf1(zp[1024]); lm[tt] = bf1(LAM[row * CB + hc]); aa[tt] = bf1(AA[row * CB + hc]); }
        float Dp = 1.0f;
#pragma unroll
        for (int tt = 0; tt < 8; ++tt) {
            const RwkvTok o = rwkv_tok(zr[tt], zk[tt], zv[tt], pr, pk, pv, lm[tt], aa[tt], mur, muk, muv, kkw, kaw, rkw, lane);
            pr = zr[tt]; pk = zk[tt]; pv = zv[tt];
            const float Dc = Dp * o.d, inv = __builtin_amdgcn_rcpf(Dc);
            LAS float* tk = tokb + tt * 320;
            tk[lane] = o.nkk * Dp; tk[64 + lane] = o.ka * inv; tk[128 + lane] = o.kp * inv; tk[192 + lane] = o.r * Dc; tk[256 + lane] = o.v;
            Dp = Dc;
            BV[(row0 + sb * 8 + tt) * CB + hc] = (bf16)(cvtpk(o.bon * o.v, 0.f) & 0xffffu);
        }
        dend[lane] = Dp;
        LDS_WAIT(); asm volatile("" ::: "memory");
#pragma unroll 1
        for (int tt = 0; tt < 8; ++tt) {
            LAS const float* tk = tokb + tt * 320;
            unsigned ci = cbase + (unsigned)(sb * 8 + tt) * 64u; const bool cisv = ci >= CPY_TOTAL; ci -= cisv ? CPY_TOTAL : 0u;
            const bool cok = ci < CPY_TOTAL; const unsigned cb = ci / PERB, co = ci - cb * PERB; const size_t cdst = (size_t)cb * (WINL * CA / 4) + co;
            f32x4 cval = {0.f, 0.f, 0.f, 0.f};
            if (cok) cval = __builtin_nontemporal_load((const f32x4*)(cisv ? cv : ck) + (cdst + (SS * CA / 4)));
#define LD4(off) (*(LAS const f32x4*)(tk + (off)))
            const float vi = tk[256 + lane];
            float sS0 = 0.f, sS1 = 0.f, sP0 = 0.f, sP1 = 0.f;
#pragma unroll
            for (int j4 = 0; j4 < 16; ++j4) { const f32x4 n4 = LD4(4 * j4);
                sS0 = fmaf(S[4 * j4], n4[0], sS0); sS1 = fmaf(S[4 * j4 + 1], n4[1], sS1); sS0 = fmaf(S[4 * j4 + 2], n4[2], sS0); sS1 = fmaf(S[4 * j4 + 3], n4[3], sS1);
                sP0 = fmaf(P[4 * j4], n4[0], sP0); sP1 = fmaf(P[4 * j4 + 1], n4[1], sP1); sP0 = fmaf(P[4 * j4 + 2], n4[2], sP0); sP1 = fmaf(P[4 * j4 + 3], n4[3], sP1); }
            const float saS = sS0 + sS1, saP = sP0 + sP1;
            float yS0 = 0.f, yS1 = 0.f, yP0 = 0.f, yP1 = 0.f;
#pragma unroll
            for (int j4 = 0; j4 < 16; ++j4) {
                const f32x4 ka = LD4(64 + 4 * j4), kp = LD4(128 + 4 * j4), r = LD4(192 + 4 * j4);
#pragma unroll
                for (int e = 0; e < 4; ++e) { const int j = 4 * j4 + e;
                    S[j] = fmaf(saS, ka[e], fmaf(vi, kp[e], S[j]));
                    P[j] = fmaf(saP, ka[e], P[j]);
                    if (e & 1) { yS1 = fmaf(S[j], r[e], yS1); yP1 = fmaf(P[j], r[e], yP1); } else { yS0 = fmaf(S[j], r[e], yS0); yP0 = fmaf(P[j], r[e], yP0); } }
            }
#undef LD4
            const size_t row = row0 + sb * 8 + tt;
            YL[row * CB + hc] = yS0 + yS1; U[row * CB + hc] = yP0 + yP1;
            if (cok) __builtin_nontemporal_store(cval, (f32x4*)(out + (cisv ? O_VWS : O_KWS)) + cdst);
        }
#pragma unroll
        for (int j4 = 0; j4 < 16; ++j4) { const f32x4 d4 = *(LAS const f32x4*)(dend + 4 * j4);
            S[4 * j4] *= d4[0]; S[4 * j4 + 1] *= d4[1]; S[4 * j4 + 2] *= d4[2]; S[4 * j4 + 3] *= d4[3];
            P[4 * j4] *= d4[0]; P[4 * j4 + 1] *= d4[1]; P[4 * j4 + 2] *= d4[2]; P[4 * j4 + 3] *= d4[3]; }
    }
    float* so = SLOC + ((size_t)((b * NH + h) * NCHUNK + c) * 64 + lane) * 64;
    float* po = PHI + ((size_t)((b * NH + h) * NCHUNK + c) * 64 + lane) * 64;
#pragma unroll
    for (int j4 = 0; j4 < 16; ++j4) { *(GAS f32x4*)(so + 4 * j4) = (f32x4){S[4 * j4], S[4 * j4 + 1], S[4 * j4 + 2], S[4 * j4 + 3]}; *(GAS f32x4*)(po + 4 * j4) = (f32x4){P[4 * j4], P[4 * j4 + 1], P[4 * j4 + 2], P[4 * j4 + 3]}; }
}
__device__ __forceinline__ void rwkv_sample(const Ctx& C, const bf16* ZB, const bf16* LAM, const bf16* AA, const bf16* G, const RwkvW& W, const float* state_wkv, const float* state_shift, bf16* HEADS, float* out) {
    if (C.vcu >= SB * NH || C.wave != 0) return;
    const int b = C.vcu >> 3, h = C.vcu & 7, lane = C.lane, hc = h * 64 + lane;
    LAS float* tk = (LAS float*)(C.lds + 98304);
    LAS float* Sl = (LAS float*)(C.lds + 98304 + 2048) + lane * 65;
    const float* s0 = state_wkv + ((size_t)(b * NH + h) * 64 + lane) * 64;
#pragma unroll 4
    for (int j = 0; j < 64; ++j) Sl[j] = s0[j];
    float pr = state_shift[(size_t)b * DBIN + hc], pk = state_shift[(size_t)b * DBIN + 512 + hc], pv = state_shift[(size_t)b * DBIN + 1024 + hc];
#pragma unroll 1
    for (int s = 0; s < SS; ++s) {
        const size_t row = (size_t)MPR + b * SS + s; const bf16* zp = ZB + row * DBIN + hc;
        const float zr = bf1(zp[0]), zk = bf1(zp[512]), zv = bf1(zp[1024]);
        const RwkvTok o = rwkv_tok(zr, zk, zv, pr, pk, pv, bf1(LAM[row * CB + hc]), bf1(AA[row * CB + hc]), W.mu[hc], W.mu[512 + hc], W.mu[1024 + hc], W.k_k[hc], W.k_a[hc], W.r_k[hc], lane);
        pr = zr; pk = zk; pv = zv;
        tk[lane] = o.nkk; tk[64 + lane] = o.ka; tk[128 + lane] = o.d; tk[192 + lane] = o.kp; tk[256 + lane] = o.r;
        LDS_WAIT(); asm volatile("" ::: "memory");
        float sa = 0.f;
#pragma unroll 4
        for (int j = 0; j < 64; ++j) sa = fmaf(Sl[j], tk[j], sa);
        float y = 0.f;
#pragma unroll 4
        for (int j = 0; j < 64; ++j) { float t = o.v * tk[192 + j]; t = fmaf(sa, tk[64 + j], t); const float sn = fmaf(Sl[j], tk[128 + j], t); Sl[j] = sn; y = fmaf(sn, tk[256 + j], y); }
        const float ym = wave_sum(y, lane) * (1.0f / 64.0f), dy = y - ym, yv = wave_sum(dy * dy, lane) * (1.0f / 64.0f);
        const float yn = dy * __builtin_amdgcn_rsqf(yv + GN_EPS) * W.lnx_w[hc] + W.lnx_b[hc];
        const float res = (yn + o.bon * o.v) * bf1(G[row * CB + hc]);
        HEADS[row * DM + CA + hc] = (bf16)(cvtpk(res, 0.f) & 0xffffu);
        LDS_WAIT(); asm volatile("" ::: "memory");
    }
    float* so = out + O_WKVS + ((size_t)(b * NH + h) * 64 + lane) * 64;
#pragma unroll 4
    for (int j = 0; j < 64; ++j) so[j] = Sl[j];
}

__device__ __forceinline__ void rwkv_carry(const Ctx& C, const float* PHI, const float* SLOC, float* SC, float* out) {
    const int bh = C.vcu >> 2, rq = C.vcu & 3, tid = C.tid;
    if (bh >= NBATCH * NH) return;
    LAS float* cur = (LAS float*)(C.lds);
    LAS float* phi = (LAS float*)(C.lds + 8192);
    const int row = tid >> 5, cp = tid & 31;
    const size_t gbase = ((size_t)(bh * NCHUNK) * 64 + rq * 16 + row) * 64 + 2 * cp;
    f32x4 pre[2]; f32x2_t sl;
    { const float* p0 = PHI + (size_t)(bh * NCHUNK) * 4096; pre[0] = *(const GAS f32x4*)(p0 + tid * 4); pre[1] = *(const GAS f32x4*)(p0 + 2048 + tid * 4); sl = *(const GAS f32x2_t*)(SLOC + gbase); }
    f32x2_t cv = {0.f, 0.f};
    for (int c = 0; c < NCHUNK; ++c) {
        LAS float* ph = phi + (c & 1) * 4096;
        *(LAS f32x4*)(ph + tid * 4) = pre[0]; *(LAS f32x4*)(ph + 2048 + tid * 4) = pre[1];
        *(LAS f32x2_t*)(cur + (c & 1) * 1024 + row * 64 + 2 * cp) = cv;
        const f32x2_t slc = sl;
        if (c + 1 < NCHUNK) { const float* p1 = PHI + (size_t)(bh * NCHUNK + c + 1) * 4096; pre[0] = *(const GAS f32x4*)(p1 + tid * 4); pre[1] = *(const GAS f32x4*)(p1 + 2048 + tid * 4); sl = *(const GAS f32x2_t*)(SLOC + gbase + (size_t)(c + 1) * 4096); }
        *(GAS f32x2_t*)(SC + gbase + (size_t)c * 4096) = cv;
        __syncthreads();
        LAS const float* cr_ = cur + (c & 1) * 1024 + row * 64;
        float a0 = slc[0], a1 = slc[1];
#pragma unroll 4
        for (int k4 = 0; k4 < 16; ++k4) { const f32x4 cr = *(LAS const f32x4*)(cr_ + 4 * k4);
#pragma unroll
            for (int e = 0; e < 4; ++e) { const f32x2_t pv = *(LAS const f32x2_t*)(ph + (4 * k4 + e) * 64 + 2 * cp); a0 = fmaf(cr[e], pv[0], a0); a1 = fmaf(cr[e], pv[1], a1); } }
        cv = (f32x2_t){a0, a1};
    }
    *(GAS f32x2_t*)(out + O_WKVP + ((size_t)bh * 64 + rq * 16 + row) * 64 + 2 * cp) = cv;
    __syncthreads();
}

__device__ __forceinline__ void rwkv_finish(const Ctx& C, const float* YL, const float* U, const float* SC, const bf16* BV, const bf16* G, const RwkvW& W, bf16* HEADS) {
    constexpr int FP = 68;
    const int tid = C.tid, lane = C.lane, r32 = lane & 31, hi = lane >> 5, slot = C.wave >> 2, wq = C.wave & 3, t256 = tid & 255;
    LAS float* Ss = (LAS float*)(C.lds + slot * 52224);
    LAS float* Us = Ss + 64 * FP;
    if ((C.vcu >> 2) >= NBATCH * NH) return;
    for (int pass = 0; pass < 4; ++pass) {
        const int item = C.vcu * 8 + pass * 2 + slot, bh = item >> 5, c = item & 31, b = bh >> 3, h = bh & 7;
        const float* sc = SC + (size_t)(bh * NCHUNK + c) * 4096;
        const size_t row0 = (size_t)b * TSEQ + c * CHL;
#pragma unroll
        for (int k = 0; k < 4; ++k) { const int e = t256 * 4 + k * 1024; *(LAS f32x4*)(Ss + (e >> 6) * FP + (e & 63)) = *(const GAS f32x4*)(sc + e); }
#pragma unroll
        for (int k = 0; k < 8; ++k) { const int e = t256 * 4 + k * 1024, t = e >> 6, j = e & 63; *(LAS f32x4*)(Us + t * FP + j) = *(const GAS f32x4*)(U + (row0 + t) * CB + h * 64 + j); }
        __syncthreads();
        const size_t row = row0 + wq * 32 + r32;
        f32x16 acc[2];
#pragma unroll
        for (int tl = 0; tl < 2; ++tl)
#pragma unroll
            for (int g4 = 0; g4 < 4; ++g4) { const f32x4 v = *(const GAS f32x4*)(YL + row * CB + h * 64 + 32 * tl + 8 * g4 + 4 * hi); acc[tl][4 * g4] = v[0]; acc[tl][4 * g4 + 1] = v[1]; acc[tl][4 * g4 + 2] = v[2]; acc[tl][4 * g4 + 3] = v[3]; }
        LAS const float* ua = Us + (wq * 32 + r32) * FP + 4 * hi;
        LAS const float* sa0 = Ss + r32 * FP + 4 * hi;
#pragma unroll
        for (int q = 0; q < 8; ++q) {
            const f32x4 b4 = *(LAS const f32x4*)(ua + 8 * q), a0 = *(LAS const f32x4*)(sa0 + 8 * q), a1 = *(LAS const f32x4*)(sa0 + 32 * FP + 8 * q);
#pragma unroll
            for (int e = 0; e < 4; ++e) { acc[0] = __builtin_amdgcn_mfma_f32_32x32x2f32(a0[e], b4[e], acc[0], 0, 0, 0); acc[1] = __builtin_amdgcn_mfma_f32_32x32x2f32(a1[e], b4[e], acc[1], 0, 0, 0); }
        }
        float sm = 0.f;
#pragma unroll
        for (int tl = 0; tl < 2; ++tl)
#pragma unroll
            for (int e = 0; e < 16; ++e) sm += acc[tl][e];
        sm += shx(sm, 32, lane);
        const float ym = sm * (1.0f / 64.0f); float sv = 0.f;
#pragma unroll
        for (int tl = 0; tl < 2; ++tl)
#pragma unroll
            for (int e = 0; e < 16; ++e) { const float d = acc[tl][e] - ym; acc[tl][e] = d; sv += d * d; }
        sv += shx(sv, 32, lane);
        const float rs = __builtin_amdgcn_rsqf(sv * (1.0f / 64.0f) + GN_EPS);
#pragma unroll
        for (int tl = 0; tl < 2; ++tl)
#pragma unroll
            for (int g4 = 0; g4 < 4; ++g4) { const int ic = h * 64 + 32 * tl + 8 * g4 + 4 * hi;
                const f32x4 lw = *(const GAS f32x4*)(W.lnx_w + ic), lb = *(const GAS f32x4*)(W.lnx_b + ic);
                const u32x2 bw = *(const GAS u32x2*)(BV + row * CB + ic), gw = *(const GAS u32x2*)(G + row * CB + ic);
                const float r0 = (acc[tl][4 * g4] * rs * lw[0] + lb[0] + bflo(bw.x)) * bflo(gw.x), r1 = (acc[tl][4 * g4 + 1] * rs * lw[1] + lb[1] + bfhi(bw.x)) * bfhi(gw.x);
                const float r2 = (acc[tl][4 * g4 + 2] * rs * lw[2] + lb[2] + bflo(bw.y)) * bflo(gw.y), r3 = (acc[tl][4 * g4 + 3] * rs * lw[3] + lb[3] + bfhi(bw.y)) * bfhi(gw.y);
                u32x2 ow; ow.x = cvtpk(r0, r1); ow.y = cvtpk(r2, r3);
                *(GAS u32x2*)(HEADS + row * DM + CA + ic) = ow; }
        __syncthreads();
    }
}

template <int U> __device__ __forceinline__ f32x16 thin_acc(const bf16* ap, const bf16* bp, int klen, f32x16 acc) {
#pragma unroll 1
    for (int k = 0; k < klen; k += 16 * U) {
        bf16x8 a[U], b[U];
#pragma unroll
        for (int u = 0; u < U; ++u) { a[u] = *(const GAS bf16x8*)(ap + k + 16 * u); b[u] = *(const GAS bf16x8*)(bp + k + 16 * u); }
#pragma unroll
        for (int u = 0; u < U; ++u) acc = __builtin_amdgcn_mfma_f32_32x32x16_bf16(a[u], b[u], acc, 0, 0, 0);
    }
    return acc;
}
#define F16Z (f32x16){0.f, 0.f, 0.f, 0.f, 0.f, 0.f, 0.f, 0.f, 0.f, 0.f, 0.f, 0.f, 0.f, 0.f, 0.f, 0.f}
#define THIN_LOOP(ntiles) const int lane = C.lane, r32 = lane & 31, hi = lane >> 5; for (int t = (255 - (int)blockIdx.x) * NWAVES + C.wave; t < (ntiles); t += 256 * NWAVES)
__device__ __forceinline__ void thin_lora(const Ctx& C, const bf16* AP, const bf16* Wl, const float* w0, const float* a0, bf16* LAM) {
    THIN_LOOP(192) { const int grp = t >> 6, rb = (t >> 4) & 3, cb = t & 15, koff = grp == 0 ? 0 : grp == 1 ? 64 : 128, klen = grp == 2 ? 128 : 64;
        const f32x16 acc = thin_acc<4>(AP + (size_t)(MPR + rb * 32 + r32) * 256 + koff + 8 * hi, Wl + (size_t)(grp * 512 + cb * 32 + r32) * 256 + koff + 8 * hi, klen, F16Z);
        const int n = cb * 32 + r32; const float bias = grp == 0 ? w0[n] : grp == 1 ? a0[n] : 0.f, mul = grp == 0 ? 0.6065306597126334f : 1.0f;
        bf16* dst = LAM + (size_t)grp * ((size_t)MT * CB);
#pragma unroll
        for (int i = 0; i < 16; ++i) { float v = acc[i] + bias; if (grp < 2) v = mul * sigm(v); dst[(size_t)(MPR + rb * 32 + crow(i, hi)) * CB + n] = (bf16)(cvtpk(v, 0.f) & 0xffffu); } }
}
#define THIN_WG_LOOP(ntiles) const int lane = C.lane, r32 = lane & 31, hi = lane >> 5, wv = C.wave; for (int t = 255 - (int)blockIdx.x; t < (ntiles); t += 256)
template <int NACC> __device__ __forceinline__ void thin_reduce(const Ctx& C, const f32x16 (&acc)[NACC], float (&res)[NACC][2]) {
    LAS float* red = (LAS float*)C.lds;
#pragma unroll
    for (int a = 0; a < NACC; ++a)
#pragma unroll
        for (int i = 0; i < 16; ++i) red[((a * 8 + C.wave) * 16 + i) * 64 + C.lane] = acc[a][i];
    __syncthreads();
#pragma unroll
    for (int a = 0; a < NACC; ++a)
#pragma unroll
        for (int q = 0; q < 2; ++q) { float s = 0.f;
#pragma unroll
            for (int w = 0; w < 8; ++w) s += red[((a * 8 + w) * 16 + 2 * C.wave + q) * 64 + C.lane];
            res[a][q] = s; }
    __syncthreads();
}
__device__ __forceinline__ void thin_wout(const Ctx& C, const bf16* HEADS, const bf16* Wout, const float* xs, float* PRE) {
    THIN_WG_LOOP(128) { const int rb = t >> 5, cb = t & 31, n = cb * 32 + r32;
        f32x16 acc[1]; float res[1][2];
        acc[0] = thin_acc<8>(HEADS + (size_t)(MPR + rb * 32 + r32) * DM + 8 * hi + wv * 128, Wout + (size_t)n * DM + 8 * hi + wv * 128, 128, F16Z);
        thin_reduce<1>(C, acc, res);
#pragma unroll
        for (int q = 0; q < 2; ++q) { const int rs = rb * 32 + crow(2 * wv + q, hi); PRE[(size_t)(MPR + rs) * DM + n] = res[0][q] + ALPHA * xs[(size_t)rs * DM + n]; } }
}
__device__ __forceinline__ void thin_gu(const Ctx& C, const bf16* H1, const bf16* Wgu, bf16* ACT) {
    THIN_WG_LOOP(352) { const int rb = t / 88, fb = t % 88, f = fb * 32 + r32, grow = (f >> 7) * 256 + (f & 127);
        const bf16* ap = H1 + (size_t)(MPR + rb * 32 + r32) * DM + 8 * hi + wv * 128;
        f32x16 acc[2]; float res[2][2];
        acc[0] = thin_acc<8>(ap, Wgu + (size_t)grow * DM + 8 * hi + wv * 128, 128, F16Z);
        acc[1] = thin_acc<8>(ap, Wgu + (size_t)(grow + 128) * DM + 8 * hi + wv * 128, 128, F16Z);
        thin_reduce<2>(C, acc, res);
#pragma unroll
        for (int q = 0; q < 2; ++q) { const float g = res[0][q]; ACT[(size_t)(MPR + rb * 32 + crow(2 * wv + q, hi)) * DFF + f] = (bf16)(cvtpk(g * sigm(g) * res[1][q], 0.f) & 0xffffu); } }
}
__device__ __forceinline__ void thin_down(const Ctx& C, const bf16* ACT, const bf16* Wd, const bf16* H1, float* PRE) {
    THIN_WG_LOOP(128) { const int rb = t >> 5, cb = t & 31, n = cb * 32 + r32;
        f32x16 acc[1]; float res[1][2];
        acc[0] = thin_acc<11>(ACT + (size_t)(MPR + rb * 32 + r32) * DFF + 8 * hi + wv * 352, Wd + (size_t)n * DFF + 8 * hi + wv * 352, 352, F16Z);
        thin_reduce<1>(C, acc, res);
#pragma unroll
        for (int q = 0; q < 2; ++q) { const size_t o = (size_t)(MPR + rb * 32 + crow(2 * wv + q, hi)) * DM + n; PRE[o] = res[0][q] + ALPHA * bf1(H1[o]); } }
}
__device__ __forceinline__ void thin_pp(const Ctx& C, const bf16* PB, const bf16* Wpp, bf16* PP) {
    THIN_WG_LOOP(128) { const int rb = t >> 5, cb = t & 31, n = cb * 32 + r32;
        f32x16 acc[1]; float res[1][2];
        acc[0] = thin_acc<2>(PB + (size_t)(MPR + rb * 32 + r32) * PLE + 8 * hi + wv * 32, Wpp + (size_t)n * PLE + 8 * hi + wv * 32, 32, F16Z);
        thin_reduce<1>(C, acc, res);
#pragma unroll
        for (int q = 0; q < 2; ++q) PP[(size_t)(MPR + rb * 32 + crow(2 * wv + q, hi)) * DM + n] = (bf16)(cvtpk(res[0][q], 0.f) & 0xffffu); }
}
__device__ __forceinline__ void thin_pg(const Ctx& C, const bf16* H2, const bf16* Wpg, const bf16* PP, float* PRE) {
    THIN_WG_LOOP(128) { const int rb = t >> 5, cb = t & 31, n = cb * 32 + r32;
        f32x16 acc[1]; float res[1][2];
        acc[0] = thin_acc<8>(H2 + (size_t)(MPR + rb * 32 + r32) * DM + 8 * hi + wv * 128, Wpg + (size_t)n * DM + 8 * hi + wv * 128, 128, F16Z);
        thin_reduce<1>(C, acc, res);
#pragma unroll
        for (int q = 0; q < 2; ++q) { const size_t o = (size_t)(MPR + rb * 32 + crow(2 * wv + q, hi)) * DM + n; PRE[o] = ALPHA * bf1(H2[o]) + sigm(res[0][q]) * bf1(PP[o]); } }
}

template <int MODE> __device__ __forceinline__ void ln_pass(const Ctx& C, const float* PRE, const float* w, const float* bsh, bf16* Hout, float* out) {
    const int gw = C.vcu * NWAVES + C.wave, NGW = C.G * NWAVES, lane = C.lane;
    f32x4 wv[4], bv[4];
#pragma unroll
    for (int j = 0; j < 4; ++j) { wv[j] = *(const GAS f32x4*)(w + 256 * j + 4 * lane); bv[j] = *(const GAS f32x4*)(bsh + 256 * j + 4 * lane); }
    for (int row = gw; row < MPR + MSA; row += NGW) {
        const GAS f32x4* xr = (const GAS f32x4*)(PRE + (size_t)row * DM) + lane;
        f32x4 v[4]; float s = 0.f;
#pragma unroll
        for (int j = 0; j < 4; ++j) { v[j] = xr[64 * j]; s += (v[j][0] + v[j][1]) + (v[j][2] + v[j][3]); }
        const float mean = wave_sum(s, lane) * (1.f / DM); float s2 = 0.f;
#pragma unroll
        for (int j = 0; j < 4; ++j) { v[j] = v[j] - mean; s2 += (v[j][0] * v[j][0] + v[j][1] * v[j][1]) + (v[j][2] * v[j][2] + v[j][3] * v[j][3]); }
        const float rstd = __builtin_amdgcn_rsqf(wave_sum(s2, lane) * (1.f / DM) + LN_EPS);
        if (MODE == 0) {
            GAS u32x2* o8 = (GAS u32x2*)(Hout + (size_t)row * DM) + lane;
#pragma unroll
            for (int j = 0; j < 4; ++j) { const f32x4 o = v[j] * rstd * wv[j] + bv[j]; u32x2 wq; wq.x = cvtpk(o[0], o[1]); wq.y = cvtpk(o[2], o[3]); o8[64 * j] = wq; }
        } else {
            float* dst = row < MPR ? out + O_YP + (size_t)row * DM : out + O_YS + (size_t)(row - MPR) * DM;
#pragma unroll
            for (int j = 0; j < 4; ++j) *((GAS f32x4*)dst + lane + 64 * j) = v[j] * rstd * wv[j] + bv[j];
        }
    }
}
struct Args { const float* in[32]; float* out; unsigned char* ws; int nphase, pad; };
#ifndef PHMASK
#define PHMASK 0xFFFFFF
#endif
#ifndef REPPH
#define REPPH -1
#endif
#ifndef REPN
#define REPN 3
#endif
#define PHON(n) if constexpr (((PHMASK) >> (n)) & 1) for (int rep_ = 0; rep_ < ((n) == (REPPH) ? (REPN) : 1); ++rep_)
#ifndef GEMM_ALIGN
#define GEMM_ALIGN true
#endif
#ifndef GEMM_SP2
#define GEMM_SP2 true
#endif
__global__ void __launch_bounds__(NWAVES * 64, 2) mega_fwd(Args args) {
    extern __shared__ __attribute__((aligned(16))) unsigned char lds_raw[];
    LAS unsigned char* const lds0 = (LAS unsigned char*)lds_raw;
    volatile LAS unsigned* MISC = (volatile LAS unsigned*)(lds0 + MISC_OFF);
    const int G0 = gridDim.x;
    for (int u = threadIdx.x; u < (LDS_BYTES - LDSCTL_OFF) / 4; u += NWAVES * 64) ((LAS unsigned*)(lds0 + LDSCTL_OFF))[u] = 0u;
    __syncthreads();
    gu32* ctl = (gu32*)(args.ws + WS_CTL);
    XcdBarrier bar = xcd_barrier_post((unsigned*)(ctl + CW_BAR), MISC + 8);
    const int nph = args.nphase;
#define GRID_BAR() xcd_barrier(bar)
    typedef const __attribute__((address_space(4))) Args* KArgs;
#define PH_BEGIN Ctx C; { int t_ = threadIdx.x; asm volatile("" : "+v"(t_)); C.lds = lds0; C.tid = t_; C.lane = t_ & 63; C.wave = __builtin_amdgcn_readfirstlane(t_ >> 6); C.G = G0; const int bx_ = blockIdx.x; C.vcu = (G0 % 8 == 0) ? (bx_ % 8) * (G0 / 8) + bx_ / 8 : bx_; } KArgs kp = (KArgs)__builtin_amdgcn_kernarg_segment_ptr(); asm volatile("" : "+s"(kp)); unsigned char* ws = kp->ws; float* out = kp->out; (void)ws; (void)out;
#define IN_(i) (kp->in[i])
#define WSB(off) ((bf16*)(ws + (off)))
#define WSF(off) ((float*)(ws + (off)))
    const int bx = (int)blockIdx.x;

    PHON(0) { PH_BEGIN P0Args A{IN_(0), IN_(1), IN_(2), IN_(3), IN_(4), IN_(5), IN_(8), IN_(20), IN_(23), IN_(24), IN_(25), IN_(28), IN_(29), IN_(11), IN_(13), IN_(14),
                       WSB(WS_WIN), WSB(WS_WOUT), WSB(WS_WGU), WSB(WS_WD), WSB(WS_WPG), WSB(WS_WPP), WSB(WS_WL), WSB(WS_R1), WSB(WS_PB), out};
      p0_prologue(C, A); }
    GRID_BAR(); if (nph <= 1) return;
    PHON(1) { PH_BEGIN pg8::Gemm g{WSB(WS_R1), WSB(WS_WIN), MT, DIN, DM}; pg8::StaticOrder S; S.init(MT, DIN, C.G, bx);
      pg8::EpiZ E{WSB(WS_QB), WSB(WS_ZB), out};
      pg8::gemm_phase<pg8::EpiZ, pg8::StaticOrder, GEMM_ALIGN, GEMM_SP2>(C.lds + RING_OFF, g, S, E); }
    GRID_BAR(); if (nph <= 2) return;
    PHON(2) { PH_BEGIN prep_a(C, WSB(WS_ZB), IN_(9), IN_(7), WSB(WS_AP), out); }
    PHON(3) { PH_BEGIN attn_prompt(C, WSB(WS_QB), WSB(WS_KB), WSB(WS_VB), WSB(WS_OG), WSF(WS_LSE)); }
    PHON(4) { PH_BEGIN attn_sample(C, WSB(WS_QB), IN_(4), IN_(5), out, WSB(WS_R1)); }
    GRID_BAR(); if (nph <= 3) return;
    PHON(5) { PH_BEGIN pg8::Gemm g{WSB(WS_AP), WSB(WS_WL), MPR, 1536, 256}; pg8::StaticOrder S; S.init(MPR, 1536, C.G, bx);
      pg8::EpiLora E{WSB(WS_QB), IN_(10), IN_(12)};
      pg8::gemm_phase<pg8::EpiLora, pg8::StaticOrder, GEMM_ALIGN, GEMM_SP2>(C.lds + RING_OFF, g, S, E);
      thin_lora(C, WSB(WS_AP), WSB(WS_WL), IN_(10), IN_(12), WSB(WS_QB)); }
    PHON(6) { PH_BEGIN attn_merge(C, WSB(WS_OG), WSF(WS_LSE), WSB(WS_R1)); }
    GRID_BAR(); if (nph <= 4) return;
    PHON(7) { PH_BEGIN const RwkvW RW{IN_(9), IN_(15), IN_(16), IN_(17), IN_(18), IN_(19)};
      rwkv_sample(C, WSB(WS_ZB), WSB(WS_QB), WSB(WS_KB), WSB(WS_VB), RW, IN_(6), IN_(7), WSB(WS_R1), out); }
    PHON(8) { PH_BEGIN const RwkvW RW{IN_(9), IN_(15), IN_(16), IN_(17), IN_(18), IN_(19)};
      const int bh = C.vcu >> 2, c = (C.vcu & 3) * 8 + C.wave;
      if (bh < NBATCH * NH) rwkv_chunk(C, WSB(WS_ZB), WSB(WS_QB), WSB(WS_KB), RW, out + O_YP, out + O_YP + (size_t)MPR * CB, WSB(WS_BV), WSF(WS_PHI), WSF(WS_SLOC), bh >> 3, bh & 7, c, IN_(4), IN_(5), out); }
    GRID_BAR(); if (nph <= 5) return;
    PHON(9) { PH_BEGIN rwkv_carry(C, WSF(WS_PHI), WSF(WS_SLOC), WSF(WS_SC), out); }
    GRID_BAR(); if (nph <= 6) return;
    PHON(10) { PH_BEGIN const RwkvW RW{IN_(9), IN_(15), IN_(16), IN_(17), IN_(18), IN_(19)};
      rwkv_finish(C, out + O_YP, out + O_YP + (size_t)MPR * CB, WSF(WS_SC), WSB(WS_BV), WSB(WS_VB), RW, WSB(WS_R1)); }
    GRID_BAR(); if (nph <= 7) return;
    PHON(11) { PH_BEGIN pg8::Gemm g{WSB(WS_R1), WSB(WS_WOUT), MPR, DM, DM}; pg8::StaticOrder S; S.init(MPR, DM, C.G, bx);
      pg8::EpiWout E{WSF(WS_PRE), IN_(0), IN_(1)};
      pg8::gemm_phase<pg8::EpiWout, pg8::StaticOrder, GEMM_ALIGN, GEMM_SP2>(C.lds + RING_OFF, g, S, E);
      thin_wout(C, WSB(WS_R1), WSB(WS_WOUT), IN_(1), WSF(WS_PRE)); }
    PHON(16) { PH_BEGIN pg8::Gemm g{WSB(WS_PB), WSB(WS_WPP), MPR, DM, PLE}; pg8::StaticOrder S; S.init(MPR, DM, C.G, bx);
      pg8::EpiPlain E{WSB(WS_PP)};
      pg8::gemm_phase<pg8::EpiPlain, pg8::StaticOrder, GEMM_ALIGN, GEMM_SP2>(C.lds + RING_OFF, g, S, E);
      thin_pp(C, WSB(WS_PB), WSB(WS_WPP), WSB(WS_PP)); }
    GRID_BAR(); if (nph <= 8) return;
    PHON(12) { PH_BEGIN ln_pass<0>(C, WSF(WS_PRE), IN_(21), IN_(22), WSB(WS_R1), out); }
    GRID_BAR(); if (nph <= 9) return;
    PHON(13) { PH_BEGIN pg8::Gemm g{WSB(WS_R1), WSB(WS_WGU), MPR, 2 * DFF, DM}; pg8::StaticOrder S; S.init(MPR, 2 * DFF, C.G, bx);
      pg8::EpiGU E{WSB(WS_ACT)};
      pg8::gemm_phase<pg8::EpiGU, pg8::StaticOrder, GEMM_ALIGN, GEMM_SP2>(C.lds + RING_OFF, g, S, E);
      thin_gu(C, WSB(WS_R1), WSB(WS_WGU), WSB(WS_ACT)); }
    GRID_BAR(); if (nph <= 10) return;
    PHON(14) { PH_BEGIN pg8::Gemm g{WSB(WS_ACT), WSB(WS_WD), MPR, DM, DFF}; pg8::StaticOrder S; S.init(MPR, DM, C.G, bx);
      pg8::EpiDown E{WSF(WS_PRE), WSB(WS_R1)};
      pg8::gemm_phase<pg8::EpiDown, pg8::StaticOrder, GEMM_ALIGN, GEMM_SP2>(C.lds + RING_OFF, g, S, E);
      thin_down(C, WSB(WS_ACT), WSB(WS_WD), WSB(WS_R1), WSF(WS_PRE)); }
    GRID_BAR(); if (nph <= 11) return;
    PHON(15) { PH_BEGIN ln_pass<0>(C, WSF(WS_PRE), IN_(26), IN_(27), WSB(WS_H2), out); }
    GRID_BAR(); if (nph <= 12) return;
    PHON(17) { PH_BEGIN pg8::Gemm g{WSB(WS_H2), WSB(WS_WPG), MPR, DM, DM}; pg8::StaticOrder S; S.init(MPR, DM, C.G, bx);
      pg8::EpiPle E{WSF(WS_PRE), WSB(WS_H2), WSB(WS_PP)};
      pg8::gemm_phase<pg8::EpiPle, pg8::StaticOrder, GEMM_ALIGN, GEMM_SP2>(C.lds + RING_OFF, g, S, E);
      thin_pg(C, WSB(WS_H2), WSB(WS_WPG), WSB(WS_PP), WSF(WS_PRE)); }
    GRID_BAR(); if (nph <= 14) return;
    PHON(18) { PH_BEGIN ln_pass<1>(C, WSF(WS_PRE), IN_(30), IN_(31), nullptr, out); }
}

#ifndef N_PHASES
#define N_PHASES 99
#endif
extern "C" void kernel_launch(void* const* d_in, const int* in_sizes, int n_in, void* d_out, int out_size, void* d_ws, size_t ws_size, hipStream_t stream) {
    static int grid = 0;
    if (grid == 0) {
        if (n_in != 32 || in_sizes[0] != MPR * DM || (size_t)out_size != O_END || ws_size < WS_END) {
            fprintf(stderr, "kernel_launch: unexpected shapes: n_in %d in0 %d out %d (want %zu) ws %zu (want >= %zu); nothing launched\n", n_in, n_in > 0 ? in_sizes[0] : -1, out_size, (size_t)O_END, ws_size, (size_t)WS_END);
            grid = -1; return; }
        int dev = 0, cus = 0, per_cu = 0;
        if (hipGetDevice(&dev) != hipSuccess || hipDeviceGetAttribute(&cus, hipDeviceAttributeMultiprocessorCount, dev) != hipSuccess) { fprintf(stderr, "kernel_launch: device query failed\n"); grid = -1; return; }
        if (hipFuncSetAttribute((const void*)mega_fwd, hipFuncAttributeMaxDynamicSharedMemorySize, LDS_BYTES) != hipSuccess) { fprintf(stderr, "kernel_launch: hipFuncSetAttribute failed\n"); grid = -1; return; }
        if (hipOccupancyMaxActiveBlocksPerMultiprocessor(&per_cu, (const void*)mega_fwd, NWAVES * 64, LDS_BYTES) != hipSuccess || per_cu < 1) { fprintf(stderr, "kernel_launch: occupancy query reports %d blocks per CU\n", per_cu); }
        (void)hipGetLastError();
        grid = cus;
        if (grid != 256) fprintf(stderr, "kernel_launch: note: %d CUs (work distribution assumes 256)\n", grid);
    }
    if (grid < 0) return;
    if (hipMemsetAsync((char*)d_ws + WS_CTL, 0, CTL_ZERO_BYTES, stream) != hipSuccess) { fprintf(stderr, "kernel_launch: memset failed\n"); return; }
    Args a{};
    for (int i = 0; i < 32; ++i) a.in[i] = (const float*)d_in[i];
    a.out = (float*)d_out; a.ws = (unsigned char*)d_ws; a.nphase = N_PHASES; a.pad = 0;
    hipLaunchKernelGGL(mega_fwd, dim3(grid), dim3(NWAVES * 64), LDS_BYTES, stream, a);
    const hipError_t le = hipPeekAtLastError();
    if (le != hipSuccess) fprintf(stderr, "kernel_launch: launch failed: %s\n", hipGetErrorName(le));
}
```

```cpp
#include <hip/hip_runtime.h>
#include <cstdio>
#include <cstdint>
constexpr int DM = 1024, TSEQ = 4096, NBATCH = 8, MPR = NBATCH * TSEQ;
constexpr int SB = 32, SS = 4, MSA = SB * SS;
constexpr int MT = MPR + 256;
constexpr int CA = 512, CB = 512, DBIN = 1792, DIN = 3328, DFF = 2816, PLE = 256, HD = 64, NH = 8;
constexpr int WINL = 2048;
constexpr float ALPHA = 1.18920711500272f;
constexpr float LN_EPS = 1e-5f, GN_EPS = 64e-5f;
constexpr float QSCALE = 0.125f * 1.4426950408889634f;
constexpr float LOG2E = 1.4426950408889634f;
constexpr size_t O_YP = 0, O_YS = O_YP + (size_t)MPR * DM, O_KWP = O_YS + (size_t)MSA * DM, O_VWP = O_KWP + (size_t)NBATCH * WINL * CA,
                 O_WKVP = O_VWP + (size_t)NBATCH * WINL * CA, O_SHP = O_WKVP + (size_t)NBATCH * NH * HD * HD, O_KWS = O_SHP + (size_t)NBATCH * DBIN,
                 O_VWS = O_KWS + (size_t)SB * WINL * CA, O_WKVS = O_VWS + (size_t)SB * WINL * CA, O_SHS = O_WKVS + (size_t)SB * NH * HD * HD,
                 O_END = O_SHS + (size_t)SB * DBIN;
namespace pg8 {
#define PG8_LAS __attribute__((address_space(3)))
typedef unsigned short bf16_t;
typedef short bf16x8 __attribute__((ext_vector_type(8)));
typedef float f32x4 __attribute__((ext_vector_type(4)));
typedef unsigned u32x4 __attribute__((ext_vector_type(4)));
constexpr int BM = 256, BK = 64, HALF = 128, HTB = HALF * BK * 2  , STAGE_BYTES = 8 * HTB, NXCD = 8, WGM = 8;

__host__ __device__ __forceinline__ int lds_byte(int r, int c) { const int st = (r >> 4) * 2 + (c >> 5), rr = r & 15, cc = c & 31, ob = rr * 64 + cc * 2; return st * 1024 + (ob ^ (((ob >> 9) & 1) << 5)); }
__host__ __device__ __forceinline__ void stage_rc(int b, int& R, int& C) { const int st = b / 1024, sb = b % 1024, swz = sb ^ (((sb >> 9) & 1) << 5); R = (st >> 1) * 16 + swz / 64; C = (st & 1) * 32 + (swz % 64) / 2; }
__host__ __device__ __forceinline__ int perm32(int rho) { const int n = rho >> 4, i = rho & 15; return 8 * (i >> 2) + 4 * n + (i & 3); }

struct Unit { int pm, pn; };
struct Gemm { const bf16_t* A; const bf16_t* Bt; int M, N, K; };

struct StaticOrder {
    int nM, nN, nwg, G, c;
    __host__ __device__ void init(int M, int N, int G_, int c_) { nM = M / BM; nN = N / BM; nwg = nM * nN; G = G_; c = c_; }
    __host__ __device__ bool next(int i, Unit& u) const {
        const long L = (long)i * G + c; if (L >= nwg) return false;
        int wgid = (int)L; { const int q = nwg / NXCD, r = nwg % NXCD, xcd = wgid % NXCD, off = wgid / NXCD; wgid = (xcd < r ? xcd * (q + 1) : r * (q + 1) + (xcd - r) * q) + off; }
        const int nig = WGM * nN, gid = wgid / nig, fm = gid * WGM, gsz = (nM - fm) < WGM ? (nM - fm) : WGM;
        u.pm = fm + ((wgid % nig) % gsz); u.pn = (wgid % nig) / gsz; return true;
    }
    __device__ __forceinline__ void a_ready(const Unit&) const {}
    __device__ __forceinline__ void done(const Unit&) const {}
};

typedef unsigned u32x2 __attribute__((ext_vector_type(2)));
__device__ __forceinline__ unsigned cvt_pk_bf16(float lo, float hi) { unsigned r; asm volatile("v_cvt_pk_bf16_f32 %0, %1, %2" : "=v"(r) : "v"(lo), "v"(hi)); return r; }
__device__ __forceinline__ float bf_lo(unsigned w) { return __uint_as_float(w << 16); }
__device__ __forceinline__ float bf_hi(unsigned w) { return __uint_as_float(w & 0xffff0000u); }
__device__ __forceinline__ float sigmoidf_(float x) { return __builtin_amdgcn_rcpf(1.0f + __builtin_amdgcn_exp2f(-x * 1.4426950408889634f)); }
__device__ __forceinline__ u32x4 pack8(const f32x4& a, const f32x4& b) { u32x4 w; w.x = cvt_pk_bf16(a[0], a[1]); w.y = cvt_pk_bf16(a[2], a[3]); w.z = cvt_pk_bf16(b[0], b[1]); w.w = cvt_pk_bf16(b[2], b[3]); return w; }

struct EpiZ {
    static constexpr bool PERM = true, AFTER_DRAIN = false;
    bf16_t *QB, *ZB; float* out;
    __device__ __forceinline__ void operator()(const f32x4 (&acc)[2][2][4][2], const Unit& u, int wr, int wc, int fr, int fq) const {
        const int pn = u.pn, pm = u.pm;
        const int kind = pn < 6 ? (pn >> 1) : 3;
        bf16_t* dst = kind == 3 ? ZB : QB + (size_t)kind * ((size_t)MT * CA);
        const int ld = kind == 3 ? DBIN : CA;
        const int col0 = (kind == 3 ? (pn - 6) * 256 : (pn & 1) * 256) + wc * 32 + 8 * fq;
        const float sc = kind == 0 ? QSCALE : 1.0f;
        const int rbase = pm * BM + wr * 64 + fr;
        const bool win_p = (kind == 1 || kind == 2) && pm < 128 && (pm & 15) >= 8;
        const bool win_s = (kind == 1 || kind == 2) && pm == 128;
        float* wout = out + (win_s ? O_KWS : O_KWP) + (kind == 2 ? (win_s ? (O_VWS - O_KWS) : (O_VWP - O_KWP)) : (size_t)0);
#pragma unroll
        for (int ai = 0; ai < 2; ++ai)
#pragma unroll
            for (int m = 0; m < 4; ++m) {
                const int row = rbase + ai * HALF + m * 16;
                bf16_t* rowp = dst + (size_t)row * ld + col0;
#pragma unroll
                for (int bj = 0; bj < 2; ++bj) {
                    const f32x4 v0 = acc[ai][bj][m][0] * sc, v1 = acc[ai][bj][m][1] * sc;
                    *(u32x4*)(rowp + bj * HALF) = pack8(v0, v1);
                    if (win_p) {
                        const int b = pm >> 4, t = (pm & 15) * 256 + (row & 255);
                        float* o = wout + ((size_t)(b * WINL + t - WINL) * CA + col0 + bj * HALF);
                        *(f32x4*)o = v0; *(f32x4*)(o + 4) = v1;
                    } else if (win_s && ai == 0) {
                        const int rs = row - MPR, b = rs >> 2, s = rs & 3;
                        float* o = wout + ((size_t)(b * WINL + (WINL - SS) + s) * CA + col0 + bj * HALF);
                        *(f32x4*)o = v0; *(f32x4*)(o + 4) = v1;
                    }
                }
            }
    }
};

struct EpiLora {
    static constexpr bool PERM = true, AFTER_DRAIN = false;
    bf16_t *LAM; const float *w0, *a0;
    __device__ __forceinline__ void operator()(const f32x4 (&acc)[2][2][4][2], const Unit& u, int wr, int wc, int fr, int fq) const {
        const int kind = u.pn >> 1;
        bf16_t* dst = LAM + (size_t)kind * ((size_t)MT * CB);
        const int col0 = (u.pn & 1) * 256 + wc * 32 + 8 * fq;
        const float* bias = kind == 0 ? w0 : a0;
        const float mul = kind == 0 ? 0.6065306597126334f : 1.0f;
        const int rbase = u.pm * BM + wr * 64 + fr;
#pragma unroll
        for (int bj = 0; bj < 2; ++bj) {
            f32x4 b0 = {0.f, 0.f, 0.f, 0.f}, b1 = b0;
            if (kind < 2) { b0 = *(const f32x4*)(bias + col0 + bj * HALF); b1 = *(const f32x4*)(bias + col0 + bj * HALF + 4); }
#pragma unroll
            for (int ai = 0; ai < 2; ++ai)
#pragma unroll
                for (int m = 0; m < 4; ++m) {
                    f32x4 v0 = acc[ai][bj][m][0] + b0, v1 = acc[ai][bj][m][1] + b1;
                    if (kind < 2) {
#pragma unroll
                        for (int e = 0; e < 4; ++e) { v0[e] = mul * sigmoidf_(v0[e]); v1[e] = mul * sigmoidf_(v1[e]); }
                    }
                    *(u32x4*)(dst + (size_t)(rbase + ai * HALF + m * 16) * CB + col0 + bj * HALF) = pack8(v0, v1);
                    asm volatile("" ::: "memory");
                }
        }
    }
};

__device__ __forceinline__ f32x4 xres4(const float* xp, const float* xs, int row, int col) {
    if (row < MPR) return *(const f32x4*)(xp + (size_t)row * DM + col);
    if (row < MPR + MSA) return *(const f32x4*)(xs + (size_t)(row - MPR) * DM + col);
    return (f32x4){0.f, 0.f, 0.f, 0.f};
}
struct EpiWout {
    static constexpr bool PERM = true, AFTER_DRAIN = false;
    bf16_t* PRE; const float *xp, *xs;
    __device__ __forceinline__ void operator()(const f32x4 (&acc)[2][2][4][2], const Unit& u, int wr, int wc, int fr, int fq) const {
        const int row0 = u.pm * BM + wr * 64 + fr, col0 = u.pn * BM + wc * 32 + 8 * fq;
#pragma unroll
        for (int ai = 0; ai < 2; ++ai)
#pragma unroll
            for (int m = 0; m < 4; ++m) { const int row = row0 + ai * HALF + m * 16;
#pragma unroll
                for (int bj = 0; bj < 2; ++bj) { const f32x4 x0 = xres4(xp, xs, row, col0 + bj * HALF), x1 = xres4(xp, xs, row, col0 + bj * HALF + 4);
                    *(u32x4*)(PRE + (size_t)row * DM + col0 + bj * HALF) = pack8(acc[ai][bj][m][0] + x0 * ALPHA, acc[ai][bj][m][1] + x1 * ALPHA); } }
    }
};
struct EpiGU {
    static constexpr bool PERM = true, AFTER_DRAIN = false;
    bf16_t* ACT;
    __device__ __forceinline__ void operator()(const f32x4 (&acc)[2][2][4][2], const Unit& u, int wr, int wc, int fr, int fq) const {
        const int row0 = u.pm * BM + wr * 64 + fr, col0 = u.pn * HALF + wc * 32 + 8 * fq;
#pragma unroll
        for (int ai = 0; ai < 2; ++ai)
#pragma unroll
            for (int m = 0; m < 4; ++m) {
                f32x4 o[2];
#pragma unroll
                for (int n = 0; n < 2; ++n)
#pragma unroll
                    for (int e = 0; e < 4; ++e) { const float g = acc[ai][0][m][n][e], up = acc[ai][1][m][n][e]; o[n][e] = g * sigmoidf_(g) * up; }
                *(u32x4*)(ACT + (size_t)(row0 + ai * HALF + m * 16) * DFF + col0) = pack8(o[0], o[1]);
            }
    }
};
struct EpiDown {
    static constexpr bool PERM = true, AFTER_DRAIN = false;
    bf16_t* PRE; const bf16_t* H;
    __device__ __forceinline__ void operator()(const f32x4 (&acc)[2][2][4][2], const Unit& u, int wr, int wc, int fr, int fq) const {
        const int row0 = u.pm * BM + wr * 64 + fr, col0 = u.pn * BM + wc * 32 + 8 * fq;
#pragma unroll
        for (int ai = 0; ai < 2; ++ai)
#pragma unroll
            for (int m = 0; m < 4; ++m) { const size_t off = (size_t)(row0 + ai * HALF + m * 16) * DM + col0;
#pragma unroll
                for (int bj = 0; bj < 2; ++bj) { const u32x4 hw = *(const u32x4*)(H + off + bj * HALF);
                    const f32x4 h0 = (f32x4){bf_lo(hw.x), bf_hi(hw.x), bf_lo(hw.y), bf_hi(hw.y)}, h1 = (f32x4){bf_lo(hw.z), bf_hi(hw.z), bf_lo(hw.w), bf_hi(hw.w)};
                    *(u32x4*)(PRE + off + bj * HALF) = pack8(acc[ai][bj][m][0] + h0 * ALPHA, acc[ai][bj][m][1] + h1 * ALPHA); } }
    }
};
struct EpiPlain {
    static constexpr bool PERM = true, AFTER_DRAIN = false;
    bf16_t* O;
    __device__ __forceinline__ void operator()(const f32x4 (&acc)[2][2][4][2], const Unit& u, int wr, int wc, int fr, int fq) const {
        const int row0 = u.pm * BM + wr * 64 + fr, col0 = u.pn * BM + wc * 32 + 8 * fq;
#pragma unroll
        for (int ai = 0; ai < 2; ++ai)
#pragma unroll
            for (int m = 0; m < 4; ++m)
#pragma unroll
                for (int bj = 0; bj < 2; ++bj) *(u32x4*)(O + (size_t)(row0 + ai * HALF + m * 16) * DM + col0 + bj * HALF) = pack8(acc[ai][bj][m][0], acc[ai][bj][m][1]);
    }
};
struct EpiPle {
    static constexpr bool PERM = true, AFTER_DRAIN = false;
    bf16_t* PRE; const bf16_t *H, *PP;
    __device__ __forceinline__ void operator()(const f32x4 (&acc)[2][2][4][2], const Unit& u, int wr, int wc, int fr, int fq) const {
        const int row0 = u.pm * BM + wr * 64 + fr, col0 = u.pn * BM + wc * 32 + 8 * fq;
#pragma unroll
        for (int ai = 0; ai < 2; ++ai)
#pragma unroll
            for (int m = 0; m < 4; ++m) { const size_t off = (size_t)(row0 + ai * HALF + m * 16) * DM + col0;
#pragma unroll
                for (int bj = 0; bj < 2; ++bj) { const u32x4 hw = *(const u32x4*)(H + off + bj * HALF), pw = *(const u32x4*)(PP + off + bj * HALF);
                    const f32x4 h0 = (f32x4){bf_lo(hw.x), bf_hi(hw.x), bf_lo(hw.y), bf_hi(hw.y)}, h1 = (f32x4){bf_lo(hw.z), bf_hi(hw.z), bf_lo(hw.w), bf_hi(hw.w)};
                    const f32x4 p0 = (f32x4){bf_lo(pw.x), bf_hi(pw.x), bf_lo(pw.y), bf_hi(pw.y)}, p1 = (f32x4){bf_lo(pw.z), bf_hi(pw.z), bf_lo(pw.w), bf_hi(pw.w)};
                    f32x4 a0 = acc[ai][bj][m][0], a1 = acc[ai][bj][m][1];
#pragma unroll
                    for (int q = 0; q < 4; ++q) { a0[q] = sigmoidf_(a0[q]); a1[q] = sigmoidf_(a1[q]); }
                    *(u32x4*)(PRE + off + bj * HALF) = pack8(h0 * ALPHA + a0 * p0, h1 * ALPHA + a1 * p1); } }
    }
};
template <class Epi, class Sched, bool ALIGN_EPI = false, bool SP2 = false>
__device__ __forceinline__ void gemm_phase(PG8_LAS unsigned char* lds, const Gemm g, const Sched& S, const Epi& E) {
    int tid_ = threadIdx.x; asm volatile("" : "+v"(tid_));
    const int tid = tid_, wid = __builtin_amdgcn_readfirstlane(tid >> 6), lane = tid & 63, wr = wid >> 2, wc = wid & 3, fr = lane & 15, fq = lane >> 4;
    int K_ = g.K; asm volatile("" : "+s"(K_));
    const int K = K_, nt = K / BK;
    unsigned voffA[2], voffB[2];
#pragma unroll
    for (int i = 0; i < 2; ++i) { int R, C; stage_rc(tid * 16 + i * 8192, R, C); const int Rb = Epi::PERM ? ((R & ~31) + perm32(R & 31)) : R;
        voffA[i] = (unsigned)(R * K + C) * 2u; voffB[i] = (unsigned)(Rb * K + C) * 2u; }
    const size_t kstep = (size_t)(BK * 2);
    const size_t hstep = (size_t)HALF * K * 2;
    const size_t tstep = 2 * hstep;
    const unsigned ldsw = (unsigned)wid * 1024u;
    const int aoff = lds_byte(wr * 64 + fr, fq * 8), boff = lds_byte(wc * 32 + fr, fq * 8);
#define PG8_SA(b, h) (((b) * 2 + (h)) * HTB)
#define PG8_SB(b, h) ((4 + (b) * 2 + (h)) * HTB)
#define PG8_STAGE(bufoff, gbase, voff) do { _Pragma("unroll") for (int _i = 0; _i < 2; ++_i) \
        __builtin_amdgcn_global_load_lds((const unsigned*)((const char*)(gbase) + (voff)[_i]), (PG8_LAS unsigned*)(lds + (bufoff) + ldsw + _i * 8192), 16, 0, 0); } while (0)
#define PG8_LDA(dst, b, h) do { _Pragma("unroll") for (int m = 0; m < 4; ++m) _Pragma("unroll") for (int k = 0; k < 2; ++k) dst[m][k] = *(const PG8_LAS bf16x8*)(lds + PG8_SA(b, h) + aoff + m * 2048 + k * 1024); } while (0)
#define PG8_LDB(dst, b, h) do { _Pragma("unroll") for (int n = 0; n < 2; ++n) _Pragma("unroll") for (int k = 0; k < 2; ++k) dst[n][k] = *(const PG8_LAS bf16x8*)(lds + PG8_SB(b, h) + boff + n * 2048 + k * 1024); } while (0)
#define PG8_MMA(ai, bj, At, Bt) do { __builtin_amdgcn_s_setprio(1); _Pragma("unroll") for (int m = 0; m < 4; ++m) _Pragma("unroll") for (int n = 0; n < 2; ++n) _Pragma("unroll") for (int k = 0; k < 2; ++k) \
        acc[ai][bj][m][n] = __builtin_amdgcn_mfma_f32_16x16x32_bf16(Bt[n][k], At[m][k], acc[ai][bj][m][n], 0, 0, 0); __builtin_amdgcn_s_setprio(0); } while (0)
#define PG8_WAIT_V(n) asm volatile("s_waitcnt vmcnt(" #n ")" ::: "memory")
#define PG8_WAIT_L(n) asm volatile("s_waitcnt lgkmcnt(" #n ")" ::: "memory")
#define PG8_BAR __builtin_amdgcn_s_barrier()
#define PG8_SCHED __builtin_amdgcn_sched_barrier(0)
    Unit cur, nxt; int ui = 0;
    if (!S.next(0, cur)) return;
    f32x4 acc[2][2][4][2];
#pragma unroll
    for (int a = 0; a < 2; ++a)
#pragma unroll
        for (int b = 0; b < 2; ++b)
#pragma unroll
            for (int m = 0; m < 4; ++m)
#pragma unroll
                for (int n = 0; n < 2; ++n) acc[a][b][m][n] = (f32x4){0.f, 0.f, 0.f, 0.f};
    bf16x8 At[4][2], B0[2][2], B1[2][2];
    const char* cA = (const char*)g.A + (size_t)cur.pm * tstep; const char* cB = (const char*)g.Bt + (size_t)cur.pn * tstep;
    S.a_ready(cur);
    if constexpr (SP2) {
        PG8_STAGE(PG8_SB(0, 0), cB, voffB); PG8_STAGE(PG8_SB(0, 1), cB + hstep, voffB); PG8_STAGE(PG8_SA(0, 0), cA, voffA); PG8_STAGE(PG8_SA(0, 1), cA + hstep, voffA);
        if (wr == 1) PG8_BAR;
        PG8_WAIT_V(2); PG8_BAR;
        PG8_STAGE(PG8_SB(1, 0), cB + kstep, voffB); PG8_STAGE(PG8_SA(1, 0), cA + kstep, voffA); PG8_STAGE(PG8_SB(1, 1), cB + hstep + kstep, voffB);
        PG8_WAIT_V(6); PG8_BAR;
    } else {
        PG8_STAGE(PG8_SB(0, 0), cB, voffB); PG8_STAGE(PG8_SA(0, 0), cA, voffA); PG8_STAGE(PG8_SB(0, 1), cB + hstep, voffB); PG8_STAGE(PG8_SA(0, 1), cA + hstep, voffA);
        if (wr == 1) PG8_BAR;
        PG8_WAIT_V(4); PG8_BAR;
        PG8_STAGE(PG8_SB(1, 0), cB + kstep, voffB); PG8_STAGE(PG8_SA(1, 0), cA + kstep, voffA); PG8_STAGE(PG8_SB(1, 1), cB + hstep + kstep, voffB);
        PG8_WAIT_V(6); PG8_BAR;
    }
    for (;;) {
        const bool has_next = S.next(ui + 1, nxt);
        const char* nA = has_next ? (const char*)g.A + (size_t)nxt.pm * tstep : cA; const char* nB = has_next ? (const char*)g.Bt + (size_t)nxt.pn * tstep : cB;
        for (int t = 0; t < nt; t += 2) {
            const bool last = (t == nt - 2);
            const char* a1 = cA + (size_t)(t + 1) * kstep;
            const char* a2 = last ? nA : cA + (size_t)(t + 2) * kstep; const char* b2 = last ? nB : cB + (size_t)(t + 2) * kstep;
            const char* a3 = a2 + kstep; const char* b3 = b2 + kstep;
            if (last && has_next) S.a_ready(nxt);
            if constexpr (SP2) {
            PG8_LDB(B0, 0, 0); PG8_LDB(B1, 0, 1); PG8_SCHED; PG8_LDA(At, 0, 0); PG8_STAGE(PG8_SA(1, 1), a1 + hstep, voffA);
            PG8_WAIT_V(8); PG8_WAIT_L(0); PG8_BAR; PG8_MMA(0, 0, At, B0); PG8_MMA(0, 1, At, B1); PG8_BAR; PG8_SCHED;
            PG8_LDA(At, 0, 1); PG8_STAGE(PG8_SB(0, 0), b2, voffB); PG8_STAGE(PG8_SB(0, 1), b2 + hstep, voffB); PG8_STAGE(PG8_SA(0, 0), a2, voffA);
            PG8_WAIT_V(8); PG8_WAIT_L(0); PG8_BAR; PG8_MMA(1, 0, At, B0); PG8_MMA(1, 1, At, B1); PG8_BAR; PG8_SCHED;
            PG8_LDB(B0, 1, 0); PG8_LDB(B1, 1, 1); PG8_SCHED; PG8_LDA(At, 1, 0); PG8_STAGE(PG8_SA(0, 1), a2 + hstep, voffA);
            PG8_WAIT_V(8); PG8_WAIT_L(0); PG8_BAR; PG8_MMA(0, 0, At, B0); PG8_MMA(0, 1, At, B1); PG8_BAR; PG8_SCHED;
            PG8_LDA(At, 1, 1); PG8_STAGE(PG8_SB(1, 0), b3, voffB); PG8_STAGE(PG8_SB(1, 1), b3 + hstep, voffB); PG8_STAGE(PG8_SA(1, 0), a3, voffA);
            PG8_WAIT_V(8); PG8_WAIT_L(0); PG8_BAR; PG8_MMA(1, 0, At, B0); PG8_MMA(1, 1, At, B1); PG8_BAR; PG8_SCHED;
            } else {
            PG8_LDB(B0, 0, 0); PG8_SCHED; PG8_LDA(At, 0, 0); PG8_STAGE(PG8_SA(1, 1), a1 + hstep, voffA);
            PG8_WAIT_L(8); PG8_BAR; PG8_WAIT_L(0); PG8_MMA(0, 0, At, B0); PG8_BAR; PG8_SCHED;
            PG8_LDB(B1, 0, 1); PG8_STAGE(PG8_SB(0, 0), b2, voffB);
            PG8_BAR; PG8_WAIT_L(0); PG8_MMA(0, 1, At, B1); PG8_BAR;
            PG8_LDA(At, 0, 1); PG8_STAGE(PG8_SA(0, 0), a2, voffA);
            PG8_BAR; PG8_WAIT_L(0); PG8_MMA(1, 0, At, B0); PG8_BAR; PG8_SCHED;
            PG8_STAGE(PG8_SB(0, 1), b2 + hstep, voffB);
            PG8_WAIT_V(6); PG8_BAR; PG8_MMA(1, 1, At, B1); PG8_BAR;
            PG8_LDB(B0, 1, 0); PG8_SCHED; PG8_LDA(At, 1, 0); PG8_STAGE(PG8_SA(0, 1), a2 + hstep, voffA);
            PG8_WAIT_L(8); PG8_BAR; PG8_WAIT_L(0); PG8_MMA(0, 0, At, B0); PG8_BAR; PG8_SCHED;
            PG8_LDB(B1, 1, 1); PG8_STAGE(PG8_SB(1, 0), b3, voffB);
            PG8_BAR; PG8_WAIT_L(0); PG8_MMA(0, 1, At, B1); PG8_BAR;
            PG8_LDA(At, 1, 1); PG8_STAGE(PG8_SA(1, 0), a3, voffA);
            PG8_BAR; PG8_WAIT_L(0); PG8_MMA(1, 0, At, B0); PG8_BAR; PG8_SCHED;
            PG8_STAGE(PG8_SB(1, 1), b3 + hstep, voffB);
            PG8_WAIT_V(6); PG8_BAR; PG8_MMA(1, 1, At, B1); PG8_BAR;
            }
        }
        if constexpr (ALIGN_EPI) { if (wr == 0) PG8_BAR; }
        if constexpr (!Epi::AFTER_DRAIN) { E(acc, cur, wr, wc, fr, fq); S.done(cur); }
        if (!has_next) break;
#pragma unroll
        for (int a = 0; a < 2; ++a)
#pragma unroll
            for (int b = 0; b < 2; ++b)
#pragma unroll
                for (int m = 0; m < 4; ++m)
#pragma unroll
                    for (int n = 0; n < 2; ++n) acc[a][b][m][n] = (f32x4){0.f, 0.f, 0.f, 0.f};
        cur = nxt; cA = nA; cB = nB; ++ui;
        if constexpr (ALIGN_EPI) { if (wr == 1) PG8_BAR; }
    }
    PG8_WAIT_V(0);
    if constexpr (!ALIGN_EPI) { if (wr == 0) PG8_BAR; }
    PG8_BAR;
    if constexpr (Epi::AFTER_DRAIN) { E.fused(acc, cur, wr, wc, fr, fq, lds, wid, lane); S.done(cur); }
#undef PG8_SA
#undef PG8_SB
#undef PG8_STAGE
#undef PG8_LDA
#undef PG8_LDB
#undef PG8_MMA
#undef PG8_WAIT_V
#undef PG8_WAIT_L
#undef PG8_BAR
#undef PG8_SCHED
}
}
#define GAS __attribute__((address_space(1)))
#define LAS __attribute__((address_space(3)))
typedef unsigned short bf16;
typedef unsigned v4u __attribute__((ext_vector_type(4)));
typedef float f32x4 __attribute__((ext_vector_type(4)));
typedef short bf16x8 __attribute__((ext_vector_type(8)));
typedef GAS unsigned gu32;
typedef GAS unsigned long long gu64;
#define RLX_AGENT __ATOMIC_RELAXED, __HIP_MEMORY_SCOPE_AGENT
#define LDS_WAIT() asm volatile("s_waitcnt lgkmcnt(0)" ::: "memory")
#define VM_WAIT() asm volatile("s_waitcnt vmcnt(0)" ::: "memory")
__device__ __forceinline__ unsigned long long rt() { return __builtin_amdgcn_s_memrealtime(); }
__device__ __forceinline__ unsigned f2bf(float f) { unsigned u = __builtin_bit_cast(unsigned, f); return (u + 0x7fffu + ((u >> 16) & 1u)) >> 16; }
__device__ __forceinline__ unsigned pk2(float lo, float hi) { return f2bf(lo) | (f2bf(hi) << 16); }

#define XB_TMO      128
#define XB_XCNT(j)  (256  + 64 * (j))
#define XB_XSUB(j)  (1280 + 64 * (j))
#define XB_XGEN(j)  (2304 + 64 * (j))
#define XB_TOP      3328
#define XB_TOPGEN   3392
#define XCD_BAR_WORDS 3456
#define XB_SPIN_CAP (1u << 18)

__device__ __forceinline__ unsigned xb_ld(unsigned* p)              { return __hip_atomic_load(p, __ATOMIC_RELAXED, __HIP_MEMORY_SCOPE_AGENT); }
__device__ __forceinline__ unsigned xb_add(unsigned* p, unsigned v) { return __hip_atomic_fetch_add(p, v, __ATOMIC_RELAXED, __HIP_MEMORY_SCOPE_AGENT); }
__device__ __forceinline__ unsigned xb_xcc_id() { return (unsigned)__builtin_amdgcn_s_getreg((3 << 11) | 20) & 0xFu; }
#define XB_SPIN(cond, bar) do { unsigned _sp = 0; while (cond) { __builtin_amdgcn_s_sleep(1); \
    if ((++_sp & 255u) == 0u) { if (xb_ld(&(bar)[XB_TMO])) break; if (_sp > XB_SPIN_CAP) { atomicAdd(&(bar)[XB_TMO], 1u); break; } } } } while (0)

struct XcdBarrier {
    unsigned* bar; unsigned x;
    volatile LAS unsigned* st;
};

__device__ __forceinline__ XcdBarrier xcd_barrier_post(unsigned* bar, volatile LAS unsigned* st) {
    XcdBarrier b; b.bar = bar; b.x = xb_xcc_id(); b.st = st;
    if (threadIdx.x == 0) (void)xb_add(&bar[XB_XCNT(b.x)], 1u);
    return b;
}
__device__ __forceinline__ void xcd_barrier_complete(unsigned* bar, unsigned x, unsigned& nloc, unsigned& nx) {
    const unsigned G = gridDim.x * gridDim.y * gridDim.z;
    unsigned sum, cnt, mine, sp = 0u;
    for (;;) {
        sum = 0u; cnt = 0u; mine = 0u;
#pragma unroll
        for (unsigned j = 0; j < 16; ++j) { const unsigned c = xb_ld(&bar[XB_XCNT(j)]); sum += c; cnt += (c > 0u) ? 1u : 0u; mine = (j == x) ? c : mine; }
        if (sum == G) break;
        __builtin_amdgcn_s_sleep(1);
        if ((++sp & 255u) == 0u) { if (xb_ld(&bar[XB_TMO])) break; if (sp > XB_SPIN_CAP) { atomicAdd(&bar[XB_TMO], 1u); break; } }
    }
    nloc = mine > 0u ? mine : 1u; nx = cnt > 0u ? cnt : 1u;
}

__device__ __forceinline__ void xcd_barrier(const XcdBarrier& b) {
    asm volatile("s_waitcnt vmcnt(0)" ::: "memory");
    __syncthreads();
    if (threadIdx.x == 0) {
        unsigned* bar = b.bar;
        __builtin_amdgcn_s_waitcnt(0);
        unsigned nloc = b.st[0], nx = b.st[1];
        if (nloc == 0u) { xcd_barrier_complete(bar, b.x, nloc, nx); b.st[0] = nloc; b.st[1] = nx; }
        const unsigned old = xb_add(&bar[XB_XSUB(b.x)], 1u);
        const unsigned gen = old / nloc;
        if (old + 1u == (gen + 1u) * nloc) {
            __builtin_amdgcn_fence(__ATOMIC_RELEASE, "agent");
            asm volatile("s_waitcnt vmcnt(0)" ::: "memory");
            const unsigned og = xb_add(&bar[XB_TOP], 1u);
            const unsigned tg = og / nx;
            if (og + 1u == (tg + 1u) * nx) xb_add(&bar[XB_TOPGEN], 1u);
            else XB_SPIN(xb_ld(&bar[XB_TOPGEN]) == tg, bar);
            __builtin_amdgcn_fence(__ATOMIC_ACQUIRE, "agent");
            xb_add(&bar[XB_XGEN(b.x)], 1u);
            asm volatile("s_waitcnt vmcnt(0)" ::: "memory");
        } else {
            XB_SPIN(xb_ld(&bar[XB_XGEN(b.x)]) == gen, bar);
            __builtin_amdgcn_fence(__ATOMIC_ACQUIRE, "agent");
            asm volatile("s_waitcnt vmcnt(0)" ::: "memory");
        }
    }
    __syncthreads();
}
constexpr size_t MiB = 1u << 20;
constexpr size_t WS_CTL = 0, CTL_ZERO_BYTES = 1 * MiB;
constexpr size_t WS_WIN = 2 * MiB, WS_WOUT = 9 * MiB, WS_WGU = 11 * MiB, WS_WD = 22 * MiB, WS_WPG = 28 * MiB, WS_WPP = 30 * MiB, WS_WL = 30 * MiB + 512 * 1024;
constexpr size_t SZ1024B = (size_t)MT * 1024 * 2, SZ512B = (size_t)MT * 512 * 2, SZ256B = (size_t)MT * 256 * 2;
constexpr size_t WS_R1 = 32 * MiB;
constexpr size_t WS_PB = 97 * MiB;
constexpr size_t WS_QB = 114 * MiB, WS_KB = WS_QB + SZ512B, WS_VB = WS_KB + SZ512B;
constexpr size_t WS_PRE = 114 * MiB;
constexpr size_t WS_ZB = 211 * MiB;
constexpr size_t WS_OG = 324 * MiB, WS_LSE = 420 * MiB;
constexpr size_t WS_BV = 324 * MiB, WS_PHI = 357 * MiB, WS_SLOC = 389 * MiB, WS_SC = 421 * MiB;
constexpr size_t WS_AP = 453 * MiB;
constexpr size_t WS_ACT = 243 * MiB;
constexpr size_t WS_H2 = 243 * MiB, WS_PP = 421 * MiB;
constexpr size_t WS_END = 486 * MiB;
static_assert(WS_VB + SZ512B <= WS_ZB && WS_ZB + (size_t)MT * DBIN * 2 <= WS_OG && WS_PRE + (size_t)MT * DM * 4 <= WS_ACT && WS_ACT + (size_t)MT * DFF * 2 <= WS_SC + 32 * MiB, "ws map");
static_assert(WS_R1 + SZ1024B <= WS_PB && WS_PB + SZ256B <= WS_QB && WS_AP + SZ256B <= WS_END && WS_ACT + (size_t)MT * DFF * 2 <= WS_PP && WS_PP + SZ1024B <= 512 * MiB, "ws map 2");
constexpr int NCHUNK = 32, CHL = TSEQ / NCHUNK;
constexpr int CW_BAR = 4096;

constexpr int RING_OFF = 0, RING_BYTES = 131072;
constexpr int LDSCTL_OFF = RING_BYTES, MISC_OFF = LDSCTL_OFF + 320;
constexpr int LDS_BYTES = 147456;
constexpr int NWAVES = 8;
typedef float f32x16 __attribute__((ext_vector_type(16)));
typedef unsigned u32x2 __attribute__((ext_vector_type(2)));
typedef short s16x4 __attribute__((ext_vector_type(4)));
typedef float f32x2_t __attribute__((ext_vector_type(2)));
typedef __bf16 bf16x2_t __attribute__((ext_vector_type(2)));
__device__ __forceinline__ unsigned cvtpk(float lo, float hi) { f32x2_t v = {lo, hi}; bf16x2_t b = __builtin_convertvector(v, bf16x2_t); return __builtin_bit_cast(unsigned, b); }
__device__ __forceinline__ float bflo(unsigned w) { return __uint_as_float(w << 16); }
__device__ __forceinline__ float bfhi(unsigned w) { return __uint_as_float(w & 0xffff0000u); }
__device__ __forceinline__ float bf1(bf16 h) { return __uint_as_float((unsigned)h << 16); }
__device__ __forceinline__ float sigm(float x) { return __builtin_amdgcn_rcpf(1.0f + __builtin_amdgcn_exp2f(-x * LOG2E)); }
__device__ __forceinline__ float shx(float v, int o, int lane) { return __int_as_float(__builtin_amdgcn_ds_bpermute((lane ^ o) << 2, __float_as_int(v))); }
__device__ __forceinline__ float wave_sum(float v, int lane) {
#pragma unroll
    for (int o = 1; o < 64; o <<= 1) v += shx(v, o, lane);
    return v;
}
#define dpp_f(v, ctrl, row_mask) __int_as_float(__builtin_amdgcn_update_dpp(0, __float_as_int(v), (ctrl), (row_mask), 0xF, false))
__device__ __forceinline__ float wave_sum_dpp(float v) {
    v += dpp_f(v, 0xB1, 0xF);
    v += dpp_f(v, 0x4E, 0xF);
    v += dpp_f(v, 0x141, 0xF);
    v += dpp_f(v, 0x140, 0xF);
    v += dpp_f(v, 0x142, 0xA);
    v += dpp_f(v, 0x143, 0xC);
    return __int_as_float(__builtin_amdgcn_readlane(__float_as_int(v), 63));
}

__device__ __forceinline__ void fmac_s(float& c, float a, float b) { asm("v_fmac_f32_e32 %0, %1, %2" : "+v"(c) : "v"(a), "v"(b)); }
__device__ __forceinline__ void mulip_s(float& c, float a) { asm("v_mul_f32_e32 %0, %0, %1" : "+v"(c) : "v"(a)); }
__device__ __forceinline__ float mul_s(float a, float b) { float r; asm("v_mul_f32_e32 %0, %1, %2" : "=v"(r) : "v"(a), "v"(b)); return r; }
struct Ctx { LAS unsigned char* lds; int tid, lane, wave, vcu, G; };

__device__ __forceinline__ void p0_transpose_item(const float* W, int N, bf16* WT, int ldk, int drow, int dk, LAS float* scr, int k0, int n0, int lane) {
#pragma unroll 8
    for (int i = 0; i < 32; ++i) { const int kk = 2 * i + (lane >> 5); scr[kk * 33 + (lane & 31)] = W[(size_t)(k0 + kk) * N + n0 + (lane & 31)]; }
    LDS_WAIT(); asm volatile("" ::: "memory");
    const int c = lane & 7;
#pragma unroll
    for (int j = 0; j < 4; ++j) { const int n = (lane >> 3) + 8 * j; const LAS float* s = scr + (8 * c) * 33 + n;
        v4u o; o.x = pk2(s[0 * 33], s[1 * 33]); o.y = pk2(s[2 * 33], s[3 * 33]); o.z = pk2(s[4 * 33], s[5 * 33]); o.w = pk2(s[6 * 33], s[7 * 33]);
        *(GAS v4u*)(WT + (size_t)(drow + n) * ldk + dk + 8 * c) = o; }
    LDS_WAIT(); asm volatile("" ::: "memory");
}
struct P0Args { const float *xp, *xs, *pp, *ps, *ck, *cv, *w_in, *w_out, *w_gate, *w_up, *w_down, *w_pg, *w_pp, *w2, *a2, *g2; bf16 *Win, *Wout, *Wgu, *Wd, *Wpg, *Wpp, *Wl, *XB, *PB; float* out; };
__device__ __forceinline__ void p0_prologue(const Ctx& C, const P0Args& A) {
    LAS float* scr = (LAS float*)(C.lds + RING_OFF + C.wave * 16384);
    const int gw = C.vcu * NWAVES + C.wave, NGW = C.G * NWAVES;
    constexpr int I0 = 16 * 104, I1 = 16 * 32, I2 = 16 * 88, I3 = I2, I4 = 44 * 32, I5 = 16 * 32, I6 = 4 * 32, I7 = 16, I8 = 16, I9 = 32;
    constexpr int NITEMS = I0 + I1 + I2 + I3 + I4 + I5 + I6 + I7 + I8 + I9;
    for (int it = gw; it < NITEMS; it += NGW) {
        int r = it;
        if (r < I0) { const int kb = r / 104, nb = r % 104; p0_transpose_item(A.w_in, DIN, A.Win, 1024, nb * 32, kb * 64, scr, kb * 64, nb * 32, C.lane); continue; } r -= I0;
        if (r < I1) { const int kb = r / 32, nb = r % 32; p0_transpose_item(A.w_out, DM, A.Wout, 1024, nb * 32, kb * 64, scr, kb * 64, nb * 32, C.lane); continue; } r -= I1;
        if (r < I2) { const int kb = r / 88, nb = r % 88, n0 = nb * 32; p0_transpose_item(A.w_gate, DFF, A.Wgu, 1024, (n0 >> 7) * 256 + (n0 & 127), kb * 64, scr, kb * 64, n0, C.lane); continue; } r -= I2;
        if (r < I3) { const int kb = r / 88, nb = r % 88, n0 = nb * 32; p0_transpose_item(A.w_up, DFF, A.Wgu, 1024, (n0 >> 7) * 256 + 128 + (n0 & 127), kb * 64, scr, kb * 64, n0, C.lane); continue; } r -= I3;
        if (r < I4) { const int kb = r / 32, nb = r % 32; p0_transpose_item(A.w_down, DM, A.Wd, DFF, nb * 32, kb * 64, scr, kb * 64, nb * 32, C.lane); continue; } r -= I4;
        if (r < I5) { const int kb = r / 32, nb = r % 32; p0_transpose_item(A.w_pg, DM, A.Wpg, 1024, nb * 32, kb * 64, scr, kb * 64, nb * 32, C.lane); continue; } r -= I5;
        if (r < I6) { const int kb = r / 32, nb = r % 32; p0_transpose_item(A.w_pp, DM, A.Wpp, 256, nb * 32, kb * 64, scr, kb * 64, nb * 32, C.lane); continue; } r -= I6;
        if (r < I7) { p0_transpose_item(A.w2, CB, A.Wl, 256, r * 32, 0, scr, 0, r * 32, C.lane); continue; } r -= I7;
        if (r < I8) { p0_transpose_item(A.a2, CB, A.Wl, 256, 512 + r * 32, 64, scr, 0, r * 32, C.lane); continue; } r -= I8;
        { const int kb = r / 16, nb = r % 16; p0_transpose_item(A.g2, CB, A.Wl, 256, 1024 + nb * 32, 128 + kb * 64, scr, kb * 64, nb * 32, C.lane); }
    }
    const int gt = C.vcu * (NWAVES * 64) + C.tid, NT = C.G * NWAVES * 64;
    for (int i = gt; i < 1536 * 32; i += NT) { const int row = i >> 5, ch = i & 31, blk = row >> 9;
        const bool nz = blk == 0 ? ch < 8 : blk == 1 ? (ch >= 8 && ch < 16) : ch >= 16;
        if (!nz) *(GAS v4u*)(A.Wl + (size_t)row * 256 + ch * 8) = (v4u){0u, 0u, 0u, 0u}; }
    for (int i = gt; i < MT * 128; i += NT) { const int row = i >> 7, ch = i & 127;
        f32x4 a = {0.f, 0.f, 0.f, 0.f}, b = a;
        if (row < MPR + MSA) { const float* src = row < MPR ? A.xp + (size_t)row * DM : A.xs + (size_t)(row - MPR) * DM; a = *(const GAS f32x4*)(src + ch * 8); b = *(const GAS f32x4*)(src + ch * 8 + 4); }
        v4u o; o.x = cvtpk(a[0], a[1]); o.y = cvtpk(a[2], a[3]); o.z = cvtpk(b[0], b[1]); o.w = cvtpk(b[2], b[3]);
        *(GAS v4u*)(A.XB + (size_t)row * DM + ch * 8) = o; }
    for (int i = gt; i < MT * 32; i += NT) { const int row = i >> 5, ch = i & 31;
        f32x4 a = {0.f, 0.f, 0.f, 0.f}, b = a;
        if (row < MPR + MSA) { const float* src = row < MPR ? A.pp + (size_t)row * PLE : A.ps + (size_t)(row - MPR) * PLE; a = *(const GAS f32x4*)(src + ch * 8); b = *(const GAS f32x4*)(src + ch * 8 + 4); }
        v4u o; o.x = cvtpk(a[0], a[1]); o.y = cvtpk(a[2], a[3]); o.z = cvtpk(b[0], b[1]); o.w = cvtpk(b[2], b[3]);
        *(GAS v4u*)(A.PB + (size_t)row * PLE + ch * 8) = o; }
}

__device__ __forceinline__ void prep_a(const Ctx& C, const bf16* ZB, const float* mu, const float* state_shift, bf16* AP, float* out) {
    const int gw = C.vcu * NWAVES + C.wave, NGW = C.G * NWAVES, lane = C.lane;
    const f32x4 m4 = *(const GAS f32x4*)(mu + 1536 + lane * 4);
    for (int row = gw; row < MPR + MSA; row += NGW) {
        const u32x2 zw = *(const GAS u32x2*)(ZB + (size_t)row * DBIN + 1536 + lane * 4);
        f32x4 z = {bflo(zw.x), bfhi(zw.x), bflo(zw.y), bfhi(zw.y)}, p;
        const bool first = row < MPR ? (row & (TSEQ - 1)) == 0 : ((row - MPR) & 3) == 0;
        if (!first) { const u32x2 pw = *(const GAS u32x2*)(ZB + (size_t)(row - 1) * DBIN + 1536 + lane * 4); p = (f32x4){bflo(pw.x), bfhi(pw.x), bflo(pw.y), bfhi(pw.y)}; }
        else if (row < MPR) p = (f32x4){0.f, 0.f, 0.f, 0.f};
        else p = *(const GAS f32x4*)(state_shift + (size_t)((row - MPR) >> 2) * DBIN + 1536 + lane * 4);
        f32x4 zm = z + (p - z) * m4, o;
#pragma unroll
        for (int e = 0; e < 4; ++e) { const float x = zm[e];
            const float th = 1.0f - 2.0f * __builtin_amdgcn_rcpf(1.0f + __builtin_amdgcn_exp2f(2.0f * LOG2E * x));
            o[e] = lane < 16 ? th : lane < 32 ? x : sigm(x); }
        u32x2 w; w.x = cvtpk(o[0], o[1]); w.y = cvtpk(o[2], o[3]);
        *(GAS u32x2*)(AP + (size_t)row * 256 + lane * 4) = w;
    }
    const int gt = C.vcu * (NWAVES * 64) + C.tid, NT = C.G * NWAVES * 64;
    for (int i = gt; i < (NBATCH + SB) * DBIN; i += NT) { const int s = i / DBIN, c = i % DBIN;
        if (s < NBATCH) out[O_SHP + (size_t)s * DBIN + c] = bf1(ZB[(size_t)(s * TSEQ + TSEQ - 1) * DBIN + c]);
        else out[O_SHS + (size_t)(s - NBATCH) * DBIN + c] = bf1(ZB[(size_t)(MPR + (s - NBATCH) * SS + SS - 1) * DBIN + c]); }
}

__device__ __forceinline__ int crow(int r, int hi) { return (r & 3) + 8 * (r >> 2) + 4 * hi; }
typedef short v4i16_t __attribute__((ext_vector_type(4)));
__device__ __forceinline__ s16x4 vtr(LAS const unsigned char* p) { return __builtin_bit_cast(s16x4, __builtin_amdgcn_ds_read_tr16_b64_v4i16((LAS v4i16_t*)p)); }
constexpr int VP = 192;
__device__ __forceinline__ void attn_unit(const Ctx& C, const bf16* QB, const bf16* KB, const bf16* VB, bf16* OGg, float* LSEg, int b, int h, int cls, int mq0, int dil) {
    LAS unsigned char* lds = C.lds;
    const int tid = C.tid, wid = C.wave, lane = C.lane, r32 = lane & 31, hi = lane >> 5;
#pragma unroll
    for (int it = 0; it < 6; ++it) { const int rr = it * 64 + (tid >> 3), ch = tid & 7; int mk = mq0 - 128 + rr; mk = mk < 0 ? 0 : mk;
        const v4u val = *(const GAS v4u*)(VB + (size_t)(b * TSEQ + mk * dil + cls) * CA + h * 64 + ch * 8);
        *(LAS v4u*)(lds + rr * VP + ch * 16) = val; }
    __syncthreads();
    const int mqw = mq0 + 32 * wid;
    const size_t qrow = (size_t)(b * TSEQ + (mqw + r32) * dil + cls);
    bf16x8 qf[4];
#pragma unroll
    for (int s = 0; s < 4; ++s) qf[s] = *(const GAS bf16x8*)(QB + qrow * CA + h * 64 + 16 * s + 8 * hi);
    f32x16 st[5];
#pragma unroll
    for (int j = 0; j < 5; ++j) { int mk = mqw - 128 + 32 * j + r32; mk = mk < 0 ? 0 : mk;
        const bf16* kp = KB + (size_t)(b * TSEQ + mk * dil + cls) * CA + h * 64 + 8 * hi;
        f32x16 a = {0.f, 0.f, 0.f, 0.f, 0.f, 0.f, 0.f, 0.f, 0.f, 0.f, 0.f, 0.f, 0.f, 0.f, 0.f, 0.f};
#pragma unroll
        for (int s = 0; s < 4; ++s) { const bf16x8 kf = *(const GAS bf16x8*)(kp + 16 * s); a = __builtin_amdgcn_mfma_f32_32x32x16_bf16(kf, qf[s], a, 0, 0, 0); }
        st[j] = a; }
    const float slope2 = __builtin_amdgcn_exp2f(-(float)(h + 1)) * LOG2E * (float)dil;
    float mx = -INFINITY;
#pragma unroll
    for (int j = 0; j < 5; ++j)
#pragma unroll
        for (int i = 0; i < 16; ++i) { const int kr = crow(i, hi), dist = 128 - 32 * j + r32 - kr, mke = mqw - 128 + 32 * j + kr;
            const bool ok = dist >= 0 && dist <= 128 && mke >= 0;
            const float v = ok ? st[j][i] - slope2 * (float)dist : -INFINITY; st[j][i] = v; mx = fmaxf(mx, v); }
    mx = fmaxf(mx, shx(mx, 32, lane));
    float l = 0.f;
#pragma unroll
    for (int j = 0; j < 5; ++j)
#pragma unroll
        for (int i = 0; i < 16; ++i) { const float p = __builtin_amdgcn_exp2f(st[j][i] - mx); st[j][i] = p; l += p; }
    l += shx(l, 32, lane);
    f32x16 o0 = {0.f, 0.f, 0.f, 0.f, 0.f, 0.f, 0.f, 0.f, 0.f, 0.f, 0.f, 0.f, 0.f, 0.f, 0.f, 0.f}, o1 = o0;
    const int i16 = lane & 15, qq = i16 >> 2, pp = i16 & 3, blk = (lane >> 4) & 1;
    LAS const unsigned char* vbase = lds + (32 * wid + 4 * hi + qq) * VP + (16 * blk + 4 * pp) * 2;
#pragma unroll
    for (int j = 0; j < 5; ++j)
#pragma unroll
        for (int s2 = 0; s2 < 2; ++s2) {
            v4u pw; pw.x = cvtpk(st[j][8 * s2 + 0], st[j][8 * s2 + 1]); pw.y = cvtpk(st[j][8 * s2 + 2], st[j][8 * s2 + 3]); pw.z = cvtpk(st[j][8 * s2 + 4], st[j][8 * s2 + 5]); pw.w = cvtpk(st[j][8 * s2 + 6], st[j][8 * s2 + 7]);
            const bf16x8 xs = __builtin_bit_cast(bf16x8, pw);
            LAS const unsigned char* vp = vbase + (32 * j + 16 * s2) * VP;
            { const s16x4 lo = vtr(vp), hh = vtr(vp + 8 * VP); const bf16x8 vf = (bf16x8){lo[0], lo[1], lo[2], lo[3], hh[0], hh[1], hh[2], hh[3]};
              o0 = __builtin_amdgcn_mfma_f32_32x32x16_bf16(vf, xs, o0, 0, 0, 0); }
            { const s16x4 lo = vtr(vp + 64), hh = vtr(vp + 8 * VP + 64); const bf16x8 vf = (bf16x8){lo[0], lo[1], lo[2], lo[3], hh[0], hh[1], hh[2], hh[3]};
              o1 = __builtin_amdgcn_mfma_f32_32x32x16_bf16(vf, xs, o1, 0, 0, 0); }
        }
    const float inv = __builtin_amdgcn_rcpf(l);
    bf16* orow = OGg + qrow * CA + h * 64 + 4 * hi;
#pragma unroll
    for (int g4 = 0; g4 < 4; ++g4) {
        u32x2 w0, w1;
        w0.x = cvtpk(o0[4 * g4] * inv, o0[4 * g4 + 1] * inv); w0.y = cvtpk(o0[4 * g4 + 2] * inv, o0[4 * g4 + 3] * inv);
        w1.x = cvtpk(o1[4 * g4] * inv, o1[4 * g4 + 1] * inv); w1.y = cvtpk(o1[4 * g4 + 2] * inv, o1[4 * g4 + 3] * inv);
        *(GAS u32x2*)(orow + 8 * g4) = w0; *(GAS u32x2*)(orow + 32 + 8 * g4) = w1; }
    if (hi == 0) LSEg[qrow * NH + h] = mx + __builtin_amdgcn_logf(l);
    __syncthreads();
}
__device__ __forceinline__ void attn_prompt(const Ctx& C, const bf16* QB, const bf16* KB, const bf16* VB, bf16* OG, float* LSE) {
    for (int i = 0; i < 12; ++i) {
        const int u = C.vcu * 12 + i, bh = u / 48, k48 = u % 48, g = k48 >> 4, k = k48 & 15;
        const int b = bh >> 3, h = bh & 7;
        int cls, mq0, dil;
        if (g == 0) { cls = 0; mq0 = 256 * k; dil = 1; } else if (g == 1) { cls = k >> 2; mq0 = 256 * (k & 3); dil = 4; } else { cls = k; mq0 = 0; dil = 16; }
        attn_unit(C, QB, KB, VB, OG + (size_t)g * MPR * CA, LSE + (size_t)g * MPR * NH, b, h, cls, mq0, dil);
    }
}
__device__ __forceinline__ void attn_sample(const Ctx& C, const bf16* QB, const float* ck, const float* cv, const float* out, bf16* HEADS) {
    if (C.vcu >= SB * NH) return;
    const int b = C.vcu >> 3, h = C.vcu & 7, s = C.wave & 3, half = C.wave >> 2, lane = C.lane;
    LAS float* qs = (LAS float*)(C.lds + C.wave * 2048);
    LAS float* ps = qs + 64;
    LAS float* part = (LAS float*)(C.lds + 16384 + C.wave * 512);
    const int row = MPR + b * SS + s, n0 = half * 194, cnt = half ? 193 : 194;
    qs[lane] = bf1(QB[(size_t)row * CA + h * 64 + lane]);
    LDS_WAIT(); asm volatile("" ::: "memory");
    const float slope2 = __builtin_amdgcn_exp2f(-(float)(h + 1)) * LOG2E;
    const float* kbase = ck + ((size_t)b * WINL * NH + h) * HD; const float* knew = out + O_KWS + ((size_t)(b * WINL + (WINL - SS)) * NH + h) * HD;
    const float* vbase = cv + ((size_t)b * WINL * NH + h) * HD; const float* vnew = out + O_VWS + ((size_t)(b * WINL + (WINL - SS)) * NH + h) * HD;
    float sc[4]; float mx = -INFINITY;
#pragma unroll
    for (int it = 0; it < 4; ++it) {
        const int nl = it * 64 + lane, n = n0 + (nl < cnt ? nl : 0), g = (n >= 129) + (n >= 258), jj = n - 129 * g, dist = jj << (2 * g), idx = WINL + s - dist;
        const float* kr = idx < WINL ? kbase + (size_t)idx * (NH * HD) : knew + (size_t)(idx - WINL) * (NH * HD);
        float d = 0.f;
#pragma unroll
        for (int c = 0; c < 16; ++c) { const f32x4 kv = *(const GAS f32x4*)(kr + 4 * c); const f32x4 qv = *(LAS const f32x4*)(qs + 4 * c); d += kv[0] * qv[0] + kv[1] * qv[1] + kv[2] * qv[2] + kv[3] * qv[3]; }
        sc[it] = nl < cnt ? d - slope2 * (float)dist : -INFINITY;
        mx = fmaxf(mx, sc[it]); }
#pragma unroll
    for (int o = 1; o < 64; o <<= 1) mx = fmaxf(mx, shx(mx, o, lane));
    float l = 0.f;
#pragma unroll
    for (int it = 0; it < 4; ++it) { const float pe = __builtin_amdgcn_exp2f(sc[it] - mx); ps[it * 64 + lane] = pe; l += pe; }
    l = wave_sum(l, lane);
    LDS_WAIT(); asm volatile("" ::: "memory");
    const int kq = lane >> 4, d4 = lane & 15;
    f32x4 o4 = {0.f, 0.f, 0.f, 0.f};
#pragma unroll 7
    for (int nb = 0; nb < 49; ++nb) {
        const int nl = nb * 4 + kq, n = n0 + (nl < cnt ? nl : 0), g = (n >= 129) + (n >= 258), jj = n - 129 * g, dist = jj << (2 * g), idx = WINL + s - dist;
        const float* vr = idx < WINL ? vbase + (size_t)idx * (NH * HD) : vnew + (size_t)(idx - WINL) * (NH * HD);
        const f32x4 vv = *(const GAS f32x4*)(vr + 4 * d4);
        const float pe = nl < cnt ? ps[nl] : 0.f;
        o4 += vv * pe; }
#pragma unroll
    for (int e = 0; e < 4; ++e) { float v = o4[e]; v += shx(v, 16, lane); v += shx(v, 32, lane); o4[e] = v; }
    if (lane < 16) *(LAS f32x4*)(part + 16 + 4 * d4) = o4;
    if (lane == 0) { part[0] = mx; part[1] = l; }
    __syncthreads();
    if (half == 0) {
        LAS const float* p0 = part, *p1 = part + 4 * 128;
        const float m0 = p0[0], m1 = p1[0], M = fmaxf(m0, m1), f0 = __builtin_amdgcn_exp2f(m0 - M), f1 = __builtin_amdgcn_exp2f(m1 - M);
        const float L = p0[1] * f0 + p1[1] * f1, o = (p0[16 + lane] * f0 + p1[16 + lane] * f1) / L;
        HEADS[(size_t)row * DM + h * 64 + lane] = (bf16)(cvtpk(o, 0.f) & 0xffffu);
    }
    __syncthreads();
}

__device__ __forceinline__ void attn_merge(const Ctx& C, const bf16* OG, const float* LSE, bf16* HEADS) {
    const int gt = C.vcu * (NWAVES * 64) + C.tid, NT = C.G * NWAVES * 64;
    for (int i = gt; i < MPR * 64; i += NT) { const int row = i >> 6, ch = i & 63, h = ch >> 3;
        float ls[3], mx = -INFINITY;
#pragma unroll
        for (int g = 0; g < 3; ++g) { ls[g] = LSE[((size_t)g * MPR + row) * NH + h]; mx = fmaxf(mx, ls[g]); }
        float w[3], ws = 0.f;
#pragma unroll
        for (int g = 0; g < 3; ++g) { w[g] = __builtin_amdgcn_exp2f(ls[g] - mx); ws += w[g]; }
        const float inv = __builtin_amdgcn_rcpf(ws);
        float acc[8] = {0.f, 0.f, 0.f, 0.f, 0.f, 0.f, 0.f, 0.f};
#pragma unroll
        for (int g = 0; g < 3; ++g) { const v4u v = *(const GAS v4u*)(OG + ((size_t)g * MPR + row) * CA + ch * 8); const float wg = w[g] * inv;
            acc[0] += wg * bflo(v.x); acc[1] += wg * bfhi(v.x); acc[2] += wg * bflo(v.y); acc[3] += wg * bfhi(v.y); acc[4] += wg * bflo(v.z); acc[5] += wg * bfhi(v.z); acc[6] += wg * bflo(v.w); acc[7] += wg * bfhi(v.w); }
        v4u o; o.x = cvtpk(acc[0], acc[1]); o.y = cvtpk(acc[2], acc[3]); o.z = cvtpk(acc[4], acc[5]); o.w = cvtpk(acc[6], acc[7]);
        *(GAS v4u*)(HEADS + (size_t)row * DM + ch * 8) = o; }
}

struct RwkvW { const float *mu, *k_k, *k_a, *r_k, *lnx_w, *lnx_b; };
struct RwkvTok { float nkk, ka, d, kp, r, v, bon; };
__device__ __forceinline__ RwkvTok rwkv_tok(float zr, float zk, float zv, float pr, float pk, float pv, float lam, float a, float mur, float muk, float muv, float kkw, float kaw, float rkw, int lane) {
    RwkvTok o;
    const float r = zr + (pr - zr) * mur, k = zk + (pk - zk) * muk, v = zv + (pv - zv) * muv;
    const float kkr = k * kkw; const float ss = wave_sum_dpp(kkr * kkr);
    const float kk = kkr * __builtin_amdgcn_rsqf(fmaxf(ss, 1e-24f));
    const float kp = k * (1.0f + (a - 1.0f) * kaw);
    o.nkk = -kk; o.ka = kk * a; o.d = __builtin_amdgcn_exp2f(-lam * LOG2E); o.kp = kp; o.r = r; o.v = v; o.bon = wave_sum_dpp(r * kp * rkw);
    return o;
}
__device__ __forceinline__ void rwkv_chunk(const Ctx& C, const bf16* ZB, const bf16* LAM, const bf16* AA, const RwkvW& W, float* YL, float* U, bf16* BV, float* PHI, float* SLOC, int b, int h, int c,
                                           const float* ck, const float* cv, float* out) {
    constexpr unsigned PERB = (WINL - SS) * CA / 4, CPY_TOTAL = SB * PERB;
    const unsigned cbase = (unsigned)(C.vcu * NWAVES + C.wave) * (CHL * 64) + C.lane;
    const int lane = C.lane;
    LAS float* tokb = (LAS float*)(C.lds + C.wave * 12288);
    float S[64], P[64];
#pragma unroll
    for (int j = 0; j < 64; ++j) { S[j] = 0.f; P[j] = (j == lane) ? 1.f : 0.f; }
    const int hc = h * 64 + lane;
    const float mur = W.mu[hc], muk = W.mu[512 + hc], muv = W.mu[1024 + hc], kkw = W.k_k[hc], kaw = W.k_a[hc], rkw = W.r_k[hc];
    const int t0 = c * CHL; const size_t row0 = (size_t)b * TSEQ + t0;
    float pr = 0.f, pk = 0.f, pv = 0.f;
    if (t0 > 0) { const bf16* zp = ZB + (row0 - 1) * DBIN + hc; pr = bf1(zp[0]); pk = bf1(zp[512]); pv = bf1(zp[1024]); }
    LAS float* dend = tokb + 8 * 320;
    for (int sb = 0; sb < CHL / 8; ++sb) {
        float zr[8], zk[8], zv[8], lm[8], aa[8];
#pragma unroll
        for (int tt = 0; tt < 8; ++tt) { const size_t row = row0 + sb * 8 + tt; const bf16* zp = ZB + row * DBIN + hc;
            zr[tt] = bf1(zp[0]); zk[tt] = bf1(zp[512]); zv[tt] = bf1(zp[1024]); lm[tt] = bf1(LAM[row * CB + hc]); aa[tt] = bf1(AA[row * CB + hc]); }
        float Dp = 1.0f;
#pragma unroll
        for (int tt = 0; tt < 8; ++tt) {
            const RwkvTok o = rwkv_tok(zr[tt], zk[tt], zv[tt], pr, pk, pv, lm[tt], aa[tt], mur, muk, muv, kkw, kaw, rkw, lane);
            pr = zr[tt]; pk = zk[tt]; pv = zv[tt];
            const float Dc = Dp * o.d, inv = __builtin_amdgcn_rcpf(Dc);
            LAS float* tk = tokb + tt * 320;
            tk[lane] = o.nkk * Dp; tk[64 + lane] = o.ka * inv; tk[128 + lane] = o.kp * inv; tk[192 + lane] = o.r * Dc; tk[256 + lane] = o.v;
            Dp = Dc;
            BV[(row0 + sb * 8 + tt) * CB + hc] = (bf16)(cvtpk(o.bon * o.v, 0.f) & 0xffffu);
        }
        dend[lane] = Dp;
        LDS_WAIT(); asm volatile("" ::: "memory");
#pragma unroll 1
        for (int tt = 0; tt < 8; ++tt) {
            LAS const float* tk = tokb + tt * 320;
            unsigned ci = cbase + (unsigned)(sb * 8 + tt) * 64u; const bool cisv = ci >= CPY_TOTAL; ci -= cisv ? CPY_TOTAL : 0u;
            const bool cok = ci < CPY_TOTAL; const unsigned cb = ci / PERB, co = ci - cb * PERB; const size_t cdst = (size_t)cb * (WINL * CA / 4) + co;
            f32x4 cval = {0.f, 0.f, 0.f, 0.f};
            if (cok) cval = __builtin_nontemporal_load((const f32x4*)(cisv ? cv : ck) + (cdst + (SS * CA / 4)));
#define LD4(off) (*(LAS const f32x4*)(tk + (off)))
            const float vi = tk[256 + lane];
            float sS0 = 0.f, sS1 = 0.f, sP0 = 0.f, sP1 = 0.f;
#pragma unroll
            for (int j4 = 0; j4 < 16; ++j4) { const f32x4 n4 = LD4(4 * j4);
                sS0 = fmaf(S[4 * j4], n4[0], sS0); sS1 = fmaf(S[4 * j4 + 1], n4[1], sS1); sS0 = fmaf(S[4 * j4 + 2], n4[2], sS0); sS1 = fmaf(S[4 * j4 + 3], n4[3], sS1);
                sP0 = fmaf(P[4 * j4], n4[0], sP0); sP1 = fmaf(P[4 * j4 + 1], n4[1], sP1); sP0 = fmaf(P[4 * j4 + 2], n4[2], sP0); sP1 = fmaf(P[4 * j4 + 3], n4[3], sP1); }
            const float saS = sS0 + sS1, saP = sP0 + sP1;
            float yS0 = 0.f, yS1 = 0.f, yP0 = 0.f, yP1 = 0.f;
#pragma unroll
            for (int j4 = 0; j4 < 16; ++j4) {
                const f32x4 ka = LD4(64 + 4 * j4), kp = LD4(128 + 4 * j4), r = LD4(192 + 4 * j4);
#pragma unroll
                for (int e = 0; e < 4; ++e) { const int j = 4 * j4 + e;
                    S[j] = fmaf(saS, ka[e], fmaf(vi, kp[e], S[j]));
                    P[j] = fmaf(saP, ka[e], P[j]);
                    if (e & 1) { yS1 = fmaf(S[j], r[e], yS1); yP1 = fmaf(P[j], r[e], yP1); } else { yS0 = fmaf(S[j], r[e], yS0); yP0 = fmaf(P[j], r[e], yP0); } }
            }
#undef LD4
            const size_t row = row0 + sb * 8 + tt;
            YL[row * CB + hc] = yS0 + yS1; U[row * CB + hc] = yP0 + yP1;
            if (cok) __builtin_nontemporal_store(cval, (f32x4*)(out + (cisv ? O_VWS : O_KWS)) + cdst);
        }
#pragma unroll
        for (int j4 = 0; j4 < 16; ++j4) { const f32x4 d4 = *(LAS const f32x4*)(dend + 4 * j4);
            S[4 * j4] *= d4[0]; S[4 * j4 + 1] *= d4[1]; S[4 * j4 + 2] *= d4[2]; S[4 * j4 + 3] *= d4[3];
            P[4 * j4] *= d4[0]; P[4 * j4 + 1] *= d4[1]; P[4 * j4 + 2] *= d4[2]; P[4 * j4 + 3] *= d4[3]; }
    }
    float* so = SLOC + ((size_t)((b * NH + h) * NCHUNK + c) * 64 + lane) * 64;
    float* po = PHI + ((size_t)((b * NH + h) * NCHUNK + c) * 64 + lane) * 64;
#pragma unroll
    for (int j4 = 0; j4 < 16; ++j4) { *(GAS f32x4*)(so + 4 * j4) = (f32x4){S[4 * j4], S[4 * j4 + 1], S[4 * j4 + 2], S[4 * j4 + 3]}; *(GAS f32x4*)(po + 4 * j4) = (f32x4){P[4 * j4], P[4 * j4 + 1], P[4 * j4 + 2], P[4 * j4 + 3]}; }
}
__device__ __forceinline__ void rwkv_sample(const Ctx& C, const bf16* ZB, const bf16* LAM, const bf16* AA, const bf16* G, const RwkvW& W, const float* state_wkv, const float* state_shift, bf16* HEADS, float* out) {
    if (C.vcu >= SB * NH || C.wave != 0) return;
    const int b = C.vcu >> 3, h = C.vcu & 7, lane = C.lane, hc = h * 64 + lane;
    LAS float* tk = (LAS float*)(C.lds + 98304);
    LAS float* Sl = (LAS float*)(C.lds + 98304 + 2048) + lane * 65;
    const float* s0 = state_wkv + ((size_t)(b * NH + h) * 64 + lane) * 64;
#pragma unroll 4
    for (int j = 0; j < 64; ++j) Sl[j] = s0[j];
    float pr = state_shift[(size_t)b * DBIN + hc], pk = state_shift[(size_t)b * DBIN + 512 + hc], pv = state_shift[(size_t)b * DBIN + 1024 + hc];
#pragma unroll 1
    for (int s = 0; s < SS; ++s) {
        const size_t row = (size_t)MPR + b * SS + s; const bf16* zp = ZB + row * DBIN + hc;
        const float zr = bf1(zp[0]), zk = bf1(zp[512]), zv = bf1(zp[1024]);
        const RwkvTok o = rwkv_tok(zr, zk, zv, pr, pk, pv, bf1(LAM[row * CB + hc]), bf1(AA[row * CB + hc]), W.mu[hc], W.mu[512 + hc], W.mu[1024 + hc], W.k_k[hc], W.k_a[hc], W.r_k[hc], lane);
        pr = zr; pk = zk; pv = zv;
        tk[lane] = o.nkk; tk[64 + lane] = o.ka; tk[128 + lane] = o.d; tk[192 + lane] = o.kp; tk[256 + lane] = o.r;
        LDS_WAIT(); asm volatile("" ::: "memory");
        float sa = 0.f;
#pragma unroll 4
        for (int j = 0; j < 64; ++j) sa = fmaf(Sl[j], tk[j], sa);
        float y = 0.f;
#pragma unroll 4
        for (int j = 0; j < 64; ++j) { float t = o.v * tk[192 + j]; t = fmaf(sa, tk[64 + j], t); const float sn = fmaf(Sl[j], tk[128 + j], t); Sl[j] = sn; y = fmaf(sn, tk[256 + j], y); }
        const float ym = wave_sum(y, lane) * (1.0f / 64.0f), dy = y - ym, yv = wave_sum(dy * dy, lane) * (1.0f / 64.0f);
        const float yn = dy * __builtin_amdgcn_rsqf(yv + GN_EPS) * W.lnx_w[hc] + W.lnx_b[hc];
        const float res = (yn + o.bon * o.v) * bf1(G[row * CB + hc]);
        HEADS[row * DM + CA + hc] = (bf16)(cvtpk(res, 0.f) & 0xffffu);
        LDS_WAIT(); asm volatile("" ::: "memory");
    }
    float* so = out + O_WKVS + ((size_t)(b * NH + h) * 64 + lane) * 64;
#pragma unroll 4
    for (int j = 0; j < 64; ++j) so[j] = Sl[j];
}

__device__ __forceinline__ void rwkv_carry(const Ctx& C, const float* PHI, const float* SLOC, float* SC, float* out) {
    const int bh = C.vcu >> 2, rq = C.vcu & 3, tid = C.tid;
    if (bh >= NBATCH * NH) return;
    LAS float* cur = (LAS float*)(C.lds);
    LAS float* phi = (LAS float*)(C.lds + 8192);
    const int row = tid >> 5, cp = tid & 31;
    const size_t gbase = ((size_t)(bh * NCHUNK) * 64 + rq * 16 + row) * 64 + 2 * cp;
    f32x4 pre[2]; f32x2_t sl;
    { const float* p0 = PHI + (size_t)(bh * NCHUNK) * 4096; pre[0] = *(const GAS f32x4*)(p0 + tid * 4); pre[1] = *(const GAS f32x4*)(p0 + 2048 + tid * 4); sl = *(const GAS f32x2_t*)(SLOC + gbase); }
    f32x2_t cv = {0.f, 0.f};
    for (int c = 0; c < NCHUNK; ++c) {
        LAS float* ph = phi + (c & 1) * 4096;
        *(LAS f32x4*)(ph + tid * 4) = pre[0]; *(LAS f32x4*)(ph + 2048 + tid * 4) = pre[1];
        *(LAS f32x2_t*)(cur + (c & 1) * 1024 + row * 64 + 2 * cp) = cv;
        const f32x2_t slc = sl;
        if (c + 1 < NCHUNK) { const float* p1 = PHI + (size_t)(bh * NCHUNK + c + 1) * 4096; pre[0] = *(const GAS f32x4*)(p1 + tid * 4); pre[1] = *(const GAS f32x4*)(p1 + 2048 + tid * 4); sl = *(const GAS f32x2_t*)(SLOC + gbase + (size_t)(c + 1) * 4096); }
        *(GAS f32x2_t*)(SC + gbase + (size_t)c * 4096) = cv;
        __syncthreads();
        LAS const float* cr_ = cur + (c & 1) * 1024 + row * 64;
        float a0 = slc[0], a1 = slc[1];
#pragma unroll 4
        for (int k4 = 0; k4 < 16; ++k4) { const f32x4 cr = *(LAS const f32x4*)(cr_ + 4 * k4);
#pragma unroll
            for (int e = 0; e < 4; ++e) { const f32x2_t pv = *(LAS const f32x2_t*)(ph + (4 * k4 + e) * 64 + 2 * cp); a0 = fmaf(cr[e], pv[0], a0); a1 = fmaf(cr[e], pv[1], a1); } }
        cv = (f32x2_t){a0, a1};
    }
    *(GAS f32x2_t*)(out + O_WKVP + ((size_t)bh * 64 + rq * 16 + row) * 64 + 2 * cp) = cv;
    __syncthreads();
}

__device__ __forceinline__ void rwkv_finish(const Ctx& C, const float* YL, const float* U, const float* SC, const bf16* BV, const bf16* G, const RwkvW& W, bf16* HEADS) {
    constexpr int FP = 68;
    const int tid = C.tid, lane = C.lane, r32 = lane & 31, hi = lane >> 5, slot = C.wave >> 2, wq = C.wave & 3, t256 = tid & 255;
    LAS float* Ss = (LAS float*)(C.lds + slot * 52224);
    LAS float* Us = Ss + 64 * FP;
    if ((C.vcu >> 2) >= NBATCH * NH) return;
    for (int pass = 0; pass < 4; ++pass) {
        const int item = C.vcu * 8 + pass * 2 + slot, bh = item >> 5, c = item & 31, b = bh >> 3, h = bh & 7;
        const float* sc = SC + (size_t)(bh * NCHUNK + c) * 4096;
        const size_t row0 = (size_t)b * TSEQ + c * CHL;
#pragma unroll
        for (int k = 0; k < 4; ++k) { const int e = t256 * 4 + k * 1024; *(LAS f32x4*)(Ss + (e >> 6) * FP + (e & 63)) = *(const GAS f32x4*)(sc + e); }
#pragma unroll
        for (int k = 0; k < 8; ++k) { const int e = t256 * 4 + k * 1024, t = e >> 6, j = e & 63; *(LAS f32x4*)(Us + t * FP + j) = *(const GAS f32x4*)(U + (row0 + t) * CB + h * 64 + j); }
        __syncthreads();
        const size_t row = row0 + wq * 32 + r32;
        f32x16 acc[2];
#pragma unroll
        for (int tl = 0; tl < 2; ++tl)
#pragma unroll
            for (int g4 = 0; g4 < 4; ++g4) { const f32x4 v = *(const GAS f32x4*)(YL + row * CB + h * 64 + 32 * tl + 8 * g4 + 4 * hi); acc[tl][4 * g4] = v[0]; acc[tl][4 * g4 + 1] = v[1]; acc[tl][4 * g4 + 2] = v[2]; acc[tl][4 * g4 + 3] = v[3]; }
        LAS const float* ua = Us + (wq * 32 + r32) * FP + 4 * hi;
        LAS const float* sa0 = Ss + r32 * FP + 4 * hi;
#pragma unroll
        for (int q = 0; q < 8; ++q) {
            const f32x4 b4 = *(LAS const f32x4*)(ua + 8 * q), a0 = *(LAS const f32x4*)(sa0 + 8 * q), a1 = *(LAS const f32x4*)(sa0 + 32 * FP + 8 * q);
#pragma unroll
            for (int e = 0; e < 4; ++e) { acc[0] = __builtin_amdgcn_mfma_f32_32x32x2f32(a0[e], b4[e], acc[0], 0, 0, 0); acc[1] = __builtin_amdgcn_mfma_f32_32x32x2f32(a1[e], b4[e], acc[1], 0, 0, 0); }
        }
        float sm = 0.f;
#pragma unroll
        for (int tl = 0; tl < 2; ++tl)
#pragma unroll
            for (int e = 0; e < 16; ++e) sm += acc[tl][e];
        sm += shx(sm, 32, lane);
        const float ym = sm * (1.0f / 64.0f); float sv = 0.f;
#pragma unroll
        for (int tl = 0; tl < 2; ++tl)
#pragma unroll
            for (int e = 0; e < 16; ++e) { const float d = acc[tl][e] - ym; acc[tl][e] = d; sv += d * d; }
        sv += shx(sv, 32, lane);
        const float rs = __builtin_amdgcn_rsqf(sv * (1.0f / 64.0f) + GN_EPS);
#pragma unroll
        for (int tl = 0; tl < 2; ++tl)
#pragma unroll
            for (int g4 = 0; g4 < 4; ++g4) { const int ic = h * 64 + 32 * tl + 8 * g4 + 4 * hi;
                const f32x4 lw = *(const GAS f32x4*)(W.lnx_w + ic), lb = *(const GAS f32x4*)(W.lnx_b + ic);
                const u32x2 bw = *(const GAS u32x2*)(BV + row * CB + ic), gw = *(const GAS u32x2*)(G + row * CB + ic);
                const float r0 = (acc[tl][4 * g4] * rs * lw[0] + lb[0] + bflo(bw.x)) * bflo(gw.x), r1 = (acc[tl][4 * g4 + 1] * rs * lw[1] + lb[1] + bfhi(bw.x)) * bfhi(gw.x);
                const float r2 = (acc[tl][4 * g4 + 2] * rs * lw[2] + lb[2] + bflo(bw.y)) * bflo(gw.y), r3 = (acc[tl][4 * g4 + 3] * rs * lw[3] + lb[3] + bfhi(bw.y)) * bfhi(gw.y);
                u32x2 ow; ow.x = cvtpk(r0, r1); ow.y = cvtpk(r2, r3);
                *(GAS u32x2*)(HEADS + row * DM + CA + ic) = ow; }
        __syncthreads();
    }
}

template <int U> __device__ __forceinline__ f32x16 thin_acc(const bf16* ap, const bf16* bp, int klen, f32x16 acc) {
#pragma unroll 1
    for (int k = 0; k < klen; k += 16 * U) {
        bf16x8 a[U], b[U];
#pragma unroll
        for (int u = 0; u < U; ++u) { a[u] = *(const GAS bf16x8*)(ap + k + 16 * u); b[u] = *(const GAS bf16x8*)(bp + k + 16 * u); }
#pragma unroll
        for (int u = 0; u < U; ++u) acc = __builtin_amdgcn_mfma_f32_32x32x16_bf16(a[u], b[u], acc, 0, 0, 0);
    }
    return acc;
}
#define F16Z (f32x16){0.f, 0.f, 0.f, 0.f, 0.f, 0.f, 0.f, 0.f, 0.f, 0.f, 0.f, 0.f, 0.f, 0.f, 0.f, 0.f}
#define THIN_LOOP(ntiles) const int lane = C.lane, r32 = lane & 31, hi = lane >> 5; for (int t = (255 - (int)blockIdx.x) * NWAVES + C.wave; t < (ntiles); t += 256 * NWAVES)
__device__ __forceinline__ void thin_lora(const Ctx& C, const bf16* AP, const bf16* Wl, const float* w0, const float* a0, bf16* LAM) {
    THIN_LOOP(192) { const int grp = t >> 6, rb = (t >> 4) & 3, cb = t & 15, koff = grp == 0 ? 0 : grp == 1 ? 64 : 128, klen = grp == 2 ? 128 : 64;
        const f32x16 acc = thin_acc<4>(AP + (size_t)(MPR + rb * 32 + r32) * 256 + koff + 8 * hi, Wl + (size_t)(grp * 512 + cb * 32 + r32) * 256 + koff + 8 * hi, klen, F16Z);
        const int n = cb * 32 + r32; const float bias = grp == 0 ? w0[n] : grp == 1 ? a0[n] : 0.f, mul = grp == 0 ? 0.6065306597126334f : 1.0f;
        bf16* dst = LAM + (size_t)grp * ((size_t)MT * CB);
#pragma unroll
        for (int i = 0; i < 16; ++i) { float v = acc[i] + bias; if (grp < 2) v = mul * sigm(v); dst[(size_t)(MPR + rb * 32 + crow(i, hi)) * CB + n] = (bf16)(cvtpk(v, 0.f) & 0xffffu); } }
}
#define THIN_WG_LOOP(ntiles) const int lane = C.lane, r32 = lane & 31, hi = lane >> 5, wv = C.wave; for (int t = 255 - (int)blockIdx.x; t < (ntiles); t += 256)
template <int NACC> __device__ __forceinline__ void thin_reduce(const Ctx& C, const f32x16 (&acc)[NACC], float (&res)[NACC][2]) {
    LAS float* red = (LAS float*)C.lds;
#pragma unroll
    for (int a = 0; a < NACC; ++a)
#pragma unroll
        for (int i = 0; i < 16; ++i) red[((a * 8 + C.wave) * 16 + i) * 64 + C.lane] = acc[a][i];
    __syncthreads();
#pragma unroll
    for (int a = 0; a < NACC; ++a)
#pragma unroll
        for (int q = 0; q < 2; ++q) { float s = 0.f;
#pragma unroll
            for (int w = 0; w < 8; ++w) s += red[((a * 8 + w) * 16 + 2 * C.wave + q) * 64 + C.lane];
            res[a][q] = s; }
    __syncthreads();
}
__device__ __forceinline__ void thin_wout(const Ctx& C, const bf16* HEADS, const bf16* Wout, const float* xs, bf16* PRE) {
    THIN_WG_LOOP(128) { const int rb = t >> 5, cb = t & 31, n = cb * 32 + r32;
        f32x16 acc[1]; float res[1][2];
        acc[0] = thin_acc<8>(HEADS + (size_t)(MPR + rb * 32 + r32) * DM + 8 * hi + wv * 128, Wout + (size_t)n * DM + 8 * hi + wv * 128, 128, F16Z);
        thin_reduce<1>(C, acc, res);
#pragma unroll
        for (int q = 0; q < 2; ++q) { const int rs = rb * 32 + crow(2 * wv + q, hi); PRE[(size_t)(MPR + rs) * DM + n] = (bf16)(cvtpk(res[0][q] + ALPHA * xs[(size_t)rs * DM + n], 0.f) & 0xffffu); } }
}
__device__ __forceinline__ void thin_gu(const Ctx& C, const bf16* H1, const bf16* Wgu, bf16* ACT) {
    THIN_WG_LOOP(352) { const int rb = t / 88, fb = t % 88, f = fb * 32 + r32, grow = (f >> 7) * 256 + (f & 127);
        const bf16* ap = H1 + (size_t)(MPR + rb * 32 + r32) * DM + 8 * hi + wv * 128;
        f32x16 acc[2]; float res[2][2];
        acc[0] = thin_acc<8>(ap, Wgu + (size_t)grow * DM + 8 * hi + wv * 128, 128, F16Z);
        acc[1] = thin_acc<8>(ap, Wgu + (size_t)(grow + 128) * DM + 8 * hi + wv * 128, 128, F16Z);
        thin_reduce<2>(C, acc, res);
#pragma unroll
        for (int q = 0; q < 2; ++q) { const float g = res[0][q]; ACT[(size_t)(MPR + rb * 32 + crow(2 * wv + q, hi)) * DFF + f] = (bf16)(cvtpk(g * sigm(g) * res[1][q], 0.f) & 0xffffu); } }
}
__device__ __forceinline__ void thin_down(const Ctx& C, const bf16* ACT, const bf16* Wd, const bf16* H1, bf16* PRE) {
    THIN_WG_LOOP(128) { const int rb = t >> 5, cb = t & 31, n = cb * 32 + r32;
        f32x16 acc[1]; float res[1][2];
        acc[0] = thin_acc<11>(ACT + (size_t)(MPR + rb * 32 + r32) * DFF + 8 * hi + wv * 352, Wd + (size_t)n * DFF + 8 * hi + wv * 352, 352, F16Z);
        thin_reduce<1>(C, acc, res);
#pragma unroll
        for (int q = 0; q < 2; ++q) { const size_t o = (size_t)(MPR + rb * 32 + crow(2 * wv + q, hi)) * DM + n; PRE[o] = (bf16)(cvtpk(res[0][q] + ALPHA * bf1(H1[o]), 0.f) & 0xffffu); } }
}
__device__ __forceinline__ void thin_pp(const Ctx& C, const bf16* PB, const bf16* Wpp, bf16* PP) {
    THIN_WG_LOOP(128) { const int rb = t >> 5, cb = t & 31, n = cb * 32 + r32;
        f32x16 acc[1]; float res[1][2];
        acc[0] = thin_acc<2>(PB + (size_t)(MPR + rb * 32 + r32) * PLE + 8 * hi + wv * 32, Wpp + (size_t)n * PLE + 8 * hi + wv * 32, 32, F16Z);
        thin_reduce<1>(C, acc, res);
#pragma unroll
        for (int q = 0; q < 2; ++q) PP[(size_t)(MPR + rb * 32 + crow(2 * wv + q, hi)) * DM + n] = (bf16)(cvtpk(res[0][q], 0.f) & 0xffffu); }
}
__device__ __forceinline__ void thin_pg(const Ctx& C, const bf16* H2, const bf16* Wpg, const bf16* PP, bf16* PRE) {
    THIN_WG_LOOP(128) { const int rb = t >> 5, cb = t & 31, n = cb * 32 + r32;
        f32x16 acc[1]; float res[1][2];
        acc[0] = thin_acc<8>(H2 + (size_t)(MPR + rb * 32 + r32) * DM + 8 * hi + wv * 128, Wpg + (size_t)n * DM + 8 * hi + wv * 128, 128, F16Z);
        thin_reduce<1>(C, acc, res);
#pragma unroll
        for (int q = 0; q < 2; ++q) { const size_t o = (size_t)(MPR + rb * 32 + crow(2 * wv + q, hi)) * DM + n; PRE[o] = (bf16)(cvtpk(ALPHA * bf1(H2[o]) + sigm(res[0][q]) * bf1(PP[o]), 0.f) & 0xffffu); } }
}

template <int MODE> __device__ __forceinline__ void ln_pass(const Ctx& C, const bf16* PRE, const float* w, const float* bsh, bf16* Hout, float* out) {
    const int gw = C.vcu * NWAVES + C.wave, NGW = C.G * NWAVES, lane = C.lane;
    f32x4 wv[4], bv[4];
#pragma unroll
    for (int j = 0; j < 2; ++j) { wv[2 * j] = *(const GAS f32x4*)(w + 512 * j + 8 * lane); wv[2 * j + 1] = *(const GAS f32x4*)(w + 512 * j + 8 * lane + 4);
                                   bv[2 * j] = *(const GAS f32x4*)(bsh + 512 * j + 8 * lane); bv[2 * j + 1] = *(const GAS f32x4*)(bsh + 512 * j + 8 * lane + 4); }
    for (int row = gw; row < MPR + MSA; row += NGW) {
        const GAS v4u* xr = (const GAS v4u*)(PRE + (size_t)row * DM) + lane;
        f32x4 v[4]; float s = 0.f;
#pragma unroll
        for (int j = 0; j < 2; ++j) { const v4u q = xr[64 * j]; v[2 * j] = (f32x4){bflo(q.x), bfhi(q.x), bflo(q.y), bfhi(q.y)}; v[2 * j + 1] = (f32x4){bflo(q.z), bfhi(q.z), bflo(q.w), bfhi(q.w)}; }
#pragma unroll
        for (int j = 0; j < 4; ++j) s += (v[j][0] + v[j][1]) + (v[j][2] + v[j][3]);
        const float mean = wave_sum(s, lane) * (1.f / DM); float s2 = 0.f;
#pragma unroll
        for (int j = 0; j < 4; ++j) { v[j] = v[j] - mean; s2 += (v[j][0] * v[j][0] + v[j][1] * v[j][1]) + (v[j][2] * v[j][2] + v[j][3] * v[j][3]); }
        const float rstd = __builtin_amdgcn_rsqf(wave_sum(s2, lane) * (1.f / DM) + LN_EPS);
        if (MODE == 0) {
            GAS v4u* o8 = (GAS v4u*)(Hout + (size_t)row * DM) + lane;
#pragma unroll
            for (int j = 0; j < 2; ++j) { const f32x4 a = v[2 * j] * rstd * wv[2 * j] + bv[2 * j], b = v[2 * j + 1] * rstd * wv[2 * j + 1] + bv[2 * j + 1];
                v4u wq; wq.x = cvtpk(a[0], a[1]); wq.y = cvtpk(a[2], a[3]); wq.z = cvtpk(b[0], b[1]); wq.w = cvtpk(b[2], b[3]); o8[64 * j] = wq; }
        } else {
            float* dst = row < MPR ? out + O_YP + (size_t)row * DM : out + O_YS + (size_t)(row - MPR) * DM;
#pragma unroll
            for (int j = 0; j < 2; ++j) { *((GAS f32x4*)(dst + 512 * j + 8 * lane)) = v[2 * j] * rstd * wv[2 * j] + bv[2 * j]; *((GAS f32x4*)(dst + 512 * j + 8 * lane + 4)) = v[2 * j + 1] * rstd * wv[2 * j + 1] + bv[2 * j + 1]; }
        }
    }
}
struct Args { const float* in[32]; float* out; unsigned char* ws; int nphase, pad; };
#ifndef PHMASK
#define PHMASK 0xFFFFFF
#endif
#ifndef REPPH
#define REPPH -1
#endif
#ifndef REPN
#define REPN 3
#endif
#define PHON(n) if constexpr (((PHMASK) >> (n)) & 1) for (int rep_ = 0; rep_ < ((n) == (REPPH) ? (REPN) : 1); ++rep_)
#ifndef GEMM_ALIGN
#define GEMM_ALIGN true
#endif
#ifndef GEMM_SP2
#define GEMM_SP2 true
#endif
__global__ void __launch_bounds__(NWAVES * 64, 2) mega_fwd(Args args) {
    extern __shared__ __attribute__((aligned(16))) unsigned char lds_raw[];
    LAS unsigned char* const lds0 = (LAS unsigned char*)lds_raw;
    volatile LAS unsigned* MISC = (volatile LAS unsigned*)(lds0 + MISC_OFF);
    const int G0 = gridDim.x;
    for (int u = threadIdx.x; u < (LDS_BYTES - LDSCTL_OFF) / 4; u += NWAVES * 64) ((LAS unsigned*)(lds0 + LDSCTL_OFF))[u] = 0u;
    __syncthreads();
    gu32* ctl = (gu32*)(args.ws + WS_CTL);
    XcdBarrier bar = xcd_barrier_post((unsigned*)(ctl + CW_BAR), MISC + 8);
    const int nph = args.nphase;
#define GRID_BAR() xcd_barrier(bar)
    typedef const __attribute__((address_space(4))) Args* KArgs;
#define PH_BEGIN Ctx C; { int t_ = threadIdx.x; asm volatile("" : "+v"(t_)); C.lds = lds0; C.tid = t_; C.lane = t_ & 63; C.wave = __builtin_amdgcn_readfirstlane(t_ >> 6); C.G = G0; const int bx_ = blockIdx.x; C.vcu = (G0 % 8 == 0) ? (bx_ % 8) * (G0 / 8) + bx_ / 8 : bx_; } KArgs kp = (KArgs)__builtin_amdgcn_kernarg_segment_ptr(); asm volatile("" : "+s"(kp)); unsigned char* ws = kp->ws; float* out = kp->out; (void)ws; (void)out;
#define IN_(i) (kp->in[i])
#define WSB(off) ((bf16*)(ws + (off)))
#define WSF(off) ((float*)(ws + (off)))
    const int bx = (int)blockIdx.x;

    PHON(0) { PH_BEGIN P0Args A{IN_(0), IN_(1), IN_(2), IN_(3), IN_(4), IN_(5), IN_(8), IN_(20), IN_(23), IN_(24), IN_(25), IN_(28), IN_(29), IN_(11), IN_(13), IN_(14),
                       WSB(WS_WIN), WSB(WS_WOUT), WSB(WS_WGU), WSB(WS_WD), WSB(WS_WPG), WSB(WS_WPP), WSB(WS_WL), WSB(WS_R1), WSB(WS_PB), out};
      p0_prologue(C, A); }
    GRID_BAR(); if (nph <= 1) return;
    PHON(1) { PH_BEGIN pg8::Gemm g{WSB(WS_R1), WSB(WS_WIN), MT, DIN, DM}; pg8::StaticOrder S; S.init(MT, DIN, C.G, bx);
      pg8::EpiZ E{WSB(WS_QB), WSB(WS_ZB), out};
      pg8::gemm_phase<pg8::EpiZ, pg8::StaticOrder, GEMM_ALIGN, GEMM_SP2>(C.lds + RING_OFF, g, S, E); }
    GRID_BAR(); if (nph <= 2) return;
    PHON(2) { PH_BEGIN prep_a(C, WSB(WS_ZB), IN_(9), IN_(7), WSB(WS_AP), out); }
    PHON(3) { PH_BEGIN attn_prompt(C, WSB(WS_QB), WSB(WS_KB), WSB(WS_VB), WSB(WS_OG), WSF(WS_LSE)); }
    PHON(4) { PH_BEGIN attn_sample(C, WSB(WS_QB), IN_(4), IN_(5), out, WSB(WS_R1)); }
    GRID_BAR(); if (nph <= 3) return;
    PHON(5) { PH_BEGIN pg8::Gemm g{WSB(WS_AP), WSB(WS_WL), MPR, 1536, 256}; pg8::StaticOrder S; S.init(MPR, 1536, C.G, bx);
      pg8::EpiLora E{WSB(WS_QB), IN_(10), IN_(12)};
      pg8::gemm_phase<pg8::EpiLora, pg8::StaticOrder, GEMM_ALIGN, GEMM_SP2>(C.lds + RING_OFF, g, S, E);
      thin_lora(C, WSB(WS_AP), WSB(WS_WL), IN_(10), IN_(12), WSB(WS_QB)); }
    PHON(6) { PH_BEGIN attn_merge(C, WSB(WS_OG), WSF(WS_LSE), WSB(WS_R1)); }
    GRID_BAR(); if (nph <= 4) return;
    PHON(7) { PH_BEGIN const RwkvW RW{IN_(9), IN_(15), IN_(16), IN_(17), IN_(18), IN_(19)};
      rwkv_sample(C, WSB(WS_ZB), WSB(WS_QB), WSB(WS_KB), WSB(WS_VB), RW, IN_(6), IN_(7), WSB(WS_R1), out); }
    PHON(8) { PH_BEGIN const RwkvW RW{IN_(9), IN_(15), IN_(16), IN_(17), IN_(18), IN_(19)};
      const int bh = C.vcu >> 2, c = (C.vcu & 3) * 8 + C.wave;
      if (bh < NBATCH * NH) rwkv_chunk(C, WSB(WS_ZB), WSB(WS_QB), WSB(WS_KB), RW, out + O_YP, out + O_YP + (size_t)MPR * CB, WSB(WS_BV), WSF(WS_PHI), WSF(WS_SLOC), bh >> 3, bh & 7, c, IN_(4), IN_(5), out); }
    GRID_BAR(); if (nph <= 5) return;
    PHON(9) { PH_BEGIN rwkv_carry(C, WSF(WS_PHI), WSF(WS_SLOC), WSF(WS_SC), out); }
    GRID_BAR(); if (nph <= 6) return;
    PHON(10) { PH_BEGIN const RwkvW RW{IN_(9), IN_(15), IN_(16), IN_(17), IN_(18), IN_(19)};
      rwkv_finish(C, out + O_YP, out + O_YP + (size_t)MPR * CB, WSF(WS_SC), WSB(WS_BV), WSB(WS_VB), RW, WSB(WS_R1)); }
    GRID_BAR(); if (nph <= 7) return;
    PHON(11) { PH_BEGIN pg8::Gemm g{WSB(WS_R1), WSB(WS_WOUT), MPR, DM, DM}; pg8::StaticOrder S; S.init(MPR, DM, C.G, bx);
      pg8::EpiWout E{WSB(WS_PRE), IN_(0), IN_(1)};
      pg8::gemm_phase<pg8::EpiWout, pg8::StaticOrder, GEMM_ALIGN, GEMM_SP2>(C.lds + RING_OFF, g, S, E);
      thin_wout(C, WSB(WS_R1), WSB(WS_WOUT), IN_(1), WSB(WS_PRE)); }
    PHON(16) { PH_BEGIN pg8::Gemm g{WSB(WS_PB), WSB(WS_WPP), MPR, DM, PLE}; pg8::StaticOrder S; S.init(MPR, DM, C.G, bx);
      pg8::EpiPlain E{WSB(WS_PP)};
      pg8::gemm_phase<pg8::EpiPlain, pg8::StaticOrder, GEMM_ALIGN, GEMM_SP2>(C.lds + RING_OFF, g, S, E);
      thin_pp(C, WSB(WS_PB), WSB(WS_WPP), WSB(WS_PP)); }
    GRID_BAR(); if (nph <= 8) return;
    PHON(12) { PH_BEGIN ln_pass<0>(C, WSB(WS_PRE), IN_(21), IN_(22), WSB(WS_R1), out); }
    GRID_BAR(); if (nph <= 9) return;
    PHON(13) { PH_BEGIN pg8::Gemm g{WSB(WS_R1), WSB(WS_WGU), MPR, 2 * DFF, DM}; pg8::StaticOrder S; S.init(MPR, 2 * DFF, C.G, bx);
      pg8::EpiGU E{WSB(WS_ACT)};
      pg8::gemm_phase<pg8::EpiGU, pg8::StaticOrder, GEMM_ALIGN, GEMM_SP2>(C.lds + RING_OFF, g, S, E);
      thin_gu(C, WSB(WS_R1), WSB(WS_WGU), WSB(WS_ACT)); }
    GRID_BAR(); if (nph <= 10) return;
    PHON(14) { PH_BEGIN pg8::Gemm g{WSB(WS_ACT), WSB(WS_WD), MPR, DM, DFF}; pg8::StaticOrder S; S.init(MPR, DM, C.G, bx);
      pg8::EpiDown E{WSB(WS_PRE), WSB(WS_R1)};
      pg8::gemm_phase<pg8::EpiDown, pg8::StaticOrder, GEMM_ALIGN, GEMM_SP2>(C.lds + RING_OFF, g, S, E);
      thin_down(C, WSB(WS_ACT), WSB(WS_WD), WSB(WS_R1), WSB(WS_PRE)); }
    GRID_BAR(); if (nph <= 11) return;
    PHON(15) { PH_BEGIN ln_pass<0>(C, WSB(WS_PRE), IN_(26), IN_(27), WSB(WS_H2), out); }
    GRID_BAR(); if (nph <= 12) return;
    PHON(17) { PH_BEGIN pg8::Gemm g{WSB(WS_H2), WSB(WS_WPG), MPR, DM, DM}; pg8::StaticOrder S; S.init(MPR, DM, C.G, bx);
      pg8::EpiPle E{WSB(WS_PRE), WSB(WS_H2), WSB(WS_PP)};
      pg8::gemm_phase<pg8::EpiPle, pg8::StaticOrder, GEMM_ALIGN, GEMM_SP2>(C.lds + RING_OFF, g, S, E);
      thin_pg(C, WSB(WS_H2), WSB(WS_WPG), WSB(WS_PP), WSB(WS_PRE)); }
    GRID_BAR(); if (nph <= 14) return;
    PHON(18) { PH_BEGIN ln_pass<1>(C, WSB(WS_PRE), IN_(30), IN_(31), nullptr, out); }
}

#ifndef N_PHASES
#define N_PHASES 99
#endif
extern "C" void kernel_launch(void* const* d_in, const int* in_sizes, int n_in, void* d_out, int out_size, void* d_ws, size_t ws_size, hipStream_t stream) {
    static int grid = 0;
    if (grid == 0) {
        if (n_in != 32 || in_sizes[0] != MPR * DM || (size_t)out_size != O_END || ws_size < WS_END) {
            fprintf(stderr, "kernel_launch: unexpected shapes: n_in %d in0 %d out %d (want %zu) ws %zu (want >= %zu); nothing launched\n", n_in, n_in > 0 ? in_sizes[0] : -1, out_size, (size_t)O_END, ws_size, (size_t)WS_END);
            grid = -1; return; }
        int dev = 0, cus = 0, per_cu = 0;
        if (hipGetDevice(&dev) != hipSuccess || hipDeviceGetAttribute(&cus, hipDeviceAttributeMultiprocessorCount, dev) != hipSuccess) { fprintf(stderr, "kernel_launch: device query failed\n"); grid = -1; return; }
        if (hipFuncSetAttribute((const void*)mega_fwd, hipFuncAttributeMaxDynamicSharedMemorySize, LDS_BYTES) != hipSuccess) { fprintf(stderr, "kernel_launch: hipFuncSetAttribute failed\n"); grid = -1; return; }
        if (hipOccupancyMaxActiveBlocksPerMultiprocessor(&per_cu, (const void*)mega_fwd, NWAVES * 64, LDS_BYTES) != hipSuccess || per_cu < 1) { fprintf(stderr, "kernel_launch: occupancy query reports %d blocks per CU\n", per_cu); }
        (void)hipGetLastError();
        grid = cus;
        if (grid != 256) fprintf(stderr, "kernel_launch: note: %d CUs (work distribution assumes 256)\n", grid);
    }
    if (grid < 0) return;
    if (hipMemsetAsync((char*)d_ws + WS_CTL, 0, CTL_ZERO_BYTES, stream) != hipSuccess) { fprintf(stderr, "kernel_launch: memset failed\n"); return; }
    Args a{};
    for (int i = 0; i < 32; ++i) a.in[i] = (const float*)d_in[i];
    a.out = (float*)d_out; a.ws = (unsigned char*)d_ws; a.nphase = N_PHASES; a.pad = 0;
    hipLaunchKernelGGL(mega_fwd, dim3(grid), dim3(NWAVES * 64), LDS_BYTES, stream, a);
    const hipError_t le = hipPeekAtLastError();
    if (le != hipSuccess) fprintf(stderr, "kernel_launch: launch failed: %s\n", hipGetErrorName(le));
}
```

```cpp
#include <hip/hip_runtime.h>
#include <cstdio>
#include <cstdint>
constexpr int DM = 1024, TSEQ = 4096, NBATCH = 8, MPR = NBATCH * TSEQ;
constexpr int SB = 32, SS = 4, MSA = SB * SS;
constexpr int MT = MPR + 256;
constexpr int CA = 512, CB = 512, DBIN = 1792, DIN = 3328, DFF = 2816, PLE = 256, HD = 64, NH = 8;
constexpr int WINL = 2048;
constexpr float ALPHA = 1.18920711500272f;
constexpr float LN_EPS = 1e-5f, GN_EPS = 64e-5f;
constexpr float QSCALE = 0.125f * 1.4426950408889634f;
constexpr float LOG2E = 1.4426950408889634f;
constexpr size_t O_YP = 0, O_YS = O_YP + (size_t)MPR * DM, O_KWP = O_YS + (size_t)MSA * DM, O_VWP = O_KWP + (size_t)NBATCH * WINL * CA,
                 O_WKVP = O_VWP + (size_t)NBATCH * WINL * CA, O_SHP = O_WKVP + (size_t)NBATCH * NH * HD * HD, O_KWS = O_SHP + (size_t)NBATCH * DBIN,
                 O_VWS = O_KWS + (size_t)SB * WINL * CA, O_WKVS = O_VWS + (size_t)SB * WINL * CA, O_SHS = O_WKVS + (size_t)SB * NH * HD * HD,
                 O_END = O_SHS + (size_t)SB * DBIN;
namespace pg8 {
#define PG8_LAS __attribute__((address_space(3)))
typedef unsigned short bf16_t;
typedef short bf16x8 __attribute__((ext_vector_type(8)));
typedef float f32x4 __attribute__((ext_vector_type(4)));
typedef unsigned u32x4 __attribute__((ext_vector_type(4)));
constexpr int BM = 256, BK = 64, HALF = 128, HTB = HALF * BK * 2  , STAGE_BYTES = 8 * HTB, NXCD = 8, WGM = 8;

__host__ __device__ __forceinline__ int lds_byte(int r, int c) { const int st = (r >> 4) * 2 + (c >> 5), rr = r & 15, cc = c & 31, ob = rr * 64 + cc * 2; return st * 1024 + (ob ^ (((ob >> 9) & 1) << 5)); }
__host__ __device__ __forceinline__ void stage_rc(int b, int& R, int& C) { const int st = b / 1024, sb = b % 1024, swz = sb ^ (((sb >> 9) & 1) << 5); R = (st >> 1) * 16 + swz / 64; C = (st & 1) * 32 + (swz % 64) / 2; }
__host__ __device__ __forceinline__ int perm32(int rho) { const int n = rho >> 4, i = rho & 15; return 8 * (i >> 2) + 4 * n + (i & 3); }

struct Unit { int pm, pn; };
struct Gemm { const bf16_t* A; const bf16_t* Bt; int M, N, K; };

struct StaticOrder {
    int nM, nN, nwg, G, c;
    __host__ __device__ void init(int M, int N, int G_, int c_) { nM = M / BM; nN = N / BM; nwg = nM * nN; G = G_; c = c_; }
    __host__ __device__ bool next(int i, Unit& u) const {
        const long L = (long)i * G + c; if (L >= nwg) return false;
        int wgid = (int)L; { const int q = nwg / NXCD, r = nwg % NXCD, xcd = wgid % NXCD, off = wgid / NXCD; wgid = (xcd < r ? xcd * (q + 1) : r * (q + 1) + (xcd - r) * q) + off; }
        const int nig = WGM * nN, gid = wgid / nig, fm = gid * WGM, gsz = (nM - fm) < WGM ? (nM - fm) : WGM;
        u.pm = fm + ((wgid % nig) % gsz); u.pn = (wgid % nig) / gsz; return true;
    }
    __device__ __forceinline__ void a_ready(const Unit&) const {}
    __device__ __forceinline__ void done(const Unit&) const {}
};

typedef unsigned u32x2 __attribute__((ext_vector_type(2)));
__device__ __forceinline__ unsigned cvt_pk_bf16(float lo, float hi) { unsigned r; asm volatile("v_cvt_pk_bf16_f32 %0, %1, %2" : "=v"(r) : "v"(lo), "v"(hi)); return r; }
__device__ __forceinline__ float bf_lo(unsigned w) { return __uint_as_float(w << 16); }
__device__ __forceinline__ float bf_hi(unsigned w) { return __uint_as_float(w & 0xffff0000u); }
__device__ __forceinline__ float sigmoidf_(float x) { return __builtin_amdgcn_rcpf(1.0f + __builtin_amdgcn_exp2f(-x * 1.4426950408889634f)); }
__device__ __forceinline__ u32x4 pack8(const f32x4& a, const f32x4& b) { u32x4 w; w.x = cvt_pk_bf16(a[0], a[1]); w.y = cvt_pk_bf16(a[2], a[3]); w.z = cvt_pk_bf16(b[0], b[1]); w.w = cvt_pk_bf16(b[2], b[3]); return w; }

struct EpiZ {
    static constexpr bool PERM = true, AFTER_DRAIN = false;
    bf16_t *QB, *ZB; float* out;
    __device__ __forceinline__ void operator()(const f32x4 (&acc)[2][2][4][2], const Unit& u, int wr, int wc, int fr, int fq) const {
        const int pn = u.pn, pm = u.pm;
        const int kind = pn < 6 ? (pn >> 1) : 3;
        bf16_t* dst = kind == 3 ? ZB : QB + (size_t)kind * ((size_t)MT * CA);
        const int ld = kind == 3 ? DBIN : CA;
        const int col0 = (kind == 3 ? (pn - 6) * 256 : (pn & 1) * 256) + wc * 32 + 8 * fq;
        const float sc = kind == 0 ? QSCALE : 1.0f;
        const int rbase = pm * BM + wr * 64 + fr;
        const bool win_p = (kind == 1 || kind == 2) && pm < 128 && (pm & 15) >= 8;
        const bool win_s = (kind == 1 || kind == 2) && pm == 128;
        float* wout = out + (win_s ? O_KWS : O_KWP) + (kind == 2 ? (win_s ? (O_VWS - O_KWS) : (O_VWP - O_KWP)) : (size_t)0);
#pragma unroll
        for (int ai = 0; ai < 2; ++ai)
#pragma unroll
            for (int m = 0; m < 4; ++m) {
                const int row = rbase + ai * HALF + m * 16;
                bf16_t* rowp = dst + (size_t)row * ld + col0;
#pragma unroll
                for (int bj = 0; bj < 2; ++bj) {
                    const f32x4 v0 = acc[ai][bj][m][0] * sc, v1 = acc[ai][bj][m][1] * sc;
                    *(u32x4*)(rowp + bj * HALF) = pack8(v0, v1);
                    if (win_p) {
                        const int b = pm >> 4, t = (pm & 15) * 256 + (row & 255);
                        float* o = wout + ((size_t)(b * WINL + t - WINL) * CA + col0 + bj * HALF);
                        *(f32x4*)o = v0; *(f32x4*)(o + 4) = v1;
                    } else if (win_s && ai == 0) {
                        const int rs = row - MPR, b = rs >> 2, s = rs & 3;
                        float* o = wout + ((size_t)(b * WINL + (WINL - SS) + s) * CA + col0 + bj * HALF);
                        *(f32x4*)o = v0; *(f32x4*)(o + 4) = v1;
                    }
                }
            }
    }
};

struct EpiLora {
    static constexpr bool PERM = true, AFTER_DRAIN = false;
    bf16_t *LAM; const float *w0, *a0;
    __device__ __forceinline__ void operator()(const f32x4 (&acc)[2][2][4][2], const Unit& u, int wr, int wc, int fr, int fq) const {
        const int kind = u.pn >> 1;
        bf16_t* dst = LAM + (size_t)kind * ((size_t)MT * CB);
        const int col0 = (u.pn & 1) * 256 + wc * 32 + 8 * fq;
        const float* bias = kind == 0 ? w0 : a0;
        const float mul = kind == 0 ? 0.6065306597126334f : 1.0f;
        const int rbase = u.pm * BM + wr * 64 + fr;
#pragma unroll
        for (int bj = 0; bj < 2; ++bj) {
            f32x4 b0 = {0.f, 0.f, 0.f, 0.f}, b1 = b0;
            if (kind < 2) { b0 = *(const f32x4*)(bias + col0 + bj * HALF); b1 = *(const f32x4*)(bias + col0 + bj * HALF + 4); }
#pragma unroll
            for (int ai = 0; ai < 2; ++ai)
#pragma unroll
                for (int m = 0; m < 4; ++m) {
                    f32x4 v0 = acc[ai][bj][m][0] + b0, v1 = acc[ai][bj][m][1] + b1;
                    if (kind < 2) {
#pragma unroll
                        for (int e = 0; e < 4; ++e) { v0[e] = mul * sigmoidf_(v0[e]); v1[e] = mul * sigmoidf_(v1[e]); }
                    }
                    *(u32x4*)(dst + (size_t)(rbase + ai * HALF + m * 16) * CB + col0 + bj * HALF) = pack8(v0, v1);
                    asm volatile("" ::: "memory");
                }
        }
    }
};

__device__ __forceinline__ f32x4 xres4(const float* xp, const float* xs, int row, int col) {
    if (row < MPR) return *(const f32x4*)(xp + (size_t)row * DM + col);
    if (row < MPR + MSA) return *(const f32x4*)(xs + (size_t)(row - MPR) * DM + col);
    return (f32x4){0.f, 0.f, 0.f, 0.f};
}
struct EpiWout {
    static constexpr bool PERM = true, AFTER_DRAIN = false;
    bf16_t* PRE; const float *xp, *xs;
    __device__ __forceinline__ void operator()(const f32x4 (&acc)[2][2][4][2], const Unit& u, int wr, int wc, int fr, int fq) const {
        const int row0 = u.pm * BM + wr * 64 + fr, col0 = u.pn * BM + wc * 32 + 8 * fq;
#pragma unroll
        for (int ai = 0; ai < 2; ++ai)
#pragma unroll
            for (int m = 0; m < 4; ++m) { const int row = row0 + ai * HALF + m * 16;
#pragma unroll
                for (int bj = 0; bj < 2; ++bj) { const f32x4 x0 = xres4(xp, xs, row, col0 + bj * HALF), x1 = xres4(xp, xs, row, col0 + bj * HALF + 4);
                    *(u32x4*)(PRE + (size_t)row * DM + col0 + bj * HALF) = pack8(acc[ai][bj][m][0] + x0 * ALPHA, acc[ai][bj][m][1] + x1 * ALPHA); } }
    }
};
struct EpiGU {
    static constexpr bool PERM = true, AFTER_DRAIN = false;
    bf16_t* ACT;
    __device__ __forceinline__ void operator()(const f32x4 (&acc)[2][2][4][2], const Unit& u, int wr, int wc, int fr, int fq) const {
        const int row0 = u.pm * BM + wr * 64 + fr, col0 = u.pn * HALF + wc * 32 + 8 * fq;
#pragma unroll
        for (int ai = 0; ai < 2; ++ai)
#pragma unroll
            for (int m = 0; m < 4; ++m) {
                f32x4 o[2];
#pragma unroll
                for (int n = 0; n < 2; ++n)
#pragma unroll
                    for (int e = 0; e < 4; ++e) { const float g = acc[ai][0][m][n][e], up = acc[ai][1][m][n][e]; o[n][e] = g * sigmoidf_(g) * up; }
                *(u32x4*)(ACT + (size_t)(row0 + ai * HALF + m * 16) * DFF + col0) = pack8(o[0], o[1]);
            }
    }
};
struct EpiDown {
    static constexpr bool PERM = true, AFTER_DRAIN = false;
    bf16_t* PRE; const bf16_t* H;
    __device__ __forceinline__ void operator()(const f32x4 (&acc)[2][2][4][2], const Unit& u, int wr, int wc, int fr, int fq) const {
        const int row0 = u.pm * BM + wr * 64 + fr, col0 = u.pn * BM + wc * 32 + 8 * fq;
#pragma unroll
        for (int ai = 0; ai < 2; ++ai)
#pragma unroll
            for (int m = 0; m < 4; ++m) { const size_t off = (size_t)(row0 + ai * HALF + m * 16) * DM + col0;
#pragma unroll
                for (int bj = 0; bj < 2; ++bj) { const u32x4 hw = *(const u32x4*)(H + off + bj * HALF);
                    const f32x4 h0 = (f32x4){bf_lo(hw.x), bf_hi(hw.x), bf_lo(hw.y), bf_hi(hw.y)}, h1 = (f32x4){bf_lo(hw.z), bf_hi(hw.z), bf_lo(hw.w), bf_hi(hw.w)};
                    *(u32x4*)(PRE + off + bj * HALF) = pack8(acc[ai][bj][m][0] + h0 * ALPHA, acc[ai][bj][m][1] + h1 * ALPHA); } }
    }
};
struct EpiPlain {
    static constexpr bool PERM = true, AFTER_DRAIN = false;
    bf16_t* O;
    __device__ __forceinline__ void operator()(const f32x4 (&acc)[2][2][4][2], const Unit& u, int wr, int wc, int fr, int fq) const {
        const int row0 = u.pm * BM + wr * 64 + fr, col0 = u.pn * BM + wc * 32 + 8 * fq;
#pragma unroll
        for (int ai = 0; ai < 2; ++ai)
#pragma unroll
            for (int m = 0; m < 4; ++m)
#pragma unroll
                for (int bj = 0; bj < 2; ++bj) *(u32x4*)(O + (size_t)(row0 + ai * HALF + m * 16) * DM + col0 + bj * HALF) = pack8(acc[ai][bj][m][0], acc[ai][bj][m][1]);
    }
};
struct EpiPle {
    static constexpr bool PERM = true, AFTER_DRAIN = false;
    bf16_t* PRE; const bf16_t *H, *PP;
    __device__ __forceinline__ void operator()(const f32x4 (&acc)[2][2][4][2], const Unit& u, int wr, int wc, int fr, int fq) const {
        const int row0 = u.pm * BM + wr * 64 + fr, col0 = u.pn * BM + wc * 32 + 8 * fq;
#pragma unroll
        for (int ai = 0; ai < 2; ++ai)
#pragma unroll
            for (int m = 0; m < 4; ++m) { const size_t off = (size_t)(row0 + ai * HALF + m * 16) * DM + col0;
#pragma unroll
                for (int bj = 0; bj < 2; ++bj) { const u32x4 hw = *(const u32x4*)(H + off + bj * HALF), pw = *(const u32x4*)(PP + off + bj * HALF);
                    const f32x4 h0 = (f32x4){bf_lo(hw.x), bf_hi(hw.x), bf_lo(hw.y), bf_hi(hw.y)}, h1 = (f32x4){bf_lo(hw.z), bf_hi(hw.z), bf_lo(hw.w), bf_hi(hw.w)};
                    const f32x4 p0 = (f32x4){bf_lo(pw.x), bf_hi(pw.x), bf_lo(pw.y), bf_hi(pw.y)}, p1 = (f32x4){bf_lo(pw.z), bf_hi(pw.z), bf_lo(pw.w), bf_hi(pw.w)};
                    f32x4 a0 = acc[ai][bj][m][0], a1 = acc[ai][bj][m][1];
#pragma unroll
                    for (int q = 0; q < 4; ++q) { a0[q] = sigmoidf_(a0[q]); a1[q] = sigmoidf_(a1[q]); }
                    *(u32x4*)(PRE + off + bj * HALF) = pack8(h0 * ALPHA + a0 * p0, h1 * ALPHA + a1 * p1); } }
    }
};
template <class Epi, class Sched, bool ALIGN_EPI = false, bool SP2 = false>
__device__ __forceinline__ void gemm_phase(PG8_LAS unsigned char* lds, const Gemm g, const Sched& S, const Epi& E) {
    int tid_ = threadIdx.x; asm volatile("" : "+v"(tid_));
    const int tid = tid_, wid = __builtin_amdgcn_readfirstlane(tid >> 6), lane = tid & 63, wr = wid >> 2, wc = wid & 3, fr = lane & 15, fq = lane >> 4;
    int K_ = g.K; asm volatile("" : "+s"(K_));
    const int K = K_, nt = K / BK;
    unsigned voffA[2], voffB[2];
#pragma unroll
    for (int i = 0; i < 2; ++i) { int R, C; stage_rc(tid * 16 + i * 8192, R, C); const int Rb = Epi::PERM ? ((R & ~31) + perm32(R & 31)) : R;
        voffA[i] = (unsigned)(R * K + C) * 2u; voffB[i] = (unsigned)(Rb * K + C) * 2u; }
    const size_t kstep = (size_t)(BK * 2);
    const size_t hstep = (size_t)HALF * K * 2;
    const size_t tstep = 2 * hstep;
    const unsigned ldsw = (unsigned)wid * 1024u;
    const int aoff = lds_byte(wr * 64 + fr, fq * 8), boff = lds_byte(wc * 32 + fr, fq * 8);
#define PG8_SA(b, h) (((b) * 2 + (h)) * HTB)
#define PG8_SB(b, h) ((4 + (b) * 2 + (h)) * HTB)
#define PG8_STAGE(bufoff, gbase, voff) do { _Pragma("unroll") for (int _i = 0; _i < 2; ++_i) \
        __builtin_amdgcn_global_load_lds((const unsigned*)((const char*)(gbase) + (voff)[_i]), (PG8_LAS unsigned*)(lds + (bufoff) + ldsw + _i * 8192), 16, 0, 0); } while (0)
#define PG8_LDA(dst, b, h) do { _Pragma("unroll") for (int m = 0; m < 4; ++m) _Pragma("unroll") for (int k = 0; k < 2; ++k) dst[m][k] = *(const PG8_LAS bf16x8*)(lds + PG8_SA(b, h) + aoff + m * 2048 + k * 1024); } while (0)
#define PG8_LDB(dst, b, h) do { _Pragma("unroll") for (int n = 0; n < 2; ++n) _Pragma("unroll") for (int k = 0; k < 2; ++k) dst[n][k] = *(const PG8_LAS bf16x8*)(lds + PG8_SB(b, h) + boff + n * 2048 + k * 1024); } while (0)
#define PG8_MMA(ai, bj, At, Bt) do { __builtin_amdgcn_s_setprio(1); _Pragma("unroll") for (int m = 0; m < 4; ++m) _Pragma("unroll") for (int n = 0; n < 2; ++n) _Pragma("unroll") for (int k = 0; k < 2; ++k) \
        acc[ai][bj][m][n] = __builtin_amdgcn_mfma_f32_16x16x32_bf16(Bt[n][k], At[m][k], acc[ai][bj][m][n], 0, 0, 0); __builtin_amdgcn_s_setprio(0); } while (0)
#define PG8_WAIT_V(n) asm volatile("s_waitcnt vmcnt(" #n ")" ::: "memory")
#define PG8_WAIT_L(n) asm volatile("s_waitcnt lgkmcnt(" #n ")" ::: "memory")
#define PG8_BAR __builtin_amdgcn_s_barrier()
#define PG8_SCHED __builtin_amdgcn_sched_barrier(0)
    Unit cur, nxt; int ui = 0;
    if (!S.next(0, cur)) return;
    f32x4 acc[2][2][4][2];
#pragma unroll
    for (int a = 0; a < 2; ++a)
#pragma unroll
        for (int b = 0; b < 2; ++b)
#pragma unroll
            for (int m = 0; m < 4; ++m)
#pragma unroll
                for (int n = 0; n < 2; ++n) acc[a][b][m][n] = (f32x4){0.f, 0.f, 0.f, 0.f};
    bf16x8 At[4][2], B0[2][2], B1[2][2];
    const char* cA = (const char*)g.A + (size_t)cur.pm * tstep; const char* cB = (const char*)g.Bt + (size_t)cur.pn * tstep;
    S.a_ready(cur);
    if constexpr (SP2) {
        PG8_STAGE(PG8_SB(0, 0), cB, voffB); PG8_STAGE(PG8_SB(0, 1), cB + hstep, voffB); PG8_STAGE(PG8_SA(0, 0), cA, voffA); PG8_STAGE(PG8_SA(0, 1), cA + hstep, voffA);
        if (wr == 1) PG8_BAR;
        PG8_WAIT_V(2); PG8_BAR;
        PG8_STAGE(PG8_SB(1, 0), cB + kstep, voffB); PG8_STAGE(PG8_SA(1, 0), cA + kstep, voffA); PG8_STAGE(PG8_SB(1, 1), cB + hstep + kstep, voffB);
        PG8_WAIT_V(6); PG8_BAR;
    } else {
        PG8_STAGE(PG8_SB(0, 0), cB, voffB); PG8_STAGE(PG8_SA(0, 0), cA, voffA); PG8_STAGE(PG8_SB(0, 1), cB + hstep, voffB); PG8_STAGE(PG8_SA(0, 1), cA + hstep, voffA);
        if (wr == 1) PG8_BAR;
        PG8_WAIT_V(4); PG8_BAR;
        PG8_STAGE(PG8_SB(1, 0), cB + kstep, voffB); PG8_STAGE(PG8_SA(1, 0), cA + kstep, voffA); PG8_STAGE(PG8_SB(1, 1), cB + hstep + kstep, voffB);
        PG8_WAIT_V(6); PG8_BAR;
    }
    for (;;) {
        const bool has_next = S.next(ui + 1, nxt);
        const char* nA = has_next ? (const char*)g.A + (size_t)nxt.pm * tstep : cA; const char* nB = has_next ? (const char*)g.Bt + (size_t)nxt.pn * tstep : cB;
        for (int t = 0; t < nt; t += 2) {
            const bool last = (t == nt - 2);
            const char* a1 = cA + (size_t)(t + 1) * kstep;
            const char* a2 = last ? nA : cA + (size_t)(t + 2) * kstep; const char* b2 = last ? nB : cB + (size_t)(t + 2) * kstep;
            const char* a3 = a2 + kstep; const char* b3 = b2 + kstep;
            if (last && has_next) S.a_ready(nxt);
            if constexpr (SP2) {
            PG8_LDB(B0, 0, 0); PG8_LDB(B1, 0, 1); PG8_SCHED; PG8_LDA(At, 0, 0); PG8_STAGE(PG8_SA(1, 1), a1 + hstep, voffA);
            PG8_WAIT_V(8); PG8_WAIT_L(0); PG8_BAR; PG8_MMA(0, 0, At, B0); PG8_MMA(0, 1, At, B1); PG8_BAR; PG8_SCHED;
            PG8_LDA(At, 0, 1); PG8_STAGE(PG8_SB(0, 0), b2, voffB); PG8_STAGE(PG8_SB(0, 1), b2 + hstep, voffB); PG8_STAGE(PG8_SA(0, 0), a2, voffA);
            PG8_WAIT_V(8); PG8_WAIT_L(0); PG8_BAR; PG8_MMA(1, 0, At, B0); PG8_MMA(1, 1, At, B1); PG8_BAR; PG8_SCHED;
            PG8_LDB(B0, 1, 0); PG8_LDB(B1, 1, 1); PG8_SCHED; PG8_LDA(At, 1, 0); PG8_STAGE(PG8_SA(0, 1), a2 + hstep, voffA);
            PG8_WAIT_V(8); PG8_WAIT_L(0); PG8_BAR; PG8_MMA(0, 0, At, B0); PG8_MMA(0, 1, At, B1); PG8_BAR; PG8_SCHED;
            PG8_LDA(At, 1, 1); PG8_STAGE(PG8_SB(1, 0), b3, voffB); PG8_STAGE(PG8_SB(1, 1), b3 + hstep, voffB); PG8_STAGE(PG8_SA(1, 0), a3, voffA);
            PG8_WAIT_V(8); PG8_WAIT_L(0); PG8_BAR; PG8_MMA(1, 0, At, B0); PG8_MMA(1, 1, At, B1); PG8_BAR; PG8_SCHED;
            } else {
            PG8_LDB(B0, 0, 0); PG8_SCHED; PG8_LDA(At, 0, 0); PG8_STAGE(PG8_SA(1, 1), a1 + hstep, voffA);
            PG8_WAIT_L(8); PG8_BAR; PG8_WAIT_L(0); PG8_MMA(0, 0, At, B0); PG8_BAR; PG8_SCHED;
            PG8_LDB(B1, 0, 1); PG8_STAGE(PG8_SB(0, 0), b2, voffB);
            PG8_BAR; PG8_WAIT_L(0); PG8_MMA(0, 1, At, B1); PG8_BAR;
            PG8_LDA(At, 0, 1); PG8_STAGE(PG8_SA(0, 0), a2, voffA);
            PG8_BAR; PG8_WAIT_L(0); PG8_MMA(1, 0, At, B0); PG8_BAR; PG8_SCHED;
            PG8_STAGE(PG8_SB(0, 1), b2 + hstep, voffB);
            PG8_WAIT_V(6); PG8_BAR; PG8_MMA(1, 1, At, B1); PG8_BAR;
            PG8_LDB(B0, 1, 0); PG8_SCHED; PG8_LDA(At, 1, 0); PG8_STAGE(PG8_SA(0, 1), a2 + hstep, voffA);
            PG8_WAIT_L(8); PG8_BAR; PG8_WAIT_L(0); PG8_MMA(0, 0, At, B0); PG8_BAR; PG8_SCHED;
            PG8_LDB(B1, 1, 1); PG8_STAGE(PG8_SB(1, 0), b3, voffB);
            PG8_BAR; PG8_WAIT_L(0); PG8_MMA(0, 1, At, B1); PG8_BAR;
            PG8_LDA(At, 1, 1); PG8_STAGE(PG8_SA(1, 0), a3, voffA);
            PG8_BAR; PG8_WAIT_L(0); PG8_MMA(1, 0, At, B0); PG8_BAR; PG8_SCHED;
            PG8_STAGE(PG8_SB(1, 1), b3 + hstep, voffB);
            PG8_WAIT_V(6); PG8_BAR; PG8_MMA(1, 1, At, B1); PG8_BAR;
            }
        }
        if constexpr (ALIGN_EPI) { if (wr == 0) PG8_BAR; }
        if constexpr (!Epi::AFTER_DRAIN) { E(acc, cur, wr, wc, fr, fq); S.done(cur); }
        if (!has_next) break;
#pragma unroll
        for (int a = 0; a < 2; ++a)
#pragma unroll
            for (int b = 0; b < 2; ++b)
#pragma unroll
                for (int m = 0; m < 4; ++m)
#pragma unroll
                    for (int n = 0; n < 2; ++n) acc[a][b][m][n] = (f32x4){0.f, 0.f, 0.f, 0.f};
        cur = nxt; cA = nA; cB = nB; ++ui;
        if constexpr (ALIGN_EPI) { if (wr == 1) PG8_BAR; }
    }
    PG8_WAIT_V(0);
    if constexpr (!ALIGN_EPI) { if (wr == 0) PG8_BAR; }
    PG8_BAR;
    if constexpr (Epi::AFTER_DRAIN) { E.fused(acc, cur, wr, wc, fr, fq, lds, wid, lane); S.done(cur); }
#undef PG8_SA
#undef PG8_SB
#undef PG8_STAGE
#undef PG8_LDA
#undef PG8_LDB
#undef PG8_MMA
#undef PG8_WAIT_V
#undef PG8_WAIT_L
#undef PG8_BAR
#undef PG8_SCHED
}
}
#define GAS __attribute__((address_space(1)))
#define LAS __attribute__((address_space(3)))
typedef unsigned short bf16;
typedef unsigned v4u __attribute__((ext_vector_type(4)));
typedef float f32x4 __attribute__((ext_vector_type(4)));
typedef short bf16x8 __attribute__((ext_vector_type(8)));
typedef GAS unsigned gu32;
typedef GAS unsigned long long gu64;
#define RLX_AGENT __ATOMIC_RELAXED, __HIP_MEMORY_SCOPE_AGENT
#define LDS_WAIT() asm volatile("s_waitcnt lgkmcnt(0)" ::: "memory")
#define VM_WAIT() asm volatile("s_waitcnt vmcnt(0)" ::: "memory")
__device__ __forceinline__ unsigned long long rt() { return __builtin_amdgcn_s_memrealtime(); }
__device__ __forceinline__ unsigned f2bf(float f) { unsigned u = __builtin_bit_cast(unsigned, f); return (u + 0x7fffu + ((u >> 16) & 1u)) >> 16; }
__device__ __forceinline__ unsigned pk2(float lo, float hi) { return f2bf(lo) | (f2bf(hi) << 16); }

#define XB_TMO      128
#define XB_XCNT(j)  (256  + 64 * (j))
#define XB_XSUB(j)  (1280 + 64 * (j))
#define XB_XGEN(j)  (2304 + 64 * (j))
#define XB_TOP      3328
#define XB_TOPGEN   3392
#define XCD_BAR_WORDS 3456
#define XB_SPIN_CAP (1u << 18)

__device__ __forceinline__ unsigned xb_ld(unsigned* p)              { return __hip_atomic_load(p, __ATOMIC_RELAXED, __HIP_MEMORY_SCOPE_AGENT); }
__device__ __forceinline__ unsigned xb_add(unsigned* p, unsigned v) { return __hip_atomic_fetch_add(p, v, __ATOMIC_RELAXED, __HIP_MEMORY_SCOPE_AGENT); }
__device__ __forceinline__ unsigned xb_xcc_id() { return (unsigned)__builtin_amdgcn_s_getreg((3 << 11) | 20) & 0xFu; }
#define XB_SPIN(cond, bar) do { unsigned _sp = 0; while (cond) { __builtin_amdgcn_s_sleep(1); \
    if ((++_sp & 255u) == 0u) { if (xb_ld(&(bar)[XB_TMO])) break; if (_sp > XB_SPIN_CAP) { atomicAdd(&(bar)[XB_TMO], 1u); break; } } } } while (0)

struct XcdBarrier {
    unsigned* bar; unsigned x;
    volatile LAS unsigned* st;
};

__device__ __forceinline__ XcdBarrier xcd_barrier_post(unsigned* bar, volatile LAS unsigned* st) {
    XcdBarrier b; b.bar = bar; b.x = xb_xcc_id(); b.st = st;
    if (threadIdx.x == 0) (void)xb_add(&bar[XB_XCNT(b.x)], 1u);
    return b;
}
__device__ __forceinline__ void xcd_barrier_complete(unsigned* bar, unsigned x, unsigned& nloc, unsigned& nx) {
    const unsigned G = gridDim.x * gridDim.y * gridDim.z;
    unsigned sum, cnt, mine, sp = 0u;
    for (;;) {
        sum = 0u; cnt = 0u; mine = 0u;
#pragma unroll
        for (unsigned j = 0; j < 16; ++j) { const unsigned c = xb_ld(&bar[XB_XCNT(j)]); sum += c; cnt += (c > 0u) ? 1u : 0u; mine = (j == x) ? c : mine; }
        if (sum == G) break;
        __builtin_amdgcn_s_sleep(1);
        if ((++sp & 255u) == 0u) { if (xb_ld(&bar[XB_TMO])) break; if (sp > XB_SPIN_CAP) { atomicAdd(&bar[XB_TMO], 1u); break; } }
    }
    nloc = mine > 0u ? mine : 1u; nx = cnt > 0u ? cnt : 1u;
}

__device__ __forceinline__ void xcd_barrier(const XcdBarrier& b) {
    asm volatile("s_waitcnt vmcnt(0)" ::: "memory");
    __syncthreads();
    if (threadIdx.x == 0) {
        unsigned* bar = b.bar;
        __builtin_amdgcn_s_waitcnt(0);
        unsigned nloc = b.st[0], nx = b.st[1];
        if (nloc == 0u) { xcd_barrier_complete(bar, b.x, nloc, nx); b.st[0] = nloc; b.st[1] = nx; }
        const unsigned old = xb_add(&bar[XB_XSUB(b.x)], 1u);
        const unsigned gen = old / nloc;
        if (old + 1u == (gen + 1u) * nloc) {
            __builtin_amdgcn_fence(__ATOMIC_RELEASE, "agent");
            asm volatile("s_waitcnt vmcnt(0)" ::: "memory");
            const unsigned og = xb_add(&bar[XB_TOP], 1u);
            const unsigned tg = og / nx;
            if (og + 1u == (tg + 1u) * nx) xb_add(&bar[XB_TOPGEN], 1u);
            else XB_SPIN(xb_ld(&bar[XB_TOPGEN]) == tg, bar);
            __builtin_amdgcn_fence(__ATOMIC_ACQUIRE, "agent");
            xb_add(&bar[XB_XGEN(b.x)], 1u);
            asm volatile("s_waitcnt vmcnt(0)" ::: "memory");
        } else {
            XB_SPIN(xb_ld(&bar[XB_XGEN(b.x)]) == gen, bar);
            __builtin_amdgcn_fence(__ATOMIC_ACQUIRE, "agent");
            asm volatile("s_waitcnt vmcnt(0)" ::: "memory");
        }
    }
    __syncthreads();
}
constexpr size_t MiB = 1u << 20;
constexpr size_t WS_CTL = 0, CTL_ZERO_BYTES = 1 * MiB;
constexpr size_t WS_WIN = 2 * MiB, WS_WOUT = 9 * MiB, WS_WGU = 11 * MiB, WS_WD = 22 * MiB, WS_WPG = 28 * MiB, WS_WPP = 30 * MiB, WS_WL = 30 * MiB + 512 * 1024;
constexpr size_t SZ1024B = (size_t)MT * 1024 * 2, SZ512B = (size_t)MT * 512 * 2, SZ256B = (size_t)MT * 256 * 2;
constexpr size_t WS_R1 = 32 * MiB;
constexpr size_t WS_PB = 97 * MiB;
constexpr size_t WS_QB = 114 * MiB, WS_KB = WS_QB + SZ512B, WS_VB = WS_KB + SZ512B;
constexpr size_t WS_PRE = 114 * MiB;
constexpr size_t WS_ZB = 211 * MiB;
constexpr size_t WS_OG = 324 * MiB, WS_LSE = 420 * MiB;
constexpr size_t WS_BV = 324 * MiB, WS_PHI = 357 * MiB, WS_SLOC = 389 * MiB, WS_SC = 421 * MiB;
constexpr size_t WS_AP = 453 * MiB;
constexpr size_t WS_ACT = 243 * MiB;
constexpr size_t WS_H2 = 243 * MiB, WS_PP = 421 * MiB;
constexpr size_t WS_END = 486 * MiB;
static_assert(WS_VB + SZ512B <= WS_ZB && WS_ZB + (size_t)MT * DBIN * 2 <= WS_OG && WS_PRE + (size_t)MT * DM * 4 <= WS_ACT && WS_ACT + (size_t)MT * DFF * 2 <= WS_SC + 32 * MiB, "ws map");
static_assert(WS_R1 + SZ1024B <= WS_PB && WS_PB + SZ256B <= WS_QB && WS_AP + SZ256B <= WS_END && WS_ACT + (size_t)MT * DFF * 2 <= WS_PP && WS_PP + SZ1024B <= 512 * MiB, "ws map 2");
constexpr int NCHUNK = 32, CHL = TSEQ / NCHUNK;
constexpr int CW_BAR = 4096;

constexpr int RING_OFF = 0, RING_BYTES = 131072;
constexpr int LDSCTL_OFF = RING_BYTES, MISC_OFF = LDSCTL_OFF + 320;
constexpr int LDS_BYTES = 147456;
constexpr int NWAVES = 8;
typedef float f32x16 __attribute__((ext_vector_type(16)));
typedef unsigned u32x2 __attribute__((ext_vector_type(2)));
typedef short s16x4 __attribute__((ext_vector_type(4)));
typedef float f32x2_t __attribute__((ext_vector_type(2)));
typedef __bf16 bf16x2_t __attribute__((ext_vector_type(2)));
__device__ __forceinline__ unsigned cvtpk(float lo, float hi) { f32x2_t v = {lo, hi}; bf16x2_t b = __builtin_convertvector(v, bf16x2_t); return __builtin_bit_cast(unsigned, b); }
__device__ __forceinline__ float bflo(unsigned w) { return __uint_as_float(w << 16); }
__device__ __forceinline__ float bfhi(unsigned w) { return __uint_as_float(w & 0xffff0000u); }
__device__ __forceinline__ float bf1(bf16 h) { return __uint_as_float((unsigned)h << 16); }
__device__ __forceinline__ float sigm(float x) { return __builtin_amdgcn_rcpf(1.0f + __builtin_amdgcn_exp2f(-x * LOG2E)); }
__device__ __forceinline__ float shx(float v, int o, int lane) { return __int_as_float(__builtin_amdgcn_ds_bpermute((lane ^ o) << 2, __float_as_int(v))); }
__device__ __forceinline__ float wave_sum(float v, int lane) {
#pragma unroll
    for (int o = 1; o < 64; o <<= 1) v += shx(v, o, lane);
    return v;
}
#define dpp_f(v, ctrl, row_mask) __int_as_float(__builtin_amdgcn_update_dpp(0, __float_as_int(v), (ctrl), (row_mask), 0xF, false))
__device__ __forceinline__ float wave_sum_dpp(float v) {
    v += dpp_f(v, 0xB1, 0xF);
    v += dpp_f(v, 0x4E, 0xF);
    v += dpp_f(v, 0x141, 0xF);
    v += dpp_f(v, 0x140, 0xF);
    v += dpp_f(v, 0x142, 0xA);
    v += dpp_f(v, 0x143, 0xC);
    return __int_as_float(__builtin_amdgcn_readlane(__float_as_int(v), 63));
}

__device__ __forceinline__ void fmac_s(float& c, float a, float b) { asm("v_fmac_f32_e32 %0, %1, %2" : "+v"(c) : "v"(a), "v"(b)); }
__device__ __forceinline__ void mulip_s(float& c, float a) { asm("v_mul_f32_e32 %0, %0, %1" : "+v"(c) : "v"(a)); }
__device__ __forceinline__ float mul_s(float a, float b) { float r; asm("v_mul_f32_e32 %0, %1, %2" : "=v"(r) : "v"(a), "v"(b)); return r; }
struct Ctx { LAS unsigned char* lds; int tid, lane, wave, vcu, G; };

__device__ __forceinline__ void p0_transpose_item(const float* W, int N, bf16* WT, int ldk, int drow, int dk, LAS float* scr, int k0, int n0, int lane) {
#pragma unroll 8
    for (int i = 0; i < 32; ++i) { const int kk = 2 * i + (lane >> 5); scr[kk * 33 + (lane & 31)] = W[(size_t)(k0 + kk) * N + n0 + (lane & 31)]; }
    LDS_WAIT(); asm volatile("" ::: "memory");
    const int c = lane & 7;
#pragma unroll
    for (int j = 0; j < 4; ++j) { const int n = (lane >> 3) + 8 * j; const LAS float* s = scr + (8 * c) * 33 + n;
        v4u o; o.x = pk2(s[0 * 33], s[1 * 33]); o.y = pk2(s[2 * 33], s[3 * 33]); o.z = pk2(s[4 * 33], s[5 * 33]); o.w = pk2(s[6 * 33], s[7 * 33]);
        *(GAS v4u*)(WT + (size_t)(drow + n) * ldk + dk + 8 * c) = o; }
    LDS_WAIT(); asm volatile("" ::: "memory");
}
struct P0Args { const float *xp, *xs, *pp, *ps, *ck, *cv, *w_in, *w_out, *w_gate, *w_up, *w_down, *w_pg, *w_pp, *w2, *a2, *g2; bf16 *Win, *Wout, *Wgu, *Wd, *Wpg, *Wpp, *Wl, *XB, *PB; float* out; };
__device__ __forceinline__ void p0_prologue(const Ctx& C, const P0Args& A) {
    LAS float* scr = (LAS float*)(C.lds + RING_OFF + C.wave * 16384);
    const int gw = C.vcu * NWAVES + C.wave, NGW = C.G * NWAVES;
    constexpr int I0 = 16 * 104, I1 = 16 * 32, I2 = 16 * 88, I3 = I2, I4 = 44 * 32, I5 = 16 * 32, I6 = 4 * 32, I7 = 16, I8 = 16, I9 = 32;
    constexpr int NITEMS = I0 + I1 + I2 + I3 + I4 + I5 + I6 + I7 + I8 + I9;
    for (int it = gw; it < NITEMS; it += NGW) {
        int r = it;
        if (r < I0) { const int kb = r / 104, nb = r % 104; p0_transpose_item(A.w_in, DIN, A.Win, 1024, nb * 32, kb * 64, scr, kb * 64, nb * 32, C.lane); continue; } r -= I0;
        if (r < I1) { const int kb = r / 32, nb = r % 32; p0_transpose_item(A.w_out, DM, A.Wout, 1024, nb * 32, kb * 64, scr, kb * 64, nb * 32, C.lane); continue; } r -= I1;
        if (r < I2) { const int kb = r / 88, nb = r % 88, n0 = nb * 32; p0_transpose_item(A.w_gate, DFF, A.Wgu, 1024, (n0 >> 7) * 256 + (n0 & 127), kb * 64, scr, kb * 64, n0, C.lane); continue; } r -= I2;
        if (r < I3) { const int kb = r / 88, nb = r % 88, n0 = nb * 32; p0_transpose_item(A.w_up, DFF, A.Wgu, 1024, (n0 >> 7) * 256 + 128 + (n0 & 127), kb * 64, scr, kb * 64, n0, C.lane); continue; } r -= I3;
        if (r < I4) { const int kb = r / 32, nb = r % 32; p0_transpose_item(A.w_down, DM, A.Wd, DFF, nb * 32, kb * 64, scr, kb * 64, nb * 32, C.lane); continue; } r -= I4;
        if (r < I5) { const int kb = r / 32, nb = r % 32; p0_transpose_item(A.w_pg, DM, A.Wpg, 1024, nb * 32, kb * 64, scr, kb * 64, nb * 32, C.lane); continue; } r -= I5;
        if (r < I6) { const int kb = r / 32, nb = r % 32; p0_transpose_item(A.w_pp, DM, A.Wpp, 256, nb * 32, kb * 64, scr, kb * 64, nb * 32, C.lane); continue; } r -= I6;
        if (r < I7) { p0_transpose_item(A.w2, CB, A.Wl, 256, r * 32, 0, scr, 0, r * 32, C.lane); continue; } r -= I7;
        if (r < I8) { p0_transpose_item(A.a2, CB, A.Wl, 256, 512 + r * 32, 64, scr, 0, r * 32, C.lane); continue; } r -= I8;
        { const int kb = r / 16, nb = r % 16; p0_transpose_item(A.g2, CB, A.Wl, 256, 1024 + nb * 32, 128 + kb * 64, scr, kb * 64, nb * 32, C.lane); }
    }
    const int gt = C.vcu * (NWAVES * 64) + C.tid, NT = C.G * NWAVES * 64;
    for (int i = gt; i < 1536 * 32; i += NT) { const int row = i >> 5, ch = i & 31, blk = row >> 9;
        const bool nz = blk == 0 ? ch < 8 : blk == 1 ? (ch >= 8 && ch < 16) : ch >= 16;
        if (!nz) *(GAS v4u*)(A.Wl + (size_t)row * 256 + ch * 8) = (v4u){0u, 0u, 0u, 0u}; }
    for (int i = gt; i < MT * 128; i += NT) { const int row = i >> 7, ch = i & 127;
        f32x4 a = {0.f, 0.f, 0.f, 0.f}, b = a;
        if (row < MPR + MSA) { const float* src = row < MPR ? A.xp + (size_t)row * DM : A.xs + (size_t)(row - MPR) * DM; a = *(const GAS f32x4*)(src + ch * 8); b = *(const GAS f32x4*)(src + ch * 8 + 4); }
        v4u o; o.x = cvtpk(a[0], a[1]); o.y = cvtpk(a[2], a[3]); o.z = cvtpk(b[0], b[1]); o.w = cvtpk(b[2], b[3]);
        *(GAS v4u*)(A.XB + (size_t)row * DM + ch * 8) = o; }
    for (int i = gt; i < MT * 32; i += NT) { const int row = i >> 5, ch = i & 31;
        f32x4 a = {0.f, 0.f, 0.f, 0.f}, b = a;
        if (row < MPR + MSA) { const float* src = row < MPR ? A.pp + (size_t)row * PLE : A.ps + (size_t)(row - MPR) * PLE; a = *(const GAS f32x4*)(src + ch * 8); b = *(const GAS f32x4*)(src + ch * 8 + 4); }
        v4u o; o.x = cvtpk(a[0], a[1]); o.y = cvtpk(a[2], a[3]); o.z = cvtpk(b[0], b[1]); o.w = cvtpk(b[2], b[3]);
        *(GAS v4u*)(A.PB + (size_t)row * PLE + ch * 8) = o; }
}

__device__ __forceinline__ void prep_a(const Ctx& C, const bf16* ZB, const float* mu, const float* state_shift, bf16* AP, float* out) {
    const int gw = C.vcu * NWAVES + C.wave, NGW = C.G * NWAVES, lane = C.lane;
    const f32x4 m4 = *(const GAS f32x4*)(mu + 1536 + lane * 4);
    for (int row = gw; row < MPR + MSA; row += NGW) {
        const u32x2 zw = *(const GAS u32x2*)(ZB + (size_t)row * DBIN + 1536 + lane * 4);
        f32x4 z = {bflo(zw.x), bfhi(zw.x), bflo(zw.y), bfhi(zw.y)}, p;
        const bool first = row < MPR ? (row & (TSEQ - 1)) == 0 : ((row - MPR) & 3) == 0;
        if (!first) { const u32x2 pw = *(const GAS u32x2*)(ZB + (size_t)(row - 1) * DBIN + 1536 + lane * 4); p = (f32x4){bflo(pw.x), bfhi(pw.x), bflo(pw.y), bfhi(pw.y)}; }
        else if (row < MPR) p = (f32x4){0.f, 0.f, 0.f, 0.f};
        else p = *(const GAS f32x4*)(state_shift + (size_t)((row - MPR) >> 2) * DBIN + 1536 + lane * 4);
        f32x4 zm = z + (p - z) * m4, o;
#pragma unroll
        for (int e = 0; e < 4; ++e) { const float x = zm[e];
            const float th = 1.0f - 2.0f * __builtin_amdgcn_rcpf(1.0f + __builtin_amdgcn_exp2f(2.0f * LOG2E * x));
            o[e] = lane < 16 ? th : lane < 32 ? x : sigm(x); }
        u32x2 w; w.x = cvtpk(o[0], o[1]); w.y = cvtpk(o[2], o[3]);
        *(GAS u32x2*)(AP + (size_t)row * 256 + lane * 4) = w;
    }
    const int gt = C.vcu * (NWAVES * 64) + C.tid, NT = C.G * NWAVES * 64;
    for (int i = gt; i < (NBATCH + SB) * DBIN; i += NT) { const int s = i / DBIN, c = i % DBIN;
        if (s < NBATCH) out[O_SHP + (size_t)s * DBIN + c] = bf1(ZB[(size_t)(s * TSEQ + TSEQ - 1) * DBIN + c]);
        else out[O_SHS + (size_t)(s - NBATCH) * DBIN + c] = bf1(ZB[(size_t)(MPR + (s - NBATCH) * SS + SS - 1) * DBIN + c]); }
}

__device__ __forceinline__ int crow(int r, int hi) { return (r & 3) + 8 * (r >> 2) + 4 * hi; }
typedef short v4i16_t __attribute__((ext_vector_type(4)));
__device__ __forceinline__ s16x4 vtr(LAS const unsigned char* p) { return __builtin_bit_cast(s16x4, __builtin_amdgcn_ds_read_tr16_b64_v4i16((LAS v4i16_t*)p)); }
constexpr int VP = 192;
constexpr int KP = 144;
constexpr int KIMG = 0, VIMG = 384 * KP;
struct AttnUnit { int b, h, g, cls, mq0, dil; };
__device__ __forceinline__ AttnUnit attn_unit_of(int u) {
    AttnUnit a; const int bh = u / 48, k48 = u % 48, k = k48 & 15; a.g = k48 >> 4; a.b = bh >> 3; a.h = bh & 7;
    if (a.g == 0) { a.cls = 0; a.mq0 = 256 * k; a.dil = 1; } else if (a.g == 1) { a.cls = k >> 2; a.mq0 = 256 * (k & 3); a.dil = 4; } else { a.cls = k; a.mq0 = 0; a.dil = 16; }
    return a;
}
struct AttnPref { v4u kr[6], vr[6]; bf16x8 qf[4]; };
__device__ __forceinline__ void attn_fetch(const Ctx& C, const AttnUnit& a, const bf16* QB, const bf16* KB, const bf16* VB, AttnPref& P) {
    const int tid = C.tid, r32 = C.lane & 31, hi = C.lane >> 5;
#pragma unroll
    for (int it = 0; it < 6; ++it) { const int rr = it * 64 + (tid >> 3), ch = tid & 7; int mk = a.mq0 - 128 + rr; mk = mk < 0 ? 0 : mk;
        const size_t go = (size_t)(a.b * TSEQ + mk * a.dil + a.cls) * CA + a.h * 64 + ch * 8;
        P.kr[it] = *(const GAS v4u*)(KB + go); P.vr[it] = *(const GAS v4u*)(VB + go); }
    const size_t qrow = (size_t)(a.b * TSEQ + (a.mq0 + 32 * C.wave + r32) * a.dil + a.cls);
#pragma unroll
    for (int s = 0; s < 4; ++s) P.qf[s] = *(const GAS bf16x8*)(QB + qrow * CA + a.h * 64 + 16 * s + 8 * hi);
}
__device__ __forceinline__ void attn_stage(const Ctx& C, const AttnPref& P) {
    const int tid = C.tid;
#pragma unroll
    for (int it = 0; it < 6; ++it) { const int rr = it * 64 + (tid >> 3), ch = tid & 7;
        *(LAS v4u*)(C.lds + KIMG + rr * KP + ch * 16) = P.kr[it]; *(LAS v4u*)(C.lds + VIMG + rr * VP + ch * 16) = P.vr[it]; }
}
__device__ __forceinline__ void attn_compute(const Ctx& C, const AttnUnit& a, const bf16x8 (&qf)[4], bf16* OG, float* LSE) {
    LAS unsigned char* lds = C.lds;
    int lane_ = C.lane; asm volatile("" : "+v"(lane_));
    const int wid = C.wave, lane = lane_, r32 = lane & 31, hi = lane >> 5;
    const int mqw = a.mq0 + 32 * wid;
    const size_t qrow = (size_t)(a.b * TSEQ + (mqw + r32) * a.dil + a.cls);
    LAS const unsigned char* kb = lds + KIMG + (32 * wid + r32) * KP + 16 * hi;
    const float slope2 = __builtin_amdgcn_exp2f(-(float)(a.h + 1)) * LOG2E * (float)a.dil;
    f32x16 o0 = {0.f, 0.f, 0.f, 0.f, 0.f, 0.f, 0.f, 0.f, 0.f, 0.f, 0.f, 0.f, 0.f, 0.f, 0.f, 0.f}, o1 = o0;
    const int i16 = lane & 15, qq = i16 >> 2, pp = i16 & 3, blk = (lane >> 4) & 1;
    LAS const unsigned char* vbase = lds + VIMG + (32 * wid + 4 * hi + qq) * VP + (16 * blk + 4 * pp) * 2;
    float mx = -1e30f, l = 0.f;
#pragma unroll
    for (int j = 0; j < 5; ++j) {
        f32x16 st = {0.f, 0.f, 0.f, 0.f, 0.f, 0.f, 0.f, 0.f, 0.f, 0.f, 0.f, 0.f, 0.f, 0.f, 0.f, 0.f};
#pragma unroll
        for (int s = 0; s < 4; ++s) { const bf16x8 kf = *(LAS const bf16x8*)(kb + 32 * j * KP + 32 * s); st = __builtin_amdgcn_mfma_f32_32x32x16_bf16(kf, qf[s], st, 0, 0, 0); }
        float tm = -INFINITY;
#pragma unroll
        for (int i = 0; i < 16; ++i) { const int kr = crow(i, hi), dist = 128 - 32 * j + r32 - kr, mke = mqw - 128 + 32 * j + kr;
            const bool ok = dist >= 0 && dist <= 128 && mke >= 0;
            const float v = ok ? st[i] - slope2 * (float)dist : -INFINITY; st[i] = v; tm = fmaxf(tm, v); }
        tm = fmaxf(tm, shx(tm, 32, lane));
        const float mn = fmaxf(mx, tm), alpha = __builtin_amdgcn_exp2f(mx - mn); mx = mn;
        float ls = 0.f;
#pragma unroll
        for (int i = 0; i < 16; ++i) { const float pe = __builtin_amdgcn_exp2f(st[i] - mn); st[i] = pe; ls += pe; }
        l = l * alpha + ls;
#pragma unroll
        for (int i = 0; i < 16; ++i) { o0[i] *= alpha; o1[i] *= alpha; }
#pragma unroll
        for (int s2 = 0; s2 < 2; ++s2) {
            v4u pw; pw.x = cvtpk(st[8 * s2 + 0], st[8 * s2 + 1]); pw.y = cvtpk(st[8 * s2 + 2], st[8 * s2 + 3]); pw.z = cvtpk(st[8 * s2 + 4], st[8 * s2 + 5]); pw.w = cvtpk(st[8 * s2 + 6], st[8 * s2 + 7]);
            const bf16x8 xs = __builtin_bit_cast(bf16x8, pw);
            LAS const unsigned char* vp = vbase + (32 * j + 16 * s2) * VP;
            { const s16x4 lo = vtr(vp), hh = vtr(vp + 8 * VP); const bf16x8 vf = (bf16x8){lo[0], lo[1], lo[2], lo[3], hh[0], hh[1], hh[2], hh[3]};
              o0 = __builtin_amdgcn_mfma_f32_32x32x16_bf16(vf, xs, o0, 0, 0, 0); }
            { const s16x4 lo = vtr(vp + 64), hh = vtr(vp + 8 * VP + 64); const bf16x8 vf = (bf16x8){lo[0], lo[1], lo[2], lo[3], hh[0], hh[1], hh[2], hh[3]};
              o1 = __builtin_amdgcn_mfma_f32_32x32x16_bf16(vf, xs, o1, 0, 0, 0); }
        }
    }
    l += shx(l, 32, lane);
    const float inv = __builtin_amdgcn_rcpf(l);
    bf16* orow = OG + (size_t)a.g * MPR * CA + qrow * CA + a.h * 64 + 4 * hi;
#pragma unroll
    for (int g4 = 0; g4 < 4; ++g4) {
        u32x2 w0, w1;
        w0.x = cvtpk(o0[4 * g4] * inv, o0[4 * g4 + 1] * inv); w0.y = cvtpk(o0[4 * g4 + 2] * inv, o0[4 * g4 + 3] * inv);
        w1.x = cvtpk(o1[4 * g4] * inv, o1[4 * g4 + 1] * inv); w1.y = cvtpk(o1[4 * g4 + 2] * inv, o1[4 * g4 + 3] * inv);
        *(GAS u32x2*)(orow + 8 * g4) = w0; *(GAS u32x2*)(orow + 32 + 8 * g4) = w1; }
    if (hi == 0) LSE[((size_t)a.g * MPR + qrow) * NH + a.h] = mx + __builtin_amdgcn_logf(l);
}
__device__ __forceinline__ void attn_prompt(const Ctx& C, const bf16* QB, const bf16* KB, const bf16* VB, bf16* OG, float* LSE) {
    AttnPref P; bf16x8 qc[4];
    AttnUnit cur = attn_unit_of(C.vcu * 12);
    attn_fetch(C, cur, QB, KB, VB, P);
    attn_stage(C, P);
#pragma unroll
    for (int s = 0; s < 4; ++s) qc[s] = P.qf[s];
    __syncthreads();
#pragma unroll 1
    for (int i = 0; i < 12; ++i) {
        AttnUnit nxt = cur;
        if (i + 1 < 12) { nxt = attn_unit_of(C.vcu * 12 + i + 1); attn_fetch(C, nxt, QB, KB, VB, P); }
        attn_compute(C, cur, qc, OG, LSE);
        __syncthreads();
        if (i + 1 < 12) { attn_stage(C, P);
#pragma unroll
            for (int s = 0; s < 4; ++s) qc[s] = P.qf[s];
            __syncthreads(); }
        cur = nxt;
    }
}
__device__ __forceinline__ void attn_sample(const Ctx& C, const bf16* QB, const float* ck, const float* cv, const float* out, bf16* HEADS) {
    if (C.vcu >= SB * NH) return;
    const int b = C.vcu >> 3, h = C.vcu & 7, s = C.wave & 3, half = C.wave >> 2, lane = C.lane;
    LAS float* qs = (LAS float*)(C.lds + C.wave * 2048);
    LAS float* ps = qs + 64;
    LAS float* part = (LAS float*)(C.lds + 16384 + C.wave * 512);
    const int row = MPR + b * SS + s, n0 = half * 194, cnt = half ? 193 : 194;
    qs[lane] = bf1(QB[(size_t)row * CA + h * 64 + lane]);
    LDS_WAIT(); asm volatile("" ::: "memory");
    const float slope2 = __builtin_amdgcn_exp2f(-(float)(h + 1)) * LOG2E;
    const float* kbase = ck + ((size_t)b * WINL * NH + h) * HD; const float* knew = out + O_KWS + ((size_t)(b * WINL + (WINL - SS)) * NH + h) * HD;
    const float* vbase = cv + ((size_t)b * WINL * NH + h) * HD; const float* vnew = out + O_VWS + ((size_t)(b * WINL + (WINL - SS)) * NH + h) * HD;
    float sc[4]; float mx = -INFINITY;
#pragma unroll
    for (int it = 0; it < 4; ++it) {
        const int nl = it * 64 + lane, n = n0 + (nl < cnt ? nl : 0), g = (n >= 129) + (n >= 258), jj = n - 129 * g, dist = jj << (2 * g), idx = WINL + s - dist;
        const float* kr = idx < WINL ? kbase + (size_t)idx * (NH * HD) : knew + (size_t)(idx - WINL) * (NH * HD);
        float d = 0.f;
#pragma unroll
        for (int c = 0; c < 16; ++c) { const f32x4 kv = *(const GAS f32x4*)(kr + 4 * c); const f32x4 qv = *(LAS const f32x4*)(qs + 4 * c); d += kv[0] * qv[0] + kv[1] * qv[1] + kv[2] * qv[2] + kv[3] * qv[3]; }
        sc[it] = nl < cnt ? d - slope2 * (float)dist : -INFINITY;
        mx = fmaxf(mx, sc[it]); }
#pragma unroll
    for (int o = 1; o < 64; o <<= 1) mx = fmaxf(mx, shx(mx, o, lane));
    float l = 0.f;
#pragma unroll
    for (int it = 0; it < 4; ++it) { const float pe = __builtin_amdgcn_exp2f(sc[it] - mx); ps[it * 64 + lane] = pe; l += pe; }
    l = wave_sum(l, lane);
    LDS_WAIT(); asm volatile("" ::: "memory");
    const int kq = lane >> 4, d4 = lane & 15;
    f32x4 o4 = {0.f, 0.f, 0.f, 0.f};
#pragma unroll 7
    for (int nb = 0; nb < 49; ++nb) {
        const int nl = nb * 4 + kq, n = n0 + (nl < cnt ? nl : 0), g = (n >= 129) + (n >= 258), jj = n - 129 * g, dist = jj << (2 * g), idx = WINL + s - dist;
        const float* vr = idx < WINL ? vbase + (size_t)idx * (NH * HD) : vnew + (size_t)(idx - WINL) * (NH * HD);
        const f32x4 vv = *(const GAS f32x4*)(vr + 4 * d4);
        const float pe = nl < cnt ? ps[nl] : 0.f;
        o4 += vv * pe; }
#pragma unroll
    for (int e = 0; e < 4; ++e) { float v = o4[e]; v += shx(v, 16, lane); v += shx(v, 32, lane); o4[e] = v; }
    if (lane < 16) *(LAS f32x4*)(part + 16 + 4 * d4) = o4;
    if (lane == 0) { part[0] = mx; part[1] = l; }
    __syncthreads();
    if (half == 0) {
        LAS const float* p0 = part, *p1 = part + 4 * 128;
        const float m0 = p0[0], m1 = p1[0], M = fmaxf(m0, m1), f0 = __builtin_amdgcn_exp2f(m0 - M), f1 = __builtin_amdgcn_exp2f(m1 - M);
        const float L = p0[1] * f0 + p1[1] * f1, o = (p0[16 + lane] * f0 + p1[16 + lane] * f1) / L;
        HEADS[(size_t)row * DM + h * 64 + lane] = (bf16)(cvtpk(o, 0.f) & 0xffffu);
    }
    __syncthreads();
}

__device__ __forceinline__ void attn_merge(const Ctx& C, const bf16* OG, const float* LSE, bf16* HEADS) {
    const int gt = C.vcu * (NWAVES * 64) + C.tid, NT = C.G * NWAVES * 64;
    for (int i = gt; i < MPR * 64; i += NT) { const int row = i >> 6, ch = i & 63, h = ch >> 3;
        float ls[3], mx = -INFINITY;
#pragma unroll
        for (int g = 0; g < 3; ++g) { ls[g] = LSE[((size_t)g * MPR + row) * NH + h]; mx = fmaxf(mx, ls[g]); }
        float w[3], ws = 0.f;
#pragma unroll
        for (int g = 0; g < 3; ++g) { w[g] = __builtin_amdgcn_exp2f(ls[g] - mx); ws += w[g]; }
        const float inv = __builtin_amdgcn_rcpf(ws);
        float acc[8] = {0.f, 0.f, 0.f, 0.f, 0.f, 0.f, 0.f, 0.f};
#pragma unroll
        for (int g = 0; g < 3; ++g) { const v4u v = *(const GAS v4u*)(OG + ((size_t)g * MPR + row) * CA + ch * 8); const float wg = w[g] * inv;
            acc[0] += wg * bflo(v.x); acc[1] += wg * bfhi(v.x); acc[2] += wg * bflo(v.y); acc[3] += wg * bfhi(v.y); acc[4] += wg * bflo(v.z); acc[5] += wg * bfhi(v.z); acc[6] += wg * bflo(v.w); acc[7] += wg * bfhi(v.w); }
        v4u o; o.x = cvtpk(acc[0], acc[1]); o.y = cvtpk(acc[2], acc[3]); o.z = cvtpk(acc[4], acc[5]); o.w = cvtpk(acc[6], acc[7]);
        *(GAS v4u*)(HEADS + (size_t)row * DM + ch * 8) = o; }
}

struct RwkvW { const float *mu, *k_k, *k_a, *r_k, *lnx_w, *lnx_b; };
struct RwkvTok { float nkk, ka, d, kp, r, v, bon; };
__device__ __forceinline__ RwkvTok rwkv_tok(float zr, float zk, float zv, float pr, float pk, float pv, float lam, float a, float mur, float muk, float muv, float kkw, float kaw, float rkw, int lane) {
    RwkvTok o;
    const float r = zr + (pr - zr) * mur, k = zk + (pk - zk) * muk, v = zv + (pv - zv) * muv;
    const float kkr = k * kkw; const float ss = wave_sum_dpp(kkr * kkr);
    const float kk = kkr * __builtin_amdgcn_rsqf(fmaxf(ss, 1e-24f));
    const float kp = k * (1.0f + (a - 1.0f) * kaw);
    o.nkk = -kk; o.ka = kk * a; o.d = __builtin_amdgcn_exp2f(-lam * LOG2E); o.kp = kp; o.r = r; o.v = v; o.bon = wave_sum_dpp(r * kp * rkw);
    return o;
}
__device__ __forceinline__ void rwkv_chunk(const Ctx& C, const bf16* ZB, const bf16* LAM, const bf16* AA, const RwkvW& W, float* YL, float* U, bf16* BV, float* PHI, float* SLOC, int b, int h, int c,
                                           const float* ck, const float* cv, float* out) {
    constexpr unsigned PERB = (WINL - SS) * CA / 4, CPY_TOTAL = SB * PERB;
    const unsigned cbase = (unsigned)(C.vcu * NWAVES + C.wave) * (CHL * 64) + C.lane;
    const int lane = C.lane;
    LAS float* tokb = (LAS float*)(C.lds + C.wave * 12288);
    float S[64], P[64];
#pragma unroll
    for (int j = 0; j < 64; ++j) { S[j] = 0.f; P[j] = (j == lane) ? 1.f : 0.f; }
    const int hc = h * 64 + lane;
    const float mur = W.mu[hc], muk = W.mu[512 + hc], muv = W.mu[1024 + hc], kkw = W.k_k[hc], kaw = W.k_a[hc], rkw = W.r_k[hc];
    const int t0 = c * CHL; const size_t row0 = (size_t)b * TSEQ + t0;
    float pr = 0.f, pk = 0.f, pv = 0.f;
    if (t0 > 0) { const bf16* zp = ZB + (row0 - 1) * DBIN + hc; pr = bf1(zp[0]); pk = bf1(zp[512]); pv = bf1(zp[1024]); }
    LAS float* dend = tokb + 8 * 320;
    for (int sb = 0; sb < CHL / 8; ++sb) {
        float zr[8], zk[8], zv[8], lm[8], aa[8];
#pragma unroll
        for (int tt = 0; tt < 8; ++tt) { const size_t row = row0 + sb * 8 + tt; const bf16* zp = ZB + row * DBIN + hc;
            zr[tt] = bf1(zp[0]); zk[tt] = bf1(zp[512]); zv[tt] = bf1(zp[1024]); lm[tt] = bf1(LAM[row * CB + hc]); aa[tt] = bf1(AA[row * CB + hc]); }
        float Dp = 1.0f;
#pragma unroll
        for (int tt = 0; tt < 8; ++tt) {
            const RwkvTok o = rwkv_tok(zr[tt], zk[tt], zv[tt], pr, pk, pv, lm[tt], aa[tt], mur, muk, muv, kkw, kaw, rkw, lane);
            pr = zr[tt]; pk = zk[tt]; pv = zv[tt];
            const float Dc = Dp * o.d, inv = __builtin_amdgcn_rcpf(Dc);
            LAS float* tk = tokb + tt * 320;
            tk[lane] = o.nkk * Dp; tk[64 + lane] = o.ka * inv; tk[128 + lane] = o.kp * inv; tk[192 + lane] = o.r * Dc; tk[256 + lane] = o.v;
            Dp = Dc;
            BV[(row0 + sb * 8 + tt) * CB + hc] = (bf16)(cvtpk(o.bon * o.v, 0.f) & 0xffffu);
        }
        dend[lane] = Dp;
        LDS_WAIT(); asm volatile("" ::: "memory");
#pragma unroll 1
        for (int tt = 0; tt < 8; ++tt) {
            LAS const float* tk = tokb + tt * 320;
            unsigned ci = cbase + (unsigned)(sb * 8 + tt) * 64u; const bool cisv = ci >= CPY_TOTAL; ci -= cisv ? CPY_TOTAL : 0u;
            const bool cok = ci < CPY_TOTAL; const unsigned cb = ci / PERB, co = ci - cb * PERB; const size_t cdst = (size_t)cb * (WINL * CA / 4) + co;
            f32x4 cval = {0.f, 0.f, 0.f, 0.f};
            if (cok) cval = __builtin_nontemporal_load((const f32x4*)(cisv ? cv : ck) + (cdst + (SS * CA / 4)));
#define LD4(off) (*(LAS const f32x4*)(tk + (off)))
            const float vi = tk[256 + lane];
            float sS0 = 0.f, sS1 = 0.f, sP0 = 0.f, sP1 = 0.f;
#pragma unroll
            for (int j4 = 0; j4 < 16; ++j4) { const f32x4 n4 = LD4(4 * j4);
                sS0 = fmaf(S[4 * j4], n4[0], sS0); sS1 = fmaf(S[4 * j4 + 1], n4[1], sS1); sS0 = fmaf(S[4 * j4 + 2], n4[2], sS0); sS1 = fmaf(S[4 * j4 + 3], n4[3], sS1);
                sP0 = fmaf(P[4 * j4], n4[0], sP0); sP1 = fmaf(P[4 * j4 + 1], n4[1], sP1); sP0 = fmaf(P[4 * j4 + 2], n4[2], sP0); sP1 = fmaf(P[4 * j4 + 3], n4[3], sP1); }
            const float saS = sS0 + sS1, saP = sP0 + sP1;
            float yS0 = 0.f, yS1 = 0.f, yP0 = 0.f, yP1 = 0.f;
#pragma unroll
            for (int j4 = 0; j4 < 16; ++j4) {
                const f32x4 ka = LD4(64 + 4 * j4), kp = LD4(128 + 4 * j4), r = LD4(192 + 4 * j4);
#pragma unroll
                for (int e = 0; e < 4; ++e) { const int j = 4 * j4 + e;
                    S[j] = fmaf(saS, ka[e], fmaf(vi, kp[e], S[j]));
                    P[j] = fmaf(saP, ka[e], P[j]);
                    if (e & 1) { yS1 = fmaf(S[j], r[e], yS1); yP1 = fmaf(P[j], r[e], yP1); } else { yS0 = fmaf(S[j], r[e], yS0); yP0 = fmaf(P[j], r[e], yP0); } }
            }
#undef LD4
            const size_t row = row0 + sb * 8 + tt;
            YL[row * CB + hc] = yS0 + yS1; U[row * CB + hc] = yP0 + yP1;
            if (cok) __builtin_nontemporal_store(cval, (f32x4*)(out + (cisv ? O_VWS : O_KWS)) + cdst);
        }
#pragma unroll
        for (int j4 = 0; j4 < 16; ++j4) { const f32x4 d4 = *(LAS const f32x4*)(dend + 4 * j4);
            S[4 * j4] *= d4[0]; S[4 * j4 + 1] *= d4[1]; S[4 * j4 + 2] *= d4[2]; S[4 * j4 + 3] *= d4[3];
            P[4 * j4] *= d4[0]; P[4 * j4 + 1] *= d4[1]; P[4 * j4 + 2] *= d4[2]; P[4 * j4 + 3] *= d4[3]; }
    }
    float* so = SLOC + ((size_t)((b * NH + h) * NCHUNK + c) * 64 + lane) * 64;
    float* po = PHI + ((size_t)((b * NH + h) * NCHUNK + c) * 64 + lane) * 64;
#pragma unroll
    for (int j4 = 0; j4 < 16; ++j4) { *(GAS f32x4*)(so + 4 * j4) = (f32x4){S[4 * j4], S[4 * j4 + 1], S[4 * j4 + 2], S[4 * j4 + 3]}; *(GAS f32x4*)(po + 4 * j4) = (f32x4){P[4 * j4], P[4 * j4 + 1], P[4 * j4 + 2], P[4 * j4 + 3]}; }
}
__device__ __forceinline__ void rwkv_sample(const Ctx& C, const bf16* ZB, const bf16* LAM, const bf16* AA, const bf16* G, const RwkvW& W, const float* state_wkv, const float* state_shift, bf16* HEADS, float* out) {
    if (C.vcu >= SB * NH || C.wave != 0) return;
    const int b = C.vcu >> 3, h = C.vcu & 7, lane = C.lane, hc = h * 64 + lane;
    LAS float* tk = (LAS float*)(C.lds + 98304);
    LAS float* Sl = (LAS float*)(C.lds + 98304 + 2048) + lane * 65;
    const float* s0 = state_wkv + ((size_t)(b * NH + h) * 64 + lane) * 64;
#pragma unroll 4
    for (int j = 0; j < 64; ++j) Sl[j] = s0[j];
    float pr = state_shift[(size_t)b * DBIN + hc], pk = state_shift[(size_t)b * DBIN + 512 + hc], pv = state_shift[(size_t)b * DBIN + 1024 + hc];
#pragma unroll 1
    for (int s = 0; s < SS; ++s) {
        const size_t row = (size_t)MPR + b * SS + s; const bf16* zp = ZB + row * DBIN + hc;
        const float zr = bf1(zp[0]), zk = bf1(zp[512]), zv = bf1(zp[1024]);
        const RwkvTok o = rwkv_tok(zr, zk, zv, pr, pk, pv, bf1(LAM[row * CB + hc]), bf1(AA[row * CB + hc]), W.mu[hc], W.mu[512 + hc], W.mu[1024 + hc], W.k_k[hc], W.k_a[hc], W.r_k[hc], lane);
        pr = zr; pk = zk; pv = zv;
        tk[lane] = o.nkk; tk[64 + lane] = o.ka; tk[128 + lane] = o.d; tk[192 + lane] = o.kp; tk[256 + lane] = o.r;
        LDS_WAIT(); asm volatile("" ::: "memory");
        float sa = 0.f;
#pragma unroll 4
        for (int j = 0; j < 64; ++j) sa = fmaf(Sl[j], tk[j], sa);
        float y = 0.f;
#pragma unroll 4
        for (int j = 0; j < 64; ++j) { float t = o.v * tk[192 + j]; t = fmaf(sa, tk[64 + j], t); const float sn = fmaf(Sl[j], tk[128 + j], t); Sl[j] = sn; y = fmaf(sn, tk[256 + j], y); }
        const float ym = wave_sum(y, lane) * (1.0f / 64.0f), dy = y - ym, yv = wave_sum(dy * dy, lane) * (1.0f / 64.0f);
        const float yn = dy * __builtin_amdgcn_rsqf(yv + GN_EPS) * W.lnx_w[hc] + W.lnx_b[hc];
        const float res = (yn + o.bon * o.v) * bf1(G[row * CB + hc]);
        HEADS[row * DM + CA + hc] = (bf16)(cvtpk(res, 0.f) & 0xffffu);
        LDS_WAIT(); asm volatile("" ::: "memory");
    }
    float* so = out + O_WKVS + ((size_t)(b * NH + h) * 64 + lane) * 64;
#pragma unroll 4
    for (int j = 0; j < 64; ++j) so[j] = Sl[j];
}

__device__ __forceinline__ void rwkv_carry(const Ctx& C, const float* PHI, const float* SLOC, float* SC, float* out) {
    const int bh = C.vcu >> 2, rq = C.vcu & 3, tid = C.tid;
    if (bh >= NBATCH * NH) return;
    LAS float* cur = (LAS float*)(C.lds);
    LAS float* phi = (LAS float*)(C.lds + 8192);
    const int row = tid >> 5, cp = tid & 31;
    const size_t gbase = ((size_t)(bh * NCHUNK) * 64 + rq * 16 + row) * 64 + 2 * cp;
    f32x4 pre[2]; f32x2_t sl;
    { const float* p0 = PHI + (size_t)(bh * NCHUNK) * 4096; pre[0] = *(const GAS f32x4*)(p0 + tid * 4); pre[1] = *(const GAS f32x4*)(p0 + 2048 + tid * 4); sl = *(const GAS f32x2_t*)(SLOC + gbase); }
    f32x2_t cv = {0.f, 0.f};
    for (int c = 0; c < NCHUNK; ++c) {
        LAS float* ph = phi + (c & 1) * 4096;
        *(LAS f32x4*)(ph + tid * 4) = pre[0]; *(LAS f32x4*)(ph + 2048 + tid * 4) = pre[1];
        *(LAS f32x2_t*)(cur + (c & 1) * 1024 + row * 64 + 2 * cp) = cv;
        const f32x2_t slc = sl;
        if (c + 1 < NCHUNK) { const float* p1 = PHI + (size_t)(bh * NCHUNK + c + 1) * 4096; pre[0] = *(const GAS f32x4*)(p1 + tid * 4); pre[1] = *(const GAS f32x4*)(p1 + 2048 + tid * 4); sl = *(const GAS f32x2_t*)(SLOC + gbase + (size_t)(c + 1) * 4096); }
        *(GAS f32x2_t*)(SC + gbase + (size_t)c * 4096) = cv;
        __syncthreads();
        LAS const float* cr_ = cur + (c & 1) * 1024 + row * 64;
        float a0 = slc[0], a1 = slc[1];
#pragma unroll 4
        for (int k4 = 0; k4 < 16; ++k4) { const f32x4 cr = *(LAS const f32x4*)(cr_ + 4 * k4);
#pragma unroll
            for (int e = 0; e < 4; ++e) { const f32x2_t pv = *(LAS const f32x2_t*)(ph + (4 * k4 + e) * 64 + 2 * cp); a0 = fmaf(cr[e], pv[0], a0); a1 = fmaf(cr[e], pv[1], a1); } }
        cv = (f32x2_t){a0, a1};
    }
    *(GAS f32x2_t*)(out + O_WKVP + ((size_t)bh * 64 + rq * 16 + row) * 64 + 2 * cp) = cv;
    __syncthreads();
}

__device__ __forceinline__ void rwkv_finish(const Ctx& C, const float* YL, const float* U, const float* SC, const bf16* BV, const bf16* G, const RwkvW& W, bf16* HEADS) {
    constexpr int FP = 68;
    const int tid = C.tid, lane = C.lane, r32 = lane & 31, hi = lane >> 5, slot = C.wave >> 2, wq = C.wave & 3, t256 = tid & 255;
    LAS float* Ss = (LAS float*)(C.lds + slot * 52224);
    LAS float* Us = Ss + 64 * FP;
    if ((C.vcu >> 2) >= NBATCH * NH) return;
    for (int pass = 0; pass < 4; ++pass) {
        const int item = C.vcu * 8 + pass * 2 + slot, bh = item >> 5, c = item & 31, b = bh >> 3, h = bh & 7;
        const float* sc = SC + (size_t)(bh * NCHUNK + c) * 4096;
        const size_t row0 = (size_t)b * TSEQ + c * CHL;
#pragma unroll
        for (int k = 0; k < 4; ++k) { const int e = t256 * 4 + k * 1024; *(LAS f32x4*)(Ss + (e >> 6) * FP + (e & 63)) = *(const GAS f32x4*)(sc + e); }
#pragma unroll
        for (int k = 0; k < 8; ++k) { const int e = t256 * 4 + k * 1024, t = e >> 6, j = e & 63; *(LAS f32x4*)(Us + t * FP + j) = *(const GAS f32x4*)(U + (row0 + t) * CB + h * 64 + j); }
        __syncthreads();
        const size_t row = row0 + wq * 32 + r32;
        f32x16 acc[2];
#pragma unroll
        for (int tl = 0; tl < 2; ++tl)
#pragma unroll
            for (int g4 = 0; g4 < 4; ++g4) { const f32x4 v = *(const GAS f32x4*)(YL + row * CB + h * 64 + 32 * tl + 8 * g4 + 4 * hi); acc[tl][4 * g4] = v[0]; acc[tl][4 * g4 + 1] = v[1]; acc[tl][4 * g4 + 2] = v[2]; acc[tl][4 * g4 + 3] = v[3]; }
        LAS const float* ua = Us + (wq * 32 + r32) * FP + 4 * hi;
        LAS const float* sa0 = Ss + r32 * FP + 4 * hi;
#pragma unroll
        for (int q = 0; q < 8; ++q) {
            const f32x4 b4 = *(LAS const f32x4*)(ua + 8 * q), a0 = *(LAS const f32x4*)(sa0 + 8 * q), a1 = *(LAS const f32x4*)(sa0 + 32 * FP + 8 * q);
#pragma unroll
            for (int e = 0; e < 4; ++e) { acc[0] = __builtin_amdgcn_mfma_f32_32x32x2f32(a0[e], b4[e], acc[0], 0, 0, 0); acc[1] = __builtin_amdgcn_mfma_f32_32x32x2f32(a1[e], b4[e], acc[1], 0, 0, 0); }
        }
        float sm = 0.f;
#pragma unroll
        for (int tl = 0; tl < 2; ++tl)
#pragma unroll
            for (int e = 0; e < 16; ++e) sm += acc[tl][e];
        sm += shx(sm, 32, lane);
        const float ym = sm * (1.0f / 64.0f); float sv = 0.f;
#pragma unroll
        for (int tl = 0; tl < 2; ++tl)
#pragma unroll
            for (int e = 0; e < 16; ++e) { const float d = acc[tl][e] - ym; acc[tl][e] = d; sv += d * d; }
        sv += shx(sv, 32, lane);
        const float rs = __builtin_amdgcn_rsqf(sv * (1.0f / 64.0f) + GN_EPS);
#pragma unroll
        for (int tl = 0; tl < 2; ++tl)
#pragma unroll
            for (int g4 = 0; g4 < 4; ++g4) { const int ic = h * 64 + 32 * tl + 8 * g4 + 4 * hi;
                const f32x4 lw = *(const GAS f32x4*)(W.lnx_w + ic), lb = *(const GAS f32x4*)(W.lnx_b + ic);
                const u32x2 bw = *(const GAS u32x2*)(BV + row * CB + ic), gw = *(const GAS u32x2*)(G + row * CB + ic);
                const float r0 = (acc[tl][4 * g4] * rs * lw[0] + lb[0] + bflo(bw.x)) * bflo(gw.x), r1 = (acc[tl][4 * g4 + 1] * rs * lw[1] + lb[1] + bfhi(bw.x)) * bfhi(gw.x);
                const float r2 = (acc[tl][4 * g4 + 2] * rs * lw[2] + lb[2] + bflo(bw.y)) * bflo(gw.y), r3 = (acc[tl][4 * g4 + 3] * rs * lw[3] + lb[3] + bfhi(bw.y)) * bfhi(gw.y);
                u32x2 ow; ow.x = cvtpk(r0, r1); ow.y = cvtpk(r2, r3);
                *(GAS u32x2*)(HEADS + row * DM + CA + ic) = ow; }
        __syncthreads();
    }
}

template <int U> __device__ __forceinline__ f32x16 thin_acc(const bf16* ap, const bf16* bp, int klen, f32x16 acc) {
#pragma unroll 1
    for (int k = 0; k < klen; k += 16 * U) {
        bf16x8 a[U], b[U];
#pragma unroll
        for (int u = 0; u < U; ++u) { a[u] = *(const GAS bf16x8*)(ap + k + 16 * u); b[u] = *(const GAS bf16x8*)(bp + k + 16 * u); }
#pragma unroll
        for (int u = 0; u < U; ++u) acc = __builtin_amdgcn_mfma_f32_32x32x16_bf16(a[u], b[u], acc, 0, 0, 0);
    }
    return acc;
}
#define F16Z (f32x16){0.f, 0.f, 0.f, 0.f, 0.f, 0.f, 0.f, 0.f, 0.f, 0.f, 0.f, 0.f, 0.f, 0.f, 0.f, 0.f}
#define THIN_LOOP(ntiles) const int lane = C.lane, r32 = lane & 31, hi = lane >> 5; for (int t = (255 - (int)blockIdx.x) * NWAVES + C.wave; t < (ntiles); t += 256 * NWAVES)
__device__ __forceinline__ void thin_lora(const Ctx& C, const bf16* AP, const bf16* Wl, const float* w0, const float* a0, bf16* LAM) {
    THIN_LOOP(192) { const int grp = t >> 6, rb = (t >> 4) & 3, cb = t & 15, koff = grp == 0 ? 0 : grp == 1 ? 64 : 128, klen = grp == 2 ? 128 : 64;
        const f32x16 acc = thin_acc<4>(AP + (size_t)(MPR + rb * 32 + r32) * 256 + koff + 8 * hi, Wl + (size_t)(grp * 512 + cb * 32 + r32) * 256 + koff + 8 * hi, klen, F16Z);
        const int n = cb * 32 + r32; const float bias = grp == 0 ? w0[n] : grp == 1 ? a0[n] : 0.f, mul = grp == 0 ? 0.6065306597126334f : 1.0f;
        bf16* dst = LAM + (size_t)grp * ((size_t)MT * CB);
#pragma unroll
        for (int i = 0; i < 16; ++i) { float v = acc[i] + bias; if (grp < 2) v = mul * sigm(v); dst[(size_t)(MPR + rb * 32 + crow(i, hi)) * CB + n] = (bf16)(cvtpk(v, 0.f) & 0xffffu); } }
}
#define THIN_WG_LOOP(ntiles) const int lane = C.lane, r32 = lane & 31, hi = lane >> 5, wv = C.wave; for (int t = 255 - (int)blockIdx.x; t < (ntiles); t += 256)
template <int NACC> __device__ __forceinline__ void thin_reduce(const Ctx& C, const f32x16 (&acc)[NACC], float (&res)[NACC][2]) {
    LAS float* red = (LAS float*)C.lds;
#pragma unroll
    for (int a = 0; a < NACC; ++a)
#pragma unroll
        for (int i = 0; i < 16; ++i) red[((a * 8 + C.wave) * 16 + i) * 64 + C.lane] = acc[a][i];
    __syncthreads();
#pragma unroll
    for (int a = 0; a < NACC; ++a)
#pragma unroll
        for (int q = 0; q < 2; ++q) { float s = 0.f;
#pragma unroll
            for (int w = 0; w < 8; ++w) s += red[((a * 8 + w) * 16 + 2 * C.wave + q) * 64 + C.lane];
            res[a][q] = s; }
    __syncthreads();
}
__device__ __forceinline__ void thin_wout(const Ctx& C, const bf16* HEADS, const bf16* Wout, const float* xs, bf16* PRE) {
    THIN_WG_LOOP(128) { const int rb = t >> 5, cb = t & 31, n = cb * 32 + r32;
        f32x16 acc[1]; float res[1][2];
        acc[0] = thin_acc<8>(HEADS + (size_t)(MPR + rb * 32 + r32) * DM + 8 * hi + wv * 128, Wout + (size_t)n * DM + 8 * hi + wv * 128, 128, F16Z);
        thin_reduce<1>(C, acc, res);
#pragma unroll
        for (int q = 0; q < 2; ++q) { const int rs = rb * 32 + crow(2 * wv + q, hi); PRE[(size_t)(MPR + rs) * DM + n] = (bf16)(cvtpk(res[0][q] + ALPHA * xs[(size_t)rs * DM + n], 0.f) & 0xffffu); } }
}
__device__ __forceinline__ void thin_gu(const Ctx& C, const bf16* H1, const bf16* Wgu, bf16* ACT) {
    THIN_WG_LOOP(352) { const int rb = t / 88, fb = t % 88, f = fb * 32 + r32, grow = (f >> 7) * 256 + (f & 127);
        const bf16* ap = H1 + (size_t)(MPR + rb * 32 + r32) * DM + 8 * hi + wv * 128;
        f32x16 acc[2]; float res[2][2];
        acc[0] = thin_acc<8>(ap, Wgu + (size_t)grow * DM + 8 * hi + wv * 128, 128, F16Z);
        acc[1] = thin_acc<8>(ap, Wgu + (size_t)(grow + 128) * DM + 8 * hi + wv * 128, 128, F16Z);
        thin_reduce<2>(C, acc, res);
#pragma unroll
        for (int q = 0; q < 2; ++q) { const float g = res[0][q]; ACT[(size_t)(MPR + rb * 32 + crow(2 * wv + q, hi)) * DFF + f] = (bf16)(cvtpk(g * sigm(g) * res[1][q], 0.f) & 0xffffu); } }
}
__device__ __forceinline__ void thin_down(const Ctx& C, const bf16* ACT, const bf16* Wd, const bf16* H1, bf16* PRE) {
    THIN_WG_LOOP(128) { const int rb = t >> 5, cb = t & 31, n = cb * 32 + r32;
        f32x16 acc[1]; float res[1][2];
        acc[0] = thin_acc<11>(ACT + (size_t)(MPR + rb * 32 + r32) * DFF + 8 * hi + wv * 352, Wd + (size_t)n * DFF + 8 * hi + wv * 352, 352, F16Z);
        thin_reduce<1>(C, acc, res);
#pragma unroll
        for (int q = 0; q < 2; ++q) { const size_t o = (size_t)(MPR + rb * 32 + crow(2 * wv + q, hi)) * DM + n; PRE[o] = (bf16)(cvtpk(res[0][q] + ALPHA * bf1(H1[o]), 0.f) & 0xffffu); } }
}
__device__ __forceinline__ void thin_pp(const Ctx& C, const bf16* PB, const bf16* Wpp, bf16* PP) {
    THIN_WG_LOOP(128) { const int rb = t >> 5, cb = t & 31, n = cb * 32 + r32;
        f32x16 acc[1]; float res[1][2];
        acc[0] = thin_acc<2>(PB + (size_t)(MPR + rb * 32 + r32) * PLE + 8 * hi + wv * 32, Wpp + (size_t)n * PLE + 8 * hi + wv * 32, 32, F16Z);
        thin_reduce<1>(C, acc, res);
#pragma unroll
        for (int q = 0; q < 2; ++q) PP[(size_t)(MPR + rb * 32 + crow(2 * wv + q, hi)) * DM + n] = (bf16)(cvtpk(res[0][q], 0.f) & 0xffffu); }
}
__device__ __forceinline__ void thin_pg(const Ctx& C, const bf16* H2, const bf16* Wpg, const bf16* PP, bf16* PRE) {
    THIN_WG_LOOP(128) { const int rb = t >> 5, cb = t & 31, n = cb * 32 + r32;
        f32x16 acc[1]; float res[1][2];
        acc[0] = thin_acc<8>(H2 + (size_t)(MPR + rb * 32 + r32) * DM + 8 * hi + wv * 128, Wpg + (size_t)n * DM + 8 * hi + wv * 128, 128, F16Z);
        thin_reduce<1>(C, acc, res);
#pragma unroll
        for (int q = 0; q < 2; ++q) { const size_t o = (size_t)(MPR + rb * 32 + crow(2 * wv + q, hi)) * DM + n; PRE[o] = (bf16)(cvtpk(ALPHA * bf1(H2[o]) + sigm(res[0][q]) * bf1(PP[o]), 0.f) & 0xffffu); } }
}

template <int MODE> __device__ __forceinline__ void ln_pass(const Ctx& C, const bf16* PRE, const float* w, const float* bsh, bf16* Hout, float* out) {
    const int gw = C.vcu * NWAVES + C.wave, NGW = C.G * NWAVES, lane = C.lane;
    f32x4 wv[4], bv[4];
#pragma unroll
    for (int j = 0; j < 2; ++j) { wv[2 * j] = *(const GAS f32x4*)(w + 512 * j + 8 * lane); wv[2 * j + 1] = *(const GAS f32x4*)(w + 512 * j + 8 * lane + 4);
                                   bv[2 * j] = *(const GAS f32x4*)(bsh + 512 * j + 8 * lane); bv[2 * j + 1] = *(const GAS f32x4*)(bsh + 512 * j + 8 * lane + 4); }
    for (int row = gw; row < MPR + MSA; row += NGW) {
        const GAS v4u* xr = (const GAS v4u*)(PRE + (size_t)row * DM) + lane;
        f32x4 v[4]; float s = 0.f;
#pragma unroll
        for (int j = 0; j < 2; ++j) { const v4u q = xr[64 * j]; v[2 * j] = (f32x4){bflo(q.x), bfhi(q.x), bflo(q.y), bfhi(q.y)}; v[2 * j + 1] = (f32x4){bflo(q.z), bfhi(q.z), bflo(q.w), bfhi(q.w)}; }
#pragma unroll
        for (int j = 0; j < 4; ++j) s += (v[j][0] + v[j][1]) + (v[j][2] + v[j][3]);
        const float mean = wave_sum(s, lane) * (1.f / DM); float s2 = 0.f;
#pragma unroll
        for (int j = 0; j < 4; ++j) { v[j] = v[j] - mean; s2 += (v[j][0] * v[j][0] + v[j][1] * v[j][1]) + (v[j][2] * v[j][2] + v[j][3] * v[j][3]); }
        const float rstd = __builtin_amdgcn_rsqf(wave_sum(s2, lane) * (1.f / DM) + LN_EPS);
        if (MODE == 0) {
            GAS v4u* o8 = (GAS v4u*)(Hout + (size_t)row * DM) + lane;
#pragma unroll
            for (int j = 0; j < 2; ++j) { const f32x4 a = v[2 * j] * rstd * wv[2 * j] + bv[2 * j], b = v[2 * j + 1] * rstd * wv[2 * j + 1] + bv[2 * j + 1];
                v4u wq; wq.x = cvtpk(a[0], a[1]); wq.y = cvtpk(a[2], a[3]); wq.z = cvtpk(b[0], b[1]); wq.w = cvtpk(b[2], b[3]); o8[64 * j] = wq; }
        } else {
            float* dst = row < MPR ? out + O_YP + (size_t)row * DM : out + O_YS + (size_t)(row - MPR) * DM;
#pragma unroll
            for (int j = 0; j < 2; ++j) { *((GAS f32x4*)(dst + 512 * j + 8 * lane)) = v[2 * j] * rstd * wv[2 * j] + bv[2 * j]; *((GAS f32x4*)(dst + 512 * j + 8 * lane + 4)) = v[2 * j + 1] * rstd * wv[2 * j + 1] + bv[2 * j + 1]; }
        }
    }
}
struct Args { const float* in[32]; float* out; unsigned char* ws; int nphase, pad; };
#ifndef PHMASK
#define PHMASK 0xFFFFFF
#endif
#ifndef REPPH
#define REPPH -1
#endif
#ifndef REPN
#define REPN 3
#endif
#define PHON(n) if constexpr (((PHMASK) >> (n)) & 1) for (int rep_ = 0; rep_ < ((n) == (REPPH) ? (REPN) : 1); ++rep_)
#ifndef GEMM_ALIGN
#define GEMM_ALIGN true
#endif
#ifndef GEMM_SP2
#define GEMM_SP2 true
#endif
__global__ void __launch_bounds__(NWAVES * 64, 2) mega_fwd(Args args) {
    extern __shared__ __attribute__((aligned(16))) unsigned char lds_raw[];
    LAS unsigned char* const lds0 = (LAS unsigned char*)lds_raw;
    volatile LAS unsigned* MISC = (volatile LAS unsigned*)(lds0 + MISC_OFF);
    const int G0 = gridDim.x;
    for (int u = threadIdx.x; u < (LDS_BYTES - LDSCTL_OFF) / 4; u += NWAVES * 64) ((LAS unsigned*)(lds0 + LDSCTL_OFF))[u] = 0u;
    __syncthreads();
    gu32* ctl = (gu32*)(args.ws + WS_CTL);
    XcdBarrier bar = xcd_barrier_post((unsigned*)(ctl + CW_BAR), MISC + 8);
    const int nph = args.nphase;
#define GRID_BAR() xcd_barrier(bar)
    typedef const __attribute__((address_space(4))) Args* KArgs;
#define PH_BEGIN Ctx C; { int t_ = threadIdx.x; asm volatile("" : "+v"(t_)); C.lds = lds0; C.tid = t_; C.lane = t_ & 63; C.wave = __builtin_amdgcn_readfirstlane(t_ >> 6); C.G = G0; const int bx_ = blockIdx.x; C.vcu = (G0 % 8 == 0) ? (bx_ % 8) * (G0 / 8) + bx_ / 8 : bx_; } KArgs kp = (KArgs)__builtin_amdgcn_kernarg_segment_ptr(); asm volatile("" : "+s"(kp)); unsigned char* ws = kp->ws; float* out = kp->out; (void)ws; (void)out;
#define IN_(i) (kp->in[i])
#define WSB(off) ((bf16*)(ws + (off)))
#define WSF(off) ((float*)(ws + (off)))
    const int bx = (int)blockIdx.x;

    PHON(0) { PH_BEGIN P0Args A{IN_(0), IN_(1), IN_(2), IN_(3), IN_(4), IN_(5), IN_(8), IN_(20), IN_(23), IN_(24), IN_(25), IN_(28), IN_(29), IN_(11), IN_(13), IN_(14),
                       WSB(WS_WIN), WSB(WS_WOUT), WSB(WS_WGU), WSB(WS_WD), WSB(WS_WPG), WSB(WS_WPP), WSB(WS_WL), WSB(WS_R1), WSB(WS_PB), out};
      p0_prologue(C, A); }
    GRID_BAR(); if (nph <= 1) return;
    PHON(1) { PH_BEGIN pg8::Gemm g{WSB(WS_R1), WSB(WS_WIN), MT, DIN, DM}; pg8::StaticOrder S; S.init(MT, DIN, C.G, bx);
      pg8::EpiZ E{WSB(WS_QB), WSB(WS_ZB), out};
      pg8::gemm_phase<pg8::EpiZ, pg8::StaticOrder, GEMM_ALIGN, GEMM_SP2>(C.lds + RING_OFF, g, S, E); }
    GRID_BAR(); if (nph <= 2) return;
    PHON(2) { PH_BEGIN prep_a(C, WSB(WS_ZB), IN_(9), IN_(7), WSB(WS_AP), out); }
    PHON(3) { PH_BEGIN attn_prompt(C, WSB(WS_QB), WSB(WS_KB), WSB(WS_VB), WSB(WS_OG), WSF(WS_LSE)); }
    PHON(4) { PH_BEGIN attn_sample(C, WSB(WS_QB), IN_(4), IN_(5), out, WSB(WS_R1)); }
    GRID_BAR(); if (nph <= 3) return;
    PHON(5) { PH_BEGIN pg8::Gemm g{WSB(WS_AP), WSB(WS_WL), MPR, 1536, 256}; pg8::StaticOrder S; S.init(MPR, 1536, C.G, bx);
      pg8::EpiLora E{WSB(WS_QB), IN_(10), IN_(12)};
      pg8::gemm_phase<pg8::EpiLora, pg8::StaticOrder, GEMM_ALIGN, GEMM_SP2>(C.lds + RING_OFF, g, S, E);
      thin_lora(C, WSB(WS_AP), WSB(WS_WL), IN_(10), IN_(12), WSB(WS_QB)); }
    PHON(6) { PH_BEGIN attn_merge(C, WSB(WS_OG), WSF(WS_LSE), WSB(WS_R1)); }
    GRID_BAR(); if (nph <= 4) return;
    PHON(7) { PH_BEGIN const RwkvW RW{IN_(9), IN_(15), IN_(16), IN_(17), IN_(18), IN_(19)};
      rwkv_sample(C, WSB(WS_ZB), WSB(WS_QB), WSB(WS_KB), WSB(WS_VB), RW, IN_(6), IN_(7), WSB(WS_R1), out); }
    PHON(8) { PH_BEGIN const RwkvW RW{IN_(9), IN_(15), IN_(16), IN_(17), IN_(18), IN_(19)};
      const int bh = C.vcu >> 2, c = (C.vcu & 3) * 8 + C.wave;
      if (bh < NBATCH * NH) rwkv_chunk(C, WSB(WS_ZB), WSB(WS_QB), WSB(WS_KB), RW, out + O_YP, out + O_YP + (size_t)MPR * CB, WSB(WS_BV), WSF(WS_PHI), WSF(WS_SLOC), bh >> 3, bh & 7, c, IN_(4), IN_(5), out); }
    GRID_BAR(); if (nph <= 5) return;
    PHON(9) { PH_BEGIN rwkv_carry(C, WSF(WS_PHI), WSF(WS_SLOC), WSF(WS_SC), out); }
    GRID_BAR(); if (nph <= 6) return;
    PHON(10) { PH_BEGIN const RwkvW RW{IN_(9), IN_(15), IN_(16), IN_(17), IN_(18), IN_(19)};
      rwkv_finish(C, out + O_YP, out + O_YP + (size_t)MPR * CB, WSF(WS_SC), WSB(WS_BV), WSB(WS_VB), RW, WSB(WS_R1)); }
    GRID_BAR(); if (nph <= 7) return;
    PHON(11) { PH_BEGIN pg8::Gemm g{WSB(WS_R1), WSB(WS_WOUT), MPR, DM, DM}; pg8::StaticOrder S; S.init(MPR, DM, C.G, bx);
      pg8::EpiWout E{WSB(WS_PRE), IN_(0), IN_(1)};
      pg8::gemm_phase<pg8::EpiWout, pg8::StaticOrder, GEMM_ALIGN, GEMM_SP2>(C.lds + RING_OFF, g, S, E);
      thin_wout(C, WSB(WS_R1), WSB(WS_WOUT), IN_(1), WSB(WS_PRE)); }
    PHON(16) { PH_BEGIN pg8::Gemm g{WSB(WS_PB), WSB(WS_WPP), MPR, DM, PLE}; pg8::StaticOrder S; S.init(MPR, DM, C.G, bx);
      pg8::EpiPlain E{WSB(WS_PP)};
      pg8::gemm_phase<pg8::EpiPlain, pg8::StaticOrder, GEMM_ALIGN, GEMM_SP2>(C.lds + RING_OFF, g, S, E);
      thin_pp(C, WSB(WS_PB), WSB(WS_WPP), WSB(WS_PP)); }
    GRID_BAR(); if (nph <= 8) return;
    PHON(12) { PH_BEGIN ln_pass<0>(C, WSB(WS_PRE), IN_(21), IN_(22), WSB(WS_R1), out); }
    GRID_BAR(); if (nph <= 9) return;
    PHON(13) { PH_BEGIN pg8::Gemm g{WSB(WS_R1), WSB(WS_WGU), MPR, 2 * DFF, DM}; pg8::StaticOrder S; S.init(MPR, 2 * DFF, C.G, bx);
      pg8::EpiGU E{WSB(WS_ACT)};
      pg8::gemm_phase<pg8::EpiGU, pg8::StaticOrder, GEMM_ALIGN, GEMM_SP2>(C.lds + RING_OFF, g, S, E);
      thin_gu(C, WSB(WS_R1), WSB(WS_WGU), WSB(WS_ACT)); }
    GRID_BAR(); if (nph <= 10) return;
    PHON(14) { PH_BEGIN pg8::Gemm g{WSB(WS_ACT), WSB(WS_WD), MPR, DM, DFF}; pg8::StaticOrder S; S.init(MPR, DM, C.G, bx);
      pg8::EpiDown E{WSB(WS_PRE), WSB(WS_R1)};
      pg8::gemm_phase<pg8::EpiDown, pg8::StaticOrder, GEMM_ALIGN, GEMM_SP2>(C.lds + RING_OFF, g, S, E);
      thin_down(C, WSB(WS_ACT), WSB(WS_WD), WSB(WS_R1), WSB(WS_PRE)); }
    GRID_BAR(); if (nph <= 11) return;
    PHON(15) { PH_BEGIN ln_pass<0>(C, WSB(WS_PRE), IN_(26), IN_(27), WSB(WS_H2), out); }
    GRID_BAR(); if (nph <= 12) return;
    PHON(17) { PH_BEGIN pg8::Gemm g{WSB(WS_H2), WSB(WS_WPG), MPR, DM, DM}; pg8::StaticOrder S; S.init(MPR, DM, C.G, bx);
      pg8::EpiPle E{WSB(WS_PRE), WSB(WS_H2), WSB(WS_PP)};
      pg8::gemm_phase<pg8::EpiPle, pg8::StaticOrder, GEMM_ALIGN, GEMM_SP2>(C.lds + RING_OFF, g, S, E);
      thin_pg(C, WSB(WS_H2), WSB(WS_WPG), WSB(WS_PP), WSB(WS_PRE)); }
    GRID_BAR(); if (nph <= 14) return;
    PHON(18) { PH_BEGIN ln_pass<1>(C, WSB(WS_PRE), IN_(30), IN_(31), nullptr, out); }
}

#ifndef N_PHASES
#define N_PHASES 99
#endif
extern "C" void kernel_launch(void* const* d_in, const int* in_sizes, int n_in, void* d_out, int out_size, void* d_ws, size_t ws_size, hipStream_t stream) {
    static int grid = 0;
    if (grid == 0) {
        if (n_in != 32 || in_sizes[0] != MPR * DM || (size_t)out_size != O_END || ws_size < WS_END) {
            fprintf(stderr, "kernel_launch: unexpected shapes: n_in %d in0 %d out %d (want %zu) ws %zu (want >= %zu); nothing launched\n", n_in, n_in > 0 ? in_sizes[0] : -1, out_size, (size_t)O_END, ws_size, (size_t)WS_END);
            grid = -1; return; }
        int dev = 0, cus = 0, per_cu = 0;
        if (hipGetDevice(&dev) != hipSuccess || hipDeviceGetAttribute(&cus, hipDeviceAttributeMultiprocessorCount, dev) != hipSuccess) { fprintf(stderr, "kernel_launch: device query failed\n"); grid = -1; return; }
        if (hipFuncSetAttribute((const void*)mega_fwd, hipFuncAttributeMaxDynamicSharedMemorySize, LDS_BYTES) != hipSuccess) { fprintf(stderr, "kernel_launch: hipFuncSetAttribute failed\n"); grid = -1; return; }
        if (hipOccupancyMaxActiveBlocksPerMultiprocessor(&per_cu, (const void*)mega_fwd, NWAVES * 64, LDS_BYTES) != hipSuccess || per_cu < 1) { fprintf(stderr, "kernel_launch: occupancy query reports %d blocks per CU\n", per_cu); }
        (void)hipGetLastError();
        grid = cus;
        if (grid != 256) fprintf(stderr, "kernel_launch: note: %d CUs (work distribution assumes 256)\n", grid);
    }
    if (grid < 0) return;
    if (hipMemsetAsync((char*)d_ws + WS_CTL, 0, CTL_ZERO_BYTES, stream) != hipSuccess) { fprintf(stderr, "kernel_launch: memset failed\n"); return; }
    Args a{};
    for (int i = 0; i < 32; ++i) a.in[i] = (const float*)d_in[i];
    a.out = (float*)d_out; a.ws = (unsigned char*)d_ws; a.nphase = N_PHASES; a.pad = 0;
    hipLaunchKernelGGL(mega_fwd, dim3(grid), dim3(NWAVES * 64), LDS_BYTES, stream, a);
    const hipError_t le = hipPeekAtLastError();
    if (le != hipSuccess) fprintf(stderr, "kernel_launch: launch failed: %s\n", hipGetErrorName(le));
}
```

```cpp
#include <hip/hip_runtime.h>
#include <cstdio>
#include <cstdint>
constexpr int DM = 1024, TSEQ = 4096, NBATCH = 8, MPR = NBATCH * TSEQ;
constexpr int SB = 32, SS = 4, MSA = SB * SS;
constexpr int MT = MPR + 256;
constexpr int CA = 512, CB = 512, DBIN = 1792, DIN = 3328, DFF = 2816, PLE = 256, HD = 64, NH = 8;
constexpr int WINL = 2048;
constexpr float ALPHA = 1.18920711500272f;
constexpr float LN_EPS = 1e-5f, GN_EPS = 64e-5f;
constexpr float QSCALE = 0.125f * 1.4426950408889634f;
constexpr float LOG2E = 1.4426950408889634f;
constexpr size_t O_YP = 0, O_YS = O_YP + (size_t)MPR * DM, O_KWP = O_YS + (size_t)MSA * DM, O_VWP = O_KWP + (size_t)NBATCH * WINL * CA,
                 O_WKVP = O_VWP + (size_t)NBATCH * WINL * CA, O_SHP = O_WKVP + (size_t)NBATCH * NH * HD * HD, O_KWS = O_SHP + (size_t)NBATCH * DBIN,
                 O_VWS = O_KWS + (size_t)SB * WINL * CA, O_WKVS = O_VWS + (size_t)SB * WINL * CA, O_SHS = O_WKVS + (size_t)SB * NH * HD * HD,
                 O_END = O_SHS + (size_t)SB * DBIN;
namespace pg8 {
#define PG8_LAS __attribute__((address_space(3)))
typedef unsigned short bf16_t;
typedef short bf16x8 __attribute__((ext_vector_type(8)));
typedef float f32x4 __attribute__((ext_vector_type(4)));
typedef unsigned u32x4 __attribute__((ext_vector_type(4)));
constexpr int BM = 256, BK = 64, HALF = 128, HTB = HALF * BK * 2  , STAGE_BYTES = 8 * HTB, NXCD = 8, WGM = 8;

__host__ __device__ __forceinline__ int lds_byte(int r, int c) { const int st = (r >> 4) * 2 + (c >> 5), rr = r & 15, cc = c & 31, ob = rr * 64 + cc * 2; return st * 1024 + (ob ^ (((ob >> 9) & 1) << 5)); }
__host__ __device__ __forceinline__ void stage_rc(int b, int& R, int& C) { const int st = b / 1024, sb = b % 1024, swz = sb ^ (((sb >> 9) & 1) << 5); R = (st >> 1) * 16 + swz / 64; C = (st & 1) * 32 + (swz % 64) / 2; }
__host__ __device__ __forceinline__ int perm32(int rho) { const int n = rho >> 4, i = rho & 15; return 8 * (i >> 2) + 4 * n + (i & 3); }

struct Unit { int pm, pn; };
struct Gemm { const bf16_t* A; const bf16_t* Bt; int M, N, K; };

struct StaticOrder {
    int nM, nN, nwg, G, c;
    __host__ __device__ void init(int M, int N, int G_, int c_) { nM = M / BM; nN = N / BM; nwg = nM * nN; G = G_; c = c_; }
    __host__ __device__ bool next(int i, Unit& u) const {
        const long L = (long)i * G + c; if (L >= nwg) return false;
        int wgid = (int)L; { const int q = nwg / NXCD, r = nwg % NXCD, xcd = wgid % NXCD, off = wgid / NXCD; wgid = (xcd < r ? xcd * (q + 1) : r * (q + 1) + (xcd - r) * q) + off; }
        const int nig = WGM * nN, gid = wgid / nig, fm = gid * WGM, gsz = (nM - fm) < WGM ? (nM - fm) : WGM;
        u.pm = fm + ((wgid % nig) % gsz); u.pn = (wgid % nig) / gsz; return true;
    }
    __device__ __forceinline__ void a_ready(const Unit&) const {}
    __device__ __forceinline__ void done(const Unit&) const {}
};

typedef unsigned u32x2 __attribute__((ext_vector_type(2)));
__device__ __forceinline__ unsigned cvt_pk_bf16(float lo, float hi) { unsigned r; asm volatile("v_cvt_pk_bf16_f32 %0, %1, %2" : "=v"(r) : "v"(lo), "v"(hi)); return r; }
__device__ __forceinline__ float bf_lo(unsigned w) { return __uint_as_float(w << 16); }
__device__ __forceinline__ float bf_hi(unsigned w) { return __uint_as_float(w & 0xffff0000u); }
__device__ __forceinline__ float sigmoidf_(float x) { return __builtin_amdgcn_rcpf(1.0f + __builtin_amdgcn_exp2f(-x * 1.4426950408889634f)); }
__device__ __forceinline__ u32x4 pack8(const f32x4& a, const f32x4& b) { u32x4 w; w.x = cvt_pk_bf16(a[0], a[1]); w.y = cvt_pk_bf16(a[2], a[3]); w.z = cvt_pk_bf16(b[0], b[1]); w.w = cvt_pk_bf16(b[2], b[3]); return w; }

struct EpiZ {
    static constexpr bool PERM = true, AFTER_DRAIN = false;
    bf16_t *QB, *ZB; float* out;
    __device__ __forceinline__ void operator()(const f32x4 (&acc)[2][2][4][2], const Unit& u, int wr, int wc, int fr, int fq) const {
        const int pn = u.pn, pm = u.pm;
        const int kind = pn < 6 ? (pn >> 1) : 3;
        bf16_t* dst = kind == 3 ? ZB : QB + (size_t)kind * ((size_t)MT * CA);
        const int ld = kind == 3 ? DBIN : CA;
        const int col0 = (kind == 3 ? (pn - 6) * 256 : (pn & 1) * 256) + wc * 32 + 8 * fq;
        const float sc = kind == 0 ? QSCALE : 1.0f;
        const int rbase = pm * BM + wr * 64 + fr;
        const bool win_p = (kind == 1 || kind == 2) && pm < 128 && (pm & 15) >= 8;
        const bool win_s = (kind == 1 || kind == 2) && pm == 128;
        float* wout = out + (win_s ? O_KWS : O_KWP) + (kind == 2 ? (win_s ? (O_VWS - O_KWS) : (O_VWP - O_KWP)) : (size_t)0);
#pragma unroll
        for (int ai = 0; ai < 2; ++ai)
#pragma unroll
            for (int m = 0; m < 4; ++m) {
                const int row = rbase + ai * HALF + m * 16;
                bf16_t* rowp = dst + (size_t)row * ld + col0;
#pragma unroll
                for (int bj = 0; bj < 2; ++bj) {
                    const f32x4 v0 = acc[ai][bj][m][0] * sc, v1 = acc[ai][bj][m][1] * sc;
                    *(u32x4*)(rowp + bj * HALF) = pack8(v0, v1);
                    if (win_p) {
                        const int b = pm >> 4, t = (pm & 15) * 256 + (row & 255);
                        float* o = wout + ((size_t)(b * WINL + t - WINL) * CA + col0 + bj * HALF);
                        *(f32x4*)o = v0; *(f32x4*)(o + 4) = v1;
                    } else if (win_s && ai == 0) {
                        const int rs = row - MPR, b = rs >> 2, s = rs & 3;
                        float* o = wout + ((size_t)(b * WINL + (WINL - SS) + s) * CA + col0 + bj * HALF);
                        *(f32x4*)o = v0; *(f32x4*)(o + 4) = v1;
                    }
                }
            }
    }
};

struct EpiLora {
    static constexpr bool PERM = true, AFTER_DRAIN = false;
    bf16_t *LAM; const float *w0, *a0;
    __device__ __forceinline__ void operator()(const f32x4 (&acc)[2][2][4][2], const Unit& u, int wr, int wc, int fr, int fq) const {
        const int kind = u.pn >> 1;
        bf16_t* dst = LAM + (size_t)kind * ((size_t)MT * CB);
        const int col0 = (u.pn & 1) * 256 + wc * 32 + 8 * fq;
        const float* bias = kind == 0 ? w0 : a0;
        const float mul = kind == 0 ? 0.6065306597126334f : 1.0f;
        const int rbase = u.pm * BM + wr * 64 + fr;
#pragma unroll
        for (int bj = 0; bj < 2; ++bj) {
            f32x4 b0 = {0.f, 0.f, 0.f, 0.f}, b1 = b0;
            if (kind < 2) { b0 = *(const f32x4*)(bias + col0 + bj * HALF); b1 = *(const f32x4*)(bias + col0 + bj * HALF + 4); }
#pragma unroll
            for (int ai = 0; ai < 2; ++ai)
#pragma unroll
                for (int m = 0; m < 4; ++m) {
                    f32x4 v0 = acc[ai][bj][m][0] + b0, v1 = acc[ai][bj][m][1] + b1;
                    if (kind < 2) {
#pragma unroll
                        for (int e = 0; e < 4; ++e) { v0[e] = mul * sigmoidf_(v0[e]); v1[e] = mul * sigmoidf_(v1[e]); }
                    }
                    *(u32x4*)(dst + (size_t)(rbase + ai * HALF + m * 16) * CB + col0 + bj * HALF) = pack8(v0, v1);
                    asm volatile("" ::: "memory");
                }
        }
    }
};

__device__ __forceinline__ f32x4 xres4(const float* xp, const float* xs, int row, int col) {
    if (row < MPR) return *(const f32x4*)(xp + (size_t)row * DM + col);
    if (row < MPR + MSA) return *(const f32x4*)(xs + (size_t)(row - MPR) * DM + col);
    return (f32x4){0.f, 0.f, 0.f, 0.f};
}
struct EpiWout {
    static constexpr bool PERM = true, AFTER_DRAIN = false;
    bf16_t* PRE; const float *xp, *xs;
    __device__ __forceinline__ void operator()(const f32x4 (&acc)[2][2][4][2], const Unit& u, int wr, int wc, int fr, int fq) const {
        const int row0 = u.pm * BM + wr * 64 + fr, col0 = u.pn * BM + wc * 32 + 8 * fq;
#pragma unroll
        for (int ai = 0; ai < 2; ++ai)
#pragma unroll
            for (int m = 0; m < 4; ++m) { const int row = row0 + ai * HALF + m * 16;
#pragma unroll
                for (int bj = 0; bj < 2; ++bj) { const f32x4 x0 = xres4(xp, xs, row, col0 + bj * HALF), x1 = xres4(xp, xs, row, col0 + bj * HALF + 4);
                    *(u32x4*)(PRE + (size_t)row * DM + col0 + bj * HALF) = pack8(acc[ai][bj][m][0] + x0 * ALPHA, acc[ai][bj][m][1] + x1 * ALPHA); } }
    }
};
struct EpiGU {
    static constexpr bool PERM = true, AFTER_DRAIN = false;
    bf16_t* ACT;
    __device__ __forceinline__ void operator()(const f32x4 (&acc)[2][2][4][2], const Unit& u, int wr, int wc, int fr, int fq) const {
        const int row0 = u.pm * BM + wr * 64 + fr, col0 = u.pn * HALF + wc * 32 + 8 * fq;
#pragma unroll
        for (int ai = 0; ai < 2; ++ai)
#pragma unroll
            for (int m = 0; m < 4; ++m) {
                f32x4 o[2];
#pragma unroll
                for (int n = 0; n < 2; ++n)
#pragma unroll
                    for (int e = 0; e < 4; ++e) { const float g = acc[ai][0][m][n][e], up = acc[ai][1][m][n][e]; o[n][e] = g * sigmoidf_(g) * up; }
                *(u32x4*)(ACT + (size_t)(row0 + ai * HALF + m * 16) * DFF + col0) = pack8(o[0], o[1]);
            }
    }
};
struct EpiDown {
    static constexpr bool PERM = true, AFTER_DRAIN = false;
    bf16_t* PRE; const bf16_t* H;
    __device__ __forceinline__ void operator()(const f32x4 (&acc)[2][2][4][2], const Unit& u, int wr, int wc, int fr, int fq) const {
        const int row0 = u.pm * BM + wr * 64 + fr, col0 = u.pn * BM + wc * 32 + 8 * fq;
#pragma unroll
        for (int ai = 0; ai < 2; ++ai)
#pragma unroll
            for (int m = 0; m < 4; ++m) { const size_t off = (size_t)(row0 + ai * HALF + m * 16) * DM + col0;
#pragma unroll
                for (int bj = 0; bj < 2; ++bj) { const u32x4 hw = *(const u32x4*)(H + off + bj * HALF);
                    const f32x4 h0 = (f32x4){bf_lo(hw.x), bf_hi(hw.x), bf_lo(hw.y), bf_hi(hw.y)}, h1 = (f32x4){bf_lo(hw.z), bf_hi(hw.z), bf_lo(hw.w), bf_hi(hw.w)};
                    *(u32x4*)(PRE + off + bj * HALF) = pack8(acc[ai][bj][m][0] + h0 * ALPHA, acc[ai][bj][m][1] + h1 * ALPHA); } }
    }
};
struct EpiPlain {
    static constexpr bool PERM = true, AFTER_DRAIN = false;
    bf16_t* O;
    __device__ __forceinline__ void operator()(const f32x4 (&acc)[2][2][4][2], const Unit& u, int wr, int wc, int fr, int fq) const {
        const int row0 = u.pm * BM + wr * 64 + fr, col0 = u.pn * BM + wc * 32 + 8 * fq;
#pragma unroll
        for (int ai = 0; ai < 2; ++ai)
#pragma unroll
            for (int m = 0; m < 4; ++m)
#pragma unroll
                for (int bj = 0; bj < 2; ++bj) *(u32x4*)(O + (size_t)(row0 + ai * HALF + m * 16) * DM + col0 + bj * HALF) = pack8(acc[ai][bj][m][0], acc[ai][bj][m][1]);
    }
};
struct EpiPle {
    static constexpr bool PERM = true, AFTER_DRAIN = false;
    bf16_t* PRE; const bf16_t *H, *PP;
    __device__ __forceinline__ void operator()(const f32x4 (&acc)[2][2][4][2], const Unit& u, int wr, int wc, int fr, int fq) const {
        const int row0 = u.pm * BM + wr * 64 + fr, col0 = u.pn * BM + wc * 32 + 8 * fq;
#pragma unroll
        for (int ai = 0; ai < 2; ++ai)
#pragma unroll
            for (int m = 0; m < 4; ++m) { const size_t off = (size_t)(row0 + ai * HALF + m * 16) * DM + col0;
#pragma unroll
                for (int bj = 0; bj < 2; ++bj) { const u32x4 hw = *(const u32x4*)(H + off + bj * HALF), pw = *(const u32x4*)(PP + off + bj * HALF);
                    const f32x4 h0 = (f32x4){bf_lo(hw.x), bf_hi(hw.x), bf_lo(hw.y), bf_hi(hw.y)}, h1 = (f32x4){bf_lo(hw.z), bf_hi(hw.z), bf_lo(hw.w), bf_hi(hw.w)};
                    const f32x4 p0 = (f32x4){bf_lo(pw.x), bf_hi(pw.x), bf_lo(pw.y), bf_hi(pw.y)}, p1 = (f32x4){bf_lo(pw.z), bf_hi(pw.z), bf_lo(pw.w), bf_hi(pw.w)};
                    f32x4 a0 = acc[ai][bj][m][0], a1 = acc[ai][bj][m][1];
#pragma unroll
                    for (int q = 0; q < 4; ++q) { a0[q] = sigmoidf_(a0[q]); a1[q] = sigmoidf_(a1[q]); }
                    *(u32x4*)(PRE + off + bj * HALF) = pack8(h0 * ALPHA + a0 * p0, h1 * ALPHA + a1 * p1); } }
    }
};
template <class Epi, class Sched, bool ALIGN_EPI = false, bool SP2 = false>
__device__ __forceinline__ void gemm_phase(PG8_LAS unsigned char* lds, const Gemm g, const Sched& S, const Epi& E) {
    int tid_ = threadIdx.x; asm volatile("" : "+v"(tid_));
    const int tid = tid_, wid = __builtin_amdgcn_readfirstlane(tid >> 6), lane = tid & 63, wr = wid >> 2, wc = wid & 3, fr = lane & 15, fq = lane >> 4;
    int K_ = g.K; asm volatile("" : "+s"(K_));
    const int K = K_, nt = K / BK;
    unsigned voffA[2], voffB[2];
#pragma unroll
    for (int i = 0; i < 2; ++i) { int R, C; stage_rc(tid * 16 + i * 8192, R, C); const int Rb = Epi::PERM ? ((R & ~31) + perm32(R & 31)) : R;
        voffA[i] = (unsigned)(R * K + C) * 2u; voffB[i] = (unsigned)(Rb * K + C) * 2u; }
    const size_t kstep = (size_t)(BK * 2);
    const size_t hstep = (size_t)HALF * K * 2;
    const size_t tstep = 2 * hstep;
    const unsigned ldsw = (unsigned)wid * 1024u;
    const int aoff = lds_byte(wr * 64 + fr, fq * 8), boff = lds_byte(wc * 32 + fr, fq * 8);
#define PG8_SA(b, h) (((b) * 2 + (h)) * HTB)
#define PG8_SB(b, h) ((4 + (b) * 2 + (h)) * HTB)
#define PG8_STAGE(bufoff, gbase, voff) do { _Pragma("unroll") for (int _i = 0; _i < 2; ++_i) \
        __builtin_amdgcn_global_load_lds((const unsigned*)((const char*)(gbase) + (voff)[_i]), (PG8_LAS unsigned*)(lds + (bufoff) + ldsw + _i * 8192), 16, 0, 0); } while (0)
#define PG8_LDA(dst, b, h) do { _Pragma("unroll") for (int m = 0; m < 4; ++m) _Pragma("unroll") for (int k = 0; k < 2; ++k) dst[m][k] = *(const PG8_LAS bf16x8*)(lds + PG8_SA(b, h) + aoff + m * 2048 + k * 1024); } while (0)
#define PG8_LDB(dst, b, h) do { _Pragma("unroll") for (int n = 0; n < 2; ++n) _Pragma("unroll") for (int k = 0; k < 2; ++k) dst[n][k] = *(const PG8_LAS bf16x8*)(lds + PG8_SB(b, h) + boff + n * 2048 + k * 1024); } while (0)
#define PG8_MMA(ai, bj, At, Bt) do { __builtin_amdgcn_s_setprio(1); _Pragma("unroll") for (int m = 0; m < 4; ++m) _Pragma("unroll") for (int n = 0; n < 2; ++n) _Pragma("unroll") for (int k = 0; k < 2; ++k) \
        acc[ai][bj][m][n] = __builtin_amdgcn_mfma_f32_16x16x32_bf16(Bt[n][k], At[m][k], acc[ai][bj][m][n], 0, 0, 0); __builtin_amdgcn_s_setprio(0); } while (0)
#define PG8_WAIT_V(n) asm volatile("s_waitcnt vmcnt(" #n ")" ::: "memory")
#define PG8_WAIT_L(n) asm volatile("s_waitcnt lgkmcnt(" #n ")" ::: "memory")
#define PG8_BAR __builtin_amdgcn_s_barrier()
#define PG8_SCHED __builtin_amdgcn_sched_barrier(0)
    Unit cur, nxt; int ui = 0;
    if (!S.next(0, cur)) return;
    f32x4 acc[2][2][4][2];
#pragma unroll
    for (int a = 0; a < 2; ++a)
#pragma unroll
        for (int b = 0; b < 2; ++b)
#pragma unroll
            for (int m = 0; m < 4; ++m)
#pragma unroll
                for (int n = 0; n < 2; ++n) acc[a][b][m][n] = (f32x4){0.f, 0.f, 0.f, 0.f};
    bf16x8 At[4][2], B0[2][2], B1[2][2];
    const char* cA = (const char*)g.A + (size_t)cur.pm * tstep; const char* cB = (const char*)g.Bt + (size_t)cur.pn * tstep;
    S.a_ready(cur);
    if constexpr (SP2) {
        PG8_STAGE(PG8_SB(0, 0), cB, voffB); PG8_STAGE(PG8_SB(0, 1), cB + hstep, voffB); PG8_STAGE(PG8_SA(0, 0), cA, voffA); PG8_STAGE(PG8_SA(0, 1), cA + hstep, voffA);
        if (wr == 1) PG8_BAR;
        PG8_WAIT_V(2); PG8_BAR;
        PG8_STAGE(PG8_SB(1, 0), cB + kstep, voffB); PG8_STAGE(PG8_SA(1, 0), cA + kstep, voffA); PG8_STAGE(PG8_SB(1, 1), cB + hstep + kstep, voffB);
        PG8_WAIT_V(6); PG8_BAR;
    } else {
        PG8_STAGE(PG8_SB(0, 0), cB, voffB); PG8_STAGE(PG8_SA(0, 0), cA, voffA); PG8_STAGE(PG8_SB(0, 1), cB + hstep, voffB); PG8_STAGE(PG8_SA(0, 1), cA + hstep, voffA);
        if (wr == 1) PG8_BAR;
        PG8_WAIT_V(4); PG8_BAR;
        PG8_STAGE(PG8_SB(1, 0), cB + kstep, voffB); PG8_STAGE(PG8_SA(1, 0), cA + kstep, voffA); PG8_STAGE(PG8_SB(1, 1), cB + hstep + kstep, voffB);
        PG8_WAIT_V(6); PG8_BAR;
    }
    for (;;) {
        const bool has_next = S.next(ui + 1, nxt);
        const char* nA = has_next ? (const char*)g.A + (size_t)nxt.pm * tstep : cA; const char* nB = has_next ? (const char*)g.Bt + (size_t)nxt.pn * tstep : cB;
        for (int t = 0; t < nt; t += 2) {
            const bool last = (t == nt - 2);
            const char* a1 = cA + (size_t)(t + 1) * kstep;
            const char* a2 = last ? nA : cA + (size_t)(t + 2) * kstep; const char* b2 = last ? nB : cB + (size_t)(t + 2) * kstep;
            const char* a3 = a2 + kstep; const char* b3 = b2 + kstep;
            if (last && has_next) S.a_ready(nxt);
            if constexpr (SP2) {
            PG8_LDB(B0, 0, 0); PG8_LDB(B1, 0, 1); PG8_SCHED; PG8_LDA(At, 0, 0); PG8_STAGE(PG8_SA(1, 1), a1 + hstep, voffA);
            PG8_WAIT_V(8); PG8_WAIT_L(0); PG8_BAR; PG8_MMA(0, 0, At, B0); PG8_MMA(0, 1, At, B1); PG8_BAR; PG8_SCHED;
            PG8_LDA(At, 0, 1); PG8_STAGE(PG8_SB(0, 0), b2, voffB); PG8_STAGE(PG8_SB(0, 1), b2 + hstep, voffB); PG8_STAGE(PG8_SA(0, 0), a2, voffA);
            PG8_WAIT_V(8); PG8_WAIT_L(0); PG8_BAR; PG8_MMA(1, 0, At, B0); PG8_MMA(1, 1, At, B1); PG8_BAR; PG8_SCHED;
            PG8_LDB(B0, 1, 0); PG8_LDB(B1, 1, 1); PG8_SCHED; PG8_LDA(At, 1, 0); PG8_STAGE(PG8_SA(0, 1), a2 + hstep, voffA);
            PG8_WAIT_V(8); PG8_WAIT_L(0); PG8_BAR; PG8_MMA(0, 0, At, B0); PG8_MMA(0, 1, At, B1); PG8_BAR; PG8_SCHED;
            PG8_LDA(At, 1, 1); PG8_STAGE(PG8_SB(1, 0), b3, voffB); PG8_STAGE(PG8_SB(1, 1), b3 + hstep, voffB); PG8_STAGE(PG8_SA(1, 0), a3, voffA);
            PG8_WAIT_V(8); PG8_WAIT_L(0); PG8_BAR; PG8_MMA(1, 0, At, B0); PG8_MMA(1, 1, At, B1); PG8_BAR; PG8_SCHED;
            } else {
            PG8_LDB(B0, 0, 0); PG8_SCHED; PG8_LDA(At, 0, 0); PG8_STAGE(PG8_SA(1, 1), a1 + hstep, voffA);
            PG8_WAIT_L(8); PG8_BAR; PG8_WAIT_L(0); PG8_MMA(0, 0, At, B0); PG8_BAR; PG8_SCHED;
            PG8_LDB(B1, 0, 1); PG8_STAGE(PG8_SB(0, 0), b2, voffB);
            PG8_BAR; PG8_WAIT_L(0); PG8_MMA(0, 1, At, B1); PG8_BAR;
            PG8_LDA(At, 0, 1); PG8_STAGE(PG8_SA(0, 0), a2, voffA);
            PG8_BAR; PG8_WAIT_L(0); PG8_MMA(1, 0, At, B0); PG8_BAR; PG8_SCHED;
            PG8_STAGE(PG8_SB(0, 1), b2 + hstep, voffB);
            PG8_WAIT_V(6); PG8_BAR; PG8_MMA(1, 1, At, B1); PG8_BAR;
            PG8_LDB(B0, 1, 0); PG8_SCHED; PG8_LDA(At, 1, 0); PG8_STAGE(PG8_SA(0, 1), a2 + hstep, voffA);
            PG8_WAIT_L(8); PG8_BAR; PG8_WAIT_L(0); PG8_MMA(0, 0, At, B0); PG8_BAR; PG8_SCHED;
            PG8_LDB(B1, 1, 1); PG8_STAGE(PG8_SB(1, 0), b3, voffB);
            PG8_BAR; PG8_WAIT_L(0); PG8_MMA(0, 1, At, B1); PG8_BAR;
            PG8_LDA(At, 1, 1); PG8_STAGE(PG8_SA(1, 0), a3, voffA);
            PG8_BAR; PG8_WAIT_L(0); PG8_MMA(1, 0, At, B0); PG8_BAR; PG8_SCHED;
            PG8_STAGE(PG8_SB(1, 1), b3 + hstep, voffB);
            PG8_WAIT_V(6); PG8_BAR; PG8_MMA(1, 1, At, B1); PG8_BAR;
            }
        }
        if constexpr (ALIGN_EPI) { if (wr == 0) PG8_BAR; }
        if constexpr (!Epi::AFTER_DRAIN) { E(acc, cur, wr, wc, fr, fq); S.done(cur); }
        if (!has_next) break;
#pragma unroll
        for (int a = 0; a < 2; ++a)
#pragma unroll
            for (int b = 0; b < 2; ++b)
#pragma unroll
                for (int m = 0; m < 4; ++m)
#pragma unroll
                    for (int n = 0; n < 2; ++n) acc[a][b][m][n] = (f32x4){0.f, 0.f, 0.f, 0.f};
        cur = nxt; cA = nA; cB = nB; ++ui;
        if constexpr (ALIGN_EPI) { if (wr == 1) PG8_BAR; }
    }
    PG8_WAIT_V(0);
    if constexpr (!ALIGN_EPI) { if (wr == 0) PG8_BAR; }
    PG8_BAR;
    if constexpr (Epi::AFTER_DRAIN) { E.fused(acc, cur, wr, wc, fr, fq, lds, wid, lane); S.done(cur); }
#undef PG8_SA
#undef PG8_SB
#undef PG8_STAGE
#undef PG8_LDA
#undef PG8_LDB
#undef PG8_MMA
#undef PG8_WAIT_V
#undef PG8_WAIT_L
#undef PG8_BAR
#undef PG8_SCHED
}
}
#define GAS __attribute__((address_space(1)))
#define LAS __attribute__((address_space(3)))
typedef unsigned short bf16;
typedef unsigned v4u __attribute__((ext_vector_type(4)));
typedef float f32x4 __attribute__((ext_vector_type(4)));
typedef short bf16x8 __attribute__((ext_vector_type(8)));
typedef GAS unsigned gu32;
typedef GAS unsigned long long gu64;
#define RLX_AGENT __ATOMIC_RELAXED, __HIP_MEMORY_SCOPE_AGENT
#define LDS_WAIT() asm volatile("s_waitcnt lgkmcnt(0)" ::: "memory")
#define VM_WAIT() asm volatile("s_waitcnt vmcnt(0)" ::: "memory")
__device__ __forceinline__ unsigned long long rt() { return __builtin_amdgcn_s_memrealtime(); }
__device__ __forceinline__ unsigned f2bf(float f) { unsigned u = __builtin_bit_cast(unsigned, f); return (u + 0x7fffu + ((u >> 16) & 1u)) >> 16; }
__device__ __forceinline__ unsigned pk2(float lo, float hi) { return f2bf(lo) | (f2bf(hi) << 16); }

#define XB_TMO      128
#define XB_XCNT(j)  (256  + 64 * (j))
#define XB_XSUB(j)  (1280 + 64 * (j))
#define XB_XGEN(j)  (2304 + 64 * (j))
#define XB_TOP      3328
#define XB_TOPGEN   3392
#define XCD_BAR_WORDS 3456
#define XB_SPIN_CAP (1u << 18)

__device__ __forceinline__ unsigned xb_ld(unsigned* p)              { return __hip_atomic_load(p, __ATOMIC_RELAXED, __HIP_MEMORY_SCOPE_AGENT); }
__device__ __forceinline__ unsigned xb_add(unsigned* p, unsigned v) { return __hip_atomic_fetch_add(p, v, __ATOMIC_RELAXED, __HIP_MEMORY_SCOPE_AGENT); }
__device__ __forceinline__ unsigned xb_xcc_id() { return (unsigned)__builtin_amdgcn_s_getreg((3 << 11) | 20) & 0xFu; }
#define XB_SPIN(cond, bar) do { unsigned _sp = 0; while (cond) { __builtin_amdgcn_s_sleep(1); \
    if ((++_sp & 255u) == 0u) { if (xb_ld(&(bar)[XB_TMO])) break; if (_sp > XB_SPIN_CAP) { atomicAdd(&(bar)[XB_TMO], 1u); break; } } } } while (0)

struct XcdBarrier {
    unsigned* bar; unsigned x;
    volatile LAS unsigned* st;
};

__device__ __forceinline__ XcdBarrier xcd_barrier_post(unsigned* bar, volatile LAS unsigned* st) {
    XcdBarrier b; b.bar = bar; b.x = xb_xcc_id(); b.st = st;
    if (threadIdx.x == 0) (void)xb_add(&bar[XB_XCNT(b.x)], 1u);
    return b;
}
__device__ __forceinline__ void xcd_barrier_complete(unsigned* bar, unsigned x, unsigned& nloc, unsigned& nx) {
    const unsigned G = gridDim.x * gridDim.y * gridDim.z;
    unsigned sum, cnt, mine, sp = 0u;
    for (;;) {
        sum = 0u; cnt = 0u; mine = 0u;
#pragma unroll
        for (unsigned j = 0; j < 16; ++j) { const unsigned c = xb_ld(&bar[XB_XCNT(j)]); sum += c; cnt += (c > 0u) ? 1u : 0u; mine = (j == x) ? c : mine; }
        if (sum == G) break;
        __builtin_amdgcn_s_sleep(1);
        if ((++sp & 255u) == 0u) { if (xb_ld(&bar[XB_TMO])) break; if (sp > XB_SPIN_CAP) { atomicAdd(&bar[XB_TMO], 1u); break; } }
    }
    nloc = mine > 0u ? mine : 1u; nx = cnt > 0u ? cnt : 1u;
}

__device__ __forceinline__ void xcd_barrier(const XcdBarrier& b) {
    asm volatile("s_waitcnt vmcnt(0)" ::: "memory");
    __syncthreads();
    if (threadIdx.x == 0) {
        unsigned* bar = b.bar;
        __builtin_amdgcn_s_waitcnt(0);
        unsigned nloc = b.st[0], nx = b.st[1];
        if (nloc == 0u) { xcd_barrier_complete(bar, b.x, nloc, nx); b.st[0] = nloc; b.st[1] = nx; }
        const unsigned old = xb_add(&bar[XB_XSUB(b.x)], 1u);
        const unsigned gen = old / nloc;
        if (old + 1u == (gen + 1u) * nloc) {
            __builtin_amdgcn_fence(__ATOMIC_RELEASE, "agent");
            asm volatile("s_waitcnt vmcnt(0)" ::: "memory");
            const unsigned og = xb_add(&bar[XB_TOP], 1u);
            const unsigned tg = og / nx;
            if (og + 1u == (tg + 1u) * nx) xb_add(&bar[XB_TOPGEN], 1u);
            else XB_SPIN(xb_ld(&bar[XB_TOPGEN]) == tg, bar);
            __builtin_amdgcn_fence(__ATOMIC_ACQUIRE, "agent");
            xb_add(&bar[XB_XGEN(b.x)], 1u);
            asm volatile("s_waitcnt vmcnt(0)" ::: "memory");
        } else {
            XB_SPIN(xb_ld(&bar[XB_XGEN(b.x)]) == gen, bar);
            __builtin_amdgcn_fence(__ATOMIC_ACQUIRE, "agent");
            asm volatile("s_waitcnt vmcnt(0)" ::: "memory");
        }
    }
    __syncthreads();
}
constexpr size_t MiB = 1u << 20;
constexpr size_t WS_CTL = 0, CTL_ZERO_BYTES = 1 * MiB;
constexpr size_t WS_WIN = 2 * MiB, WS_WOUT = 9 * MiB, WS_WGU = 11 * MiB, WS_WD = 22 * MiB, WS_WPG = 28 * MiB, WS_WPP = 30 * MiB, WS_WL = 30 * MiB + 512 * 1024;
constexpr size_t SZ1024B = (size_t)MT * 1024 * 2, SZ512B = (size_t)MT * 512 * 2, SZ256B = (size_t)MT * 256 * 2;
constexpr size_t WS_R1 = 32 * MiB;
constexpr size_t WS_PB = 97 * MiB;
constexpr size_t WS_QB = 114 * MiB, WS_KB = WS_QB + SZ512B, WS_VB = WS_KB + SZ512B;
constexpr size_t WS_PRE = 114 * MiB;
constexpr size_t WS_ZB = 211 * MiB;
constexpr size_t WS_OG = 324 * MiB, WS_LSE = 420 * MiB;
constexpr size_t WS_BV = 324 * MiB, WS_PHI = 357 * MiB, WS_SLOC = 389 * MiB, WS_SC = 421 * MiB;
constexpr size_t WS_AP = 453 * MiB;
constexpr size_t WS_ACT = 243 * MiB;
constexpr size_t WS_H2 = 243 * MiB, WS_PP = 421 * MiB;
constexpr size_t WS_END = 486 * MiB;
static_assert(WS_VB + SZ512B <= WS_ZB && WS_ZB + (size_t)MT * DBIN * 2 <= WS_OG && WS_PRE + (size_t)MT * DM * 4 <= WS_ACT && WS_ACT + (size_t)MT * DFF * 2 <= WS_SC + 32 * MiB, "ws map");
static_assert(WS_R1 + SZ1024B <= WS_PB && WS_PB + SZ256B <= WS_QB && WS_AP + SZ256B <= WS_END && WS_ACT + (size_t)MT * DFF * 2 <= WS_PP && WS_PP + SZ1024B <= 512 * MiB, "ws map 2");
constexpr int NCHUNK = 32, CHL = TSEQ / NCHUNK;
constexpr int CW_BAR = 4096;

constexpr int RING_OFF = 0, RING_BYTES = 131072;
constexpr int LDSCTL_OFF = RING_BYTES, MISC_OFF = LDSCTL_OFF + 320;
constexpr int LDS_BYTES = 147456;
constexpr int NWAVES = 8;
typedef float f32x16 __attribute__((ext_vector_type(16)));
typedef unsigned u32x2 __attribute__((ext_vector_type(2)));
typedef short s16x4 __attribute__((ext_vector_type(4)));
typedef float f32x2_t __attribute__((ext_vector_type(2)));
typedef __bf16 bf16x2_t __attribute__((ext_vector_type(2)));
__device__ __forceinline__ unsigned cvtpk(float lo, float hi) { f32x2_t v = {lo, hi}; bf16x2_t b = __builtin_convertvector(v, bf16x2_t); return __builtin_bit_cast(unsigned, b); }
__device__ __forceinline__ float bflo(unsigned w) { return __uint_as_float(w << 16); }
__device__ __forceinline__ float bfhi(unsigned w) { return __uint_as_float(w & 0xffff0000u); }
__device__ __forceinline__ float bf1(bf16 h) { return __uint_as_float((unsigned)h << 16); }
__device__ __forceinline__ float sigm(float x) { return __builtin_amdgcn_rcpf(1.0f + __builtin_amdgcn_exp2f(-x * LOG2E)); }
__device__ __forceinline__ float shx(float v, int o, int lane) { return __int_as_float(__builtin_amdgcn_ds_bpermute((lane ^ o) << 2, __float_as_int(v))); }
__device__ __forceinline__ float wave_sum(float v, int lane) {
#pragma unroll
    for (int o = 1; o < 64; o <<= 1) v += shx(v, o, lane);
    return v;
}
#define dpp_f(v, ctrl, row_mask) __int_as_float(__builtin_amdgcn_update_dpp(0, __float_as_int(v), (ctrl), (row_mask), 0xF, false))
__device__ __forceinline__ float wave_sum_dpp(float v) {
    v += dpp_f(v, 0xB1, 0xF);
    v += dpp_f(v, 0x4E, 0xF);
    v += dpp_f(v, 0x141, 0xF);
    v += dpp_f(v, 0x140, 0xF);
    v += dpp_f(v, 0x142, 0xA);
    v += dpp_f(v, 0x143, 0xC);
    return __int_as_float(__builtin_amdgcn_readlane(__float_as_int(v), 63));
}

__device__ __forceinline__ void fmac_s(float& c, float a, float b) { asm("v_fmac_f32_e32 %0, %1, %2" : "+v"(c) : "v"(a), "v"(b)); }
__device__ __forceinline__ void mulip_s(float& c, float a) { asm("v_mul_f32_e32 %0, %0, %1" : "+v"(c) : "v"(a)); }
__device__ __forceinline__ float mul_s(float a, float b) { float r; asm("v_mul_f32_e32 %0, %1, %2" : "=v"(r) : "v"(a), "v"(b)); return r; }
struct Ctx { LAS unsigned char* lds; int tid, lane, wave, vcu, G; };

__device__ __forceinline__ void p0_transpose_item(const float* W, int N, bf16* WT, int ldk, int drow, int dk, LAS float* scr, int k0, int n0, int lane) {
#pragma unroll 8
    for (int i = 0; i < 32; ++i) { const int kk = 2 * i + (lane >> 5); scr[kk * 33 + (lane & 31)] = W[(size_t)(k0 + kk) * N + n0 + (lane & 31)]; }
    LDS_WAIT(); asm volatile("" ::: "memory");
    const int c = lane & 7;
#pragma unroll
    for (int j = 0; j < 4; ++j) { const int n = (lane >> 3) + 8 * j; const LAS float* s = scr + (8 * c) * 33 + n;
        v4u o; o.x = pk2(s[0 * 33], s[1 * 33]); o.y = pk2(s[2 * 33], s[3 * 33]); o.z = pk2(s[4 * 33], s[5 * 33]); o.w = pk2(s[6 * 33], s[7 * 33]);
        *(GAS v4u*)(WT + (size_t)(drow + n) * ldk + dk + 8 * c) = o; }
    LDS_WAIT(); asm volatile("" ::: "memory");
}
struct P0Args { const float *xp, *xs, *pp, *ps, *ck, *cv, *w_in, *w_out, *w_gate, *w_up, *w_down, *w_pg, *w_pp, *w2, *a2, *g2; bf16 *Win, *Wout, *Wgu, *Wd, *Wpg, *Wpp, *Wl, *XB, *PB; float* out; };
__device__ __forceinline__ void p0_prologue(const Ctx& C, const P0Args& A) {
    LAS float* scr = (LAS float*)(C.lds + RING_OFF + C.wave * 16384);
    const int gw = C.vcu * NWAVES + C.wave, NGW = C.G * NWAVES;
    constexpr int I0 = 16 * 104, I1 = 16 * 32, I2 = 16 * 88, I3 = I2, I4 = 44 * 32, I5 = 16 * 32, I6 = 4 * 32, I7 = 16, I8 = 16, I9 = 32;
    constexpr int NITEMS = I0 + I1 + I2 + I3 + I4 + I5 + I6 + I7 + I8 + I9;
    for (int it = gw; it < NITEMS; it += NGW) {
        int r = it;
        if (r < I0) { const int kb = r / 104, nb = r % 104; p0_transpose_item(A.w_in, DIN, A.Win, 1024, nb * 32, kb * 64, scr, kb * 64, nb * 32, C.lane); continue; } r -= I0;
        if (r < I1) { const int kb = r / 32, nb = r % 32; p0_transpose_item(A.w_out, DM, A.Wout, 1024, nb * 32, kb * 64, scr, kb * 64, nb * 32, C.lane); continue; } r -= I1;
        if (r < I2) { const int kb = r / 88, nb = r % 88, n0 = nb * 32; p0_transpose_item(A.w_gate, DFF, A.Wgu, 1024, (n0 >> 7) * 256 + (n0 & 127), kb * 64, scr, kb * 64, n0, C.lane); continue; } r -= I2;
        if (r < I3) { const int kb = r / 88, nb = r % 88, n0 = nb * 32; p0_transpose_item(A.w_up, DFF, A.Wgu, 1024, (n0 >> 7) * 256 + 128 + (n0 & 127), kb * 64, scr, kb * 64, n0, C.lane); continue; } r -= I3;
        if (r < I4) { const int kb = r / 32, nb = r % 32; p0_transpose_item(A.w_down, DM, A.Wd, DFF, nb * 32, kb * 64, scr, kb * 64, nb * 32, C.lane); continue; } r -= I4;
        if (r < I5) { const int kb = r / 32, nb = r % 32; p0_transpose_item(A.w_pg, DM, A.Wpg, 1024, nb * 32, kb * 64, scr, kb * 64, nb * 32, C.lane); continue; } r -= I5;
        if (r < I6) { const int kb = r / 32, nb = r % 32; p0_transpose_item(A.w_pp, DM, A.Wpp, 256, nb * 32, kb * 64, scr, kb * 64, nb * 32, C.lane); continue; } r -= I6;
        if (r < I7) { p0_transpose_item(A.w2, CB, A.Wl, 256, r * 32, 0, scr, 0, r * 32, C.lane); continue; } r -= I7;
        if (r < I8) { p0_transpose_item(A.a2, CB, A.Wl, 256, 512 + r * 32, 64, scr, 0, r * 32, C.lane); continue; } r -= I8;
        { const int kb = r / 16, nb = r % 16; p0_transpose_item(A.g2, CB, A.Wl, 256, 1024 + nb * 32, 128 + kb * 64, scr, kb * 64, nb * 32, C.lane); }
    }
    const int gt = C.vcu * (NWAVES * 64) + C.tid, NT = C.G * NWAVES * 64;
    for (int i = gt; i < 1536 * 32; i += NT) { const int row = i >> 5, ch = i & 31, blk = row >> 9;
        const bool nz = blk == 0 ? ch < 8 : blk == 1 ? (ch >= 8 && ch < 16) : ch >= 16;
        if (!nz) *(GAS v4u*)(A.Wl + (size_t)row * 256 + ch * 8) = (v4u){0u, 0u, 0u, 0u}; }
    for (int i = gt; i < MT * 128; i += NT) { const int row = i >> 7, ch = i & 127;
        f32x4 a = {0.f, 0.f, 0.f, 0.f}, b = a;
        if (row < MPR + MSA) { const float* src = row < MPR ? A.xp + (size_t)row * DM : A.xs + (size_t)(row - MPR) * DM; a = *(const GAS f32x4*)(src + ch * 8); b = *(const GAS f32x4*)(src + ch * 8 + 4); }
        v4u o; o.x = cvtpk(a[0], a[1]); o.y = cvtpk(a[2], a[3]); o.z = cvtpk(b[0], b[1]); o.w = cvtpk(b[2], b[3]);
        *(GAS v4u*)(A.XB + (size_t)row * DM + ch * 8) = o; }
    for (int i = gt; i < MT * 32; i += NT) { const int row = i >> 5, ch = i & 31;
        f32x4 a = {0.f, 0.f, 0.f, 0.f}, b = a;
        if (row < MPR + MSA) { const float* src = row < MPR ? A.pp + (size_t)row * PLE : A.ps + (size_t)(row - MPR) * PLE; a = *(const GAS f32x4*)(src + ch * 8); b = *(const GAS f32x4*)(src + ch * 8 + 4); }
        v4u o; o.x = cvtpk(a[0], a[1]); o.y = cvtpk(a[2], a[3]); o.z = cvtpk(b[0], b[1]); o.w = cvtpk(b[2], b[3]);
        *(GAS v4u*)(A.PB + (size_t)row * PLE + ch * 8) = o; }
}

__device__ __forceinline__ void prep_a(const Ctx& C, const bf16* ZB, const float* mu, const float* state_shift, bf16* AP, float* out) {
    const int gw = C.vcu * NWAVES + C.wave, NGW = C.G * NWAVES, lane = C.lane;
    const f32x4 m4 = *(const GAS f32x4*)(mu + 1536 + lane * 4);
    for (int row = gw; row < MPR + MSA; row += NGW) {
        const u32x2 zw = *(const GAS u32x2*)(ZB + (size_t)row * DBIN + 1536 + lane * 4);
        f32x4 z = {bflo(zw.x), bfhi(zw.x), bflo(zw.y), bfhi(zw.y)}, p;
        const bool first = row < MPR ? (row & (TSEQ - 1)) == 0 : ((row - MPR) & 3) == 0;
        if (!first) { const u32x2 pw = *(const GAS u32x2*)(ZB + (size_t)(row - 1) * DBIN + 1536 + lane * 4); p = (f32x4){bflo(pw.x), bfhi(pw.x), bflo(pw.y), bfhi(pw.y)}; }
        else if (row < MPR) p = (f32x4){0.f, 0.f, 0.f, 0.f};
        else p = *(const GAS f32x4*)(state_shift + (size_t)((row - MPR) >> 2) * DBIN + 1536 + lane * 4);
        f32x4 zm = z + (p - z) * m4, o;
#pragma unroll
        for (int e = 0; e < 4; ++e) { const float x = zm[e];
            const float th = 1.0f - 2.0f * __builtin_amdgcn_rcpf(1.0f + __builtin_amdgcn_exp2f(2.0f * LOG2E * x));
            o[e] = lane < 16 ? th : lane < 32 ? x : sigm(x); }
        u32x2 w; w.x = cvtpk(o[0], o[1]); w.y = cvtpk(o[2], o[3]);
        *(GAS u32x2*)(AP + (size_t)row * 256 + lane * 4) = w;
    }
    const int gt = C.vcu * (NWAVES * 64) + C.tid, NT = C.G * NWAVES * 64;
    for (int i = gt; i < (NBATCH + SB) * DBIN; i += NT) { const int s = i / DBIN, c = i % DBIN;
        if (s < NBATCH) out[O_SHP + (size_t)s * DBIN + c] = bf1(ZB[(size_t)(s * TSEQ + TSEQ - 1) * DBIN + c]);
        else out[O_SHS + (size_t)(s - NBATCH) * DBIN + c] = bf1(ZB[(size_t)(MPR + (s - NBATCH) * SS + SS - 1) * DBIN + c]); }
}

__device__ __forceinline__ int crow(int r, int hi) { return (r & 3) + 8 * (r >> 2) + 4 * hi; }
typedef short v4i16_t __attribute__((ext_vector_type(4)));
__device__ __forceinline__ s16x4 vtr(LAS const unsigned char* p) { return __builtin_bit_cast(s16x4, __builtin_amdgcn_ds_read_tr16_b64_v4i16((LAS v4i16_t*)p)); }
constexpr int VP = 192;
constexpr int KP = 144;
constexpr int KIMG = 0, VIMG = 384 * KP;
struct AttnUnit { int b, h, g, cls, mq0, dil; };
__device__ __forceinline__ AttnUnit attn_unit_of(int u) {
    AttnUnit a; const int bh = u / 48, k48 = u % 48, k = k48 & 15; a.g = k48 >> 4; a.b = bh >> 3; a.h = bh & 7;
    if (a.g == 0) { a.cls = 0; a.mq0 = 256 * k; a.dil = 1; } else if (a.g == 1) { a.cls = k >> 2; a.mq0 = 256 * (k & 3); a.dil = 4; } else { a.cls = k; a.mq0 = 0; a.dil = 16; }
    return a;
}
struct AttnPref { v4u kr[6], vr[6]; bf16x8 qf[4]; };
__device__ __forceinline__ void attn_fetch(const Ctx& C, const AttnUnit& a, const bf16* QB, const bf16* KB, const bf16* VB, AttnPref& P) {
    const int tid = C.tid, r32 = C.lane & 31, hi = C.lane >> 5;
#pragma unroll
    for (int it = 0; it < 6; ++it) { const int rr = it * 64 + (tid >> 3), ch = tid & 7; int mk = a.mq0 - 128 + rr; mk = mk < 0 ? 0 : mk;
        const size_t go = (size_t)(a.b * TSEQ + mk * a.dil + a.cls) * CA + a.h * 64 + ch * 8;
        P.kr[it] = *(const GAS v4u*)(KB + go); P.vr[it] = *(const GAS v4u*)(VB + go); }
    const size_t qrow = (size_t)(a.b * TSEQ + (a.mq0 + 32 * C.wave + r32) * a.dil + a.cls);
#pragma unroll
    for (int s = 0; s < 4; ++s) P.qf[s] = *(const GAS bf16x8*)(QB + qrow * CA + a.h * 64 + 16 * s + 8 * hi);
}
__device__ __forceinline__ void attn_stage(const Ctx& C, const AttnPref& P) {
    const int tid = C.tid;
#pragma unroll
    for (int it = 0; it < 6; ++it) { const int rr = it * 64 + (tid >> 3), ch = tid & 7;
        *(LAS v4u*)(C.lds + KIMG + rr * KP + ch * 16) = P.kr[it]; *(LAS v4u*)(C.lds + VIMG + rr * VP + ch * 16) = P.vr[it]; }
}
__device__ __forceinline__ void attn_compute(const Ctx& C, const AttnUnit& a, const bf16x8 (&qf)[4], bf16* OG, float* LSE) {
    LAS unsigned char* lds = C.lds;
    int lane_ = C.lane; asm volatile("" : "+v"(lane_));
    const int wid = C.wave, lane = lane_, r32 = lane & 31, hi = lane >> 5;
    const int mqw = a.mq0 + 32 * wid;
    const size_t qrow = (size_t)(a.b * TSEQ + (mqw + r32) * a.dil + a.cls);
    LAS const unsigned char* kb = lds + KIMG + (32 * wid + r32) * KP + 16 * hi;
    const float slope2 = __builtin_amdgcn_exp2f(-(float)(a.h + 1)) * LOG2E * (float)a.dil;
    f32x16 o0 = {0.f, 0.f, 0.f, 0.f, 0.f, 0.f, 0.f, 0.f, 0.f, 0.f, 0.f, 0.f, 0.f, 0.f, 0.f, 0.f}, o1 = o0;
    const int i16 = lane & 15, qq = i16 >> 2, pp = i16 & 3, blk = (lane >> 4) & 1;
    LAS const unsigned char* vbase = lds + VIMG + (32 * wid + 4 * hi + qq) * VP + (16 * blk + 4 * pp) * 2;
    float mx = -1e30f, l = 0.f;
#pragma unroll
    for (int j = 0; j < 5; ++j) {
        f32x16 st = {0.f, 0.f, 0.f, 0.f, 0.f, 0.f, 0.f, 0.f, 0.f, 0.f, 0.f, 0.f, 0.f, 0.f, 0.f, 0.f};
#pragma unroll
        for (int s = 0; s < 4; ++s) { const bf16x8 kf = *(LAS const bf16x8*)(kb + 32 * j * KP + 32 * s); st = __builtin_amdgcn_mfma_f32_32x32x16_bf16(kf, qf[s], st, 0, 0, 0); }
        float tm = -INFINITY;
#pragma unroll
        for (int i = 0; i < 16; ++i) { const int kr = crow(i, hi), dist = 128 - 32 * j + r32 - kr, mke = mqw - 128 + 32 * j + kr;
            const bool ok = dist >= 0 && dist <= 128 && mke >= 0;
            const float v = ok ? st[i] - slope2 * (float)dist : -INFINITY; st[i] = v; tm = fmaxf(tm, v); }
        tm = fmaxf(tm, shx(tm, 32, lane));
        const float mn = fmaxf(mx, tm), alpha = __builtin_amdgcn_exp2f(mx - mn); mx = mn;
        float ls = 0.f;
#pragma unroll
        for (int i = 0; i < 16; ++i) { const float pe = __builtin_amdgcn_exp2f(st[i] - mn); st[i] = pe; ls += pe; }
        l = l * alpha + ls;
#pragma unroll
        for (int i = 0; i < 16; ++i) { o0[i] *= alpha; o1[i] *= alpha; }
#pragma unroll
        for (int s2 = 0; s2 < 2; ++s2) {
            v4u pw; pw.x = cvtpk(st[8 * s2 + 0], st[8 * s2 + 1]); pw.y = cvtpk(st[8 * s2 + 2], st[8 * s2 + 3]); pw.z = cvtpk(st[8 * s2 + 4], st[8 * s2 + 5]); pw.w = cvtpk(st[8 * s2 + 6], st[8 * s2 + 7]);
            const bf16x8 xs = __builtin_bit_cast(bf16x8, pw);
            LAS const unsigned char* vp = vbase + (32 * j + 16 * s2) * VP;
            { const s16x4 lo = vtr(vp), hh = vtr(vp + 8 * VP); const bf16x8 vf = (bf16x8){lo[0], lo[1], lo[2], lo[3], hh[0], hh[1], hh[2], hh[3]};
              o0 = __builtin_amdgcn_mfma_f32_32x32x16_bf16(vf, xs, o0, 0, 0, 0); }
            { const s16x4 lo = vtr(vp + 64), hh = vtr(vp + 8 * VP + 64); const bf16x8 vf = (bf16x8){lo[0], lo[1], lo[2], lo[3], hh[0], hh[1], hh[2], hh[3]};
              o1 = __builtin_amdgcn_mfma_f32_32x32x16_bf16(vf, xs, o1, 0, 0, 0); }
        }
    }
    l += shx(l, 32, lane);
    const float inv = __builtin_amdgcn_rcpf(l);
    bf16* orow = OG + (size_t)a.g * MPR * CA + qrow * CA + a.h * 64 + 4 * hi;
#pragma unroll
    for (int g4 = 0; g4 < 4; ++g4) {
        u32x2 w0, w1;
        w0.x = cvtpk(o0[4 * g4] * inv, o0[4 * g4 + 1] * inv); w0.y = cvtpk(o0[4 * g4 + 2] * inv, o0[4 * g4 + 3] * inv);
        w1.x = cvtpk(o1[4 * g4] * inv, o1[4 * g4 + 1] * inv); w1.y = cvtpk(o1[4 * g4 + 2] * inv, o1[4 * g4 + 3] * inv);
        *(GAS u32x2*)(orow + 8 * g4) = w0; *(GAS u32x2*)(orow + 32 + 8 * g4) = w1; }
    if (hi == 0) LSE[((size_t)a.g * MPR + qrow) * NH + a.h] = mx + __builtin_amdgcn_logf(l);
}
__device__ __forceinline__ void attn_prompt(const Ctx& C, const bf16* QB, const bf16* KB, const bf16* VB, bf16* OG, float* LSE) {
    AttnPref P; bf16x8 qc[4];
    AttnUnit cur = attn_unit_of(C.vcu * 12);
    attn_fetch(C, cur, QB, KB, VB, P);
    attn_stage(C, P);
#pragma unroll
    for (int s = 0; s < 4; ++s) qc[s] = P.qf[s];
    __syncthreads();
#pragma unroll 1
    for (int i = 0; i < 12; ++i) {
        AttnUnit nxt = cur;
        if (i + 1 < 12) { nxt = attn_unit_of(C.vcu * 12 + i + 1); attn_fetch(C, nxt, QB, KB, VB, P); }
        attn_compute(C, cur, qc, OG, LSE);
        __syncthreads();
        if (i + 1 < 12) { attn_stage(C, P);
#pragma unroll
            for (int s = 0; s < 4; ++s) qc[s] = P.qf[s];
            __syncthreads(); }
        cur = nxt;
    }
}
__device__ __forceinline__ void attn_sample(const Ctx& C, const bf16* QB, const float* ck, const float* cv, const float* out, bf16* HEADS) {
    if (C.vcu >= SB * NH) return;
    const int b = C.vcu >> 3, h = C.vcu & 7, s = C.wave & 3, half = C.wave >> 2, lane = C.lane;
    LAS float* qs = (LAS float*)(C.lds + C.wave * 2048);
    LAS float* ps = qs + 64;
    LAS float* part = (LAS float*)(C.lds + 16384 + C.wave * 512);
    const int row = MPR + b * SS + s, n0 = half * 194, cnt = half ? 193 : 194;
    qs[lane] = bf1(QB[(size_t)row * CA + h * 64 + lane]);
    LDS_WAIT(); asm volatile("" ::: "memory");
    const float slope2 = __builtin_amdgcn_exp2f(-(float)(h + 1)) * LOG2E;
    const float* kbase = ck + ((size_t)b * WINL * NH + h) * HD; const float* knew = out + O_KWS + ((size_t)(b * WINL + (WINL - SS)) * NH + h) * HD;
    const float* vbase = cv + ((size_t)b * WINL * NH + h) * HD; const float* vnew = out + O_VWS + ((size_t)(b * WINL + (WINL - SS)) * NH + h) * HD;
    float sc[4]; float mx = -INFINITY;
#pragma unroll
    for (int it = 0; it < 4; ++it) {
        const int nl = it * 64 + lane, n = n0 + (nl < cnt ? nl : 0), g = (n >= 129) + (n >= 258), jj = n - 129 * g, dist = jj << (2 * g), idx = WINL + s - dist;
        const float* kr = idx < WINL ? kbase + (size_t)idx * (NH * HD) : knew + (size_t)(idx - WINL) * (NH * HD);
        float d = 0.f;
#pragma unroll
        for (int c = 0; c < 16; ++c) { const f32x4 kv = *(const GAS f32x4*)(kr + 4 * c); const f32x4 qv = *(LAS const f32x4*)(qs + 4 * c); d += kv[0] * qv[0] + kv[1] * qv[1] + kv[2] * qv[2] + kv[3] * qv[3]; }
        sc[it] = nl < cnt ? d - slope2 * (float)dist : -INFINITY;
        mx = fmaxf(mx, sc[it]); }
#pragma unroll
    for (int o = 1; o < 64; o <<= 1) mx = fmaxf(mx, shx(mx, o, lane));
    float l = 0.f;
#pragma unroll
    for (int it = 0; it < 4; ++it) { const float pe = __builtin_amdgcn_exp2f(sc[it] - mx); ps[it * 64 + lane] = pe; l += pe; }
    l = wave_sum(l, lane);
    LDS_WAIT(); asm volatile("" ::: "memory");
    const int kq = lane >> 4, d4 = lane & 15;
    f32x4 o4 = {0.f, 0.f, 0.f, 0.f};
#pragma unroll 7
    for (int nb = 0; nb < 49; ++nb) {
        const int nl = nb * 4 + kq, n = n0 + (nl < cnt ? nl : 0), g = (n >= 129) + (n >= 258), jj = n - 129 * g, dist = jj << (2 * g), idx = WINL + s - dist;
        const float* vr = idx < WINL ? vbase + (size_t)idx * (NH * HD) : vnew + (size_t)(idx - WINL) * (NH * HD);
        const f32x4 vv = *(const GAS f32x4*)(vr + 4 * d4);
        const float pe = nl < cnt ? ps[nl] : 0.f;
        o4 += vv * pe; }
#pragma unroll
    for (int e = 0; e < 4; ++e) { float v = o4[e]; v += shx(v, 16, lane); v += shx(v, 32, lane); o4[e] = v; }
    if (lane < 16) *(LAS f32x4*)(part + 16 + 4 * d4) = o4;
    if (lane == 0) { part[0] = mx; part[1] = l; }
    __syncthreads();
    if (half == 0) {
        LAS const float* p0 = part, *p1 = part + 4 * 128;
        const float m0 = p0[0], m1 = p1[0], M = fmaxf(m0, m1), f0 = __builtin_amdgcn_exp2f(m0 - M), f1 = __builtin_amdgcn_exp2f(m1 - M);
        const float L = p0[1] * f0 + p1[1] * f1, o = (p0[16 + lane] * f0 + p1[16 + lane] * f1) / L;
        HEADS[(size_t)row * DM + h * 64 + lane] = (bf16)(cvtpk(o, 0.f) & 0xffffu);
    }
    __syncthreads();
}

__device__ __forceinline__ void attn_merge(const Ctx& C, const bf16* OG, const float* LSE, bf16* HEADS) {
    const int gt = C.vcu * (NWAVES * 64) + C.tid, NT = C.G * NWAVES * 64;
    for (int i = gt; i < MPR * 64; i += NT) { const int row = i >> 6, ch = i & 63, h = ch >> 3;
        float ls[3], mx = -INFINITY;
#pragma unroll
        for (int g = 0; g < 3; ++g) { ls[g] = LSE[((size_t)g * MPR + row) * NH + h]; mx = fmaxf(mx, ls[g]); }
        float w[3], ws = 0.f;
#pragma unroll
        for (int g = 0; g < 3; ++g) { w[g] = __builtin_amdgcn_exp2f(ls[g] - mx); ws += w[g]; }
        const float inv = __builtin_amdgcn_rcpf(ws);
        float acc[8] = {0.f, 0.f, 0.f, 0.f, 0.f, 0.f, 0.f, 0.f};
#pragma unroll
        for (int g = 0; g < 3; ++g) { const v4u v = *(const GAS v4u*)(OG + ((size_t)g * MPR + row) * CA + ch * 8); const float wg = w[g] * inv;
            acc[0] += wg * bflo(v.x); acc[1] += wg * bfhi(v.x); acc[2] += wg * bflo(v.y); acc[3] += wg * bfhi(v.y); acc[4] += wg * bflo(v.z); acc[5] += wg * bfhi(v.z); acc[6] += wg * bflo(v.w); acc[7] += wg * bfhi(v.w); }
        v4u o; o.x = cvtpk(acc[0], acc[1]); o.y = cvtpk(acc[2], acc[3]); o.z = cvtpk(acc[4], acc[5]); o.w = cvtpk(acc[6], acc[7]);
        *(GAS v4u*)(HEADS + (size_t)row * DM + ch * 8) = o; }
}

struct RwkvW { const float *mu, *k_k, *k_a, *r_k, *lnx_w, *lnx_b; };
struct RwkvTok { float nkk, ka, d, kp, r, v, bon; };
__device__ __forceinline__ RwkvTok rwkv_tok(float zr, float zk, float zv, float pr, float pk, float pv, float lam, float a, float mur, float muk, float muv, float kkw, float kaw, float rkw, int lane) {
    RwkvTok o;
    const float r = zr + (pr - zr) * mur, k = zk + (pk - zk) * muk, v = zv + (pv - zv) * muv;
    const float kkr = k * kkw; const float ss = wave_sum_dpp(kkr * kkr);
    const float kk = kkr * __builtin_amdgcn_rsqf(fmaxf(ss, 1e-24f));
    const float kp = k * (1.0f + (a - 1.0f) * kaw);
    o.nkk = -kk; o.ka = kk * a; o.d = __builtin_amdgcn_exp2f(-lam * LOG2E); o.kp = kp; o.r = r; o.v = v; o.bon = wave_sum_dpp(r * kp * rkw);
    return o;
}
__device__ __forceinline__ void rwkv_chunk(const Ctx& C, const bf16* ZB, const bf16* LAM, const bf16* AA, const RwkvW& W, float* YL, float* U, bf16* BV, float* PHI, float* SLOC, int b, int h, int c,
                                           const float* ck, const float* cv, float* out) {
    constexpr unsigned PERB = (WINL - SS) * CA / 4, CPY_TOTAL = SB * PERB;
    const unsigned cbase = (unsigned)(C.vcu * NWAVES + C.wave) * (CHL * 64) + C.lane;
    const int lane = C.lane;
    LAS float* tokb = (LAS float*)(C.lds + C.wave * 12288);
    const int r32 = lane & 31, hi = lane >> 5;
    f32x2_t S0[16], S1[16], P0[16], P1[16];
#pragma unroll
    for (int c = 0; c < 16; ++c) { S0[c] = (f32x2_t){0.f, 0.f}; S1[c] = S0[c];
        P0[c] = (f32x2_t){(32 * hi + 2 * c == r32) ? 1.f : 0.f, (32 * hi + 2 * c + 1 == r32) ? 1.f : 0.f};
        P1[c] = (f32x2_t){(32 * hi + 2 * c == r32 + 32) ? 1.f : 0.f, (32 * hi + 2 * c + 1 == r32 + 32) ? 1.f : 0.f}; }
    const int hc = h * 64 + lane;
    const float mur = W.mu[hc], muk = W.mu[512 + hc], muv = W.mu[1024 + hc], kkw = W.k_k[hc], kaw = W.k_a[hc], rkw = W.r_k[hc];
    const int t0 = c * CHL; const size_t row0 = (size_t)b * TSEQ + t0;
    float pr = 0.f, pk = 0.f, pv = 0.f;
    if (t0 > 0) { const bf16* zp = ZB + (row0 - 1) * DBIN + hc; pr = bf1(zp[0]); pk = bf1(zp[512]); pv = bf1(zp[1024]); }
    LAS float* dend = tokb + 8 * 320;
    f32x4 cq0 = {0.f, 0.f, 0.f, 0.f}, cq1 = cq0;
    { unsigned ci = cbase; const bool isv = ci >= CPY_TOTAL; ci -= isv ? CPY_TOTAL : 0u;
      if (ci < CPY_TOTAL) { const unsigned cb = ci / PERB, co = ci - cb * PERB; cq0 = __builtin_nontemporal_load((const f32x4*)(isv ? cv : ck) + ((size_t)cb * (WINL * CA / 4) + co + (SS * CA / 4))); }
      ci = cbase + 64u; const bool isv1 = ci >= CPY_TOTAL; ci -= isv1 ? CPY_TOTAL : 0u;
      if (ci < CPY_TOTAL) { const unsigned cb = ci / PERB, co = ci - cb * PERB; cq1 = __builtin_nontemporal_load((const f32x4*)(isv1 ? cv : ck) + ((size_t)cb * (WINL * CA / 4) + co + (SS * CA / 4))); } }
    for (int sb = 0; sb < CHL / 8; ++sb) {
        float zr[8], zk[8], zv[8], lm[8], aa[8];
#pragma unroll
        for (int tt = 0; tt < 8; ++tt) { const size_t row = row0 + sb * 8 + tt; const bf16* zp = ZB + row * DBIN + hc;
            zr[tt] = bf1(zp[0]); zk[tt] = bf1(zp[512]); zv[tt] = bf1(zp[1024]); lm[tt] = bf1(LAM[row * CB + hc]); aa[tt] = bf1(AA[row * CB + hc]); }
        float Dp = 1.0f;
#pragma unroll
        for (int tt = 0; tt < 8; ++tt) {
            const RwkvTok o = rwkv_tok(zr[tt], zk[tt], zv[tt], pr, pk, pv, lm[tt], aa[tt], mur, muk, muv, kkw, kaw, rkw, lane);
            pr = zr[tt]; pk = zk[tt]; pv = zv[tt];
            const float Dc = Dp * o.d, inv = __builtin_amdgcn_rcpf(Dc);
            LAS float* tk = tokb + tt * 320;
            tk[lane] = o.nkk * Dp; tk[64 + lane] = o.ka * inv; tk[128 + lane] = o.kp * inv; tk[192 + lane] = o.r * Dc; tk[256 + lane] = o.v;
            Dp = Dc;
            BV[(row0 + sb * 8 + tt) * CB + hc] = (bf16)(cvtpk(o.bon * o.v, 0.f) & 0xffffu);
        }
        dend[lane] = Dp;
        LDS_WAIT(); asm volatile("" ::: "memory");
#pragma unroll 1
        for (int tt = 0; tt < 8; ++tt) {
            LAS const float* tk = tokb + tt * 320 + 32 * hi;
            const f32x4 cst = cq0; cq0 = cq1;
            { const int g2 = sb * 8 + tt + 2; cq1 = (f32x4){0.f, 0.f, 0.f, 0.f};
              if (g2 < CHL) { unsigned ci = cbase + (unsigned)g2 * 64u; const bool isv = ci >= CPY_TOTAL; ci -= isv ? CPY_TOTAL : 0u;
                  if (ci < CPY_TOTAL) { const unsigned cb = ci / PERB, co = ci - cb * PERB; cq1 = __builtin_nontemporal_load((const f32x4*)(isv ? cv : ck) + ((size_t)cb * (WINL * CA / 4) + co + (SS * CA / 4))); } } }
#define LD4(off) (*(LAS const f32x4*)(tk + (off)))
            const float v0 = tokb[tt * 320 + 256 + r32], v1 = tokb[tt * 320 + 256 + 32 + r32];
#define FMA2(a, b, c) __builtin_elementwise_fma((a), (b), (c))
            f32x2_t q0 = {0.f, 0.f}, q1 = q0, q2 = q0, q3 = q0;
#pragma unroll
            for (int j4 = 0; j4 < 8; ++j4) { const f32x4 n4 = LD4(4 * j4); const f32x2_t nlo = {n4[0], n4[1]}, nhi = {n4[2], n4[3]};
                q0 = FMA2(S0[2 * j4], nlo, q0); q1 = FMA2(S1[2 * j4], nlo, q1); q2 = FMA2(P0[2 * j4], nlo, q2); q3 = FMA2(P1[2 * j4], nlo, q3);
                q0 = FMA2(S0[2 * j4 + 1], nhi, q0); q1 = FMA2(S1[2 * j4 + 1], nhi, q1); q2 = FMA2(P0[2 * j4 + 1], nhi, q2); q3 = FMA2(P1[2 * j4 + 1], nhi, q3); }
            float a0 = q0[0] + q0[1], a1 = q1[0] + q1[1], a2 = q2[0] + q2[1], a3 = q3[0] + q3[1];
            a0 += shx(a0, 32, lane); a1 += shx(a1, 32, lane); a2 += shx(a2, 32, lane); a3 += shx(a3, 32, lane);
            const f32x2_t A0 = {a0, a0}, A1 = {a1, a1}, A2 = {a2, a2}, A3 = {a3, a3}, V0 = {v0, v0}, V1 = {v1, v1};
            f32x2_t w0 = {0.f, 0.f}, w1 = w0, w2 = w0, w3 = w0;
#pragma unroll
            for (int j4 = 0; j4 < 8; ++j4) {
                const f32x4 ka = LD4(64 + 4 * j4), kp = LD4(128 + 4 * j4), r = LD4(192 + 4 * j4);
#pragma unroll
                for (int e = 0; e < 2; ++e) { const int cc = 2 * j4 + e;
                    const f32x2_t ka2 = {ka[2 * e], ka[2 * e + 1]}, kp2 = {kp[2 * e], kp[2 * e + 1]}, r2 = {r[2 * e], r[2 * e + 1]};
                    S0[cc] = FMA2(A0, ka2, FMA2(V0, kp2, S0[cc])); S1[cc] = FMA2(A1, ka2, FMA2(V1, kp2, S1[cc]));
                    P0[cc] = FMA2(A2, ka2, P0[cc]); P1[cc] = FMA2(A3, ka2, P1[cc]);
                    w0 = FMA2(S0[cc], r2, w0); w1 = FMA2(S1[cc], r2, w1); w2 = FMA2(P0[cc], r2, w2); w3 = FMA2(P1[cc], r2, w3); }
            }
#undef LD4
            float y0 = w0[0] + w0[1], y1 = w1[0] + w1[1], y2 = w2[0] + w2[1], y3 = w3[0] + w3[1];
            y0 += shx(y0, 32, lane); y1 += shx(y1, 32, lane); y2 += shx(y2, 32, lane); y3 += shx(y3, 32, lane);
            const size_t row = row0 + sb * 8 + tt;
            YL[row * CB + hc] = hi ? y1 : y0; U[row * CB + hc] = hi ? y3 : y2;
            { unsigned ci = cbase + (unsigned)(sb * 8 + tt) * 64u; const bool isv = ci >= CPY_TOTAL; ci -= isv ? CPY_TOTAL : 0u;
              if (ci < CPY_TOTAL) { const unsigned cb = ci / PERB, co = ci - cb * PERB; __builtin_nontemporal_store(cst, (f32x4*)(out + (isv ? O_VWS : O_KWS)) + ((size_t)cb * (WINL * CA / 4) + co)); } }
        }
#pragma unroll
        for (int j4 = 0; j4 < 8; ++j4) { const f32x4 d4 = *(LAS const f32x4*)(dend + 32 * hi + 4 * j4); const f32x2_t dlo = {d4[0], d4[1]}, dhi = {d4[2], d4[3]};
            S0[2 * j4] *= dlo; S1[2 * j4] *= dlo; P0[2 * j4] *= dlo; P1[2 * j4] *= dlo; S0[2 * j4 + 1] *= dhi; S1[2 * j4 + 1] *= dhi; P0[2 * j4 + 1] *= dhi; P1[2 * j4 + 1] *= dhi; }
    }
    const size_t gb = (size_t)((b * NH + h) * NCHUNK + c) * 4096;
    float* so0 = SLOC + gb + (size_t)r32 * 64 + 32 * hi; float* po0 = PHI + gb + (size_t)r32 * 64 + 32 * hi;
#pragma unroll
    for (int j4 = 0; j4 < 8; ++j4) {
        *(GAS f32x4*)(so0 + 4 * j4) = (f32x4){S0[2 * j4][0], S0[2 * j4][1], S0[2 * j4 + 1][0], S0[2 * j4 + 1][1]}; *(GAS f32x4*)(so0 + 2048 + 4 * j4) = (f32x4){S1[2 * j4][0], S1[2 * j4][1], S1[2 * j4 + 1][0], S1[2 * j4 + 1][1]};
        *(GAS f32x4*)(po0 + 4 * j4) = (f32x4){P0[2 * j4][0], P0[2 * j4][1], P0[2 * j4 + 1][0], P0[2 * j4 + 1][1]}; *(GAS f32x4*)(po0 + 2048 + 4 * j4) = (f32x4){P1[2 * j4][0], P1[2 * j4][1], P1[2 * j4 + 1][0], P1[2 * j4 + 1][1]}; }
}
__device__ __forceinline__ void rwkv_sample(const Ctx& C, const bf16* ZB, const bf16* LAM, const bf16* AA, const bf16* G, const RwkvW& W, const float* state_wkv, const float* state_shift, bf16* HEADS, float* out) {
    if (C.vcu >= SB * NH || C.wave != 0) return;
    const int b = C.vcu >> 3, h = C.vcu & 7, lane = C.lane, hc = h * 64 + lane;
    LAS float* tk = (LAS float*)(C.lds + 98304);
    LAS float* Sl = (LAS float*)(C.lds + 98304 + 2048) + lane * 65;
    const float* s0 = state_wkv + ((size_t)(b * NH + h) * 64 + lane) * 64;
#pragma unroll 4
    for (int j = 0; j < 64; ++j) Sl[j] = s0[j];
    float pr = state_shift[(size_t)b * DBIN + hc], pk = state_shift[(size_t)b * DBIN + 512 + hc], pv = state_shift[(size_t)b * DBIN + 1024 + hc];
#pragma unroll 1
    for (int s = 0; s < SS; ++s) {
        const size_t row = (size_t)MPR + b * SS + s; const bf16* zp = ZB + row * DBIN + hc;
        const float zr = bf1(zp[0]), zk = bf1(zp[512]), zv = bf1(zp[1024]);
        const RwkvTok o = rwkv_tok(zr, zk, zv, pr, pk, pv, bf1(LAM[row * CB + hc]), bf1(AA[row * CB + hc]), W.mu[hc], W.mu[512 + hc], W.mu[1024 + hc], W.k_k[hc], W.k_a[hc], W.r_k[hc], lane);
        pr = zr; pk = zk; pv = zv;
        tk[lane] = o.nkk; tk[64 + lane] = o.ka; tk[128 + lane] = o.d; tk[192 + lane] = o.kp; tk[256 + lane] = o.r;
        LDS_WAIT(); asm volatile("" ::: "memory");
        float sa = 0.f;
#pragma unroll 4
        for (int j = 0; j < 64; ++j) sa = fmaf(Sl[j], tk[j], sa);
        float y = 0.f;
#pragma unroll 4
        for (int j = 0; j < 64; ++j) { float t = o.v * tk[192 + j]; t = fmaf(sa, tk[64 + j], t); const float sn = fmaf(Sl[j], tk[128 + j], t); Sl[j] = sn; y = fmaf(sn, tk[256 + j], y); }
        const float ym = wave_sum(y, lane) * (1.0f / 64.0f), dy = y - ym, yv = wave_sum(dy * dy, lane) * (1.0f / 64.0f);
        const float yn = dy * __builtin_amdgcn_rsqf(yv + GN_EPS) * W.lnx_w[hc] + W.lnx_b[hc];
        const float res = (yn + o.bon * o.v) * bf1(G[row * CB + hc]);
        HEADS[row * DM + CA + hc] = (bf16)(cvtpk(res, 0.f) & 0xffffu);
        LDS_WAIT(); asm volatile("" ::: "memory");
    }
    float* so = out + O_WKVS + ((size_t)(b * NH + h) * 64 + lane) * 64;
#pragma unroll 4
    for (int j = 0; j < 64; ++j) so[j] = Sl[j];
}

__device__ __forceinline__ void rwkv_carry(const Ctx& C, const float* PHI, const float* SLOC, float* SC, float* out) {
    const int bh = C.vcu >> 2, rq = C.vcu & 3, tid = C.tid;
    if (bh >= NBATCH * NH) return;
    LAS float* cur = (LAS float*)(C.lds);
    LAS float* phi = (LAS float*)(C.lds + 8192);
    const int row = tid >> 5, cp = tid & 31;
    const size_t gbase = ((size_t)(bh * NCHUNK) * 64 + rq * 16 + row) * 64 + 2 * cp;
    f32x4 pre[2]; f32x2_t sl;
    { const float* p0 = PHI + (size_t)(bh * NCHUNK) * 4096; pre[0] = *(const GAS f32x4*)(p0 + tid * 4); pre[1] = *(const GAS f32x4*)(p0 + 2048 + tid * 4); sl = *(const GAS f32x2_t*)(SLOC + gbase); }
    f32x2_t cv = {0.f, 0.f};
    for (int c = 0; c < NCHUNK; ++c) {
        LAS float* ph = phi + (c & 1) * 4096;
        *(LAS f32x4*)(ph + tid * 4) = pre[0]; *(LAS f32x4*)(ph + 2048 + tid * 4) = pre[1];
        *(LAS f32x2_t*)(cur + (c & 1) * 1024 + row * 64 + 2 * cp) = cv;
        const f32x2_t slc = sl;
        if (c + 1 < NCHUNK) { const float* p1 = PHI + (size_t)(bh * NCHUNK + c + 1) * 4096; pre[0] = *(const GAS f32x4*)(p1 + tid * 4); pre[1] = *(const GAS f32x4*)(p1 + 2048 + tid * 4); sl = *(const GAS f32x2_t*)(SLOC + gbase + (size_t)(c + 1) * 4096); }
        *(GAS f32x2_t*)(SC + gbase + (size_t)c * 4096) = cv;
        __syncthreads();
        LAS const float* cr_ = cur + (c & 1) * 1024 + row * 64;
        float a0 = slc[0], a1 = slc[1];
#pragma unroll 4
        for (int k4 = 0; k4 < 16; ++k4) { const f32x4 cr = *(LAS const f32x4*)(cr_ + 4 * k4);
#pragma unroll
            for (int e = 0; e < 4; ++e) { const f32x2_t pv = *(LAS const f32x2_t*)(ph + (4 * k4 + e) * 64 + 2 * cp); a0 = fmaf(cr[e], pv[0], a0); a1 = fmaf(cr[e], pv[1], a1); } }
        cv = (f32x2_t){a0, a1};
    }
    *(GAS f32x2_t*)(out + O_WKVP + ((size_t)bh * 64 + rq * 16 + row) * 64 + 2 * cp) = cv;
    __syncthreads();
}

__device__ __forceinline__ void rwkv_finish(const Ctx& C, const float* YL, const float* U, const float* SC, const bf16* BV, const bf16* G, const RwkvW& W, bf16* HEADS) {
    constexpr int FP = 68;
    const int tid = C.tid, lane = C.lane, r32 = lane & 31, hi = lane >> 5, slot = C.wave >> 2, wq = C.wave & 3, t256 = tid & 255;
    LAS float* Ss = (LAS float*)(C.lds + slot * 52224);
    LAS float* Us = Ss + 64 * FP;
    if ((C.vcu >> 2) >= NBATCH * NH) return;
    for (int pass = 0; pass < 4; ++pass) {
        const int item = C.vcu * 8 + pass * 2 + slot, bh = item >> 5, c = item & 31, b = bh >> 3, h = bh & 7;
        const float* sc = SC + (size_t)(bh * NCHUNK + c) * 4096;
        const size_t row0 = (size_t)b * TSEQ + c * CHL;
#pragma unroll
        for (int k = 0; k < 4; ++k) { const int e = t256 * 4 + k * 1024; *(LAS f32x4*)(Ss + (e >> 6) * FP + (e & 63)) = *(const GAS f32x4*)(sc + e); }
#pragma unroll
        for (int k = 0; k < 8; ++k) { const int e = t256 * 4 + k * 1024, t = e >> 6, j = e & 63; *(LAS f32x4*)(Us + t * FP + j) = *(const GAS f32x4*)(U + (row0 + t) * CB + h * 64 + j); }
        __syncthreads();
        const size_t row = row0 + wq * 32 + r32;
        f32x16 acc[2];
#pragma unroll
        for (int tl = 0; tl < 2; ++tl)
#pragma unroll
            for (int g4 = 0; g4 < 4; ++g4) { const f32x4 v = *(const GAS f32x4*)(YL + row * CB + h * 64 + 32 * tl + 8 * g4 + 4 * hi); acc[tl][4 * g4] = v[0]; acc[tl][4 * g4 + 1] = v[1]; acc[tl][4 * g4 + 2] = v[2]; acc[tl][4 * g4 + 3] = v[3]; }
        LAS const float* ua = Us + (wq * 32 + r32) * FP + 4 * hi;
        LAS const float* sa0 = Ss + r32 * FP + 4 * hi;
#pragma unroll
        for (int q = 0; q < 8; ++q) {
            const f32x4 b4 = *(LAS const f32x4*)(ua + 8 * q), a0 = *(LAS const f32x4*)(sa0 + 8 * q), a1 = *(LAS const f32x4*)(sa0 + 32 * FP + 8 * q);
#pragma unroll
            for (int e = 0; e < 4; ++e) { acc[0] = __builtin_amdgcn_mfma_f32_32x32x2f32(a0[e], b4[e], acc[0], 0, 0, 0); acc[1] = __builtin_amdgcn_mfma_f32_32x32x2f32(a1[e], b4[e], acc[1], 0, 0, 0); }
        }
        float sm = 0.f;
#pragma unroll
        for (int tl = 0; tl < 2; ++tl)
#pragma unroll
            for (int e = 0; e < 16; ++e) sm += acc[tl][e];
        sm += shx(sm, 32, lane);
        const float ym = sm * (1.0f / 64.0f); float sv = 0.f;
#pragma unroll
        for (int tl = 0; tl < 2; ++tl)
#pragma unroll
            for (int e = 0; e < 16; ++e) { const float d = acc[tl][e] - ym; acc[tl][e] = d; sv += d * d; }
        sv += shx(sv, 32, lane);
        const float rs = __builtin_amdgcn_rsqf(sv * (1.0f / 64.0f) + GN_EPS);
#pragma unroll
        for (int tl = 0; tl < 2; ++tl)
#pragma unroll
            for (int g4 = 0; g4 < 4; ++g4) { const int ic = h * 64 + 32 * tl + 8 * g4 + 4 * hi;
                const f32x4 lw = *(const GAS f32x4*)(W.lnx_w + ic), lb = *(const GAS f32x4*)(W.lnx_b + ic);
                const u32x2 bw = *(const GAS u32x2*)(BV + row * CB + ic), gw = *(const GAS u32x2*)(G + row * CB + ic);
                const float r0 = (acc[tl][4 * g4] * rs * lw[0] + lb[0] + bflo(bw.x)) * bflo(gw.x), r1 = (acc[tl][4 * g4 + 1] * rs * lw[1] + lb[1] + bfhi(bw.x)) * bfhi(gw.x);
                const float r2 = (acc[tl][4 * g4 + 2] * rs * lw[2] + lb[2] + bflo(bw.y)) * bflo(gw.y), r3 = (acc[tl][4 * g4 + 3] * rs * lw[3] + lb[3] + bfhi(bw.y)) * bfhi(gw.y);
                u32x2 ow; ow.x = cvtpk(r0, r1); ow.y = cvtpk(r2, r3);
                *(GAS u32x2*)(HEADS + row * DM + CA + ic) = ow; }
        __syncthreads();
    }
}

template <int U> __device__ __forceinline__ f32x16 thin_acc(const bf16* ap, const bf16* bp, int klen, f32x16 acc) {
#pragma unroll 1
    for (int k = 0; k < klen; k += 16 * U) {
        bf16x8 a[U], b[U];
#pragma unroll
        for (int u = 0; u < U; ++u) { a[u] = *(const GAS bf16x8*)(ap + k + 16 * u); b[u] = *(const GAS bf16x8*)(bp + k + 16 * u); }
#pragma unroll
        for (int u = 0; u < U; ++u) acc = __builtin_amdgcn_mfma_f32_32x32x16_bf16(a[u], b[u], acc, 0, 0, 0);
    }
    return acc;
}
#define F16Z (f32x16){0.f, 0.f, 0.f, 0.f, 0.f, 0.f, 0.f, 0.f, 0.f, 0.f, 0.f, 0.f, 0.f, 0.f, 0.f, 0.f}
#define THIN_LOOP(ntiles) const int lane = C.lane, r32 = lane & 31, hi = lane >> 5; for (int t = (255 - (int)blockIdx.x) * NWAVES + C.wave; t < (ntiles); t += 256 * NWAVES)
__device__ __forceinline__ void thin_lora(const Ctx& C, const bf16* AP, const bf16* Wl, const float* w0, const float* a0, bf16* LAM) {
    THIN_LOOP(192) { const int grp = t >> 6, rb = (t >> 4) & 3, cb = t & 15, koff = grp == 0 ? 0 : grp == 1 ? 64 : 128, klen = grp == 2 ? 128 : 64;
        const f32x16 acc = thin_acc<4>(AP + (size_t)(MPR + rb * 32 + r32) * 256 + koff + 8 * hi, Wl + (size_t)(grp * 512 + cb * 32 + r32) * 256 + koff + 8 * hi, klen, F16Z);
        const int n = cb * 32 + r32; const float bias = grp == 0 ? w0[n] : grp == 1 ? a0[n] : 0.f, mul = grp == 0 ? 0.6065306597126334f : 1.0f;
        bf16* dst = LAM + (size_t)grp * ((size_t)MT * CB);
#pragma unroll
        for (int i = 0; i < 16; ++i) { float v = acc[i] + bias; if (grp < 2) v = mul * sigm(v); dst[(size_t)(MPR + rb * 32 + crow(i, hi)) * CB + n] = (bf16)(cvtpk(v, 0.f) & 0xffffu); } }
}
#define THIN_WG_LOOP(ntiles) const int lane = C.lane, r32 = lane & 31, hi = lane >> 5, wv = C.wave; for (int t = 255 - (int)blockIdx.x; t < (ntiles); t += 256)
template <int NACC> __device__ __forceinline__ void thin_reduce(const Ctx& C, const f32x16 (&acc)[NACC], float (&res)[NACC][2]) {
    LAS float* red = (LAS float*)C.lds;
#pragma unroll
    for (int a = 0; a < NACC; ++a)
#pragma unroll
        for (int i = 0; i < 16; ++i) red[((a * 8 + C.wave) * 16 + i) * 64 + C.lane] = acc[a][i];
    __syncthreads();
#pragma unroll
    for (int a = 0; a < NACC; ++a)
#pragma unroll
        for (int q = 0; q < 2; ++q) { float s = 0.f;
#pragma unroll
            for (int w = 0; w < 8; ++w) s += red[((a * 8 + w) * 16 + 2 * C.wave + q) * 64 + C.lane];
            res[a][q] = s; }
    __syncthreads();
}
__device__ __forceinline__ void thin_wout(const Ctx& C, const bf16* HEADS, const bf16* Wout, const float* xs, bf16* PRE) {
    THIN_WG_LOOP(128) { const int rb = t >> 5, cb = t & 31, n = cb * 32 + r32;
        f32x16 acc[1]; float res[1][2];
        acc[0] = thin_acc<8>(HEADS + (size_t)(MPR + rb * 32 + r32) * DM + 8 * hi + wv * 128, Wout + (size_t)n * DM + 8 * hi + wv * 128, 128, F16Z);
        thin_reduce<1>(C, acc, res);
#pragma unroll
        for (int q = 0; q < 2; ++q) { const int rs = rb * 32 + crow(2 * wv + q, hi); PRE[(size_t)(MPR + rs) * DM + n] = (bf16)(cvtpk(res[0][q] + ALPHA * xs[(size_t)rs * DM + n], 0.f) & 0xffffu); } }
}
__device__ __forceinline__ void thin_gu(const Ctx& C, const bf16* H1, const bf16* Wgu, bf16* ACT) {
    THIN_WG_LOOP(352) { const int rb = t / 88, fb = t % 88, f = fb * 32 + r32, grow = (f >> 7) * 256 + (f & 127);
        const bf16* ap = H1 + (size_t)(MPR + rb * 32 + r32) * DM + 8 * hi + wv * 128;
        f32x16 acc[2]; float res[2][2];
        acc[0] = thin_acc<8>(ap, Wgu + (size_t)grow * DM + 8 * hi + wv * 128, 128, F16Z);
        acc[1] = thin_acc<8>(ap, Wgu + (size_t)(grow + 128) * DM + 8 * hi + wv * 128, 128, F16Z);
        thin_reduce<2>(C, acc, res);
#pragma unroll
        for (int q = 0; q < 2; ++q) { const float g = res[0][q]; ACT[(size_t)(MPR + rb * 32 + crow(2 * wv + q, hi)) * DFF + f] = (bf16)(cvtpk(g * sigm(g) * res[1][q], 0.f) & 0xffffu); } }
}
__device__ __forceinline__ void thin_down(const Ctx& C, const bf16* ACT, const bf16* Wd, const bf16* H1, bf16* PRE) {
    THIN_WG_LOOP(128) { const int rb = t >> 5, cb = t & 31, n = cb * 32 + r32;
        f32x16 acc[1]; float res[1][2];
        acc[0] = thin_acc<11>(ACT + (size_t)(MPR + rb * 32 + r32) * DFF + 8 * hi + wv * 352, Wd + (size_t)n * DFF + 8 * hi + wv * 352, 352, F16Z);
        thin_reduce<1>(C, acc, res);
#pragma unroll
        for (int q = 0; q < 2; ++q) { const size_t o = (size_t)(MPR + rb * 32 + crow(2 * wv + q, hi)) * DM + n; PRE[o] = (bf16)(cvtpk(res[0][q] + ALPHA * bf1(H1[o]), 0.f) & 0xffffu); } }
}
__device__ __forceinline__ void thin_pp(const Ctx& C, const bf16* PB, const bf16* Wpp, bf16* PP) {
    THIN_WG_LOOP(128) { const int rb = t >> 5, cb = t & 31, n = cb * 32 + r32;
        f32x16 acc[1]; float res[1][2];
        acc[0] = thin_acc<2>(PB + (size_t)(MPR + rb * 32 + r32) * PLE + 8 * hi + wv * 32, Wpp + (size_t)n * PLE + 8 * hi + wv * 32, 32, F16Z);
        thin_reduce<1>(C, acc, res);
#pragma unroll
        for (int q = 0; q < 2; ++q) PP[(size_t)(MPR + rb * 32 + crow(2 * wv + q, hi)) * DM + n] = (bf16)(cvtpk(res[0][q], 0.f) & 0xffffu); }
}
__device__ __forceinline__ void thin_pg(const Ctx& C, const bf16* H2, const bf16* Wpg, const bf16* PP, bf16* PRE) {
    THIN_WG_LOOP(128) { const int rb = t >> 5, cb = t & 31, n = cb * 32 + r32;
        f32x16 acc[1]; float res[1][2];
        acc[0] = thin_acc<8>(H2 + (size_t)(MPR + rb * 32 + r32) * DM + 8 * hi + wv * 128, Wpg + (size_t)n * DM + 8 * hi + wv * 128, 128, F16Z);
        thin_reduce<1>(C, acc, res);
#pragma unroll
        for (int q = 0; q < 2; ++q) { const size_t o = (size_t)(MPR + rb * 32 + crow(2 * wv + q, hi)) * DM + n; PRE[o] = (bf16)(cvtpk(ALPHA * bf1(H2[o]) + sigm(res[0][q]) * bf1(PP[o]), 0.f) & 0xffffu); } }
}

template <int MODE> __device__ __forceinline__ void ln_pass(const Ctx& C, const bf16* PRE, const float* w, const float* bsh, bf16* Hout, float* out) {
    const int gw = C.vcu * NWAVES + C.wave, NGW = C.G * NWAVES, lane = C.lane;
    f32x4 wv[4], bv[4];
#pragma unroll
    for (int j = 0; j < 2; ++j) { wv[2 * j] = *(const GAS f32x4*)(w + 512 * j + 8 * lane); wv[2 * j + 1] = *(const GAS f32x4*)(w + 512 * j + 8 * lane + 4);
                                   bv[2 * j] = *(const GAS f32x4*)(bsh + 512 * j + 8 * lane); bv[2 * j + 1] = *(const GAS f32x4*)(bsh + 512 * j + 8 * lane + 4); }
    for (int row = gw; row < MPR + MSA; row += NGW) {
        const GAS v4u* xr = (const GAS v4u*)(PRE + (size_t)row * DM) + lane;
        f32x4 v[4]; float s = 0.f;
#pragma unroll
        for (int j = 0; j < 2; ++j) { const v4u q = xr[64 * j]; v[2 * j] = (f32x4){bflo(q.x), bfhi(q.x), bflo(q.y), bfhi(q.y)}; v[2 * j + 1] = (f32x4){bflo(q.z), bfhi(q.z), bflo(q.w), bfhi(q.w)}; }
#pragma unroll
        for (int j = 0; j < 4; ++j) s += (v[j][0] + v[j][1]) + (v[j][2] + v[j][3]);
        const float mean = wave_sum(s, lane) * (1.f / DM); float s2 = 0.f;
#pragma unroll
        for (int j = 0; j < 4; ++j) { v[j] = v[j] - mean; s2 += (v[j][0] * v[j][0] + v[j][1] * v[j][1]) + (v[j][2] * v[j][2] + v[j][3] * v[j][3]); }
        const float rstd = __builtin_amdgcn_rsqf(wave_sum(s2, lane) * (1.f / DM) + LN_EPS);
        if (MODE == 0) {
            GAS v4u* o8 = (GAS v4u*)(Hout + (size_t)row * DM) + lane;
#pragma unroll
            for (int j = 0; j < 2; ++j) { const f32x4 a = v[2 * j] * rstd * wv[2 * j] + bv[2 * j], b = v[2 * j + 1] * rstd * wv[2 * j + 1] + bv[2 * j + 1];
                v4u wq; wq.x = cvtpk(a[0], a[1]); wq.y = cvtpk(a[2], a[3]); wq.z = cvtpk(b[0], b[1]); wq.w = cvtpk(b[2], b[3]); o8[64 * j] = wq; }
        } else {
            float* dst = row < MPR ? out + O_YP + (size_t)row * DM : out + O_YS + (size_t)(row - MPR) * DM;
#pragma unroll
            for (int j = 0; j < 2; ++j) { *((GAS f32x4*)(dst + 512 * j + 8 * lane)) = v[2 * j] * rstd * wv[2 * j] + bv[2 * j]; *((GAS f32x4*)(dst + 512 * j + 8 * lane + 4)) = v[2 * j + 1] * rstd * wv[2 * j + 1] + bv[2 * j + 1]; }
        }
    }
}
struct Args { const float* in[32]; float* out; unsigned char* ws; int nphase, pad; };
#ifndef PHMASK
#define PHMASK 0xFFFFFF
#endif
#ifndef REPPH
#define REPPH -1
#endif
#ifndef REPN
#define REPN 3
#endif
#define PHON(n) if constexpr (((PHMASK) >> (n)) & 1) for (int rep_ = 0; rep_ < ((n) == (REPPH) ? (REPN) : 1); ++rep_)
#ifndef GEMM_ALIGN
#define GEMM_ALIGN true
#endif
#ifndef GEMM_SP2
#define GEMM_SP2 true
#endif
__global__ void __launch_bounds__(NWAVES * 64, 2) mega_fwd(Args args) {
    extern __shared__ __attribute__((aligned(16))) unsigned char lds_raw[];
    LAS unsigned char* const lds0 = (LAS unsigned char*)lds_raw;
    volatile LAS unsigned* MISC = (volatile LAS unsigned*)(lds0 + MISC_OFF);
    const int G0 = gridDim.x;
    for (int u = threadIdx.x; u < (LDS_BYTES - LDSCTL_OFF) / 4; u += NWAVES * 64) ((LAS unsigned*)(lds0 + LDSCTL_OFF))[u] = 0u;
    __syncthreads();
    gu32* ctl = (gu32*)(args.ws + WS_CTL);
    XcdBarrier bar = xcd_barrier_post((unsigned*)(ctl + CW_BAR), MISC + 8);
    const int nph = args.nphase;
#define GRID_BAR() xcd_barrier(bar)
    typedef const __attribute__((address_space(4))) Args* KArgs;
#define PH_BEGIN Ctx C; { int t_ = threadIdx.x; asm volatile("" : "+v"(t_)); C.lds = lds0; C.tid = t_; C.lane = t_ & 63; C.wave = __builtin_amdgcn_readfirstlane(t_ >> 6); C.G = G0; const int bx_ = blockIdx.x; C.vcu = (G0 % 8 == 0) ? (bx_ % 8) * (G0 / 8) + bx_ / 8 : bx_; } KArgs kp = (KArgs)__builtin_amdgcn_kernarg_segment_ptr(); asm volatile("" : "+s"(kp)); unsigned char* ws = kp->ws; float* out = kp->out; (void)ws; (void)out;
#define IN_(i) (kp->in[i])
#define WSB(off) ((bf16*)(ws + (off)))
#define WSF(off) ((float*)(ws + (off)))
    const int bx = (int)blockIdx.x;

    PHON(0) { PH_BEGIN P0Args A{IN_(0), IN_(1), IN_(2), IN_(3), IN_(4), IN_(5), IN_(8), IN_(20), IN_(23), IN_(24), IN_(25), IN_(28), IN_(29), IN_(11), IN_(13), IN_(14),
                       WSB(WS_WIN), WSB(WS_WOUT), WSB(WS_WGU), WSB(WS_WD), WSB(WS_WPG), WSB(WS_WPP), WSB(WS_WL), WSB(WS_R1), WSB(WS_PB), out};
      p0_prologue(C, A); }
    GRID_BAR(); if (nph <= 1) return;
    PHON(1) { PH_BEGIN pg8::Gemm g{WSB(WS_R1), WSB(WS_WIN), MT, DIN, DM}; pg8::StaticOrder S; S.init(MT, DIN, C.G, bx);
      pg8::EpiZ E{WSB(WS_QB), WSB(WS_ZB), out};
      pg8::gemm_phase<pg8::EpiZ, pg8::StaticOrder, GEMM_ALIGN, GEMM_SP2>(C.lds + RING_OFF, g, S, E); }
    GRID_BAR(); if (nph <= 2) return;
    PHON(2) { PH_BEGIN prep_a(C, WSB(WS_ZB), IN_(9), IN_(7), WSB(WS_AP), out); }
    PHON(3) { PH_BEGIN attn_prompt(C, WSB(WS_QB), WSB(WS_KB), WSB(WS_VB), WSB(WS_OG), WSF(WS_LSE)); }
    PHON(4) { PH_BEGIN attn_sample(C, WSB(WS_QB), IN_(4), IN_(5), out, WSB(WS_R1)); }
    GRID_BAR(); if (nph <= 3) return;
    PHON(5) { PH_BEGIN pg8::Gemm g{WSB(WS_AP), WSB(WS_WL), MPR, 1536, 256}; pg8::StaticOrder S; S.init(MPR, 1536, C.G, bx);
      pg8::EpiLora E{WSB(WS_QB), IN_(10), IN_(12)};
      pg8::gemm_phase<pg8::EpiLora, pg8::StaticOrder, GEMM_ALIGN, GEMM_SP2>(C.lds + RING_OFF, g, S, E);
      thin_lora(C, WSB(WS_AP), WSB(WS_WL), IN_(10), IN_(12), WSB(WS_QB)); }
    PHON(6) { PH_BEGIN attn_merge(C, WSB(WS_OG), WSF(WS_LSE), WSB(WS_R1)); }
    GRID_BAR(); if (nph <= 4) return;
    PHON(7) { PH_BEGIN const RwkvW RW{IN_(9), IN_(15), IN_(16), IN_(17), IN_(18), IN_(19)};
      rwkv_sample(C, WSB(WS_ZB), WSB(WS_QB), WSB(WS_KB), WSB(WS_VB), RW, IN_(6), IN_(7), WSB(WS_R1), out); }
    PHON(8) { PH_BEGIN const RwkvW RW{IN_(9), IN_(15), IN_(16), IN_(17), IN_(18), IN_(19)};
      const int bh = C.vcu >> 2, c = (C.vcu & 3) * 8 + C.wave;
      if (bh < NBATCH * NH) rwkv_chunk(C, WSB(WS_ZB), WSB(WS_QB), WSB(WS_KB), RW, out + O_YP, out + O_YP + (size_t)MPR * CB, WSB(WS_BV), WSF(WS_PHI), WSF(WS_SLOC), bh >> 3, bh & 7, c, IN_(4), IN_(5), out); }
    GRID_BAR(); if (nph <= 5) return;
    PHON(9) { PH_BEGIN rwkv_carry(C, WSF(WS_PHI), WSF(WS_SLOC), WSF(WS_SC), out); }
    GRID_BAR(); if (nph <= 6) return;
    PHON(10) { PH_BEGIN const RwkvW RW{IN_(9), IN_(15), IN_(16), IN_(17), IN_(18), IN_(19)};
      rwkv_finish(C, out + O_YP, out + O_YP + (size_t)MPR * CB, WSF(WS_SC), WSB(WS_BV), WSB(WS_VB), RW, WSB(WS_R1)); }
    GRID_BAR(); if (nph <= 7) return;
    PHON(11) { PH_BEGIN pg8::Gemm g{WSB(WS_R1), WSB(WS_WOUT), MPR, DM, DM}; pg8::StaticOrder S; S.init(MPR, DM, C.G, bx);
      pg8::EpiWout E{WSB(WS_PRE), IN_(0), IN_(1)};
      pg8::gemm_phase<pg8::EpiWout, pg8::StaticOrder, GEMM_ALIGN, GEMM_SP2>(C.lds + RING_OFF, g, S, E);
      thin_wout(C, WSB(WS_R1), WSB(WS_WOUT), IN_(1), WSB(WS_PRE)); }
    PHON(16) { PH_BEGIN pg8::Gemm g{WSB(WS_PB), WSB(WS_WPP), MPR, DM, PLE}; pg8::StaticOrder S; S.init(MPR, DM, C.G, bx);
      pg8::EpiPlain E{WSB(WS_PP)};
      pg8::gemm_phase<pg8::EpiPlain, pg8::StaticOrder, GEMM_ALIGN, GEMM_SP2>(C.lds + RING_OFF, g, S, E);
      thin_pp(C, WSB(WS_PB), WSB(WS_WPP), WSB(WS_PP)); }
    GRID_BAR(); if (nph <= 8) return;
    PHON(12) { PH_BEGIN ln_pass<0>(C, WSB(WS_PRE), IN_(21), IN_(22), WSB(WS_R1), out); }
    GRID_BAR(); if (nph <= 9) return;
    PHON(13) { PH_BEGIN pg8::Gemm g{WSB(WS_R1), WSB(WS_WGU), MPR, 2 * DFF, DM}; pg8::StaticOrder S; S.init(MPR, 2 * DFF, C.G, bx);
      pg8::EpiGU E{WSB(WS_ACT)};
      pg8::gemm_phase<pg8::EpiGU, pg8::StaticOrder, GEMM_ALIGN, GEMM_SP2>(C.lds + RING_OFF, g, S, E);
      thin_gu(C, WSB(WS_R1), WSB(WS_WGU), WSB(WS_ACT)); }
    GRID_BAR(); if (nph <= 10) return;
    PHON(14) { PH_BEGIN pg8::Gemm g{WSB(WS_ACT), WSB(WS_WD), MPR, DM, DFF}; pg8::StaticOrder S; S.init(MPR, DM, C.G, bx);
      pg8::EpiDown E{WSB(WS_PRE), WSB(WS_R1)};
      pg8::gemm_phase<pg8::EpiDown, pg8::StaticOrder, GEMM_ALIGN, GEMM_SP2>(C.lds + RING_OFF, g, S, E);
      thin_down(C, WSB(WS_ACT), WSB(WS_WD), WSB(WS_R1), WSB(WS_PRE)); }
    GRID_BAR(); if (nph <= 11) return;
    PHON(15) { PH_BEGIN ln_pass<0>(C, WSB(WS_PRE), IN_(26), IN_(27), WSB(WS_H2), out); }
    GRID_BAR(); if (nph <= 12) return;
    PHON(17) { PH_BEGIN pg8::Gemm g{WSB(WS_H2), WSB(WS_WPG), MPR, DM, DM}; pg8::StaticOrder S; S.init(MPR, DM, C.G, bx);
      pg8::EpiPle E{WSB(WS_PRE), WSB(WS_H2), WSB(WS_PP)};
      pg8::gemm_phase<pg8::EpiPle, pg8::StaticOrder, GEMM_ALIGN, GEMM_SP2>(C.lds + RING_OFF, g, S, E);
      thin_pg(C, WSB(WS_H2), WSB(WS_WPG), WSB(WS_PP), WSB(WS_PRE)); }
    GRID_BAR(); if (nph <= 14) return;
    PHON(18) { PH_BEGIN ln_pass<1>(C, WSB(WS_PRE), IN_(30), IN_(31), nullptr, out); }
}

#ifndef N_PHASES
#define N_PHASES 99
#endif
extern "C" void kernel_launch(void* const* d_in, const int* in_sizes, int n_in, void* d_out, int out_size, void* d_ws, size_t ws_size, hipStream_t stream) {
    static int grid = 0;
    if (grid == 0) {
        if (n_in != 32 || in_sizes[0] != MPR * DM || (size_t)out_size != O_END || ws_size < WS_END) {
            fprintf(stderr, "kernel_launch: unexpected shapes: n_in %d in0 %d out %d (want %zu) ws %zu (want >= %zu); nothing launched\n", n_in, n_in > 0 ? in_sizes[0] : -1, out_size, (size_t)O_END, ws_size, (size_t)WS_END);
            grid = -1; return; }
        int dev = 0, cus = 0, per_cu = 0;
        if (hipGetDevice(&dev) != hipSuccess || hipDeviceGetAttribute(&cus, hipDeviceAttributeMultiprocessorCount, dev) != hipSuccess) { fprintf(stderr, "kernel_launch: device query failed\n"); grid = -1; return; }
        if (hipFuncSetAttribute((const void*)mega_fwd, hipFuncAttributeMaxDynamicSharedMemorySize, LDS_BYTES) != hipSuccess) { fprintf(stderr, "kernel_launch: hipFuncSetAttribute failed\n"); grid = -1; return; }
        if (hipOccupancyMaxActiveBlocksPerMultiprocessor(&per_cu, (const void*)mega_fwd, NWAVES * 64, LDS_BYTES) != hipSuccess || per_cu < 1) { fprintf(stderr, "kernel_launch: occupancy query reports %d blocks per CU\n", per_cu); }
        (void)hipGetLastError();
        grid = cus;
        if (grid != 256) fprintf(stderr, "kernel_launch: note: %d CUs (work distribution assumes 256)\n", grid);
    }
    if (grid < 0) return;
    if (hipMemsetAsync((char*)d_ws + WS_CTL, 0, CTL_ZERO_BYTES, stream) != hipSuccess) { fprintf(stderr, "kernel_launch: memset failed\n"); return; }
    Args a{};
    for (int i = 0; i < 32; ++i) a.in[i] = (const float*)d_in[i];
    a.out = (float*)d_out; a.ws = (unsigned char*)d_ws; a.nphase = N_PHASES; a.pad = 0;
    hipLaunchKernelGGL(mega_fwd, dim3(grid), dim3(NWAVES * 64), LDS_BYTES, stream, a);
    const hipError_t le = hipPeekAtLastError();
    if (le != hipSuccess) fprintf(stderr, "kernel_launch: launch failed: %s\n", hipGetErrorName(le));
}
```
